# Optimizing an MI355X kernel written in HIP

```python
import jax
import jax.numpy as jnp
from jax import lax
import numpy as np

D_MODEL = 2048
BATCH = 2
SEQ = 4096
DEPTH = 1
DEC_BATCH = 32
DEC_SEQ = 4
PAST_LEN = 8192
PAGE_SIZE = 128

N_HEADS_A = 16
HEAD_DIM_A = 64
KV_GROUPS_A = 2
CMP_BLOCK = 32
CMP_STRIDE = 16
CMP_HIDDEN = 256
SLC_BLOCK = 64
N_SELECT = 16
WINDOW = 512
N_HEADS_B = 8
HEAD_DIM_B = 128
IDX_HEADS = 16
IDX_DIM = 64
DSA_TOPK = 256
MEM_TOKENS = 256
MEM_HEADS = 4
MEM_HEAD_DIM = 128
D_FF = 5632
CONV_WIDTH = 3
ROPE_THETA = 500000.0
ROT_FRACTION = 4
Q_BLOCK = 128
EPS = 1e-6

HPG_A = N_HEADS_A // KV_GROUPS_A
KV_A = KV_GROUPS_A * HEAD_DIM_A
CMP_PER_SLC = SLC_BLOCK // CMP_STRIDE
DSA_ROW = 2 * HEAD_DIM_B + IDX_DIM
IN_SIZES = (N_HEADS_A * HEAD_DIM_A, 6 * KV_A, 3 * N_HEADS_A, N_HEADS_B * HEAD_DIM_B, 2 * HEAD_DIM_B,
            IDX_HEADS * IDX_DIM, IDX_DIM, IDX_HEADS, 2 * D_MODEL)
IN_OFFSETS = tuple(sum(IN_SIZES[:i + 1]) for i in range(len(IN_SIZES) - 1))
D_IN = sum(IN_SIZES)

kernel_name = 'nsa_dsa_gated_hybrid_step'


def rmsnorm(x, g):
    xf = x.astype(jnp.float32)
    y = xf * lax.rsqrt(jnp.mean(xf * xf, axis=-1, keepdims=True) + EPS)
    return (y * g.astype(jnp.float32)).astype(x.dtype)


def rope_partial(x, pos):
    d = x.shape[-1]
    rot = d // ROT_FRACTION
    half = rot // 2
    inv = ROPE_THETA ** (-jnp.arange(half, dtype=jnp.float32) / half)
    ang = pos.astype(jnp.float32)[:, None] * inv[None, :]
    ang = ang.reshape((ang.shape[0],) + (1,) * (x.ndim - 3) + (half,))
    cos = jnp.cos(ang).astype(x.dtype)
    sin = jnp.sin(ang).astype(x.dtype)
    x1 = x[..., :half]
    x2 = x[..., half:rot]
    return jnp.concatenate([x1 * cos - x2 * sin, x2 * cos + x1 * sin, x[..., rot:]], axis=-1)


def masked_softmax(s, mask):
    s = jnp.where(mask, s, -jnp.inf)
    m = jnp.max(s, axis=-1, keepdims=True)
    m = jnp.where(jnp.isfinite(m), m, 0.0)
    e = jnp.exp(s - m)
    return e / jnp.maximum(jnp.sum(e, axis=-1, keepdims=True), 1e-30)


def pad_rows(a, n):
    return jnp.pad(a, [(0, 0), (0, n - a.shape[1])] + [(0, 0)] * (a.ndim - 2))


def gather_pages(pool, page_table):
    pages = pool[page_table]
    return pages.reshape((pages.shape[0], pages.shape[1] * pages.shape[2]) + pages.shape[3:])


def compress(raw, pe, w1, b1, w2):
    b, n, g, d = raw.shape
    nc = -(-n // CMP_STRIDE)
    ratio = CMP_BLOCK // CMP_STRIDE
    chunks = pad_rows(raw, (nc + ratio - 1) * CMP_STRIDE).reshape(b, nc + ratio - 1, CMP_STRIDE, g, d)
    blocks = jnp.concatenate([chunks[:, j:j + nc] for j in range(ratio)], axis=2) + pe[:, None, :]
    flat = jnp.swapaxes(blocks, 2, 3).reshape(b, nc, g, CMP_BLOCK * d)
    return jax.nn.gelu(flat @ w1 + b1) @ w2


def project(xn, w_in, pos):
    b, t, _ = xn.shape
    qa, kva, ga, qb, kvb, qi, ki, wi, gm = jnp.split(xn @ w_in, IN_OFFSETS, axis=-1)
    qa = qa.reshape(b, t, N_HEADS_A, HEAD_DIM_A)
    kva = kva.reshape(b, t, 6, KV_GROUPS_A, HEAD_DIM_A)
    kvb = kvb.reshape(b, t, 2, HEAD_DIM_B)
    gm = jax.nn.sigmoid(gm.reshape(b, t, 2, D_MODEL))
    return {
        'q_cmp': qa, 'q_rot': rope_partial(qa, pos),
        'k_cmp': kva[:, :, 0], 'v_cmp': kva[:, :, 1],
        'k_slc': rope_partial(kva[:, :, 2], pos), 'v_slc': kva[:, :, 3],
        'k_win': rope_partial(kva[:, :, 4], pos), 'v_win': kva[:, :, 5],
        'g_nsa': jax.nn.sigmoid(ga.reshape(b, t, 3, N_HEADS_A)),
        'q_b': rope_partial(qb.reshape(b, t, N_HEADS_B, HEAD_DIM_B), pos),
        'k_b': rope_partial(kvb[:, :, 0], pos), 'v_b': kvb[:, :, 1],
        'q_idx': rope_partial(qi.reshape(b, t, IDX_HEADS, IDX_DIM), pos),
        'k_idx': rope_partial(ki, pos), 'w_idx': wi,
        'g_a': gm[:, :, 0], 'g_b': gm[:, :, 1],
    }


def nsa_global(q_c, q_r, qpos, kc, vc, ks, vs):
    b, t, h, d = q_c.shape
    g = kc.shape[2]
    hpg = h // g
    nc = kc.shape[1]
    scale = d ** -0.5
    s = jnp.einsum('btghd,bngd->btghn', q_c.reshape(b, t, g, hpg, d), kc).astype(jnp.float32) * scale
    blk_last = jnp.arange(nc, dtype=jnp.int32) * CMP_STRIDE + (CMP_BLOCK - 1)
    p = masked_softmax(s, (blk_last[None, :] <= qpos[:, None])[None, :, None, None, :])
    o_cmp = jnp.einsum('btghn,bngd->btghd', p.astype(vc.dtype), vc)
    ns = ks.shape[1] // SLC_BLOCK
    imp = jnp.pad(p.sum(axis=3), ((0, 0), (0, 0), (0, 0), (0, ns * CMP_PER_SLC - nc)))
    imp = imp.reshape(b, t, g, ns, CMP_PER_SLC)
    score = imp.sum(-1) + jnp.pad(imp[..., -1], ((0, 0), (0, 0), (0, 0), (1, 0)))[..., :ns]
    blk = jnp.arange(ns, dtype=jnp.int32)[None, :]
    cur = (qpos // SLC_BLOCK)[:, None]
    visible = blk * SLC_BLOCK <= qpos[:, None]
    forced = (blk == 0) | (blk == cur) | (blk == cur - 1)
    score = jnp.where(forced[None, :, None, :], jnp.inf, jnp.where(visible[None, :, None, :], score, -jnp.inf))
    _, sel = lax.top_k(score, min(N_SELECT, ns))
    tok = (sel[..., None] * SLC_BLOCK + jnp.arange(SLC_BLOCK, dtype=jnp.int32)).reshape(b, t, g, -1)
    bi = jnp.arange(b)[:, None, None, None]
    gi = jnp.arange(g)[None, None, :, None]
    kg = ks[bi, tok, gi]
    vg = vs[bi, tok, gi]
    s2 = jnp.einsum('btghd,btgmd->btghm', q_r.reshape(b, t, g, hpg, d), kg).astype(jnp.float32) * scale
    p2 = masked_softmax(s2, (tok <= qpos[None, :, None, None])[:, :, :, None, :])
    o_slc = jnp.einsum('btghm,btgmd->btghd', p2.astype(vg.dtype), vg)
    return o_cmp.reshape(b, t, h, d), o_slc.reshape(b, t, h, d)


def window_attend(q, k, v, qpos, kpos):
    b, t, h, d = q.shape
    g = k.shape[2]
    s = jnp.einsum('btghd,bkgd->btghk', q.reshape(b, t, g, h // g, d), k).astype(jnp.float32) * d ** -0.5
    dist = qpos[:, None] - kpos[None, :]
    mask = (dist >= 0) & (dist < WINDOW) & (kpos >= 0)[None, :]
    p = masked_softmax(s, mask[None, :, None, None, :])
    return jnp.einsum('btghk,bkgd->btghd', p.astype(v.dtype), v).reshape(b, t, h, d)


def dsa_attend(q, q_idx, w_idx, qpos, k, v, k_idx, n_keep):
    b, t, h, d = q.shape
    n = k.shape[1]
    dots = jnp.einsum('bthd,bsd->bths', q_idx, k_idx).astype(jnp.float32) * IDX_DIM ** -0.5
    score = jnp.einsum('bth,bths->bts', w_idx.astype(jnp.float32) * IDX_HEADS ** -0.5, jax.nn.relu(dots))
    vis = jnp.arange(n, dtype=jnp.int32)[None, :] <= qpos[:, None]
    _, idx = lax.top_k(jnp.where(vis[None], score, -jnp.inf), n_keep)
    bi = jnp.arange(b)[:, None, None]
    kg = k[bi, idx]
    vg = v[bi, idx]
    s = jnp.einsum('bthd,btkd->bthk', q, kg).astype(jnp.float32) * d ** -0.5
    p = masked_softmax(s, (idx <= qpos[None, :, None])[:, :, None, :])
    return jnp.einsum('bthk,btkd->bthd', p.astype(vg.dtype), vg)


def nsa_combine(g, o_cmp, o_slc, o_win):
    return g[:, :, 0, :, None] * o_cmp + g[:, :, 1, :, None] * o_slc + g[:, :, 2, :, None] * o_win


def merge_branches(o_nsa, o_dsa, g_a, g_b, w_oa, w_ob, w_o):
    b, t = o_nsa.shape[:2]
    ya = o_nsa.reshape(b, t, -1) @ w_oa
    yb = o_dsa.reshape(b, t, -1) @ w_ob
    return (g_a * ya + g_b * yb) @ w_o


def mixer_prompt(xn, w_in, cmp_pe, cmp_w1, cmp_b1, cmp_w2, w_oa, w_ob, w_o):
    b, s, _ = xn.shape
    pos = jnp.arange(s, dtype=jnp.int32)
    p = project(xn, w_in, pos)
    kc = compress(p['k_cmp'], cmp_pe[0], cmp_w1[0], cmp_b1[0], cmp_w2[0])
    vc = compress(p['v_cmp'], cmp_pe[1], cmp_w1[1], cmp_b1[1], cmp_w2[1])
    n_rows = -(-s // SLC_BLOCK) * SLC_BLOCK
    ks = pad_rows(p['k_slc'], n_rows)
    vs = pad_rows(p['v_slc'], n_rows)
    nb = s // Q_BLOCK
    nback = -(-WINDOW // Q_BLOCK)

    def band(a):
        ap = jnp.pad(a, [(0, 0), (nback * Q_BLOCK, 0)] + [(0, 0)] * (a.ndim - 2))
        ap = ap.reshape((b, nb + nback, Q_BLOCK) + a.shape[2:])
        return jnp.moveaxis(jnp.concatenate([ap[:, j:j + nb] for j in range(nback + 1)], axis=2), 1, 0)

    kpos_p = jnp.arange(-nback * Q_BLOCK, s, dtype=jnp.int32).reshape(nb + nback, Q_BLOCK)
    kpos_band = jnp.concatenate([kpos_p[j:j + nb] for j in range(nback + 1)], axis=1)
    n_keep = min(DSA_TOPK, s // 4)

    def blocks(a):
        return jnp.moveaxis(a.reshape((b, nb, Q_BLOCK) + a.shape[2:]), 1, 0)

    def block_fn(xs):
        qc, qr, g, qb, qi, wi, kw, vw, qpos, kpos = xs
        o_cmp, o_slc = nsa_global(qc, qr, qpos, kc, vc, ks, vs)
        o_win = window_attend(qr, kw, vw, qpos, kpos)
        o_dsa = dsa_attend(qb, qi, wi, qpos, p['k_b'], p['v_b'], p['k_idx'], n_keep)
        return nsa_combine(g, o_cmp, o_slc, o_win), o_dsa

    xs = (blocks(p['q_cmp']), blocks(p['q_rot']), blocks(p['g_nsa']), blocks(p['q_b']), blocks(p['q_idx']),
          blocks(p['w_idx']), band(p['k_win']), band(p['v_win']), pos.reshape(nb, Q_BLOCK), kpos_band)
    o_nsa, o_dsa = lax.map(block_fn, xs)

    def unblock(a):
        return jnp.moveaxis(a, 0, 1).reshape((b, s) + a.shape[3:])

    y = merge_branches(unblock(o_nsa), unblock(o_dsa), p['g_a'], p['g_b'], w_oa, w_ob, w_o)
    nsa_rows = jnp.stack([p['k_cmp'], p['v_cmp'], p['k_slc'], p['v_slc']], axis=2)
    win_state = jnp.stack([p['k_win'], p['v_win']], axis=2)[:, -min(WINDOW, s):]
    dsa_rows = jnp.concatenate([p['k_b'], p['v_b'], p['k_idx']], axis=-1)
    return y, nsa_rows, win_state, dsa_rows


def mixer_sample(xn, cache_nsa, win_buf, cache_dsa, page_table, w_in, cmp_pe, cmp_w1, cmp_b1, cmp_w2,
                 w_oa, w_ob, w_o):
    b, t, _ = xn.shape
    pos = PAST_LEN + jnp.arange(t, dtype=jnp.int32)
    p = project(xn, w_in, pos)
    nsa_rows = jnp.stack([p['k_cmp'], p['v_cmp'], p['k_slc'], p['v_slc']], axis=2)
    full = jnp.concatenate([gather_pages(cache_nsa, page_table), nsa_rows], axis=1)
    n_keys = full.shape[1]
    kc = compress(full[:, :, 0], cmp_pe[0], cmp_w1[0], cmp_b1[0], cmp_w2[0])
    vc = compress(full[:, :, 1], cmp_pe[1], cmp_w1[1], cmp_b1[1], cmp_w2[1])
    n_rows = -(-n_keys // SLC_BLOCK) * SLC_BLOCK
    o_cmp, o_slc = nsa_global(p['q_cmp'], p['q_rot'], pos, kc, vc,
                              pad_rows(full[:, :, 2], n_rows), pad_rows(full[:, :, 3], n_rows))
    w_len = win_buf.shape[1]
    win_all = jnp.concatenate([win_buf, jnp.stack([p['k_win'], p['v_win']], axis=2)], axis=1)
    kpos = jnp.concatenate([PAST_LEN - w_len + jnp.arange(w_len, dtype=jnp.int32), pos])
    o_win = window_attend(p['q_rot'], win_all[:, :, 0], win_all[:, :, 1], pos, kpos)
    dsa_rows = jnp.concatenate([p['k_b'], p['v_b'], p['k_idx']], axis=-1)
    dfull = jnp.concatenate([gather_pages(cache_dsa, page_table), dsa_rows], axis=1)
    o_dsa = dsa_attend(p['q_b'], p['q_idx'], p['w_idx'], pos, dfull[..., :HEAD_DIM_B],
                       dfull[..., HEAD_DIM_B:2 * HEAD_DIM_B], dfull[..., 2 * HEAD_DIM_B:], min(DSA_TOPK, n_keys // 4))
    y = merge_branches(nsa_combine(p['g_nsa'], o_cmp, o_slc, o_win), o_dsa, p['g_a'], p['g_b'], w_oa, w_ob, w_o)
    return y, nsa_rows, win_all[:, -w_len:], dsa_rows


def mem_kv(mem, g, w_kv):
    b, m, _ = mem.shape
    return (rmsnorm(mem, g) @ w_kv).reshape(b, m, 2, MEM_HEADS, MEM_HEAD_DIM)


def mem_attend(hn, kv, w_q, w_o):
    b, t, _ = hn.shape
    q = (hn @ w_q).reshape(b, t, MEM_HEADS, MEM_HEAD_DIM)
    s = jnp.einsum('bthd,bmhd->bthm', q, kv[:, :, 0]).astype(jnp.float32) * MEM_HEAD_DIM ** -0.5
    p = jax.nn.softmax(s, axis=-1).astype(kv.dtype)
    o = jnp.einsum('bthm,bmhd->bthd', p, kv[:, :, 1])
    return o.reshape(b, t, -1) @ w_o


def conv_ffn(hn, prev, w_up, conv_w, conv_b, w_down):
    t = hn.shape[1]
    ext = jnp.concatenate([prev, hn @ w_up], axis=1)
    c = conv_b + sum(ext[:, j:j + t] * conv_w[j] for j in range(CONV_WIDTH))
    gate, up = jnp.split(c, 2, axis=-1)
    return (jax.nn.silu(gate) * up) @ w_down, ext[:, t:]


def setup_inputs(seed: int = 0) -> dict:
    key = jax.random.key(seed)
    ks = jax.random.split(key, 27)
    n_pages = PAST_LEN // PAGE_SIZE
    used = DEC_BATCH * n_pages
    pool = (5 * used + 3) // 4
    w_len = min(WINDOW, PAST_LEN)

    def nrm(k, shape, scale=1.0):
        return jax.random.normal(k, shape, jnp.float32) * scale

    return {
        'x_prompt': nrm(ks[0], (BATCH, SEQ, D_MODEL)),
        'x_sample': nrm(ks[1], (DEC_BATCH, DEC_SEQ, D_MODEL)),
        'mem_prompt': nrm(ks[2], (BATCH, MEM_TOKENS, D_MODEL)),
        'cache_nsa_kv': nrm(ks[3], (DEPTH, pool, PAGE_SIZE, 4, KV_GROUPS_A, HEAD_DIM_A)),
        'state_nsa_win': nrm(ks[4], (DEPTH, DEC_BATCH, w_len, 2, KV_GROUPS_A, HEAD_DIM_A)),
        'cache_dsa_kv': nrm(ks[5], (DEPTH, pool, PAGE_SIZE, DSA_ROW)),
        'cache_mem_kv': nrm(ks[6], (DEPTH, DEC_BATCH, MEM_TOKENS, 2, MEM_HEADS, MEM_HEAD_DIM)),
        'state_conv': nrm(ks[7], (DEPTH, DEC_BATCH, CONV_WIDTH - 1, 2 * D_FF)),
        'page_table': jax.random.permutation(ks[8], pool)[:used].reshape(DEC_BATCH, n_pages).astype(jnp.int32),
        'norm_g': 1.0 + nrm(ks[9], (DEPTH, 4, D_MODEL), 0.02),
        'w_in': nrm(ks[10], (DEPTH, D_MODEL, D_IN), D_MODEL ** -0.5),
        'cmp_pe': nrm(ks[11], (DEPTH, 2, CMP_BLOCK, HEAD_DIM_A), 0.1),
        'cmp_w1': nrm(ks[12], (DEPTH, 2, CMP_BLOCK * HEAD_DIM_A, CMP_HIDDEN), (CMP_BLOCK * HEAD_DIM_A) ** -0.5),
        'cmp_b1': nrm(ks[13], (DEPTH, 2, CMP_HIDDEN), 0.01),
        'cmp_w2': nrm(ks[14], (DEPTH, 2, CMP_HIDDEN, HEAD_DIM_A), CMP_HIDDEN ** -0.5),
        'w_out_a': nrm(ks[15], (DEPTH, N_HEADS_A * HEAD_DIM_A, D_MODEL), (N_HEADS_A * HEAD_DIM_A) ** -0.5),
        'w_out_b': nrm(ks[16], (DEPTH, N_HEADS_B * HEAD_DIM_B, D_MODEL), (N_HEADS_B * HEAD_DIM_B) ** -0.5),
        'w_out': nrm(ks[17], (DEPTH, D_MODEL, D_MODEL), D_MODEL ** -0.5),
        'w_mem_q': nrm(ks[18], (DEPTH, D_MODEL, MEM_HEADS * MEM_HEAD_DIM), D_MODEL ** -0.5),
        'w_mem_kv': nrm(ks[19], (DEPTH, D_MODEL, 2 * MEM_HEADS * MEM_HEAD_DIM), D_MODEL ** -0.5),
        'w_mem_out': nrm(ks[20], (DEPTH, MEM_HEADS * MEM_HEAD_DIM, D_MODEL), (MEM_HEADS * MEM_HEAD_DIM) ** -0.5),
        'w_up': nrm(ks[21], (DEPTH, D_MODEL, 2 * D_FF), D_MODEL ** -0.5),
        'conv_w': nrm(ks[22], (DEPTH, CONV_WIDTH, 2 * D_FF), CONV_WIDTH ** -0.5),
        'conv_b': nrm(ks[23], (DEPTH, 2 * D_FF), 0.01),
        'w_down': nrm(ks[24], (DEPTH, D_FF, D_MODEL), D_FF ** -0.5),
        'final_g': 1.0 + nrm(ks[25], (D_MODEL,), 0.02),
    }


def reference(x_prompt, x_sample, mem_prompt, cache_nsa_kv, state_nsa_win, cache_dsa_kv, cache_mem_kv, state_conv,
              page_table, norm_g, w_in, cmp_pe, cmp_w1, cmp_b1, cmp_w2, w_out_a, w_out_b, w_out, w_mem_q, w_mem_kv,
              w_mem_out, w_up, conv_w, conv_b, w_down, final_g):
    xp, xs = x_prompt, x_sample
    nsa_p, nsa_s, win_p, win_s, dsa_p, dsa_s, mem_p, conv_p, conv_s = [], [], [], [], [], [], [], [], []
    for l in range(DEPTH):
        yp, a, bwin, c = mixer_prompt(rmsnorm(xp, norm_g[l, 0]), w_in[l], cmp_pe[l], cmp_w1[l], cmp_b1[l], cmp_w2[l],
                                      w_out_a[l], w_out_b[l], w_out[l])
        nsa_p.append(a); win_p.append(bwin); dsa_p.append(c)
        ys, a, bwin, c = mixer_sample(rmsnorm(xs, norm_g[l, 0]), cache_nsa_kv[l], state_nsa_win[l], cache_dsa_kv[l],
                                      page_table, w_in[l], cmp_pe[l], cmp_w1[l], cmp_b1[l], cmp_w2[l],
                                      w_out_a[l], w_out_b[l], w_out[l])
        nsa_s.append(a); win_s.append(bwin); dsa_s.append(c)
        xp = xp + yp
        xs = xs + ys
        kv_p = mem_kv(mem_prompt, norm_g[l, 2], w_mem_kv[l])
        mem_p.append(kv_p)
        xp = xp + mem_attend(rmsnorm(xp, norm_g[l, 1]), kv_p, w_mem_q[l], w_mem_out[l])
        xs = xs + mem_attend(rmsnorm(xs, norm_g[l, 1]), cache_mem_kv[l], w_mem_q[l], w_mem_out[l])
        fp, cp = conv_ffn(rmsnorm(xp, norm_g[l, 3]), jnp.zeros((xp.shape[0], CONV_WIDTH - 1, 2 * D_FF), xp.dtype),
                          w_up[l], conv_w[l], conv_b[l], w_down[l])
        fs, cs = conv_ffn(rmsnorm(xs, norm_g[l, 3]), state_conv[l], w_up[l], conv_w[l], conv_b[l], w_down[l])
        conv_p.append(cp); conv_s.append(cs)
        xp = xp + fp
        xs = xs + fs
    y_prompt = rmsnorm(xp, final_g)
    y_sample = rmsnorm(xs, final_g)
    return (y_prompt, y_sample, jnp.stack(nsa_p), jnp.stack(nsa_s), jnp.stack(win_p), jnp.stack(win_s),
            jnp.stack(dsa_p), jnp.stack(dsa_s), jnp.stack(mem_p), jnp.stack(conv_p), jnp.stack(conv_s))
```

```cpp
#include <hip/hip_runtime.h>
#include <cstdio>
#include <cstdint>

#define DI __device__ __forceinline__
#define LAS __attribute__((address_space(3)))
typedef unsigned short bf16_t;
typedef short bf16x8 __attribute__((ext_vector_type(8)));
typedef float f32x4 __attribute__((ext_vector_type(4)));
typedef float f32x2 __attribute__((ext_vector_type(2)));
typedef unsigned u32x4 __attribute__((ext_vector_type(4)));
typedef unsigned u32x2 __attribute__((ext_vector_type(2)));

constexpr int DM = 2048, SEQ = 4096, TP = 8192, TS = 128, TT = 8320, MP = 8448;
constexpr int DIN = 8320, DINP = 8448, DFF = 5632, DFF2 = 11264;
constexpr int NPAGES = 64;
constexpr int C_QA = 0, C_KVA = 1024, C_GA = 1792, C_QB = 1840, C_KVB = 2864, C_QI = 3120, C_KI = 4144, C_WI = 4208, C_GM = 4224;
constexpr size_t O_YP = 0, O_YS = O_YP + (size_t)TP * DM, O_NSAP = O_YS + (size_t)TS * DM, O_NSAS = O_NSAP + (size_t)TP * 512, O_WINP = O_NSAS + (size_t)TS * 512,
                 O_WINS = O_WINP + (size_t)2 * 512 * 256, O_DSAP = O_WINS + (size_t)32 * 512 * 256, O_DSAS = O_DSAP + (size_t)TP * 320, O_MEMP = O_DSAS + (size_t)TS * 320,
                 O_CONVP = O_MEMP + (size_t)512 * 1024, O_CONVS = O_CONVP + (size_t)2 * 2 * DFF2, O_END = O_CONVS + (size_t)32 * 2 * DFF2;
static_assert(O_END == 29708288, "output size");
enum { I_XP = 0, I_XS, I_MEM, I_CNSA, I_SWIN, I_CDSA, I_CMEM, I_SCONV, I_PT, I_NG, I_WIN, I_PE, I_CW1, I_CB1, I_CW2, I_WOA, I_WOB, I_WO, I_WMQ, I_WMKV, I_WMO, I_WUP, I_CVW, I_CVB, I_WDN, I_FG, N_IN };

constexpr size_t al256(size_t x) { return (x + 255) & ~(size_t)255; }
constexpr size_t WS_CTL = 0, CTL_BYTES = 1u << 20;
constexpr size_t WS_BT_IN = CTL_BYTES;
constexpr size_t WS_BT_OA = WS_BT_IN + (size_t)DINP * DM * 2;
constexpr size_t WS_BT_OB = WS_BT_OA + (size_t)DM * 1024 * 2;
constexpr size_t WS_BT_O = WS_BT_OB + (size_t)DM * 1024 * 2;
constexpr size_t WS_BT_MQ = WS_BT_O + (size_t)DM * DM * 2;
constexpr size_t WS_BT_MKV = WS_BT_MQ + (size_t)512 * DM * 2;
constexpr size_t WS_BT_MO = WS_BT_MKV + (size_t)1024 * DM * 2;
constexpr size_t WS_BT_UP = WS_BT_MO + (size_t)DM * 512 * 2;
constexpr size_t WS_BT_DN = WS_BT_UP + (size_t)DFF2 * DM * 2;
constexpr size_t WS_BT_C1 = WS_BT_DN + (size_t)DM * DFF * 2;
constexpr size_t WS_XN = WS_BT_C1 + (size_t)2 * 256 * 2048 * 2;
constexpr size_t WS_MEMN = WS_XN + (size_t)MP * DM * 2;
constexpr size_t WS_P = WS_MEMN + (size_t)512 * DM * 2;
constexpr size_t WS_QC = WS_P + (size_t)MP * DINP * 4;
constexpr size_t WS_QR = WS_QC + (size_t)MP * 1024 * 2;
constexpr size_t WS_QB = WS_QR + (size_t)MP * 1024 * 2;
constexpr size_t WS_QI = WS_QB + (size_t)MP * 1024 * 2;
constexpr size_t WS_GN = WS_QI + (size_t)MP * 1024 * 2;
constexpr size_t WS_WI = WS_GN + (size_t)MP * 48 * 4;
constexpr size_t WS_GAB = WS_WI + (size_t)MP * 16 * 4;
constexpr size_t WS_KW = WS_GAB + (size_t)MP * 4096 * 2;
constexpr int KCP_ROWS = SEQ + 32;
constexpr size_t WS_KCRAW = WS_KW + (size_t)MP * 256 * 4;
constexpr size_t KCS_OFF = (size_t)8 * KCP_ROWS * 64;
constexpr size_t WS_BPART = al256(WS_KCRAW + (KCS_OFF + (size_t)128 * 8192 * 64 + 64 * 64) * 2);
constexpr size_t WS_BIASC = WS_BPART + 16 * 512 * 4;
constexpr int HC_ROWS = 132 * 256;
constexpr size_t WS_HC = WS_BIASC + 512 * 4;
constexpr size_t WS_KCV = WS_HC + (size_t)2 * HC_ROWS * 256 * 2;
constexpr size_t WS_OCMP = WS_KCV + (size_t)34 * 4 * 512 * 64 * 4;
constexpr size_t WS_SEL = WS_OCMP + (size_t)MP * 1024 * 4;
constexpr size_t WS_IDX = WS_SEL + (size_t)MP * 32 * 4;
constexpr size_t WS_ONSA = WS_IDX + (size_t)MP * 256 * 4;
constexpr size_t WS_ODSA = WS_ONSA + (size_t)MP * 1024 * 2;
constexpr size_t WS_TMPG = WS_ODSA + (size_t)MP * 1024 * 2;
constexpr size_t WS_MG = WS_TMPG + (size_t)MP * DM * 4;
constexpr size_t WS_X1 = WS_MG + (size_t)MP * DM * 2;
constexpr size_t WS_X2 = WS_X1 + (size_t)MP * DM * 4;
constexpr size_t WS_X3 = WS_X2 + (size_t)MP * DM * 4;
constexpr size_t WS_QMB = WS_X3 + (size_t)MP * DM * 4;
constexpr size_t WS_OM = WS_QMB + (size_t)MP * 512 * 2;
constexpr size_t WS_UB = WS_OM + (size_t)MP * 512 * 2;
constexpr size_t WS_ACT = WS_UB + (size_t)MP * DFF2 * 2;
constexpr size_t WS_END = WS_ACT + (size_t)MP * DFF * 2;
static_assert(WS_END < (size_t)2400 * 1024 * 1024, "ws map too large");
constexpr int CW_BAR = 4096;

constexpr int RING_BYTES = 131072, MISC_OFF = RING_BYTES + 320, LDS_BYTES = 147456;

#define LDS_WAIT() asm volatile("s_waitcnt lgkmcnt(0)" ::: "memory")
#define VM_WAIT() asm volatile("s_waitcnt vmcnt(0)" ::: "memory")
DI unsigned cvt_pk_bf16(float lo, float hi) { unsigned r; asm volatile("v_cvt_pk_bf16_f32 %0, %1, %2" : "=v"(r) : "v"(lo), "v"(hi)); return r; }
DI float bf2f(bf16_t b) { return __uint_as_float(((unsigned)b) << 16); }
DI bf16x8 cvt8(f32x4 a, f32x4 b) { u32x4 w; w.x = cvt_pk_bf16(a.x, a.y); w.y = cvt_pk_bf16(a.z, a.w); w.z = cvt_pk_bf16(b.x, b.y); w.w = cvt_pk_bf16(b.z, b.w); return __builtin_bit_cast(bf16x8, w); }
DI u32x2 cvt4(f32x4 a) { u32x2 w; w.x = cvt_pk_bf16(a.x, a.y); w.y = cvt_pk_bf16(a.z, a.w); return w; }
DI float wave_sum(float v) {
#pragma unroll
    for (int o = 1; o < 64; o <<= 1) v += __shfl_xor(v, o);
    return v;
}
DI f32x4 shfl_xor4(f32x4 v, int m) { f32x4 r; r.x = __shfl_xor(v.x, m); r.y = __shfl_xor(v.y, m); r.z = __shfl_xor(v.z, m); r.w = __shfl_xor(v.w, m); return r; }
DI float sigmoidf_(float x) { return 1.f / (1.f + __expf(-x)); }
#define MFMA16(a, b, c) __builtin_amdgcn_mfma_f32_16x16x32_bf16((a), (b), (c), 0, 0, 0)
namespace pg8 {
constexpr int BM = 256, BK = 64, HALF = 128, HTB = HALF * BK * 2  , STAGE_BYTES = 8 * HTB, NXCD = 8, WGM = 8;
__host__ __device__ __forceinline__ int lds_byte(int r, int c) { const int st = (r >> 4) * 2 + (c >> 5), rr = r & 15, cc = c & 31, ob = rr * 64 + cc * 2; return st * 1024 + (ob ^ (((ob >> 9) & 1) << 5)); }
__host__ __device__ __forceinline__ void stage_rc(int b, int& R, int& C) { const int st = b / 1024, sb = b % 1024, swz = sb ^ (((sb >> 9) & 1) << 5); R = (st >> 1) * 16 + swz / 64; C = (st & 1) * 32 + (swz % 64) / 2; }

struct Unit { int pm, pn, ks; };
struct Gemm { const bf16_t* A; const bf16_t* Bt; int lda, ldb, K; };

struct StaticOrder {
    int nM, nN, nwg, G, c, lda, ldb;
    __device__ void init(int nM_, int nN_, int G_, int c_, int lda_, int ldb_) { nM = nM_; nN = nN_; nwg = nM * nN; G = G_; c = c_; lda = lda_; ldb = ldb_; }
    __device__ bool next(int i, Unit& u) const {
        const long L = (long)i * G + c; if (L >= nwg) return false;
        int wgid = (int)L; { const int q = nwg / NXCD, r = nwg % NXCD, xcd = wgid % NXCD, off = wgid / NXCD; wgid = (xcd < r ? xcd * (q + 1) : r * (q + 1) + (xcd - r) * q) + off; }
        const int nig = WGM * nN, gid = wgid / nig, fm = gid * WGM, gsz = (nM - fm) < WGM ? (nM - fm) : WGM;
        u.pm = fm + ((wgid % nig) % gsz); u.pn = (wgid % nig) / gsz; u.ks = 0; return true;
    }
    __device__ __forceinline__ size_t offA(const Unit& u) const { return (size_t)u.pm * BM * lda * 2; }
    __device__ __forceinline__ size_t offB(const Unit& u) const { return (size_t)u.pn * BM * ldb * 2; }
};

template <class F> struct EpiEach {
    F f;
    __device__ __forceinline__ void operator()(const f32x4 (&acc)[2][2][4][2], const Unit& u, int wr, int wc, int fr, int fq) const {
#pragma unroll
        for (int ai = 0; ai < 2; ++ai)
#pragma unroll
            for (int m = 0; m < 4; ++m) { const int row = ai * HALF + wr * 64 + m * 16 + fr;
#pragma unroll
                for (int bj = 0; bj < 2; ++bj)
#pragma unroll
                    for (int n = 0; n < 2; ++n) f(u, row, bj * HALF + wc * 32 + n * 16 + 4 * fq, acc[ai][bj][m][n]); }
    }
};

template <class Epi, class Sched>
__device__ __forceinline__ void gemm_phase(LAS unsigned char* lds, const Gemm g, const Sched& S, const Epi& E) {
    const int tid = threadIdx.x, wid = __builtin_amdgcn_readfirstlane(tid >> 6), lane = tid & 63, wr = wid >> 2, wc = wid & 3, fr = lane & 15, fq = lane >> 4;
    const int nt = g.K / BK;
    unsigned voffA[2], voffB[2];
#pragma unroll
    for (int i = 0; i < 2; ++i) { int R, C; stage_rc(tid * 16 + i * 8192, R, C); voffA[i] = (unsigned)(R * g.lda + C) * 2u; voffB[i] = (unsigned)(R * g.ldb + C) * 2u; }
    const size_t kstep = (size_t)(BK * 2);
    const size_t hA = (size_t)HALF * g.lda * 2, hB = (size_t)HALF * g.ldb * 2;
    const unsigned ldsw = (unsigned)wid * 1024u;
    const int aoff = lds_byte(wr * 64 + fr, fq * 8), boff = lds_byte(wc * 32 + fr, fq * 8);
#define PG8_SA(b, h) (((b) * 2 + (h)) * HTB)
#define PG8_SB(b, h) ((4 + (b) * 2 + (h)) * HTB)
#define PG8_STAGE(bufoff, gbase, voff) do { _Pragma("unroll") for (int _i = 0; _i < 2; ++_i) \
        __builtin_amdgcn_global_load_lds((const unsigned*)((const char*)(gbase) + (voff)[_i]), (LAS unsigned*)(lds + (bufoff) + ldsw + _i * 8192), 16, 0, 0); } while (0)
#define PG8_LDA(dst, b, h) do { _Pragma("unroll") for (int m = 0; m < 4; ++m) _Pragma("unroll") for (int k = 0; k < 2; ++k) dst[m][k] = *(const LAS bf16x8*)(lds + PG8_SA(b, h) + aoff + m * 2048 + k * 1024); } while (0)
#define PG8_LDB(dst, b, h) do { _Pragma("unroll") for (int n = 0; n < 2; ++n) _Pragma("unroll") for (int k = 0; k < 2; ++k) dst[n][k] = *(const LAS bf16x8*)(lds + PG8_SB(b, h) + boff + n * 2048 + k * 1024); } while (0)
#define PG8_MMA(ai, bj, At, Bt) do { __builtin_amdgcn_s_setprio(1); _Pragma("unroll") for (int m = 0; m < 4; ++m) _Pragma("unroll") for (int n = 0; n < 2; ++n) _Pragma("unroll") for (int k = 0; k < 2; ++k) \
        acc[ai][bj][m][n] = __builtin_amdgcn_mfma_f32_16x16x32_bf16(Bt[n][k], At[m][k], acc[ai][bj][m][n], 0, 0, 0); __builtin_amdgcn_s_setprio(0); } while (0)
#define PG8_WAIT_V(n) asm volatile("s_waitcnt vmcnt(" #n ")" ::: "memory")
#define PG8_WAIT_L(n) asm volatile("s_waitcnt lgkmcnt(" #n ")" ::: "memory")
#define PG8_BAR __builtin_amdgcn_s_barrier()
#define PG8_SCHED __builtin_amdgcn_sched_barrier(0)
    Unit cur, nxt; int ui = 0;
    if (!S.next(0, cur)) return;
    f32x4 acc[2][2][4][2];
#pragma unroll
    for (int a = 0; a < 2; ++a)
#pragma unroll
        for (int b = 0; b < 2; ++b)
#pragma unroll
            for (int m = 0; m < 4; ++m)
#pragma unroll
                for (int n = 0; n < 2; ++n) acc[a][b][m][n] = (f32x4){0.f, 0.f, 0.f, 0.f};
    bf16x8 At[4][2], B0[2][2], B1[2][2];
    const char* cA = (const char*)g.A + S.offA(cur); const char* cB = (const char*)g.Bt + S.offB(cur);
    PG8_STAGE(PG8_SB(0, 0), cB, voffB); PG8_STAGE(PG8_SB(0, 1), cB + hB, voffB); PG8_STAGE(PG8_SA(0, 0), cA, voffA); PG8_STAGE(PG8_SA(0, 1), cA + hA, voffA);
    if (wr == 1) PG8_BAR;
    PG8_WAIT_V(2); PG8_BAR;
    PG8_STAGE(PG8_SB(1, 0), cB + kstep, voffB); PG8_STAGE(PG8_SA(1, 0), cA + kstep, voffA); PG8_STAGE(PG8_SB(1, 1), cB + hB + kstep, voffB);
    PG8_WAIT_V(6); PG8_BAR;
    for (;;) {
        const bool has_next = S.next(ui + 1, nxt);
        const char* nA = has_next ? (const char*)g.A + S.offA(nxt) : cA; const char* nB = has_next ? (const char*)g.Bt + S.offB(nxt) : cB;
        for (int t = 0; t < nt; t += 2) {
            const bool last = (t == nt - 2);
            const char* a1 = cA + (size_t)(t + 1) * kstep;
            const char* a2 = last ? nA : cA + (size_t)(t + 2) * kstep; const char* b2 = last ? nB : cB + (size_t)(t + 2) * kstep;
            const char* a3 = a2 + kstep; const char* b3 = b2 + kstep;
            PG8_LDB(B0, 0, 0); PG8_LDB(B1, 0, 1); PG8_SCHED; PG8_LDA(At, 0, 0); PG8_STAGE(PG8_SA(1, 1), a1 + hA, voffA);
            PG8_WAIT_V(8); PG8_WAIT_L(0); PG8_BAR; PG8_MMA(0, 0, At, B0); PG8_MMA(0, 1, At, B1); PG8_BAR; PG8_SCHED;
            PG8_LDA(At, 0, 1); PG8_STAGE(PG8_SB(0, 0), b2, voffB); PG8_STAGE(PG8_SB(0, 1), b2 + hB, voffB); PG8_STAGE(PG8_SA(0, 0), a2, voffA);
            PG8_WAIT_V(8); PG8_WAIT_L(0); PG8_BAR; PG8_MMA(1, 0, At, B0); PG8_MMA(1, 1, At, B1); PG8_BAR; PG8_SCHED;
            PG8_LDB(B0, 1, 0); PG8_LDB(B1, 1, 1); PG8_SCHED; PG8_LDA(At, 1, 0); PG8_STAGE(PG8_SA(0, 1), a2 + hA, voffA);
            PG8_WAIT_V(8); PG8_WAIT_L(0); PG8_BAR; PG8_MMA(0, 0, At, B0); PG8_MMA(0, 1, At, B1); PG8_BAR; PG8_SCHED;
            PG8_LDA(At, 1, 1); PG8_STAGE(PG8_SB(1, 0), b3, voffB); PG8_STAGE(PG8_SB(1, 1), b3 + hB, voffB); PG8_STAGE(PG8_SA(1, 0), a3, voffA);
            PG8_WAIT_V(8); PG8_WAIT_L(0); PG8_BAR; PG8_MMA(1, 0, At, B0); PG8_MMA(1, 1, At, B1); PG8_BAR; PG8_SCHED;
        }
        if (wr == 0) PG8_BAR;
        E(acc, cur, wr, wc, fr, fq);
        if (!has_next) break;
#pragma unroll
        for (int a = 0; a < 2; ++a)
#pragma unroll
            for (int b = 0; b < 2; ++b)
#pragma unroll
                for (int m = 0; m < 4; ++m)
#pragma unroll
                    for (int n = 0; n < 2; ++n) acc[a][b][m][n] = (f32x4){0.f, 0.f, 0.f, 0.f};
        cur = nxt; cA = nA; cB = nB; ++ui;
        if (wr == 1) PG8_BAR;
    }
    PG8_WAIT_V(0);
    PG8_BAR;
#undef PG8_SA
#undef PG8_SB
#undef PG8_STAGE
#undef PG8_LDA
#undef PG8_LDB
#undef PG8_MMA
#undef PG8_WAIT_V
#undef PG8_WAIT_L
#undef PG8_BAR
#undef PG8_SCHED
}
}
#define XB_TMO      128
#define XB_XCNT(j)  (256  + 64 * (j))
#define XB_XSUB(j)  (1280 + 64 * (j))
#define XB_XGEN(j)  (2304 + 64 * (j))
#define XB_TOP      3328
#define XB_TOPGEN   3392
#define XCD_BAR_WORDS 3456
#define XB_SPIN_CAP (1u << 18)

__device__ __forceinline__ unsigned xb_ld(unsigned* p)              { return __hip_atomic_load(p, __ATOMIC_RELAXED, __HIP_MEMORY_SCOPE_AGENT); }
__device__ __forceinline__ unsigned xb_add(unsigned* p, unsigned v) { return __hip_atomic_fetch_add(p, v, __ATOMIC_RELAXED, __HIP_MEMORY_SCOPE_AGENT); }
__device__ __forceinline__ unsigned xb_xcc_id() { return (unsigned)__builtin_amdgcn_s_getreg((3 << 11) | 20) & 0xFu; }
#define XB_SPIN(cond, bar) do { unsigned _sp = 0; while (cond) { __builtin_amdgcn_s_sleep(1); \
    if ((++_sp & 255u) == 0u) { if (xb_ld(&(bar)[XB_TMO])) break; if (_sp > XB_SPIN_CAP) { atomicAdd(&(bar)[XB_TMO], 1u); break; } } } } while (0)

struct XcdBarrier {
    unsigned* bar; unsigned x;
    volatile LAS unsigned* st;
};

__device__ __forceinline__ XcdBarrier xcd_barrier_post(unsigned* bar, volatile LAS unsigned* st) {
    XcdBarrier b; b.bar = bar; b.x = xb_xcc_id(); b.st = st;
    if (threadIdx.x == 0) (void)xb_add(&bar[XB_XCNT(b.x)], 1u);
    return b;
}
__device__ __forceinline__ void xcd_barrier_complete(unsigned* bar, unsigned x, unsigned& nloc, unsigned& nx) {
    const unsigned G = gridDim.x * gridDim.y * gridDim.z;
    unsigned sum, cnt, mine, sp = 0u;
    for (;;) {
        sum = 0u; cnt = 0u; mine = 0u;
#pragma unroll
        for (unsigned j = 0; j < 16; ++j) { const unsigned c = xb_ld(&bar[XB_XCNT(j)]); sum += c; cnt += (c > 0u) ? 1u : 0u; mine = (j == x) ? c : mine; }
        if (sum == G) break;
        __builtin_amdgcn_s_sleep(1);
        if ((++sp & 255u) == 0u) { if (xb_ld(&bar[XB_TMO])) break; if (sp > XB_SPIN_CAP) { atomicAdd(&bar[XB_TMO], 1u); break; } }
    }
    nloc = mine > 0u ? mine : 1u; nx = cnt > 0u ? cnt : 1u;
}

__device__ __forceinline__ void xcd_barrier(const XcdBarrier& b) {
    asm volatile("s_waitcnt vmcnt(0)" ::: "memory");
    __syncthreads();
    if (threadIdx.x == 0) {
        unsigned* bar = b.bar;
        __builtin_amdgcn_s_waitcnt(0);
        unsigned nloc = b.st[0], nx = b.st[1];
        if (nloc == 0u) { xcd_barrier_complete(bar, b.x, nloc, nx); b.st[0] = nloc; b.st[1] = nx; }
        const unsigned old = xb_add(&bar[XB_XSUB(b.x)], 1u);
        const unsigned gen = old / nloc;
        if (old + 1u == (gen + 1u) * nloc) {
            __builtin_amdgcn_fence(__ATOMIC_RELEASE, "agent");
            asm volatile("s_waitcnt vmcnt(0)" ::: "memory");
            const unsigned og = xb_add(&bar[XB_TOP], 1u);
            const unsigned tg = og / nx;
            if (og + 1u == (tg + 1u) * nx) xb_add(&bar[XB_TOPGEN], 1u);
            else XB_SPIN(xb_ld(&bar[XB_TOPGEN]) == tg, bar);
            __builtin_amdgcn_fence(__ATOMIC_ACQUIRE, "agent");
            xb_add(&bar[XB_XGEN(b.x)], 1u);
            asm volatile("s_waitcnt vmcnt(0)" ::: "memory");
        } else {
            XB_SPIN(xb_ld(&bar[XB_XGEN(b.x)]) == gen, bar);
            __builtin_amdgcn_fence(__ATOMIC_ACQUIRE, "agent");
            asm volatile("s_waitcnt vmcnt(0)" ::: "memory");
        }
    }
    __syncthreads();
}
struct Args { const void* in[N_IN]; float* out; unsigned char* ws; int ph_lo, ph_hi; };
constexpr int NWAVES = 8, NTHR = 512;

struct FStoreF32 { float* C; int ldc; DI void operator()(const pg8::Unit& u, int row, int col, f32x4 v) const { *(f32x4*)(C + (size_t)(u.pm * 256 + row) * ldc + u.pn * 256 + col) = v; } };

DI void p0_transpose_item(const float* W, int K, int N, bf16_t* WT, LAS float* scr, int item, int lane) {
    const int nblk = N / 32, kb = item / nblk, nb = item % nblk, k0 = 64 * kb, n0 = 32 * nb;
#pragma unroll 8
    for (int i = 0; i < 32; ++i) { const int kk = 2 * i + (lane >> 5); scr[kk * 33 + (lane & 31)] = W[(size_t)(k0 + kk) * N + n0 + (lane & 31)]; }
    LDS_WAIT();
    const int c = lane & 7;
#pragma unroll
    for (int j = 0; j < 4; ++j) { const int n = (lane >> 3) + 8 * j; const LAS float* s = scr + (8 * c) * 33 + n;
        u32x4 o; o.x = cvt_pk_bf16(s[0 * 33], s[1 * 33]); o.y = cvt_pk_bf16(s[2 * 33], s[3 * 33]); o.z = cvt_pk_bf16(s[4 * 33], s[5 * 33]); o.w = cvt_pk_bf16(s[6 * 33], s[7 * 33]);
        *(u32x4*)(WT + (size_t)(n0 + n) * K + k0 + 8 * c) = o; }
    LDS_WAIT();
}
DI void rms_row_bf16(const float* xrow, const float* g, bf16_t* orow, int lane) {
    const f32x4* xr = (const f32x4*)xrow + lane; const f32x4* gr = (const f32x4*)g + lane;
    f32x4 v[8]; float s = 0.f;
#pragma unroll
    for (int j = 0; j < 8; ++j) { v[j] = xr[64 * j]; s += (v[j].x * v[j].x + v[j].y * v[j].y) + (v[j].z * v[j].z + v[j].w * v[j].w); }
    const float rstd = rsqrtf(wave_sum(s) * (1.f / 2048.f) + 1e-6f);
    u32x2* o8 = (u32x2*)orow + lane;
#pragma unroll
    for (int j = 0; j < 8; ++j) { const f32x4 gg = gr[64 * j]; o8[64 * j] = cvt4(v[j] * rstd * gg); }
}

DI void phase0(const Args& a, LAS unsigned char* lds) {
    const int tid = threadIdx.x, lane = tid & 63, wave = __builtin_amdgcn_readfirstlane(tid >> 6);
    const int gw = blockIdx.x * NWAVES + wave, NGW = gridDim.x * NWAVES;
    LAS float* scr = (LAS float*)(lds + wave * 16384);
    unsigned char* ws = a.ws;
    constexpr int NT_IN = 32 * 260, NT_OA = 16 * 64, NT_O = 32 * 64, NT_MQ = 32 * 16, NT_MKV = 32 * 32, NT_MO = 8 * 64, NT_UP = 32 * 352, NT_DN = 88 * 64, NT_C1 = 32 * 8;
    constexpr int N_ROWS = TT, N_MEM = 512, N_PG = 32 * NPAGES, N_BP = 128, N_WC = 32 * 508;
    constexpr int NITEMS = NT_UP + NT_IN + NT_DN + NT_O + 2 * NT_OA + NT_MQ + NT_MKV + NT_MO + 2 * NT_C1 + N_ROWS + N_MEM + N_PG + N_BP + N_WC;
    for (int it = gw; it < NITEMS; it += NGW) {
        int r = it;
        if (r < NT_UP) { p0_transpose_item((const float*)a.in[I_WUP], DM, DFF2, (bf16_t*)(ws + WS_BT_UP), scr, r, lane); continue; } r -= NT_UP;
        if (r < NT_IN) { p0_transpose_item((const float*)a.in[I_WIN], DM, DIN, (bf16_t*)(ws + WS_BT_IN), scr, r, lane); continue; } r -= NT_IN;
        if (r < NT_DN) { p0_transpose_item((const float*)a.in[I_WDN], DFF, DM, (bf16_t*)(ws + WS_BT_DN), scr, r, lane); continue; } r -= NT_DN;
        if (r < NT_O) { p0_transpose_item((const float*)a.in[I_WO], DM, DM, (bf16_t*)(ws + WS_BT_O), scr, r, lane); continue; } r -= NT_O;
        if (r < NT_OA) { p0_transpose_item((const float*)a.in[I_WOA], 1024, DM, (bf16_t*)(ws + WS_BT_OA), scr, r, lane); continue; } r -= NT_OA;
        if (r < NT_OA) { p0_transpose_item((const float*)a.in[I_WOB], 1024, DM, (bf16_t*)(ws + WS_BT_OB), scr, r, lane); continue; } r -= NT_OA;
        if (r < NT_MQ) { p0_transpose_item((const float*)a.in[I_WMQ], DM, 512, (bf16_t*)(ws + WS_BT_MQ), scr, r, lane); continue; } r -= NT_MQ;
        if (r < NT_MKV) { p0_transpose_item((const float*)a.in[I_WMKV], DM, 1024, (bf16_t*)(ws + WS_BT_MKV), scr, r, lane); continue; } r -= NT_MKV;
        if (r < NT_MO) { p0_transpose_item((const float*)a.in[I_WMO], 512, DM, (bf16_t*)(ws + WS_BT_MO), scr, r, lane); continue; } r -= NT_MO;
        if (r < NT_C1) { p0_transpose_item((const float*)a.in[I_CW1], 2048, 256, (bf16_t*)(ws + WS_BT_C1), scr, r, lane); continue; } r -= NT_C1;
        if (r < NT_C1) { p0_transpose_item((const float*)a.in[I_CW1] + (size_t)2048 * 256, 2048, 256, (bf16_t*)(ws + WS_BT_C1) + (size_t)256 * 2048, scr, r, lane); continue; } r -= NT_C1;
        if (r < N_ROWS) {
            const float* xrow = r < TP ? (const float*)a.in[I_XP] + (size_t)r * DM : (const float*)a.in[I_XS] + (size_t)(r - TP) * DM;
            rms_row_bf16(xrow, (const float*)a.in[I_NG], (bf16_t*)(ws + WS_XN) + (size_t)r * DM, lane); continue; } r -= N_ROWS;
        if (r < N_MEM) { rms_row_bf16((const float*)a.in[I_MEM] + (size_t)r * DM, (const float*)a.in[I_NG] + 2 * DM, (bf16_t*)(ws + WS_MEMN) + (size_t)r * DM, lane); continue; } r -= N_MEM;
        if (r < N_PG) {
            const int db = r >> 6, pj = r & 63; const int page = ((const int*)a.in[I_PT])[db * NPAGES + pj];
            const float* src = (const float*)a.in[I_CNSA] + (size_t)page * 128 * 512;
            bf16_t* dst = (bf16_t*)(ws + WS_KCRAW) + KCS_OFF;
            const int c = lane >> 5, g = (lane >> 4) & 1, d0 = (lane & 15) * 4;
            bf16_t* drow = dst + ((size_t)((db * 2 + c) * 2 + g) * 8192 + pj * 128) * 64 + d0;
#pragma unroll 8
            for (int s = 0; s < 128; ++s) { const f32x4 v = *(const f32x4*)(src + (size_t)s * 512 + lane * 4); *(u32x2*)(drow + (size_t)s * 64) = cvt4(v); }
            continue; } r -= N_PG;
        if (r < N_BP) {
            const int kv = r >> 6, nch = (r >> 4) & 3, kch = r & 15, n = nch * 64 + lane;
            const float* pe = (const float*)a.in[I_PE] + (size_t)kv * 2048 + kch * 128; const float* w1 = (const float*)a.in[I_CW1] + ((size_t)kv * 2048 + kch * 128) * 256 + n;
            float acc = 0.f;
#pragma unroll 8
            for (int k = 0; k < 128; ++k) acc += pe[k] * w1[(size_t)k * 256];
            ((float*)(ws + WS_BPART))[(kch * 2 + kv) * 256 + n] = acc; continue; } r -= N_BP;
        {
            const int db = r / 508, j = r % 508;
            const f32x4 v = *((const f32x4*)((const float*)a.in[I_SWIN] + ((size_t)db * 512 + j + 4) * 256) + lane);
            *((f32x4*)(a.out + O_WINS + ((size_t)db * 512 + j) * 256) + lane) = v;
        }
    }
    { const size_t gt = (size_t)blockIdx.x * NTHR + tid, NG = (size_t)gridDim.x * NTHR; const u32x4 z = (u32x4){0u, 0u, 0u, 0u};
      u32x4* p1 = (u32x4*)((bf16_t*)(ws + WS_BT_IN) + (size_t)DIN * DM); u32x4* p2 = (u32x4*)((bf16_t*)(ws + WS_XN) + (size_t)TT * DM);
      for (size_t i = gt; i < (size_t)128 * DM / 8; i += NG) { p1[i] = z; p2[i] = z; } }
}

DI f32x4 rope4(f32x4 v, f32x4 pv, int d0, int half, int tb, float cv, float sv) {
    const int fi = tb + (d0 & (half - 1));
    f32x4 c, s;
    c.x = __shfl(cv, fi); c.y = __shfl(cv, fi + 1); c.z = __shfl(cv, fi + 2); c.w = __shfl(cv, fi + 3);
    s.x = __shfl(sv, fi); s.y = __shfl(sv, fi + 1); s.z = __shfl(sv, fi + 2); s.w = __shfl(sv, fi + 3);
    const f32x4 lo = v * c - pv * s, hi = v * c + pv * s;
    return d0 < half ? lo : (d0 < 2 * half ? hi : v);
}
DI f32x4 sig4(f32x4 v) { f32x4 r; r.x = sigmoidf_(v.x); r.y = sigmoidf_(v.y); r.z = sigmoidf_(v.z); r.w = sigmoidf_(v.w); return r; }

DI void phase2(const Args& a, LAS unsigned char* lds) {
    const int tid = threadIdx.x, lane = tid & 63, wave = __builtin_amdgcn_readfirstlane(tid >> 6);
    const int gw = blockIdx.x * NWAVES + wave, NGW = gridDim.x * NWAVES;
    unsigned char* ws = a.ws; float* out = a.out;
    const float* P = (const float*)(ws + WS_P);
    bf16_t* QC = (bf16_t*)(ws + WS_QC); bf16_t* QR = (bf16_t*)(ws + WS_QR); bf16_t* QB = (bf16_t*)(ws + WS_QB); bf16_t* QI = (bf16_t*)(ws + WS_QI);
    float* GN = (float*)(ws + WS_GN); float* WI = (float*)(ws + WS_WI); bf16_t* GAB = (bf16_t*)(ws + WS_GAB); float* KW = (float*)(ws + WS_KW);
    bf16_t* KCP = (bf16_t*)(ws + WS_KCRAW);
    if (gw == 0) {
        for (int i = lane; i < 512; i += 64) { float s = ((const float*)a.in[I_CB1])[i];
            for (int k = 0; k < 16; ++k) s += ((const float*)(ws + WS_BPART))[k * 512 + i];
            ((float*)(ws + WS_BIASC))[i] = s; }
    }
    for (int r = gw; r < TT; r += NGW) {
        const bool pr = r < TP; const int b = r >> 12, s = r & 4095, q = r - TP, db = q >> 2, tt = q & 3;
        const int pos = pr ? s : 8192 + tt;
        float cv, sv; { const float e = lane < 8 ? -(float)lane / 8.f : -(float)((lane - 8) & 15) / 16.f; const float inv = powf(500000.f, e); const float ang = (float)pos * inv; cv = cosf(ang); sv = sinf(ang); }
        const float* Pr = P + (size_t)r * DINP;
#pragma unroll
        for (int i = 0; i < 4; ++i) { const int col = 256 * i + 4 * lane; const f32x4 v = *(const f32x4*)(Pr + C_QA + col); const f32x4 pv = shfl_xor4(v, 2);
            const f32x4 rv = rope4(v, pv, (4 * lane) & 63, 8, 0, cv, sv);
            *(u32x2*)(QC + (size_t)r * 1024 + col) = cvt4(v); *(u32x2*)(QR + (size_t)r * 1024 + col) = cvt4(rv); }
#pragma unroll
        for (int i = 0; i < 3; ++i) { const int cl = 256 * i + 4 * lane; const f32x4 v = *(const f32x4*)(Pr + C_KVA + cl); const f32x4 pv = shfl_xor4(v, 2);
            const int j = cl >> 7, g = (cl >> 6) & 1, d0 = cl & 63;
            const f32x4 rv = rope4(v, pv, d0, 8, 0, cv, sv); const f32x4 o = (j == 2 || j == 4) ? rv : v;
            if (j < 4) {
                float* dst = pr ? out + O_NSAP + ((size_t)r * 4 + j) * 128 + g * 64 + d0 : out + O_NSAS + ((size_t)q * 4 + j) * 128 + g * 64 + d0;
                *(f32x4*)dst = o;
                if (pr && j < 2) *(u32x2*)(KCP + ((size_t)((b * 2 + j) * 2 + g) * KCP_ROWS + s) * 64 + d0) = cvt4(o);
            } else {
                const int kv = j - 4;
                *(f32x4*)(KW + (size_t)r * 256 + kv * 128 + g * 64 + d0) = o;
                if (pr) { if (s >= SEQ - 512) *(f32x4*)(out + O_WINP + (((size_t)b * 512 + s - (SEQ - 512)) * 2 + kv) * 128 + g * 64 + d0) = o; }
                else *(f32x4*)(out + O_WINS + (((size_t)db * 512 + 508 + tt) * 2 + kv) * 128 + g * 64 + d0) = o;
            } }
        if (lane < 12) { const f32x4 v = *(const f32x4*)(Pr + C_GA + 4 * lane); *(f32x4*)(GN + (size_t)r * 48 + 4 * lane) = sig4(v); }
#pragma unroll
        for (int i = 0; i < 4; ++i) { const int col = 256 * i + 4 * lane; const f32x4 v = *(const f32x4*)(Pr + C_QB + col); const f32x4 pv = shfl_xor4(v, 4);
            const f32x4 rv = rope4(v, pv, (4 * lane) & 127, 16, 8, cv, sv);
            *(u32x2*)(QB + (size_t)r * 1024 + col) = cvt4(rv); }
        { const int cl = 4 * lane; const f32x4 v = *(const f32x4*)(Pr + C_KVB + cl); const f32x4 pv = shfl_xor4(v, 4);
          const f32x4 rv = rope4(v, pv, cl & 127, 16, 8, cv, sv); const f32x4 o = cl < 128 ? rv : v;
          float* dst = pr ? out + O_DSAP + (size_t)r * 320 + cl : out + O_DSAS + (size_t)q * 320 + cl; *(f32x4*)dst = o; }
#pragma unroll
        for (int i = 0; i < 4; ++i) { const int col = 256 * i + 4 * lane; const f32x4 v = *(const f32x4*)(Pr + C_QI + col); const f32x4 pv = shfl_xor4(v, 2);
            const f32x4 rv = rope4(v, pv, (4 * lane) & 63, 8, 0, cv, sv);
            *(u32x2*)(QI + (size_t)r * 1024 + col) = cvt4(rv); }
        { const f32x4 v = lane < 16 ? *(const f32x4*)(Pr + C_KI + 4 * lane) : (f32x4){0.f, 0.f, 0.f, 0.f}; const f32x4 pv = shfl_xor4(v, 2);
          const f32x4 rv = rope4(v, pv, (4 * lane) & 63, 8, 0, cv, sv);
          if (lane < 16) { float* dst = pr ? out + O_DSAP + (size_t)r * 320 + 256 + 4 * lane : out + O_DSAS + (size_t)q * 320 + 256 + 4 * lane; *(f32x4*)dst = rv; }
          if (lane < 4) *(f32x4*)(WI + (size_t)r * 16 + 4 * lane) = *(const f32x4*)(Pr + C_WI + 4 * lane); }
#pragma unroll 4
        for (int i = 0; i < 16; ++i) { const int col = 256 * i + 4 * lane; const f32x4 v = *(const f32x4*)(Pr + C_GM + col); *(u32x2*)(GAB + (size_t)r * 4096 + col) = cvt4(sig4(v)); }
    }
}
DI void phase1(const Args& a, LAS unsigned char* lds) {
    unsigned char* ws = a.ws;
    { pg8::Gemm g{(const bf16_t*)(ws + WS_XN), (const bf16_t*)(ws + WS_BT_IN), DM, DM, DM};
      pg8::StaticOrder S; S.init(MP / 256, DINP / 256, gridDim.x, blockIdx.x, DM, DM);
      pg8::EpiEach<FStoreF32> E{FStoreF32{(float*)(ws + WS_P), DINP}};
      pg8::gemm_phase(lds, g, S, E); }
    { pg8::Gemm g{(const bf16_t*)(ws + WS_MEMN), (const bf16_t*)(ws + WS_BT_MKV), DM, DM, DM};
      pg8::StaticOrder S; S.init(2, 4, gridDim.x, blockIdx.x, DM, DM);
      pg8::EpiEach<FStoreF32> E{FStoreF32{a.out + O_MEMP, 1024}};
      pg8::gemm_phase(lds, g, S, E); }
}
struct CmpOrder { int G, c;
    DI bool next(int i, pg8::Unit& u) const { const int L = i * G + c; if (L >= 264) return false; u.pn = L / 132; u.pm = L % 132; u.ks = 0; return true; }
    DI size_t offA(const pg8::Unit& u) const { const int rt = u.pm, kv = u.pn; size_t e;
        if (rt < 4) { const int b = rt >> 1, g = rt & 1; e = (size_t)((b * 2 + kv) * 2 + g) * KCP_ROWS * 64; }
        else { const int s = rt - 4, db = s >> 2, g = (s >> 1) & 1, half = s & 1; e = KCS_OFF + ((size_t)((db * 2 + kv) * 2 + g) * 8192 + half * 4096) * 64; }
        return e * 2; }
    DI size_t offB(const pg8::Unit& u) const { return (size_t)u.pn * 256 * 2048 * 2; }
};
DI float gelu_tanh(float x) { const float u = 0.7978845608028654f * (x + 0.044715f * x * x * x); const float t = 1.f - 2.f / (1.f + __expf(2.f * u)); return 0.5f * x * (1.f + t); }
struct FCmpH { const float* biasc; bf16_t* HC;
    DI void operator()(const pg8::Unit& u, int row, int col, f32x4 v) const { const f32x4 bb = *(const f32x4*)(biasc + u.pn * 256 + col); f32x4 x = v + bb;
        x.x = gelu_tanh(x.x); x.y = gelu_tanh(x.y); x.z = gelu_tanh(x.z); x.w = gelu_tanh(x.w);
        *(u32x2*)(HC + ((size_t)(u.pn * 132 + u.pm) * 256 + row) * 256 + col) = cvt4(x); } };
DI void phase3(const Args& a, LAS unsigned char* lds) {
    unsigned char* ws = a.ws;
    pg8::Gemm g{(const bf16_t*)(ws + WS_KCRAW), (const bf16_t*)(ws + WS_BT_C1), 1024, 2048, 2048};
    CmpOrder S{(int)gridDim.x, (int)blockIdx.x};
    pg8::EpiEach<FCmpH> E{FCmpH{(const float*)(ws + WS_BIASC), (bf16_t*)(ws + WS_HC)}};
    pg8::gemm_phase(lds, g, S, E);
}
DI void phase4(const Args& a, LAS unsigned char* lds) {
    const int tid = threadIdx.x, lane = tid & 63, wave = __builtin_amdgcn_readfirstlane(tid >> 6);
    const int gw = blockIdx.x * NWAVES + wave, NGW = gridDim.x * NWAVES;
    unsigned char* ws = a.ws;
    LAS bf16_t* W2T = (LAS bf16_t*)lds;
    const float* w2 = (const float*)a.in[I_CW2];
    for (int idx = tid; idx < 2 * 256 * 64; idx += NTHR) { const int kv = idx >> 14, k = (idx >> 6) & 255, n = idx & 63; W2T[(kv * 64 + n) * 264 + k] = (bf16_t)(cvt_pk_bf16(w2[idx], 0.f) & 0xffffu); }
    __syncthreads();
    const bf16_t* HC = (const bf16_t*)(ws + WS_HC); float* KCV = (float*)(ws + WS_KCV);
    const int kg = lane >> 4, c16 = lane & 15;
    constexpr int NIT = 2 * HC_ROWS / 16;
    for (int it = gw; it < NIT; it += NGW) {
        const int kv = it / (HC_ROWS / 16), row0 = (it % (HC_ROWS / 16)) * 16;
        f32x4 acc[4];
#pragma unroll
        for (int nt = 0; nt < 4; ++nt) acc[nt] = (f32x4){0.f, 0.f, 0.f, 0.f};
#pragma unroll
        for (int ks = 0; ks < 8; ++ks) {
            const bf16x8 bfr = *(const bf16x8*)(HC + ((size_t)kv * HC_ROWS + row0 + c16) * 256 + 32 * ks + 8 * kg);
#pragma unroll
            for (int nt = 0; nt < 4; ++nt) { const bf16x8 afr = *(const LAS bf16x8*)(W2T + (kv * 64 + 16 * nt + c16) * 264 + 32 * ks + 8 * kg); acc[nt] = MFMA16(afr, bfr, acc[nt]); }
        }
        const int R = row0 + c16, rt = R >> 8, iin = R & 255; int seq, g, blk;
        if (rt < 4) { seq = rt >> 1; g = rt & 1; blk = iin; } else { const int s = rt - 4; seq = 2 + (s >> 2); g = (s >> 1) & 1; blk = (s & 1) * 256 + iin; }
        float* dst = KCV + ((size_t)((seq * 2 + kv) * 2 + g) * 512 + blk) * 64 + 4 * kg;
#pragma unroll
        for (int nt = 0; nt < 4; ++nt) *(f32x4*)(dst + 16 * nt) = acc[nt];
    }
}

struct RowInfo { bool pr; int b, db, pos, seq; };
DI RowInfo rowinfo(int r) { RowInfo ri; ri.pr = r < TP; const int q = r - TP; ri.b = r >> 12; ri.db = q >> 2; ri.pos = ri.pr ? (r & 4095) : 8192 + (q & 3); ri.seq = ri.pr ? ri.b : 2 + ri.db; return ri; }
template <int D> struct Flash { f32x4 o[D / 16]; float m, l; };
template <int D> DI void flash_init(Flash<D>& f) {
#pragma unroll
    for (int i = 0; i < D / 16; ++i) f.o[i] = (f32x4){0.f, 0.f, 0.f, 0.f};
    f.m = -INFINITY; f.l = 0.f; }
DI bf16x8 ldk8(const float* p) { return cvt8(*(const f32x4*)p, *(const f32x4*)(p + 4)); }
DI int kslot(int kg, int j) { return j < 4 ? 4 * kg + j : 16 + 4 * kg + (j - 4); }
template <int D> DI void flash_step(Flash<D>& f, const bf16x8 (&qf)[D / 32], const float* kp0, const float* kp1, const float* const (&vp)[8], unsigned okm, float scale, int lane) {
    const int kg = lane >> 4, c16 = lane & 15;
    f32x4 s0 = (f32x4){0.f, 0.f, 0.f, 0.f}, s1 = s0;
#pragma unroll
    for (int ks = 0; ks < D / 32; ++ks) { const bf16x8 a0 = ldk8(kp0 + 32 * ks + 8 * kg), a1 = ldk8(kp1 + 32 * ks + 8 * kg); s0 = MFMA16(a0, qf[ks], s0); s1 = MFMA16(a1, qf[ks], s1); }
    float v[8];
#pragma unroll
    for (int j = 0; j < 4; ++j) { v[j] = ((okm >> j) & 1u) ? s0[j] * scale : -INFINITY; v[4 + j] = ((okm >> (4 + j)) & 1u) ? s1[j] * scale : -INFINITY; }
    float mx = fmaxf(fmaxf(fmaxf(v[0], v[1]), fmaxf(v[2], v[3])), fmaxf(fmaxf(v[4], v[5]), fmaxf(v[6], v[7])));
    mx = fmaxf(mx, __shfl_xor(mx, 16)); mx = fmaxf(mx, __shfl_xor(mx, 32));
    const float mnew = fmaxf(f.m, mx), msafe = (mnew == -INFINITY) ? 0.f : mnew;
    const float alpha = __expf(f.m - msafe);
    float p[8], sum = 0.f;
#pragma unroll
    for (int e = 0; e < 8; ++e) { p[e] = __expf(v[e] - msafe); sum += p[e]; }
    sum += __shfl_xor(sum, 16); sum += __shfl_xor(sum, 32);
    f.l = f.l * alpha + sum; f.m = mnew;
    u32x4 w; w.x = cvt_pk_bf16(p[0], p[1]); w.y = cvt_pk_bf16(p[2], p[3]); w.z = cvt_pk_bf16(p[4], p[5]); w.w = cvt_pk_bf16(p[6], p[7]);
    const bf16x8 pb = __builtin_bit_cast(bf16x8, w);
#pragma unroll
    for (int dt = 0; dt < D / 16; ++dt) {
        float x[8];
#pragma unroll
        for (int j = 0; j < 8; ++j) x[j] = vp[j][16 * dt + c16];
        u32x4 aw; aw.x = cvt_pk_bf16(x[0], x[1]); aw.y = cvt_pk_bf16(x[2], x[3]); aw.z = cvt_pk_bf16(x[4], x[5]); aw.w = cvt_pk_bf16(x[6], x[7]);
        f.o[dt] = MFMA16(__builtin_bit_cast(bf16x8, aw), pb, f.o[dt] * alpha);
    }
}

DI void cmp_item(const Args& a, LAS unsigned char* wl, int seq, int r0, int pos0, int g, int lane) {
    unsigned char* ws = a.ws;
    LAS float* imp = (LAS float*)wl; LAS float* scv = imp + 1040;
    const int kg = lane >> 4, c16 = lane & 15, tl = c16 >> 3, hh = c16 & 7;
    const int myrow = r0 + tl, qpos = pos0 + tl, head = g * 8 + hh;
    const bf16_t* QC = (const bf16_t*)(ws + WS_QC);
    bf16x8 qf[2];
#pragma unroll
    for (int ks = 0; ks < 2; ++ks) qf[ks] = *(const bf16x8*)(QC + (size_t)myrow * 1024 + head * 64 + 32 * ks + 8 * kg);
    const float* KCV = (const float*)(ws + WS_KCV);
    const float* kcb = KCV + (size_t)((seq * 2 + 0) * 2 + g) * 512 * 64; const float* vcb = KCV + (size_t)((seq * 2 + 1) * 2 + g) * 512 * 64;
    const int qlast = pos0 + 1, NV = qlast >= 31 ? ((qlast - 31) >> 4) + 1 : 0, nsteps = (NV + 31) >> 5;
    for (int i = lane; i < 1040; i += 64) imp[i] = 0.f;
    float m = -INFINITY, l = 0.f;
    for (int st = 0; st < nsteps; ++st) {
        f32x4 s0 = (f32x4){0.f, 0.f, 0.f, 0.f}, s1 = s0;
#pragma unroll
        for (int ks = 0; ks < 2; ++ks) { const bf16x8 a0 = ldk8(kcb + (size_t)(32 * st + c16) * 64 + 32 * ks + 8 * kg), a1 = ldk8(kcb + (size_t)(32 * st + 16 + c16) * 64 + 32 * ks + 8 * kg); s0 = MFMA16(a0, qf[ks], s0); s1 = MFMA16(a1, qf[ks], s1); }
        float v[8];
#pragma unroll
        for (int j = 0; j < 4; ++j) { const int n = 32 * st + 4 * kg + j; v[j] = (16 * n + 31 <= qpos) ? s0[j] * 0.125f : -INFINITY; v[4 + j] = (16 * (n + 16) + 31 <= qpos) ? s1[j] * 0.125f : -INFINITY; }
        float mx = fmaxf(fmaxf(fmaxf(v[0], v[1]), fmaxf(v[2], v[3])), fmaxf(fmaxf(v[4], v[5]), fmaxf(v[6], v[7])));
        mx = fmaxf(mx, __shfl_xor(mx, 16)); mx = fmaxf(mx, __shfl_xor(mx, 32));
        const float mnew = fmaxf(m, mx), msafe = (mnew == -INFINITY) ? 0.f : mnew;
        float sum = 0.f;
#pragma unroll
        for (int e = 0; e < 8; ++e) sum += __expf(v[e] - msafe);
        sum += __shfl_xor(sum, 16); sum += __shfl_xor(sum, 32);
        l = l * __expf(m - msafe) + sum; m = mnew;
    }
    const float msafe = (m == -INFINITY) ? 0.f : m, linv = 1.f / fmaxf(l, 1e-30f);
    f32x4 o[4];
#pragma unroll
    for (int dt = 0; dt < 4; ++dt) o[dt] = (f32x4){0.f, 0.f, 0.f, 0.f};
    for (int st = 0; st < nsteps; ++st) {
        f32x4 s0 = (f32x4){0.f, 0.f, 0.f, 0.f}, s1 = s0;
#pragma unroll
        for (int ks = 0; ks < 2; ++ks) { const bf16x8 a0 = ldk8(kcb + (size_t)(32 * st + c16) * 64 + 32 * ks + 8 * kg), a1 = ldk8(kcb + (size_t)(32 * st + 16 + c16) * 64 + 32 * ks + 8 * kg); s0 = MFMA16(a0, qf[ks], s0); s1 = MFMA16(a1, qf[ks], s1); }
        float p[8];
#pragma unroll
        for (int j = 0; j < 4; ++j) { const int n = 32 * st + 4 * kg + j;
            p[j] = (16 * n + 31 <= qpos) ? __expf(s0[j] * 0.125f - msafe) * linv : 0.f; p[4 + j] = (16 * (n + 16) + 31 <= qpos) ? __expf(s1[j] * 0.125f - msafe) * linv : 0.f; }
#pragma unroll
        for (int e = 0; e < 8; ++e) { float t = p[e]; t += __shfl_xor(t, 1); t += __shfl_xor(t, 2); t += __shfl_xor(t, 4);
            if (hh == 0) imp[tl * 520 + 32 * st + kslot(kg, e)] = t; }
        u32x4 w; w.x = cvt_pk_bf16(p[0], p[1]); w.y = cvt_pk_bf16(p[2], p[3]); w.z = cvt_pk_bf16(p[4], p[5]); w.w = cvt_pk_bf16(p[6], p[7]);
        const bf16x8 pb = __builtin_bit_cast(bf16x8, w);
#pragma unroll
        for (int dt = 0; dt < 4; ++dt) {
            float x[8];
#pragma unroll
            for (int j = 0; j < 8; ++j) x[j] = vcb[(size_t)(32 * st + kslot(kg, j)) * 64 + 16 * dt + c16];
            u32x4 aw; aw.x = cvt_pk_bf16(x[0], x[1]); aw.y = cvt_pk_bf16(x[2], x[3]); aw.z = cvt_pk_bf16(x[4], x[5]); aw.w = cvt_pk_bf16(x[6], x[7]);
            o[dt] = MFMA16(__builtin_bit_cast(bf16x8, aw), pb, o[dt]);
        }
    }
    float* OC = (float*)(ws + WS_OCMP) + (size_t)myrow * 1024 + head * 64 + 4 * kg;
#pragma unroll
    for (int dt = 0; dt < 4; ++dt) *(f32x4*)(OC + 16 * dt) = o[dt];
    LDS_WAIT();
    int* SEL = (int*)(ws + WS_SEL);
    for (int t2 = 0; t2 < 2; ++t2) {
        const int qp = pos0 + t2, cur = qp >> 6, nsb = cur + 1;
        int* selp = SEL + ((size_t)(r0 + t2) * 2 + g) * 16;
        if (nsb <= 16) { if (lane < 16) selp[lane] = lane < nsb ? lane : -1; }
        else {
            const LAS float* im = imp + t2 * 520;
            for (int j = lane; j < nsb; j += 64) { const float sc = (im[4 * j] + im[4 * j + 1]) + (im[4 * j + 2] + im[4 * j + 3]) + (j ? im[4 * j - 1] : 0.f);
                scv[j] = (j == 0 || j == cur || j == cur - 1) ? INFINITY : sc; }
            LDS_WAIT();
            for (int j = lane; j < nsb; j += 64) { const float vj = scv[j]; int rank = 0;
                for (int k = 0; k < nsb; ++k) { const float vk = scv[k]; rank += (vk > vj || (vk == vj && k < j)) ? 1 : 0; }
                if (rank < 16) selp[rank] = j; }
            LDS_WAIT();
        }
    }
}

DI const float* dsa_ptr(const Args& a, const RowInfo& ri, int idx) {
    if (ri.pr) return a.out + O_DSAP + ((size_t)ri.b * 4096 + idx) * 320;
    if (idx < 8192) return (const float*)a.in[I_CDSA] + ((size_t)((const int*)a.in[I_PT])[ri.db * NPAGES + (idx >> 7)] * 128 + (idx & 127)) * 320;
    return a.out + O_DSAS + ((size_t)ri.db * 4 + idx - 8192) * 320;
}
DI unsigned sortable(float x) { const unsigned u = __float_as_uint(x); return (u & 0x80000000u) ? ~u : (u | 0x80000000u); }
DI void idx_item(const Args& a, LAS unsigned char* lds, int r) {
    const int tid = threadIdx.x, lane = tid & 63, wave = __builtin_amdgcn_readfirstlane(tid >> 6);
    unsigned char* ws = a.ws;
    LAS unsigned* sc = (LAS unsigned*)(lds + 65536); LAS unsigned* hist = sc + 8200; LAS unsigned* misc = hist + 256; LAS unsigned* wc = misc + 16;
    const RowInfo ri = rowinfo(r); const int n = ri.pos + 1;
    int* idxp = (int*)(ws + WS_IDX) + (size_t)r * 256;
    if (n <= 256) { if (tid < 256) idxp[tid] = tid < n ? tid : -1; return; }
    const int kg = lane >> 4, c16 = lane & 15;
    { const bf16_t* QI = (const bf16_t*)(ws + WS_QI); bf16x8 qf[2];
#pragma unroll
      for (int ks = 0; ks < 2; ++ks) qf[ks] = *(const bf16x8*)(QI + (size_t)r * 1024 + c16 * 64 + 32 * ks + 8 * kg);
      const float w = ((const float*)(ws + WS_WI))[(size_t)r * 16 + c16] * 0.03125f;
      const int nt32 = (n + 31) >> 5;
      for (int kt = wave; kt < nt32; kt += NWAVES) {
          const int p0 = min(32 * kt + c16, n - 1), p1 = min(32 * kt + 16 + c16, n - 1);
          const float* kp0 = dsa_ptr(a, ri, p0) + 256; const float* kp1 = dsa_ptr(a, ri, p1) + 256;
          f32x4 s0 = (f32x4){0.f, 0.f, 0.f, 0.f}, s1 = s0;
#pragma unroll
          for (int ks = 0; ks < 2; ++ks) { const bf16x8 a0 = ldk8(kp0 + 32 * ks + 8 * kg), a1 = ldk8(kp1 + 32 * ks + 8 * kg); s0 = MFMA16(a0, qf[ks], s0); s1 = MFMA16(a1, qf[ks], s1); }
#pragma unroll
          for (int e = 0; e < 8; ++e) { float x = fmaxf(e < 4 ? s0[e & 3] : s1[e & 3], 0.f) * w;
              x += __shfl_xor(x, 1); x += __shfl_xor(x, 2); x += __shfl_xor(x, 4); x += __shfl_xor(x, 8);
              const int key = 32 * kt + kslot(kg, e); if (c16 == 0 && key < n) sc[key] = sortable(x); }
      } }
    __syncthreads();
    unsigned prefix = 0u, mask = 0u; int need = 256;
    for (int pass = 0; pass < 4; ++pass) { const int shift = 24 - 8 * pass;
        if (tid < 256) hist[tid] = 0u;
        __syncthreads();
        for (int i = tid; i < n; i += NTHR) { const unsigned u = sc[i]; if ((u & mask) == prefix) __hip_atomic_fetch_add(&hist[(u >> shift) & 255u], 1u, __ATOMIC_RELAXED, __HIP_MEMORY_SCOPE_WORKGROUP); }
        __syncthreads();
        if (wave == 0) { const int h0 = hist[4 * lane], h1 = hist[4 * lane + 1], h2 = hist[4 * lane + 2], h3 = hist[4 * lane + 3]; const int ls = h0 + h1 + h2 + h3; int suf = ls;
#pragma unroll
            for (int o = 1; o < 64; o <<= 1) { const int t = __shfl_down(suf, o); if (lane + o < 64) suf += t; }
            int above = suf - ls;
            if (above < need && need <= above + h3) { misc[0] = 4 * lane + 3; misc[1] = need - above; } above += h3;
            if (above < need && need <= above + h2) { misc[0] = 4 * lane + 2; misc[1] = need - above; } above += h2;
            if (above < need && need <= above + h1) { misc[0] = 4 * lane + 1; misc[1] = need - above; } above += h1;
            if (above < need && need <= above + h0) { misc[0] = 4 * lane + 0; misc[1] = need - above; } }
        __syncthreads();
        const unsigned bin = misc[0]; need = (int)misc[1]; prefix |= bin << shift; mask |= 0xFFu << shift;
    }
    const unsigned thr = prefix; const int need_eq = need; int run_gt = 0, run_eq = 0;
    for (int base = 0; base < n; base += NTHR) {
        const int i = base + tid; const unsigned u = i < n ? sc[i] : 0u; const bool gt = i < n && u > thr, eq = i < n && u == thr;
        const unsigned long long bg = __ballot(gt), be = __ballot(eq);
        if (lane == 0) { wc[wave * 2] = (unsigned)__popcll(bg); wc[wave * 2 + 1] = (unsigned)__popcll(be); }
        __syncthreads();
        int pg = 0, pe = 0, tg = 0, te = 0;
#pragma unroll
        for (int w = 0; w < NWAVES; ++w) { const int cg = (int)wc[2 * w], ce = (int)wc[2 * w + 1]; if (w < wave) { pg += cg; pe += ce; } tg += cg; te += ce; }
        const unsigned long long lm = (1ull << lane) - 1ull;
        const int gb = run_gt + pg + __popcll(bg & lm), eb = run_eq + pe + __popcll(be & lm);
        const int opos = gb + min(eb, need_eq);
        if ((gt || (eq && eb < need_eq)) && opos < 256) idxp[opos] = i;
        run_gt += tg; run_eq += te;
        __syncthreads();
    }
}

DI int balanced_s(int u, int stride) { const int kk = u / stride, x = u % stride, t = (kk >> 1) * stride + x; return (kk & 1) ? 4095 - t : t; }
DI void phase5(const Args& a, LAS unsigned char* lds) {
    const int tid = threadIdx.x, lane = tid & 63, wave = __builtin_amdgcn_readfirstlane(tid >> 6);
    const int gw = blockIdx.x * NWAVES + wave;
    { LAS unsigned char* wl = lds + wave * 8192;
      const int NGW = gridDim.x * NWAVES;
#pragma unroll 1
      for (int it = gw; it < 8192; it += NGW) { const int g = it & 1, base = (it >> 1) & 1023, k = it >> 11, b = k >> 1, tp = (k & 1) ? 2047 - base : base; cmp_item(a, wl, b, b * 4096 + 2 * tp, 2 * tp, g, lane); }
#pragma unroll 1
      for (int it = gw; it < 128; it += NGW) { const int g = it & 1, db = it >> 2, tp = (it >> 1) & 1; cmp_item(a, wl, 2 + db, TP + db * 4 + 2 * tp, 8192 + 2 * tp, g, lane); } }
    __syncthreads();
    { const int bid = blockIdx.x, G = gridDim.x;
#pragma unroll 1
      for (int j = bid; j < TP; j += G) { const int b = j >> 12, s = balanced_s(j & 4095, G); idx_item(a, lds, b * 4096 + s); __syncthreads(); }
#pragma unroll 1
      for (int j = bid; j < TS; j += G) { idx_item(a, lds, TP + j); __syncthreads(); } }
}

DI const float* win_ptr(const Args& a, const RowInfo& ri, int pos, int kv, int g) {
    const float* KW = (const float*)(a.ws + WS_KW);
    if (ri.pr) return KW + ((size_t)ri.b * 4096 + pos) * 256 + kv * 128 + g * 64;
    if (pos < 8192) return (const float*)a.in[I_SWIN] + (((size_t)ri.db * 512 + (pos - 7680)) * 2 + kv) * 128 + g * 64;
    return KW + ((size_t)TP + ri.db * 4 + (pos - 8192)) * 256 + kv * 128 + g * 64;
}
DI const float* slc_ptr(const Args& a, const RowInfo& ri, int pos, int c, int g) {
    if (ri.pr) return a.out + O_NSAP + (((size_t)ri.b * 4096 + pos) * 4 + c) * 128 + g * 64;
    if (pos < 8192) return (const float*)a.in[I_CNSA] + (((size_t)((const int*)a.in[I_PT])[ri.db * NPAGES + (pos >> 7)] * 128 + (pos & 127)) * 4 + c) * 128 + g * 64;
    return a.out + O_NSAS + (((size_t)ri.db * 4 + pos - 8192) * 4 + c) * 128 + g * 64;
}
DI void nsa2_item(const Args& a, int r, int g, int lane) {
    unsigned char* ws = a.ws;
    const RowInfo ri = rowinfo(r); const int qpos = ri.pos;
    const int kg = lane >> 4, c16 = lane & 15, hh = c16 & 7, head = g * 8 + hh;
    bf16x8 qf[2];
    { const bf16_t* QR = (const bf16_t*)(ws + WS_QR);
#pragma unroll
      for (int ks = 0; ks < 2; ++ks) qf[ks] = *(const bf16x8*)(QR + (size_t)r * 1024 + head * 64 + 32 * ks + 8 * kg); }
    Flash<64> fw; flash_init(fw);
    { const int lo = max(0, qpos - 511);
      for (int base = lo & ~31; base <= qpos; base += 32) {
          const float* kp0 = win_ptr(a, ri, min(max(base + c16, lo), qpos), 0, g); const float* kp1 = win_ptr(a, ri, min(max(base + 16 + c16, lo), qpos), 0, g);
          const float* vp[8]; unsigned okm = 0u;
#pragma unroll
          for (int j = 0; j < 8; ++j) { const int p = base + kslot(kg, j); okm |= (p >= lo && p <= qpos) ? (1u << j) : 0u; vp[j] = win_ptr(a, ri, min(max(p, lo), qpos), 1, g); }
          flash_step<64>(fw, qf, kp0, kp1, vp, okm, 0.125f, lane);
      } }
    Flash<64> fs; flash_init(fs);
    { const int* selp = (const int*)(ws + WS_SEL) + ((size_t)r * 2 + g) * 16;
      for (int i = 0; i < 16; ++i) { const int sb = __builtin_amdgcn_readfirstlane(selp[i]); if (sb < 0) continue;
          for (int h2 = 0; h2 < 2; ++h2) { const int base = sb * 64 + h2 * 32; if (base > qpos) continue;
              const float* kp0 = slc_ptr(a, ri, min(base + c16, qpos), 2, g); const float* kp1 = slc_ptr(a, ri, min(base + 16 + c16, qpos), 2, g);
              const float* vp[8]; unsigned okm = 0u;
#pragma unroll
              for (int j = 0; j < 8; ++j) { const int p = base + kslot(kg, j); okm |= (p <= qpos) ? (1u << j) : 0u; vp[j] = slc_ptr(a, ri, min(p, qpos), 3, g); }
              flash_step<64>(fs, qf, kp0, kp1, vp, okm, 0.125f, lane);
          } } }
    const float* GN = (const float*)(ws + WS_GN) + (size_t)r * 48;
    const float g0 = GN[head], g1 = GN[16 + head] / fmaxf(fs.l, 1e-30f), g2 = GN[32 + head] / fmaxf(fw.l, 1e-30f);
    const float* OC = (const float*)(ws + WS_OCMP) + (size_t)r * 1024 + head * 64 + 4 * kg;
    bf16_t* ON = (bf16_t*)(ws + WS_ONSA) + (size_t)r * 1024 + head * 64 + 4 * kg;
#pragma unroll
    for (int dt = 0; dt < 4; ++dt) { const f32x4 oc = *(const f32x4*)(OC + 16 * dt); const f32x4 o = oc * g0 + fs.o[dt] * g1 + fw.o[dt] * g2; if (c16 < 8) *(u32x2*)(ON + 16 * dt) = cvt4(o); }
}
DI void dsa_item(const Args& a, int r, int lane) {
    unsigned char* ws = a.ws;
    const RowInfo ri = rowinfo(r); const int nvalid = min(256, ri.pos + 1);
    const int kg = lane >> 4, c16 = lane & 15, hh = c16 & 7;
    bf16x8 qf[4];
    { const bf16_t* QB = (const bf16_t*)(ws + WS_QB);
#pragma unroll
      for (int ks = 0; ks < 4; ++ks) qf[ks] = *(const bf16x8*)(QB + (size_t)r * 1024 + hh * 128 + 32 * ks + 8 * kg); }
    const int* idxp = (const int*)(ws + WS_IDX) + (size_t)r * 256;
    Flash<128> f; flash_init(f);
    for (int st = 0; st * 32 < nvalid; ++st) {
        const int i0 = idxp[32 * st + c16], i1 = idxp[32 * st + 16 + c16];
        const float* kp0 = dsa_ptr(a, ri, max(i0, 0)); const float* kp1 = dsa_ptr(a, ri, max(i1, 0));
        const float* vp[8]; unsigned okm = 0u;
#pragma unroll
        for (int j = 0; j < 8; ++j) { const int id = idxp[32 * st + kslot(kg, j)]; okm |= (id >= 0) ? (1u << j) : 0u; vp[j] = dsa_ptr(a, ri, max(id, 0)) + 128; }
        flash_step<128>(f, qf, kp0, kp1, vp, okm, 0.08838834764831845f, lane);
    }
    const float inv = 1.f / fmaxf(f.l, 1e-30f);
    bf16_t* OD = (bf16_t*)(ws + WS_ODSA) + (size_t)r * 1024 + hh * 128 + 4 * kg;
#pragma unroll
    for (int dt = 0; dt < 8; ++dt) if (c16 < 8) *(u32x2*)(OD + 16 * dt) = cvt4(f.o[dt] * inv);
}
DI void phase6(const Args& a, LAS unsigned char* lds) {
    const int tid = threadIdx.x, lane = tid & 63, wave = __builtin_amdgcn_readfirstlane(tid >> 6);
    const int gw = blockIdx.x * NWAVES + wave, NGW = gridDim.x * NWAVES;
#pragma unroll 1
    for (int it = gw; it < 2 * TP; it += NGW) { const int g = it & 1, j = it >> 1, b = j >> 12, s = balanced_s(j & 4095, NGW >> 1); nsa2_item(a, b * 4096 + s, g, lane); }
#pragma unroll 1
    for (int it = gw; it < 2 * TS; it += NGW) nsa2_item(a, TP + (it >> 1), it & 1, lane);
#pragma unroll 1
    for (int it = gw; it < TT; it += NGW) dsa_item(a, it, lane);
}

DI void phase11(const Args& a, LAS unsigned char* lds) {
    const int tid = threadIdx.x, lane = tid & 63, wave = __builtin_amdgcn_readfirstlane(tid >> 6);
    const int gw = blockIdx.x * NWAVES + wave, NGW = gridDim.x * NWAVES;
    unsigned char* ws = a.ws;
    const int kg = lane >> 4, c16 = lane & 15;
#pragma unroll 1
    for (int it = gw; it < 2048 + 128; it += NGW) {
        int myrow, h; const float* kvb; bool st_ok;
        if (it < 2048) { const int rg = it >> 2; h = it & 3; myrow = rg * 16 + c16; kvb = a.out + O_MEMP + (size_t)(rg >> 8) * 256 * 1024 + h * 128; st_ok = true; }
        else { const int j = it - 2048, db = j >> 2; h = j & 3; myrow = TP + db * 4 + (c16 & 3); kvb = (const float*)a.in[I_CMEM] + (size_t)db * 256 * 1024 + h * 128; st_ok = c16 < 4; }
        bf16x8 qf[4];
        { const bf16_t* QM = (const bf16_t*)(ws + WS_QMB);
#pragma unroll
          for (int ks = 0; ks < 4; ++ks) qf[ks] = *(const bf16x8*)(QM + (size_t)myrow * 512 + h * 128 + 32 * ks + 8 * kg); }
        Flash<128> f; flash_init(f);
        for (int st = 0; st < 8; ++st) {
            const float* kp0 = kvb + (size_t)(32 * st + c16) * 1024; const float* kp1 = kp0 + 16 * 1024;
            const float* vp[8];
#pragma unroll
            for (int j = 0; j < 8; ++j) vp[j] = kvb + (size_t)(32 * st + kslot(kg, j)) * 1024 + 512;
            flash_step<128>(f, qf, kp0, kp1, vp, 0xFFu, 0.08838834764831845f, lane);
        }
        const float inv = 1.f / fmaxf(f.l, 1e-30f);
        bf16_t* OM = (bf16_t*)(ws + WS_OM) + (size_t)myrow * 512 + h * 128 + 4 * kg;
#pragma unroll
        for (int dt = 0; dt < 8; ++dt) if (st_ok) *(u32x2*)(OM + 16 * dt) = cvt4(f.o[dt] * inv);
    }
}
DI f32x4 ldbf4(const bf16_t* p) { const u32x2 w = *(const u32x2*)p; f32x4 r; r.x = __uint_as_float(w.x << 16); r.y = __uint_as_float(w.x & 0xffff0000u); r.z = __uint_as_float(w.y << 16); r.w = __uint_as_float(w.y & 0xffff0000u); return r; }
struct FMergeA { const bf16_t* GAB; float* TMP; DI void operator()(const pg8::Unit& u, int row, int col, f32x4 v) const { const size_t r = (size_t)u.pm * 256 + row; const int c = u.pn * 256 + col;
    *(f32x4*)(TMP + r * DM + c) = v * ldbf4(GAB + r * 4096 + c); } };
struct FMergeB { const bf16_t* GAB; const float* TMP; bf16_t* MG; DI void operator()(const pg8::Unit& u, int row, int col, f32x4 v) const { const size_t r = (size_t)u.pm * 256 + row; const int c = u.pn * 256 + col;
    const f32x4 t = *(const f32x4*)(TMP + r * DM + c); *(u32x2*)(MG + r * DM + c) = cvt4(t + v * ldbf4(GAB + r * 4096 + 2048 + c)); } };
DI void phase7(const Args& a, LAS unsigned char* lds) {
    unsigned char* ws = a.ws;
    { pg8::Gemm g{(const bf16_t*)(ws + WS_ONSA), (const bf16_t*)(ws + WS_BT_OA), 1024, 1024, 1024};
      pg8::StaticOrder S; S.init(MP / 256, DM / 256, gridDim.x, blockIdx.x, 1024, 1024);
      pg8::EpiEach<FMergeA> E{FMergeA{(const bf16_t*)(ws + WS_GAB), (float*)(ws + WS_TMPG)}};
      pg8::gemm_phase(lds, g, S, E); }
    { pg8::Gemm g{(const bf16_t*)(ws + WS_ODSA), (const bf16_t*)(ws + WS_BT_OB), 1024, 1024, 1024};
      pg8::StaticOrder S; S.init(MP / 256, DM / 256, gridDim.x, blockIdx.x, 1024, 1024);
      pg8::EpiEach<FMergeB> E{FMergeB{(const bf16_t*)(ws + WS_GAB), (const float*)(ws + WS_TMPG), (bf16_t*)(ws + WS_MG)}};
      pg8::gemm_phase(lds, g, S, E); }
}
struct FResX { const float* xp; const float* xs; float* dst; DI void operator()(const pg8::Unit& u, int row, int col, f32x4 v) const { const int r = u.pm * 256 + row, c = u.pn * 256 + col;
    f32x4 o = (f32x4){0.f, 0.f, 0.f, 0.f}; if (r < TT) o = v + (r < TP ? *(const f32x4*)(xp + (size_t)r * DM + c) : *(const f32x4*)(xs + (size_t)(r - TP) * DM + c)); *(f32x4*)(dst + (size_t)r * DM + c) = o; } };
struct FResW { const float* base; float* dst; DI void operator()(const pg8::Unit& u, int row, int col, f32x4 v) const { const int r = u.pm * 256 + row, c = u.pn * 256 + col;
    f32x4 o = (f32x4){0.f, 0.f, 0.f, 0.f}; if (r < TT) o = v + *(const f32x4*)(base + (size_t)r * DM + c); *(f32x4*)(dst + (size_t)r * DM + c) = o; } };
struct FStoreBf { bf16_t* C; int ldc; DI void operator()(const pg8::Unit& u, int row, int col, f32x4 v) const { *(u32x2*)(C + (size_t)(u.pm * 256 + row) * ldc + u.pn * 256 + col) = cvt4(v); } };

DI void phase8(const Args& a, LAS unsigned char* lds) {
    unsigned char* ws = a.ws;
    pg8::Gemm g{(const bf16_t*)(ws + WS_MG), (const bf16_t*)(ws + WS_BT_O), DM, DM, DM};
    pg8::StaticOrder S; S.init(MP / 256, DM / 256, gridDim.x, blockIdx.x, DM, DM);
    pg8::EpiEach<FResX> E{FResX{(const float*)a.in[I_XP], (const float*)a.in[I_XS], (float*)(ws + WS_X1)}};
    pg8::gemm_phase(lds, g, S, E);
}
DI void phase_norm(const Args& a, size_t ws_src, int gidx) {
    const int tid = threadIdx.x, lane = tid & 63, wave = __builtin_amdgcn_readfirstlane(tid >> 6);
    const int gw = blockIdx.x * NWAVES + wave, NGW = gridDim.x * NWAVES;
    for (int r = gw; r < TT; r += NGW) rms_row_bf16((const float*)(a.ws + ws_src) + (size_t)r * DM, (const float*)a.in[I_NG] + gidx * DM, (bf16_t*)(a.ws + WS_XN) + (size_t)r * DM, lane);
}
DI void phase10(const Args& a, LAS unsigned char* lds) {
    unsigned char* ws = a.ws;
    pg8::Gemm g{(const bf16_t*)(ws + WS_XN), (const bf16_t*)(ws + WS_BT_MQ), DM, DM, DM};
    pg8::StaticOrder S; S.init(MP / 256, 2, gridDim.x, blockIdx.x, DM, DM);
    pg8::EpiEach<FStoreBf> E{FStoreBf{(bf16_t*)(ws + WS_QMB), 512}};
    pg8::gemm_phase(lds, g, S, E);
}
DI void phase12(const Args& a, LAS unsigned char* lds) {
    unsigned char* ws = a.ws;
    pg8::Gemm g{(const bf16_t*)(ws + WS_OM), (const bf16_t*)(ws + WS_BT_MO), 512, 512, 512};
    pg8::StaticOrder S; S.init(MP / 256, DM / 256, gridDim.x, blockIdx.x, 512, 512);
    pg8::EpiEach<FResW> E{FResW{(const float*)(ws + WS_X1), (float*)(ws + WS_X2)}};
    pg8::gemm_phase(lds, g, S, E);
}
DI void phase14(const Args& a, LAS unsigned char* lds) {
    unsigned char* ws = a.ws;
    pg8::Gemm g{(const bf16_t*)(ws + WS_XN), (const bf16_t*)(ws + WS_BT_UP), DM, DM, DM};
    pg8::StaticOrder S; S.init(MP / 256, DFF2 / 256, gridDim.x, blockIdx.x, DM, DM);
    pg8::EpiEach<FStoreBf> E{FStoreBf{(bf16_t*)(ws + WS_UB), DFF2}};
    pg8::gemm_phase(lds, g, S, E);
}
DI void phase15(const Args& a, LAS unsigned char* lds) {
    const int tid = threadIdx.x, lane = tid & 63, wave = __builtin_amdgcn_readfirstlane(tid >> 6);
    const int gw = blockIdx.x * NWAVES + wave, NGW = gridDim.x * NWAVES;
    unsigned char* ws = a.ws;
    const bf16_t* U = (const bf16_t*)(ws + WS_UB); bf16_t* ACT = (bf16_t*)(ws + WS_ACT);
    const float* cw = (const float*)a.in[I_CVW]; const float* cb = (const float*)a.in[I_CVB];
    for (int r = gw; r < TT; r += NGW) {
        const bool pr = r < TP; const int s = r & 4095, q = r - TP, db = q >> 2, tt = q & 3, b = r >> 12;
        const int tin = pr ? s : tt;
        const float* st = (const float*)a.in[I_SCONV] + (size_t)db * 2 * DFF2;
        float* cout = nullptr;
        if (pr) { if (s >= SEQ - 2) cout = a.out + O_CONVP + ((size_t)b * 2 + (s - (SEQ - 2))) * DFF2; }
        else if (tt >= 2) cout = a.out + O_CONVS + ((size_t)db * 2 + (tt - 2)) * DFF2;
        for (int i = 0; i < DFF / 256; ++i) {
            const int c = 256 * i + 4 * lane;
            f32x4 res[2];
#pragma unroll
            for (int hf = 0; hf < 2; ++hf) { const int cc = c + hf * DFF;
                const f32x4 u0 = ldbf4(U + (size_t)r * DFF2 + cc);
                f32x4 u1, u2;
                if (tin >= 1) u1 = ldbf4(U + (size_t)(r - 1) * DFF2 + cc); else u1 = pr ? (f32x4){0.f, 0.f, 0.f, 0.f} : *(const f32x4*)(st + DFF2 + cc);
                if (tin >= 2) u2 = ldbf4(U + (size_t)(r - 2) * DFF2 + cc); else u2 = pr ? (f32x4){0.f, 0.f, 0.f, 0.f} : *(const f32x4*)(st + (size_t)tin * DFF2 + cc);
                res[hf] = *(const f32x4*)(cb + cc) + u2 * *(const f32x4*)(cw + cc) + u1 * *(const f32x4*)(cw + DFF2 + cc) + u0 * *(const f32x4*)(cw + 2 * DFF2 + cc);
                if (cout) *(f32x4*)(cout + cc) = u0; }
            f32x4 o; o.x = res[0].x * sigmoidf_(res[0].x) * res[1].x; o.y = res[0].y * sigmoidf_(res[0].y) * res[1].y; o.z = res[0].z * sigmoidf_(res[0].z) * res[1].z; o.w = res[0].w * sigmoidf_(res[0].w) * res[1].w;
            *(u32x2*)(ACT + (size_t)r * DFF + c) = cvt4(o);
        }
    }
}
DI void phase16(const Args& a, LAS unsigned char* lds) {
    unsigned char* ws = a.ws;
    pg8::Gemm g{(const bf16_t*)(ws + WS_ACT), (const bf16_t*)(ws + WS_BT_DN), DFF, DFF, DFF};
    pg8::StaticOrder S; S.init(MP / 256, DM / 256, gridDim.x, blockIdx.x, DFF, DFF);
    pg8::EpiEach<FResW> E{FResW{(const float*)(ws + WS_X2), (float*)(ws + WS_X3)}};
    pg8::gemm_phase(lds, g, S, E);
}
DI void phase17(const Args& a) {
    const int tid = threadIdx.x, lane = tid & 63, wave = __builtin_amdgcn_readfirstlane(tid >> 6);
    const int gw = blockIdx.x * NWAVES + wave, NGW = gridDim.x * NWAVES;
    const float* X3 = (const float*)(a.ws + WS_X3); const f32x4* gr = (const f32x4*)a.in[I_FG] + lane;
    for (int r = gw; r < TT; r += NGW) {
        const f32x4* xr = (const f32x4*)(X3 + (size_t)r * DM) + lane; f32x4 v[8]; float s = 0.f;
#pragma unroll
        for (int j = 0; j < 8; ++j) { v[j] = xr[64 * j]; s += (v[j].x * v[j].x + v[j].y * v[j].y) + (v[j].z * v[j].z + v[j].w * v[j].w); }
        const float rstd = rsqrtf(wave_sum(s) * (1.f / 2048.f) + 1e-6f);
        f32x4* o = (f32x4*)(a.out + (r < TP ? O_YP + (size_t)r * DM : O_YS + (size_t)(r - TP) * DM)) + lane;
#pragma unroll
        for (int j = 0; j < 8; ++j) o[64 * j] = v[j] * rstd * gr[64 * j];
    }
}
#define PHASES_REST \
    if (IN(3)) { phase3(args, lds); } SEAM(3); \
    if (IN(4)) { phase4(args, lds); } SEAM(4); \
    if (IN(5)) { phase5(args, lds); } SEAM(5); \
    if (IN(6)) { phase6(args, lds); } SEAM(6); \
    if (IN(7)) { phase7(args, lds); } SEAM(7); \
    if (IN(8)) { phase8(args, lds); } SEAM(8); \
    if (IN(9)) { phase_norm(args, WS_X1, 1); } SEAM(9); \
    if (IN(10)) { phase10(args, lds); } SEAM(10); \
    if (IN(11)) { phase11(args, lds); } SEAM(11); \
    if (IN(12)) { phase12(args, lds); } SEAM(12); \
    if (IN(13)) { phase_norm(args, WS_X2, 3); } SEAM(13); \
    if (IN(14)) { phase14(args, lds); } SEAM(14); \
    if (IN(15)) { phase15(args, lds); } SEAM(15); \
    if (IN(16)) { phase16(args, lds); } SEAM(16); \
    if (IN(17)) { phase17(args); }
#ifndef MK_N_LAUNCHES
#define MK_N_LAUNCHES 1
#endif
constexpr int N_PHASES = 18;
__global__ void __launch_bounds__(NTHR, 2) mk_fwd(Args args) {
    extern __shared__ __attribute__((aligned(16))) unsigned char lds_raw[];
    LAS unsigned char* lds = (LAS unsigned char*)lds_raw;
    volatile LAS unsigned* MISC = (volatile LAS unsigned*)(lds + MISC_OFF);
    const int tid = threadIdx.x;
    for (int u = tid; u < (LDS_BYTES - RING_BYTES) / 4; u += NTHR) ((LAS unsigned*)(lds + RING_BYTES))[u] = 0u;
    __syncthreads();
    unsigned* ctl = (unsigned*)(args.ws + WS_CTL);
    XcdBarrier bar; bar.bar = ctl + CW_BAR; bar.x = 0; bar.st = nullptr;
    const bool use_bar = (args.ph_hi - args.ph_lo) > 1;
    if (use_bar) bar = xcd_barrier_post(ctl + CW_BAR, MISC + 8);
    const int lo = args.ph_lo, hi = args.ph_hi;
#define IN(k) (lo <= (k) && (k) < hi)
#define SEAM(k) do { if (IN(k) && IN((k) + 1)) xcd_barrier(bar); } while (0)
    if (IN(0)) { phase0(args, lds); } SEAM(0);
    if (IN(1)) { phase1(args, lds); } SEAM(1);
    if (IN(2)) { phase2(args, lds); } SEAM(2);
    PHASES_REST
#undef IN
#undef SEAM
}

extern "C" void kernel_launch(void* const* d_in, const int* in_sizes, int n_in, void* d_out, int out_size, void* d_ws, size_t ws_size, hipStream_t stream) {
    static int grid = 0;
    if (grid == 0) {
        if (n_in != N_IN || (size_t)out_size != O_END || ws_size < WS_END) { fprintf(stderr, "kernel_launch: unexpected shapes: n_in %d out %d ws %zu (need %zu)\n", n_in, out_size, ws_size, (size_t)WS_END); grid = -1; return; }
        int dev = 0, cus = 0, per_cu = 0;
        if (hipGetDevice(&dev) != hipSuccess || hipDeviceGetAttribute(&cus, hipDeviceAttributeMultiprocessorCount, dev) != hipSuccess) { grid = -1; return; }
        if (hipFuncSetAttribute((const void*)mk_fwd, hipFuncAttributeMaxDynamicSharedMemorySize, LDS_BYTES) != hipSuccess) { fprintf(stderr, "kernel_launch: hipFuncSetAttribute failed\n"); grid = -1; return; }
        if (hipOccupancyMaxActiveBlocksPerMultiprocessor(&per_cu, (const void*)mk_fwd, NTHR, LDS_BYTES) != hipSuccess || per_cu < 1) fprintf(stderr, "kernel_launch: occupancy query reports %d\n", per_cu);
        (void)hipGetLastError();
        grid = cus;
    }
    if (grid < 0) return;
    (void)hipMemsetAsync((char*)d_ws + WS_CTL, 0, CTL_BYTES, stream);
    Args a{};
    for (int i = 0; i < N_IN; ++i) a.in[i] = d_in[i];
    a.out = (float*)d_out; a.ws = (unsigned char*)d_ws;
#if MK_N_LAUNCHES == 1
    a.ph_lo = 0; a.ph_hi = N_PHASES;
    hipLaunchKernelGGL(mk_fwd, dim3(grid), dim3(NTHR), LDS_BYTES, stream, a);
#else
    for (int p = 0; p < N_PHASES; ++p) { a.ph_lo = p; a.ph_hi = p + 1; hipLaunchKernelGGL(mk_fwd, dim3(grid), dim3(NTHR), LDS_BYTES, stream, a); }
#endif
}
```

```cpp
#include <hip/hip_runtime.h>
#include <cstdio>
#include <cstdint>

#define DI __device__ __forceinline__
#define LAS __attribute__((address_space(3)))
typedef unsigned short bf16_t;
typedef short bf16x8 __attribute__((ext_vector_type(8)));
typedef float f32x4 __attribute__((ext_vector_type(4)));
typedef float f32x2 __attribute__((ext_vector_type(2)));
typedef unsigned u32x4 __attribute__((ext_vector_type(4)));
typedef unsigned u32x2 __attribute__((ext_vector_type(2)));

constexpr int DM = 2048, SEQ = 4096, TP = 8192, TS = 128, TT = 8320, MP = 8448;
constexpr int DIN = 8320, DINP = 8448, DFF = 5632, DFF2 = 11264;
constexpr int NPAGES = 64;
constexpr int C_QA = 0, C_KVA = 1024, C_GA = 1792, C_QB = 1840, C_KVB = 2864, C_QI = 3120, C_KI = 4144, C_WI = 4208, C_GM = 4224;
constexpr size_t O_YP = 0, O_YS = O_YP + (size_t)TP * DM, O_NSAP = O_YS + (size_t)TS * DM, O_NSAS = O_NSAP + (size_t)TP * 512, O_WINP = O_NSAS + (size_t)TS * 512,
                 O_WINS = O_WINP + (size_t)2 * 512 * 256, O_DSAP = O_WINS + (size_t)32 * 512 * 256, O_DSAS = O_DSAP + (size_t)TP * 320, O_MEMP = O_DSAS + (size_t)TS * 320,
                 O_CONVP = O_MEMP + (size_t)512 * 1024, O_CONVS = O_CONVP + (size_t)2 * 2 * DFF2, O_END = O_CONVS + (size_t)32 * 2 * DFF2;
static_assert(O_END == 29708288, "output size");
enum { I_XP = 0, I_XS, I_MEM, I_CNSA, I_SWIN, I_CDSA, I_CMEM, I_SCONV, I_PT, I_NG, I_WIN, I_PE, I_CW1, I_CB1, I_CW2, I_WOA, I_WOB, I_WO, I_WMQ, I_WMKV, I_WMO, I_WUP, I_CVW, I_CVB, I_WDN, I_FG, N_IN };

constexpr size_t al256(size_t x) { return (x + 255) & ~(size_t)255; }
constexpr size_t WS_CTL = 0, CTL_BYTES = 1u << 20;
constexpr size_t WS_BT_IN = CTL_BYTES;
constexpr size_t WS_BT_OA = WS_BT_IN + (size_t)DINP * DM * 2;
constexpr size_t WS_BT_OB = WS_BT_OA + (size_t)DM * 1024 * 2;
constexpr size_t WS_BT_O = WS_BT_OB + (size_t)DM * 1024 * 2;
constexpr size_t WS_BT_MQ = WS_BT_O + (size_t)DM * DM * 2;
constexpr size_t WS_BT_MKV = WS_BT_MQ + (size_t)512 * DM * 2;
constexpr size_t WS_BT_MO = WS_BT_MKV + (size_t)1024 * DM * 2;
constexpr size_t WS_BT_UP = WS_BT_MO + (size_t)DM * 512 * 2;
constexpr size_t WS_BT_DN = WS_BT_UP + (size_t)DFF2 * DM * 2;
constexpr size_t WS_BT_C1 = WS_BT_DN + (size_t)DM * DFF * 2;
constexpr size_t WS_XN = WS_BT_C1 + (size_t)2 * 256 * 2048 * 2;
constexpr size_t WS_MEMN = WS_XN + (size_t)MP * DM * 2;
constexpr size_t WS_P = WS_MEMN + (size_t)512 * DM * 2;
constexpr size_t WS_QC = WS_P + (size_t)MP * DINP * 4;
constexpr size_t WS_QR = WS_QC + (size_t)MP * 1024 * 2;
constexpr size_t WS_QB = WS_QR + (size_t)MP * 1024 * 2;
constexpr size_t WS_QI = WS_QB + (size_t)MP * 1024 * 2;
constexpr size_t WS_GN = WS_QI + (size_t)MP * 1024 * 2;
constexpr size_t WS_WI = WS_GN + (size_t)MP * 48 * 4;
constexpr size_t WS_GAB = WS_WI + (size_t)MP * 16 * 4;
constexpr size_t WS_KW = WS_GAB + (size_t)MP * 4096 * 2;
constexpr int KCP_ROWS = SEQ + 32;
constexpr size_t WS_KCRAW = WS_KW + (size_t)MP * 256 * 4;
constexpr size_t KCS_OFF = (size_t)8 * KCP_ROWS * 64;
constexpr size_t WS_BPART = al256(WS_KCRAW + (KCS_OFF + (size_t)128 * 8192 * 64 + 64 * 64) * 2);
constexpr size_t WS_BIASC = WS_BPART + 16 * 512 * 4;
constexpr int HC_ROWS = 132 * 256;
constexpr size_t WS_HC = WS_BIASC + 512 * 4;
constexpr size_t WS_KCV = WS_HC + (size_t)2 * HC_ROWS * 256 * 2;
constexpr size_t WS_OCMP = WS_KCV + (size_t)34 * 4 * 512 * 64 * 4;
constexpr size_t WS_SEL = WS_OCMP + (size_t)MP * 1024 * 4;
constexpr size_t WS_IDX = WS_SEL + (size_t)MP * 32 * 4;
constexpr size_t WS_ONSA = WS_IDX + (size_t)MP * 256 * 4;
constexpr size_t WS_ODSA = WS_ONSA + (size_t)MP * 1024 * 2;
constexpr size_t WS_TMPG = WS_ODSA + (size_t)MP * 1024 * 2;
constexpr size_t WS_MG = WS_TMPG + (size_t)MP * DM * 4;
constexpr size_t WS_X1 = WS_MG + (size_t)MP * DM * 2;
constexpr size_t WS_X2 = WS_X1 + (size_t)MP * DM * 4;
constexpr size_t WS_X3 = WS_X2 + (size_t)MP * DM * 4;
constexpr size_t WS_QMB = WS_X3 + (size_t)MP * DM * 4;
constexpr size_t WS_OM = WS_QMB + (size_t)MP * 512 * 2;
constexpr size_t WS_UB = WS_OM + (size_t)MP * 512 * 2;
constexpr size_t WS_ACT = WS_UB + (size_t)MP * DFF2 * 2;
constexpr size_t WS_NSAF = WS_ACT + (size_t)MP * DFF * 2;
constexpr size_t WS_KCF = WS_NSAF + (size_t)4 * 128 * 8192 * 2;
constexpr size_t WS_KIF = WS_KCF + (size_t)34 * 2 * 16 * 4096 * 2;
constexpr size_t WS_DSAB = WS_KIF + (size_t)2 * 256 * 1024 * 2;
constexpr size_t WS_PART = WS_DSAB + (size_t)2 * 4096 * 256 * 2;
constexpr size_t WS_END = WS_PART + (size_t)22 * 128 * DM * 4;
static_assert(WS_END < (size_t)2400 * 1024 * 1024, "ws map too large");
constexpr int CW_BAR = 4096;

constexpr int RING_BYTES = 131072, LDS_BYTES = 147456, MISC_OFF = LDS_BYTES - 256;

#define LDS_WAIT() asm volatile("s_waitcnt lgkmcnt(0)" ::: "memory")
#define VM_WAIT() asm volatile("s_waitcnt vmcnt(0)" ::: "memory")
DI unsigned cvt_pk_bf16(float lo, float hi) { unsigned r; asm volatile("v_cvt_pk_bf16_f32 %0, %1, %2" : "=v"(r) : "v"(lo), "v"(hi)); return r; }
DI float bf2f(bf16_t b) { return __uint_as_float(((unsigned)b) << 16); }
DI bf16x8 cvt8(f32x4 a, f32x4 b) { u32x4 w; w.x = cvt_pk_bf16(a.x, a.y); w.y = cvt_pk_bf16(a.z, a.w); w.z = cvt_pk_bf16(b.x, b.y); w.w = cvt_pk_bf16(b.z, b.w); return __builtin_bit_cast(bf16x8, w); }
DI u32x2 cvt4(f32x4 a) { u32x2 w; w.x = cvt_pk_bf16(a.x, a.y); w.y = cvt_pk_bf16(a.z, a.w); return w; }
DI float wave_sum(float v) {
#pragma unroll
    for (int o = 1; o < 64; o <<= 1) v += __shfl_xor(v, o);
    return v;
}
DI f32x4 shfl_xor4(f32x4 v, int m) { f32x4 r; r.x = __shfl_xor(v.x, m); r.y = __shfl_xor(v.y, m); r.z = __shfl_xor(v.z, m); r.w = __shfl_xor(v.w, m); return r; }
DI float sigmoidf_(float x) { return 1.f / (1.f + __expf(-x)); }
#define MFMA16(a, b, c) __builtin_amdgcn_mfma_f32_16x16x32_bf16((a), (b), (c), 0, 0, 0)
namespace pg8 {
constexpr int BM = 256, BK = 64, HALF = 128, HTB = HALF * BK * 2  , STAGE_BYTES = 8 * HTB, NXCD = 8, WGM = 8;
__host__ __device__ __forceinline__ int lds_byte(int r, int c) { const int st = (r >> 4) * 2 + (c >> 5), rr = r & 15, cc = c & 31, ob = rr * 64 + cc * 2; return st * 1024 + (ob ^ (((ob >> 9) & 1) << 5)); }
__host__ __device__ __forceinline__ void stage_rc(int b, int& R, int& C) { const int st = b / 1024, sb = b % 1024, swz = sb ^ (((sb >> 9) & 1) << 5); R = (st >> 1) * 16 + swz / 64; C = (st & 1) * 32 + (swz % 64) / 2; }

struct Unit { int pm, pn, ks; };
struct Gemm { const bf16_t* A; const bf16_t* Bt; int lda, ldb, K; };

struct StaticOrder {
    int nM, nN, nwg, G, c, lda, ldb;
    __device__ void init(int nM_, int nN_, int G_, int c_, int lda_, int ldb_) { nM = nM_; nN = nN_; nwg = nM * nN; G = G_; c = c_; lda = lda_; ldb = ldb_; }
    __device__ bool next(int i, Unit& u) const { return at((long)i * G + c, u); }
    __device__ bool at(long L, Unit& u) const {
        if (L >= nwg) return false;
        int wgid = (int)L; { const int q = nwg / NXCD, r = nwg % NXCD, xcd = wgid % NXCD, off = wgid / NXCD; wgid = (xcd < r ? xcd * (q + 1) : r * (q + 1) + (xcd - r) * q) + off; }
        const int nig = WGM * nN, gid = wgid / nig, fm = gid * WGM, gsz = (nM - fm) < WGM ? (nM - fm) : WGM;
        u.pm = fm + ((wgid % nig) % gsz); u.pn = (wgid % nig) / gsz; u.ks = 0; return true;
    }
    __device__ __forceinline__ size_t offA(const Unit& u) const { return (size_t)u.pm * BM * lda * 2; }
    __device__ __forceinline__ size_t offB(const Unit& u) const { return (size_t)u.pn * BM * ldb * 2; }
};

template <class F> struct EpiEach {
    F f;
    __device__ __forceinline__ void operator()(const f32x4 (&acc)[2][2][4][2], const Unit& u, int wr, int wc, int fr, int fq) const {
#pragma unroll
        for (int ai = 0; ai < 2; ++ai)
#pragma unroll
            for (int m = 0; m < 4; ++m) { const int row = ai * HALF + wr * 64 + m * 16 + fr;
#pragma unroll
                for (int bj = 0; bj < 2; ++bj)
#pragma unroll
                    for (int n = 0; n < 2; ++n) f(u, row, bj * HALF + wc * 32 + n * 16 + 4 * fq, acc[ai][bj][m][n]); }
    }
};

template <class Epi, class Sched>
__device__ __forceinline__ void gemm_phase(LAS unsigned char* lds, const Gemm g, const Sched& S, const Epi& E) {
    const int tid = threadIdx.x, wid = __builtin_amdgcn_readfirstlane(tid >> 6), lane = tid & 63, wr = wid >> 2, wc = wid & 3, fr = lane & 15, fq = lane >> 4;
    const int nt = g.K / BK;
    unsigned voffA[2], voffB[2];
#pragma unroll
    for (int i = 0; i < 2; ++i) { int R, C; stage_rc(tid * 16 + i * 8192, R, C); voffA[i] = (unsigned)(R * g.lda + C) * 2u; voffB[i] = (unsigned)(R * g.ldb + C) * 2u; }
    const size_t kstep = (size_t)(BK * 2);
    const size_t hA = (size_t)HALF * g.lda * 2, hB = (size_t)HALF * g.ldb * 2;
    const unsigned ldsw = (unsigned)wid * 1024u;
    const int aoff = lds_byte(wr * 64 + fr, fq * 8), boff = lds_byte(wc * 32 + fr, fq * 8);
#define PG8_SA(b, h) (((b) * 2 + (h)) * HTB)
#define PG8_SB(b, h) ((4 + (b) * 2 + (h)) * HTB)
#define PG8_STAGE(bufoff, gbase, voff) do { _Pragma("unroll") for (int _i = 0; _i < 2; ++_i) \
        __builtin_amdgcn_global_load_lds((const unsigned*)((const char*)(gbase) + (voff)[_i]), (LAS unsigned*)(lds + (bufoff) + ldsw + _i * 8192), 16, 0, 0); } while (0)
#define PG8_LDA(dst, b, h) do { _Pragma("unroll") for (int m = 0; m < 4; ++m) _Pragma("unroll") for (int k = 0; k < 2; ++k) dst[m][k] = *(const LAS bf16x8*)(lds + PG8_SA(b, h) + aoff + m * 2048 + k * 1024); } while (0)
#define PG8_LDB(dst, b, h) do { _Pragma("unroll") for (int n = 0; n < 2; ++n) _Pragma("unroll") for (int k = 0; k < 2; ++k) dst[n][k] = *(const LAS bf16x8*)(lds + PG8_SB(b, h) + boff + n * 2048 + k * 1024); } while (0)
#define PG8_MMA(ai, bj, At, Bt) do { __builtin_amdgcn_s_setprio(1); _Pragma("unroll") for (int m = 0; m < 4; ++m) _Pragma("unroll") for (int n = 0; n < 2; ++n) _Pragma("unroll") for (int k = 0; k < 2; ++k) \
        acc[ai][bj][m][n] = __builtin_amdgcn_mfma_f32_16x16x32_bf16(Bt[n][k], At[m][k], acc[ai][bj][m][n], 0, 0, 0); __builtin_amdgcn_s_setprio(0); } while (0)
#define PG8_WAIT_V(n) asm volatile("s_waitcnt vmcnt(" #n ")" ::: "memory")
#define PG8_WAIT_L(n) asm volatile("s_waitcnt lgkmcnt(" #n ")" ::: "memory")
#define PG8_BAR __builtin_amdgcn_s_barrier()
#define PG8_SCHED __builtin_amdgcn_sched_barrier(0)
    Unit cur, nxt; int ui = 0;
    if (!S.next(0, cur)) return;
    f32x4 acc[2][2][4][2];
#pragma unroll
    for (int a = 0; a < 2; ++a)
#pragma unroll
        for (int b = 0; b < 2; ++b)
#pragma unroll
            for (int m = 0; m < 4; ++m)
#pragma unroll
                for (int n = 0; n < 2; ++n) acc[a][b][m][n] = (f32x4){0.f, 0.f, 0.f, 0.f};
    bf16x8 At[4][2], B0[2][2], B1[2][2];
    const char* cA = (const char*)g.A + S.offA(cur); const char* cB = (const char*)g.Bt + S.offB(cur);
    PG8_STAGE(PG8_SB(0, 0), cB, voffB); PG8_STAGE(PG8_SB(0, 1), cB + hB, voffB); PG8_STAGE(PG8_SA(0, 0), cA, voffA); PG8_STAGE(PG8_SA(0, 1), cA + hA, voffA);
    if (wr == 1) PG8_BAR;
    PG8_WAIT_V(2); PG8_BAR;
    PG8_STAGE(PG8_SB(1, 0), cB + kstep, voffB); PG8_STAGE(PG8_SA(1, 0), cA + kstep, voffA); PG8_STAGE(PG8_SB(1, 1), cB + hB + kstep, voffB);
    PG8_WAIT_V(6); PG8_BAR;
    for (;;) {
        const bool has_next = S.next(ui + 1, nxt);
        const char* nA = has_next ? (const char*)g.A + S.offA(nxt) : cA; const char* nB = has_next ? (const char*)g.Bt + S.offB(nxt) : cB;
        for (int t = 0; t < nt; t += 2) {
            const bool last = (t == nt - 2);
            const char* a1 = cA + (size_t)(t + 1) * kstep;
            const char* a2 = last ? nA : cA + (size_t)(t + 2) * kstep; const char* b2 = last ? nB : cB + (size_t)(t + 2) * kstep;
            const char* a3 = a2 + kstep; const char* b3 = b2 + kstep;
            PG8_LDB(B0, 0, 0); PG8_LDB(B1, 0, 1); PG8_SCHED; PG8_LDA(At, 0, 0); PG8_STAGE(PG8_SA(1, 1), a1 + hA, voffA);
            PG8_WAIT_V(8); PG8_WAIT_L(0); PG8_BAR; PG8_MMA(0, 0, At, B0); PG8_MMA(0, 1, At, B1); PG8_BAR; PG8_SCHED;
            PG8_LDA(At, 0, 1); PG8_STAGE(PG8_SB(0, 0), b2, voffB); PG8_STAGE(PG8_SB(0, 1), b2 + hB, voffB); PG8_STAGE(PG8_SA(0, 0), a2, voffA);
            PG8_WAIT_V(8); PG8_WAIT_L(0); PG8_BAR; PG8_MMA(1, 0, At, B0); PG8_MMA(1, 1, At, B1); PG8_BAR; PG8_SCHED;
            PG8_LDB(B0, 1, 0); PG8_LDB(B1, 1, 1); PG8_SCHED; PG8_LDA(At, 1, 0); PG8_STAGE(PG8_SA(0, 1), a2 + hA, voffA);
            PG8_WAIT_V(8); PG8_WAIT_L(0); PG8_BAR; PG8_MMA(0, 0, At, B0); PG8_MMA(0, 1, At, B1); PG8_BAR; PG8_SCHED;
            PG8_LDA(At, 1, 1); PG8_STAGE(PG8_SB(1, 0), b3, voffB); PG8_STAGE(PG8_SB(1, 1), b3 + hB, voffB); PG8_STAGE(PG8_SA(1, 0), a3, voffA);
            PG8_WAIT_V(8); PG8_WAIT_L(0); PG8_BAR; PG8_MMA(1, 0, At, B0); PG8_MMA(1, 1, At, B1); PG8_BAR; PG8_SCHED;
        }
        if (wr == 0) PG8_BAR;
        E(acc, cur, wr, wc, fr, fq);
        if (!has_next) break;
#pragma unroll
        for (int a = 0; a < 2; ++a)
#pragma unroll
            for (int b = 0; b < 2; ++b)
#pragma unroll
                for (int m = 0; m < 4; ++m)
#pragma unroll
                    for (int n = 0; n < 2; ++n) acc[a][b][m][n] = (f32x4){0.f, 0.f, 0.f, 0.f};
        cur = nxt; cA = nA; cB = nB; ++ui;
        if (wr == 1) PG8_BAR;
    }
    PG8_WAIT_V(0);
    PG8_BAR;
#undef PG8_SA
#undef PG8_SB
#undef PG8_STAGE
#undef PG8_LDA
#undef PG8_LDB
#undef PG8_MMA
#undef PG8_WAIT_V
#undef PG8_WAIT_L
#undef PG8_BAR
#undef PG8_SCHED
}
}
#define XB_TMO      128
#define XB_XCNT(j)  (256  + 64 * (j))
#define XB_XSUB(j)  (1280 + 64 * (j))
#define XB_XGEN(j)  (2304 + 64 * (j))
#define XB_TOP      3328
#define XB_TOPGEN   3392
#define XCD_BAR_WORDS 3456
#define XB_SPIN_CAP (1u << 18)

__device__ __forceinline__ unsigned xb_ld(unsigned* p)              { return __hip_atomic_load(p, __ATOMIC_RELAXED, __HIP_MEMORY_SCOPE_AGENT); }
__device__ __forceinline__ unsigned xb_add(unsigned* p, unsigned v) { return __hip_atomic_fetch_add(p, v, __ATOMIC_RELAXED, __HIP_MEMORY_SCOPE_AGENT); }
__device__ __forceinline__ unsigned xb_xcc_id() { return (unsigned)__builtin_amdgcn_s_getreg((3 << 11) | 20) & 0xFu; }
#define XB_SPIN(cond, bar) do { unsigned _sp = 0; while (cond) { __builtin_amdgcn_s_sleep(1); \
    if ((++_sp & 255u) == 0u) { if (xb_ld(&(bar)[XB_TMO])) break; if (_sp > XB_SPIN_CAP) { atomicAdd(&(bar)[XB_TMO], 1u); break; } } } } while (0)

struct XcdBarrier {
    unsigned* bar; unsigned x;
    volatile LAS unsigned* st;
};

__device__ __forceinline__ XcdBarrier xcd_barrier_post(unsigned* bar, volatile LAS unsigned* st) {
    XcdBarrier b; b.bar = bar; b.x = xb_xcc_id(); b.st = st;
    if (threadIdx.x == 0) (void)xb_add(&bar[XB_XCNT(b.x)], 1u);
    return b;
}
__device__ __forceinline__ void xcd_barrier_complete(unsigned* bar, unsigned x, unsigned& nloc, unsigned& nx) {
    const unsigned G = gridDim.x * gridDim.y * gridDim.z;
    unsigned sum, cnt, mine, sp = 0u;
    for (;;) {
        sum = 0u; cnt = 0u; mine = 0u;
#pragma unroll
        for (unsigned j = 0; j < 16; ++j) { const unsigned c = xb_ld(&bar[XB_XCNT(j)]); sum += c; cnt += (c > 0u) ? 1u : 0u; mine = (j == x) ? c : mine; }
        if (sum == G) break;
        __builtin_amdgcn_s_sleep(1);
        if ((++sp & 255u) == 0u) { if (xb_ld(&bar[XB_TMO])) break; if (sp > XB_SPIN_CAP) { atomicAdd(&bar[XB_TMO], 1u); break; } }
    }
    nloc = mine > 0u ? mine : 1u; nx = cnt > 0u ? cnt : 1u;
}

__device__ __forceinline__ void xcd_barrier(const XcdBarrier& b) {
    asm volatile("s_waitcnt vmcnt(0)" ::: "memory");
    __syncthreads();
    if (threadIdx.x == 0) {
        unsigned* bar = b.bar;
        __builtin_amdgcn_s_waitcnt(0);
        unsigned nloc = b.st[0], nx = b.st[1];
        if (nloc == 0u) { xcd_barrier_complete(bar, b.x, nloc, nx); b.st[0] = nloc; b.st[1] = nx; }
        const unsigned old = xb_add(&bar[XB_XSUB(b.x)], 1u);
        const unsigned gen = old / nloc;
        if (old + 1u == (gen + 1u) * nloc) {
            __builtin_amdgcn_fence(__ATOMIC_RELEASE, "agent");
            asm volatile("s_waitcnt vmcnt(0)" ::: "memory");
            const unsigned og = xb_add(&bar[XB_TOP], 1u);
            const unsigned tg = og / nx;
            if (og + 1u == (tg + 1u) * nx) xb_add(&bar[XB_TOPGEN], 1u);
            else XB_SPIN(xb_ld(&bar[XB_TOPGEN]) == tg, bar);
            __builtin_amdgcn_fence(__ATOMIC_ACQUIRE, "agent");
            xb_add(&bar[XB_XGEN(b.x)], 1u);
            asm volatile("s_waitcnt vmcnt(0)" ::: "memory");
        } else {
            XB_SPIN(xb_ld(&bar[XB_XGEN(b.x)]) == gen, bar);
            __builtin_amdgcn_fence(__ATOMIC_ACQUIRE, "agent");
            asm volatile("s_waitcnt vmcnt(0)" ::: "memory");
        }
    }
    __syncthreads();
}
struct Args { const void* in[N_IN]; float* out; unsigned char* ws; int ph_lo, ph_hi; };
constexpr int NWAVES = 8, NTHR = 512;

struct FStoreF32 { float* C; int ldc; DI void operator()(const pg8::Unit& u, int row, int col, f32x4 v) const { *(f32x4*)(C + (size_t)(u.pm * 256 + row) * ldc + u.pn * 256 + col) = v; } };

DI void p0_transpose_item(const float* W, int K, int N, bf16_t* WT, LAS float* scr, int item, int lane) {
    const int nblk = N / 32, kb = item / nblk, nb = item % nblk, k0 = 64 * kb, n0 = 32 * nb;
#pragma unroll 8
    for (int i = 0; i < 32; ++i) { const int kk = 2 * i + (lane >> 5); scr[kk * 33 + (lane & 31)] = W[(size_t)(k0 + kk) * N + n0 + (lane & 31)]; }
    LDS_WAIT();
    const int c = lane & 7;
#pragma unroll
    for (int j = 0; j < 4; ++j) { const int n = (lane >> 3) + 8 * j; const LAS float* s = scr + (8 * c) * 33 + n;
        u32x4 o; o.x = cvt_pk_bf16(s[0 * 33], s[1 * 33]); o.y = cvt_pk_bf16(s[2 * 33], s[3 * 33]); o.z = cvt_pk_bf16(s[4 * 33], s[5 * 33]); o.w = cvt_pk_bf16(s[6 * 33], s[7 * 33]);
        *(u32x4*)(WT + (size_t)(n0 + n) * K + k0 + 8 * c) = o; }
    LDS_WAIT();
}
DI void rms_row_bf16(const float* xrow, const float* g, bf16_t* orow, int lane) {
    const f32x4* xr = (const f32x4*)xrow + lane; const f32x4* gr = (const f32x4*)g + lane;
    f32x4 v[8]; float s = 0.f;
#pragma unroll
    for (int j = 0; j < 8; ++j) { v[j] = xr[64 * j]; s += (v[j].x * v[j].x + v[j].y * v[j].y) + (v[j].z * v[j].z + v[j].w * v[j].w); }
    const float rstd = rsqrtf(wave_sum(s) * (1.f / 2048.f) + 1e-6f);
    u32x2* o8 = (u32x2*)orow + lane;
#pragma unroll
    for (int j = 0; j < 8; ++j) { const f32x4 gg = gr[64 * j]; o8[64 * j] = cvt4(v[j] * rstd * gg); }
}

constexpr int NT_IN = 32 * 260, NT_OA = 16 * 64, NT_O = 32 * 64, NT_MQ = 32 * 16, NT_MKV = 32 * 32, NT_MO = 8 * 64, NT_UP = 32 * 352, NT_DN = 88 * 64, NT_C1 = 32 * 8;
constexpr int N_PG = 32 * NPAGES, N_BP = 128, N_WC = 32 * 508;
constexpr int PI_A = NT_IN + NT_MKV + TT + 512;
constexpr int PI_B = PI_A + N_PG + 2 * NT_C1 + N_BP + N_WC;
constexpr int PI_C = PI_B + NT_UP + NT_DN + NT_O + 2 * NT_OA + NT_MQ + NT_MO;
DI void prologue_item(const Args& a, LAS float* scr, int lane, int it) {
    unsigned char* ws = a.ws; int r = it;
    if (r < NT_IN) { p0_transpose_item((const float*)a.in[I_WIN], DM, DIN, (bf16_t*)(ws + WS_BT_IN), scr, r, lane); return; } r -= NT_IN;
    if (r < NT_MKV) { p0_transpose_item((const float*)a.in[I_WMKV], DM, 1024, (bf16_t*)(ws + WS_BT_MKV), scr, r, lane); return; } r -= NT_MKV;
    if (r < TT) {
        const float* xrow = r < TP ? (const float*)a.in[I_XP] + (size_t)r * DM : (const float*)a.in[I_XS] + (size_t)(r - TP) * DM;
        rms_row_bf16(xrow, (const float*)a.in[I_NG], (bf16_t*)(ws + WS_XN) + (size_t)r * DM, lane); return; } r -= TT;
    if (r < 512) { rms_row_bf16((const float*)a.in[I_MEM] + (size_t)r * DM, (const float*)a.in[I_NG] + 2 * DM, (bf16_t*)(ws + WS_MEMN) + (size_t)r * DM, lane); return; } r -= 512;
    if (r < N_PG) {
        const int db = r >> 6, pj = r & 63; const int page = ((const int*)a.in[I_PT])[db * NPAGES + pj];
        const float* src = (const float*)a.in[I_CNSA] + (size_t)page * 128 * 512;
        bf16_t* dst = (bf16_t*)(ws + WS_KCRAW) + KCS_OFF;
        const int c = lane >> 5, g = (lane >> 4) & 1, d0 = (lane & 15) * 4;
        bf16_t* drow = dst + ((size_t)((db * 2 + c) * 2 + g) * 8192 + pj * 128) * 64 + d0;
#pragma unroll 8
        for (int s = 0; s < 128; ++s) { const f32x4 v = *(const f32x4*)(src + (size_t)s * 512 + lane * 4); *(u32x2*)(drow + (size_t)s * 64) = cvt4(v); }
        return; } r -= N_PG;
    if (r < NT_C1) { p0_transpose_item((const float*)a.in[I_CW1], 2048, 256, (bf16_t*)(ws + WS_BT_C1), scr, r, lane); return; } r -= NT_C1;
    if (r < NT_C1) { p0_transpose_item((const float*)a.in[I_CW1] + (size_t)2048 * 256, 2048, 256, (bf16_t*)(ws + WS_BT_C1) + (size_t)256 * 2048, scr, r, lane); return; } r -= NT_C1;
    if (r < N_BP) {
        const int kv = r >> 6, nch = (r >> 4) & 3, kch = r & 15, n = nch * 64 + lane;
        const float* pe = (const float*)a.in[I_PE] + (size_t)kv * 2048 + kch * 128; const float* w1 = (const float*)a.in[I_CW1] + ((size_t)kv * 2048 + kch * 128) * 256 + n;
        float acc = 0.f;
#pragma unroll 8
        for (int k = 0; k < 128; ++k) acc += pe[k] * w1[(size_t)k * 256];
        ((float*)(ws + WS_BPART))[(kch * 2 + kv) * 256 + n] = acc; return; } r -= N_BP;
    if (r < N_WC) {
        const int db = r / 508, j = r % 508;
        const f32x4 v = *((const f32x4*)((const float*)a.in[I_SWIN] + ((size_t)db * 512 + j + 4) * 256) + lane);
        *((f32x4*)(a.out + O_WINS + ((size_t)db * 512 + j) * 256) + lane) = v; return; } r -= N_WC;
    if (r < NT_UP) { p0_transpose_item((const float*)a.in[I_WUP], DM, DFF2, (bf16_t*)(ws + WS_BT_UP), scr, r, lane); return; } r -= NT_UP;
    if (r < NT_DN) { p0_transpose_item((const float*)a.in[I_WDN], DFF, DM, (bf16_t*)(ws + WS_BT_DN), scr, r, lane); return; } r -= NT_DN;
    if (r < NT_O) { p0_transpose_item((const float*)a.in[I_WO], DM, DM, (bf16_t*)(ws + WS_BT_O), scr, r, lane); return; } r -= NT_O;
    if (r < NT_OA) { p0_transpose_item((const float*)a.in[I_WOA], 1024, DM, (bf16_t*)(ws + WS_BT_OA), scr, r, lane); return; } r -= NT_OA;
    if (r < NT_OA) { p0_transpose_item((const float*)a.in[I_WOB], 1024, DM, (bf16_t*)(ws + WS_BT_OB), scr, r, lane); return; } r -= NT_OA;
    if (r < NT_MQ) { p0_transpose_item((const float*)a.in[I_WMQ], DM, 512, (bf16_t*)(ws + WS_BT_MQ), scr, r, lane); return; } r -= NT_MQ;
    p0_transpose_item((const float*)a.in[I_WMO], 512, DM, (bf16_t*)(ws + WS_BT_MO), scr, r, lane);
}
DI void prologue_fill(const Args& a, LAS unsigned char* lds, unsigned* ctr, int lo, int hi) {
    const int tid = threadIdx.x, lane = tid & 63, wave = __builtin_amdgcn_readfirstlane(tid >> 6);
    LAS float* scr = (LAS float*)(lds + wave * 16384);
#pragma unroll 1
    for (;;) { int v = 0; if (lane == 0) v = (int)__hip_atomic_fetch_add(ctr, 1u, __ATOMIC_RELAXED, __HIP_MEMORY_SCOPE_AGENT); const int it = lo + __builtin_amdgcn_readfirstlane(v); if (it >= hi) break; prologue_item(a, scr, lane, it); }
}
DI void phase0(const Args& a, LAS unsigned char* lds) {
    const int tid = threadIdx.x, lane = tid & 63, wave = __builtin_amdgcn_readfirstlane(tid >> 6);
    const int gw = blockIdx.x * NWAVES + wave, NGW = gridDim.x * NWAVES;
    LAS float* scr = (LAS float*)(lds + wave * 16384);
    unsigned char* ws = a.ws;
#pragma unroll 1
    for (int it = gw; it < PI_C; it += NGW) prologue_item(a, scr, lane, it);
    { const size_t gt = (size_t)blockIdx.x * NTHR + tid, NG = (size_t)gridDim.x * NTHR; const u32x4 z = (u32x4){0u, 0u, 0u, 0u};
      u32x4* p1 = (u32x4*)((bf16_t*)(ws + WS_BT_IN) + (size_t)DIN * DM); u32x4* p2 = (u32x4*)((bf16_t*)(ws + WS_XN) + (size_t)TT * DM);
      for (size_t i = gt; i < (size_t)128 * DM / 8; i += NG) { p1[i] = z; p2[i] = z; } }
}

DI f32x4 rope4(f32x4 v, f32x4 pv, int d0, int half, int tb, float cv, float sv) {
    const int fi = tb + (d0 & (half - 1));
    f32x4 c, s;
    c.x = __shfl(cv, fi); c.y = __shfl(cv, fi + 1); c.z = __shfl(cv, fi + 2); c.w = __shfl(cv, fi + 3);
    s.x = __shfl(sv, fi); s.y = __shfl(sv, fi + 1); s.z = __shfl(sv, fi + 2); s.w = __shfl(sv, fi + 3);
    const f32x4 lo = v * c - pv * s, hi = v * c + pv * s;
    return d0 < half ? lo : (d0 < 2 * half ? hi : v);
}
DI f32x4 sig4(f32x4 v) { f32x4 r; r.x = sigmoidf_(v.x); r.y = sigmoidf_(v.y); r.z = sigmoidf_(v.z); r.w = sigmoidf_(v.w); return r; }

DI void phase2(const Args& a, LAS unsigned char* lds) {
    const int tid = threadIdx.x, lane = tid & 63, wave = __builtin_amdgcn_readfirstlane(tid >> 6);
    const int gw = blockIdx.x * NWAVES + wave, NGW = gridDim.x * NWAVES;
    unsigned char* ws = a.ws; float* out = a.out;
    const float* P = (const float*)(ws + WS_P);
    bf16_t* QC = (bf16_t*)(ws + WS_QC); bf16_t* QR = (bf16_t*)(ws + WS_QR); bf16_t* QB = (bf16_t*)(ws + WS_QB); bf16_t* QI = (bf16_t*)(ws + WS_QI);
    float* GN = (float*)(ws + WS_GN); float* WI = (float*)(ws + WS_WI); bf16_t* GAB = (bf16_t*)(ws + WS_GAB); float* KW = (float*)(ws + WS_KW);
    bf16_t* KCP = (bf16_t*)(ws + WS_KCRAW); bf16_t* NSAF = (bf16_t*)(ws + WS_NSAF);
    if (gw == 0) {
        for (int i = lane; i < 512; i += 64) { float s = ((const float*)a.in[I_CB1])[i];
            for (int k = 0; k < 16; ++k) s += ((const float*)(ws + WS_BPART))[k * 512 + i];
            ((float*)(ws + WS_BIASC))[i] = s; }
    }
    for (int r = gw; r < TT; r += NGW) {
        const bool pr = r < TP; const int b = r >> 12, s = r & 4095, q = r - TP, db = q >> 2, tt = q & 3;
        const int pos = pr ? s : 8192 + tt;
        float cv, sv; { const float e = lane < 8 ? -(float)lane / 8.f : -(float)((lane - 8) & 15) / 16.f; const float inv = powf(500000.f, e); const float ang = (float)pos * inv; cv = cosf(ang); sv = sinf(ang); }
        const float* Pr = P + (size_t)r * DINP;
#pragma unroll
        for (int i = 0; i < 4; ++i) { const int col = 256 * i + 4 * lane; const f32x4 v = *(const f32x4*)(Pr + C_QA + col); const f32x4 pv = shfl_xor4(v, 2);
            const f32x4 rv = rope4(v, pv, (4 * lane) & 63, 8, 0, cv, sv);
            *(u32x2*)(QC + (size_t)r * 1024 + col) = cvt4(v); *(u32x2*)(QR + (size_t)r * 1024 + col) = cvt4(rv); }
#pragma unroll
        for (int i = 0; i < 3; ++i) { const int cl = 256 * i + 4 * lane; const f32x4 v = *(const f32x4*)(Pr + C_KVA + cl); const f32x4 pv = shfl_xor4(v, 2);
            const int j = cl >> 7, g = (cl >> 6) & 1, d0 = cl & 63;
            const f32x4 rv = rope4(v, pv, d0, 8, 0, cv, sv); const f32x4 o = (j == 2 || j == 4) ? rv : v;
            if (pr && j >= 2) {
                bf16_t* tile = NSAF + ((size_t)((b * 2 + g) * 128 + (s >> 5)) * 4 + (j - 2)) * 2048; const int slot = s & 31;
                if ((j & 1) == 0) { *(u32x2*)(tile + (((d0 >> 5) * 2 + (slot >> 4)) * 64 + ((d0 >> 3) & 3) * 16 + (slot & 15)) * 8 + ((d0 >> 2) & 1) * 4) = cvt4(o); }
                else { const int kgv = (slot & 15) >> 2, jv = (slot & 3) + ((slot >> 4) << 2); const u32x2 w = cvt4(o);
                    bf16_t* t0 = tile + (((d0 >> 4) * 64 + kgv * 16 + (d0 & 15)) * 8) + jv;
                    t0[0] = (bf16_t)(w.x & 0xffffu); t0[8] = (bf16_t)(w.x >> 16); t0[16] = (bf16_t)(w.y & 0xffffu); t0[24] = (bf16_t)(w.y >> 16); }
            }
            if (j < 4) {
                float* dst = pr ? out + O_NSAP + ((size_t)r * 4 + j) * 128 + g * 64 + d0 : out + O_NSAS + ((size_t)q * 4 + j) * 128 + g * 64 + d0;
                *(f32x4*)dst = o;
                if (pr && j < 2) *(u32x2*)(KCP + ((size_t)((b * 2 + j) * 2 + g) * KCP_ROWS + s) * 64 + d0) = cvt4(o);
            } else {
                const int kv = j - 4;
                *(f32x4*)(KW + (size_t)r * 256 + kv * 128 + g * 64 + d0) = o;
                if (pr) { if (s >= SEQ - 512) *(f32x4*)(out + O_WINP + (((size_t)b * 512 + s - (SEQ - 512)) * 2 + kv) * 128 + g * 64 + d0) = o; }
                else *(f32x4*)(out + O_WINS + (((size_t)db * 512 + 508 + tt) * 2 + kv) * 128 + g * 64 + d0) = o;
            } }
        if (lane < 12) { const f32x4 v = *(const f32x4*)(Pr + C_GA + 4 * lane); *(f32x4*)(GN + (size_t)r * 48 + 4 * lane) = sig4(v); }
#pragma unroll
        for (int i = 0; i < 4; ++i) { const int col = 256 * i + 4 * lane; const f32x4 v = *(const f32x4*)(Pr + C_QB + col); const f32x4 pv = shfl_xor4(v, 4);
            const f32x4 rv = rope4(v, pv, (4 * lane) & 127, 16, 8, cv, sv);
            *(u32x2*)(QB + (size_t)r * 1024 + col) = cvt4(rv); }
        { const int cl = 4 * lane; const f32x4 v = *(const f32x4*)(Pr + C_KVB + cl); const f32x4 pv = shfl_xor4(v, 4);
          const f32x4 rv = rope4(v, pv, cl & 127, 16, 8, cv, sv); const f32x4 o = cl < 128 ? rv : v;
          float* dst = pr ? out + O_DSAP + (size_t)r * 320 + cl : out + O_DSAS + (size_t)q * 320 + cl; *(f32x4*)dst = o;
          if (pr) *(u32x2*)((bf16_t*)(ws + WS_DSAB) + (size_t)r * 256 + cl) = cvt4(o); }
#pragma unroll
        for (int i = 0; i < 4; ++i) { const int col = 256 * i + 4 * lane; const f32x4 v = *(const f32x4*)(Pr + C_QI + col); const f32x4 pv = shfl_xor4(v, 2);
            const f32x4 rv = rope4(v, pv, (4 * lane) & 63, 8, 0, cv, sv);
            *(u32x2*)(QI + (size_t)r * 1024 + col) = cvt4(rv); }
        { const f32x4 v = lane < 16 ? *(const f32x4*)(Pr + C_KI + 4 * lane) : (f32x4){0.f, 0.f, 0.f, 0.f}; const f32x4 pv = shfl_xor4(v, 2);
          const f32x4 rv = rope4(v, pv, (4 * lane) & 63, 8, 0, cv, sv);
          if (lane < 16) { float* dst = pr ? out + O_DSAP + (size_t)r * 320 + 256 + 4 * lane : out + O_DSAS + (size_t)q * 320 + 256 + 4 * lane; *(f32x4*)dst = rv;
              if (pr) { const int d0 = 4 * lane; *(u32x2*)((bf16_t*)(ws + WS_KIF) + ((size_t)(b * 256 + (s >> 4)) * 2 + (d0 >> 5)) * 512 + (((d0 >> 3) & 3) * 16 + (s & 15)) * 8 + ((d0 >> 2) & 1) * 4) = cvt4(rv); } }
          if (lane < 4) *(f32x4*)(WI + (size_t)r * 16 + 4 * lane) = *(const f32x4*)(Pr + C_WI + 4 * lane); }
#pragma unroll 4
        for (int i = 0; i < 16; ++i) { const int col = 256 * i + 4 * lane; const f32x4 v = *(const f32x4*)(Pr + C_GM + col); *(u32x2*)(GAB + (size_t)r * 4096 + col) = cvt4(sig4(v)); }
    }
}
struct P1Order { pg8::StaticOrder so;
    DI bool next(int i, pg8::Unit& u) const { const long L = (long)i * so.G + so.c; if (L < so.nwg) return so.at(L, u); const int j = (int)(L - so.nwg); if (j >= 8) return false; u.pm = j >> 2; u.pn = j & 3; u.ks = 1; return true; }
    DI size_t offA(const pg8::Unit& u) const { return (size_t)u.pm * 256 * DM * 2 + (u.ks ? (WS_MEMN - WS_XN) : 0); }
    DI size_t offB(const pg8::Unit& u) const { return (size_t)u.pn * 256 * DM * 2 + (u.ks ? (WS_BT_MKV - WS_BT_IN) : 0); }
};
struct FP1 { float* P; float* memkv; DI void operator()(const pg8::Unit& u, int row, int col, f32x4 v) const {
    if (u.ks) *(f32x4*)(memkv + (size_t)(u.pm * 256 + row) * 1024 + u.pn * 256 + col) = v; else *(f32x4*)(P + (size_t)(u.pm * 256 + row) * DINP + u.pn * 256 + col) = v; } };
DI void phase1(const Args& a, LAS unsigned char* lds) {
    unsigned char* ws = a.ws;
    pg8::Gemm g{(const bf16_t*)(ws + WS_XN), (const bf16_t*)(ws + WS_BT_IN), DM, DM, DM};
    P1Order S; S.so.init(MP / 256, DINP / 256, gridDim.x, blockIdx.x, DM, DM);
    pg8::EpiEach<FP1> E{FP1{(float*)(ws + WS_P), a.out + O_MEMP}};
    pg8::gemm_phase(lds, g, S, E);
}
struct CmpOrder { int G, c;
    DI bool next(int i, pg8::Unit& u) const { const int L = i * G + c; if (L >= 264) return false; u.pn = L / 132; u.pm = L % 132; u.ks = 0; return true; }
    DI size_t offA(const pg8::Unit& u) const { const int rt = u.pm, kv = u.pn; size_t e;
        if (rt < 4) { const int b = rt >> 1, g = rt & 1; e = (size_t)((b * 2 + kv) * 2 + g) * KCP_ROWS * 64; }
        else { const int s = rt - 4, db = s >> 2, g = (s >> 1) & 1, half = s & 1; e = KCS_OFF + ((size_t)((db * 2 + kv) * 2 + g) * 8192 + half * 4096) * 64; }
        return e * 2; }
    DI size_t offB(const pg8::Unit& u) const { return (size_t)u.pn * 256 * 2048 * 2; }
};
DI float gelu_tanh(float x) { const float u = 0.7978845608028654f * (x + 0.044715f * x * x * x); const float t = 1.f - 2.f / (1.f + __expf(2.f * u)); return 0.5f * x * (1.f + t); }
struct FCmpH { const float* biasc; bf16_t* HC;
    DI void operator()(const pg8::Unit& u, int row, int col, f32x4 v) const { const f32x4 bb = *(const f32x4*)(biasc + u.pn * 256 + col); f32x4 x = v + bb;
        x.x = gelu_tanh(x.x); x.y = gelu_tanh(x.y); x.z = gelu_tanh(x.z); x.w = gelu_tanh(x.w);
        *(u32x2*)(HC + ((size_t)(u.pn * 132 + u.pm) * 256 + row) * 256 + col) = cvt4(x); } };
DI void phase3(const Args& a, LAS unsigned char* lds) {
    unsigned char* ws = a.ws;
    pg8::Gemm g{(const bf16_t*)(ws + WS_KCRAW), (const bf16_t*)(ws + WS_BT_C1), 1024, 2048, 2048};
    CmpOrder S{(int)gridDim.x, (int)blockIdx.x};
    pg8::EpiEach<FCmpH> E{FCmpH{(const float*)(ws + WS_BIASC), (bf16_t*)(ws + WS_HC)}};
    pg8::gemm_phase(lds, g, S, E);
}
DI void phase4(const Args& a, LAS unsigned char* lds) {
    const int tid = threadIdx.x, lane = tid & 63, wave = __builtin_amdgcn_readfirstlane(tid >> 6);
    const int gw = blockIdx.x * NWAVES + wave, NGW = gridDim.x * NWAVES;
    unsigned char* ws = a.ws;
    LAS bf16_t* W2T = (LAS bf16_t*)lds;
    const float* w2 = (const float*)a.in[I_CW2];
    for (int idx = tid; idx < 2 * 256 * 64; idx += NTHR) { const int kv = idx >> 14, k = (idx >> 6) & 255, n = idx & 63; W2T[(kv * 64 + n) * 264 + k] = (bf16_t)(cvt_pk_bf16(w2[idx], 0.f) & 0xffffu); }
    __syncthreads();
    const bf16_t* HC = (const bf16_t*)(ws + WS_HC); bf16_t* KCF = (bf16_t*)(ws + WS_KCF);
    const int kg = lane >> 4, c16 = lane & 15;
    constexpr int NIT = 2 * HC_ROWS / 16;
    for (int it = gw; it < NIT; it += NGW) {
        const int kv = it / (HC_ROWS / 16), row0 = (it % (HC_ROWS / 16)) * 16;
        f32x4 acc[4];
#pragma unroll
        for (int nt = 0; nt < 4; ++nt) acc[nt] = (f32x4){0.f, 0.f, 0.f, 0.f};
#pragma unroll
        for (int ks = 0; ks < 8; ++ks) {
            const bf16x8 bfr = *(const bf16x8*)(HC + ((size_t)kv * HC_ROWS + row0 + c16) * 256 + 32 * ks + 8 * kg);
#pragma unroll
            for (int nt = 0; nt < 4; ++nt) { const bf16x8 afr = *(const LAS bf16x8*)(W2T + (kv * 64 + 16 * nt + c16) * 264 + 32 * ks + 8 * kg); acc[nt] = MFMA16(afr, bfr, acc[nt]); }
        }
        const int R = row0 + c16, rt = R >> 8, iin = R & 255; int seq, g, blk;
        if (rt < 4) { seq = rt >> 1; g = rt & 1; blk = iin; } else { const int s = rt - 4; seq = 2 + (s >> 2); g = (s >> 1) & 1; blk = (s & 1) * 256 + iin; }
        bf16_t* tile = KCF + ((size_t)(seq * 2 + g) * 16 + (blk >> 5)) * 4096; const int slot = blk & 31;
        if (kv == 0) {
#pragma unroll
            for (int nt = 0; nt < 4; ++nt) { const int d0 = 16 * nt + 4 * kg; *(u32x2*)(tile + (((d0 >> 5) * 2 + (slot >> 4)) * 64 + ((d0 >> 3) & 3) * 16 + (slot & 15)) * 8 + ((d0 >> 2) & 1) * 4) = cvt4(acc[nt]); }
        } else {
            const int kgv = (slot & 15) >> 2, jv = (slot & 3) + ((slot >> 4) << 2);
#pragma unroll
            for (int nt = 0; nt < 4; ++nt) { const u32x2 w = cvt4(acc[nt]); bf16_t* t0 = tile + 2048 + ((nt * 64 + kgv * 16 + 4 * kg) * 8) + jv;
                t0[0] = (bf16_t)(w.x & 0xffffu); t0[8] = (bf16_t)(w.x >> 16); t0[16] = (bf16_t)(w.y & 0xffffu); t0[24] = (bf16_t)(w.y >> 16); }
        }
    }
}

struct RowInfo { bool pr; int b, db, pos, seq; };
DI RowInfo rowinfo(int r) { RowInfo ri; ri.pr = r < TP; const int q = r - TP; ri.b = r >> 12; ri.db = q >> 2; ri.pos = ri.pr ? (r & 4095) : 8192 + (q & 3); ri.seq = ri.pr ? ri.b : 2 + ri.db; return ri; }
DI float xmax16(float x) { const auto r = __builtin_amdgcn_permlane16_swap(__float_as_uint(x), __float_as_uint(x), false, false); return fmaxf(__uint_as_float(r[0]), __uint_as_float(r[1])); }
DI float xmax32(float x) { const auto r = __builtin_amdgcn_permlane32_swap(__float_as_uint(x), __float_as_uint(x), false, false); return fmaxf(__uint_as_float(r[0]), __uint_as_float(r[1])); }
DI float xsum16(float x) { const auto r = __builtin_amdgcn_permlane16_swap(__float_as_uint(x), __float_as_uint(x), false, false); return __uint_as_float(r[0]) + __uint_as_float(r[1]); }
DI float xsum32(float x) { const auto r = __builtin_amdgcn_permlane32_swap(__float_as_uint(x), __float_as_uint(x), false, false); return __uint_as_float(r[0]) + __uint_as_float(r[1]); }
template <int CTRL> DI float dppf(float x) { return __int_as_float(__builtin_amdgcn_update_dpp(0, __float_as_int(x), CTRL, 0xF, 0xF, true)); }
DI float sum8(float x) { x += dppf<0xB1>(x); x += dppf<0x4E>(x); x += dppf<0x141>(x); return x; }
DI float sum16r(float x) { x = sum8(x); x += dppf<0x140>(x); return x; }
DI int q_next(unsigned* ctr, int lane) { int v = 0; if (lane == 0) v = (int)__hip_atomic_fetch_add(ctr, 1u, __ATOMIC_RELAXED, __HIP_MEMORY_SCOPE_AGENT); return __builtin_amdgcn_readfirstlane(v); }

template <int D> struct Flash { f32x4 o[D / 16]; float m, l; };
template <int D> DI void flash_init(Flash<D>& f) {
#pragma unroll
    for (int i = 0; i < D / 16; ++i) f.o[i] = (f32x4){0.f, 0.f, 0.f, 0.f};
    f.m = -INFINITY; f.l = 0.f; }
template <int D> DI float flash_linv(const Flash<D>& f) { return 1.f / fmaxf(xsum32(xsum16(f.l)), 1e-30f); }
DI bf16x8 ldk8(const float* p) { return cvt8(*(const f32x4*)p, *(const f32x4*)(p + 4)); }
DI int kslot(int kg, int j) { return j < 4 ? 4 * kg + j : 16 + 4 * kg + (j - 4); }
template <int D> DI bf16x8 flash_update(Flash<D>& f, const float (&v)[8]) {
    float mx = fmaxf(fmaxf(fmaxf(v[0], v[1]), fmaxf(v[2], v[3])), fmaxf(fmaxf(v[4], v[5]), fmaxf(v[6], v[7])));
    if (!__all(mx <= f.m + 8.f)) {
        mx = xmax32(xmax16(mx));
        const float mnew = fmaxf(f.m, mx), msafe = (mnew == -INFINITY) ? 0.f : mnew, alpha = __expf(f.m - msafe);
        f.l *= alpha; f.m = mnew;
#pragma unroll
        for (int dt = 0; dt < D / 16; ++dt) f.o[dt] *= alpha;
    }
    const float mref = (f.m == -INFINITY) ? 0.f : f.m;
    float p[8], sum = 0.f;
#pragma unroll
    for (int e = 0; e < 8; ++e) { p[e] = __expf(v[e] - mref); sum += p[e]; }
    f.l += sum;
    u32x4 w; w.x = cvt_pk_bf16(p[0], p[1]); w.y = cvt_pk_bf16(p[2], p[3]); w.z = cvt_pk_bf16(p[4], p[5]); w.w = cvt_pk_bf16(p[6], p[7]);
    return __builtin_bit_cast(bf16x8, w);
}
template <int D> DI void flash_step(Flash<D>& f, const bf16x8 (&qf)[D / 32], const float* kp0, const float* kp1, const float* const (&vp)[8], unsigned okm, float scale, int lane) {
    const int kg = lane >> 4, c16 = lane & 15;
    f32x4 s0 = (f32x4){0.f, 0.f, 0.f, 0.f}, s1 = s0;
#pragma unroll
    for (int ks = 0; ks < D / 32; ++ks) { const bf16x8 a0 = ldk8(kp0 + 32 * ks + 8 * kg), a1 = ldk8(kp1 + 32 * ks + 8 * kg); s0 = MFMA16(a0, qf[ks], s0); s1 = MFMA16(a1, qf[ks], s1); }
    float v[8];
#pragma unroll
    for (int j = 0; j < 4; ++j) { v[j] = ((okm >> j) & 1u) ? s0[j] * scale : -INFINITY; v[4 + j] = ((okm >> (4 + j)) & 1u) ? s1[j] * scale : -INFINITY; }
    const bf16x8 pb = flash_update<D>(f, v);
#pragma unroll
    for (int dt = 0; dt < D / 16; ++dt) {
        float x[8];
#pragma unroll
        for (int j = 0; j < 8; ++j) x[j] = vp[j][16 * dt + c16];
        u32x4 aw; aw.x = cvt_pk_bf16(x[0], x[1]); aw.y = cvt_pk_bf16(x[2], x[3]); aw.z = cvt_pk_bf16(x[4], x[5]); aw.w = cvt_pk_bf16(x[6], x[7]);
        f.o[dt] = MFMA16(__builtin_bit_cast(bf16x8, aw), pb, f.o[dt]);
    }
}
struct Tile64 { bf16x8 k[4]; bf16x8 v[4]; };
DI void load_tile64(Tile64& t, const bf16_t* kt, const bf16_t* vt, int lane) {
#pragma unroll
    for (int i = 0; i < 4; ++i) t.k[i] = *(const bf16x8*)(kt + (i * 64 + lane) * 8);
#pragma unroll
    for (int i = 0; i < 4; ++i) t.v[i] = *(const bf16x8*)(vt + (i * 64 + lane) * 8);
}
DI void flash_tile64(Flash<64>& f, const bf16x8 (&qf)[2], const Tile64& t, unsigned okm, float scale) {
    f32x4 s0 = (f32x4){0.f, 0.f, 0.f, 0.f}, s1 = s0;
#pragma unroll
    for (int ks = 0; ks < 2; ++ks) { s0 = MFMA16(t.k[ks * 2], qf[ks], s0); s1 = MFMA16(t.k[ks * 2 + 1], qf[ks], s1); }
    float v[8];
#pragma unroll
    for (int j = 0; j < 4; ++j) { v[j] = ((okm >> j) & 1u) ? s0[j] * scale : -INFINITY; v[4 + j] = ((okm >> (4 + j)) & 1u) ? s1[j] * scale : -INFINITY; }
    const bf16x8 pb = flash_update<64>(f, v);
#pragma unroll
    for (int dt = 0; dt < 4; ++dt) f.o[dt] = MFMA16(t.v[dt], pb, f.o[dt]);
}

DI void cmp_item(const Args& a, LAS unsigned char* wl, int seq, int r0, int pos0, int g, int lane) {
    unsigned char* ws = a.ws;
    LAS float* imp = (LAS float*)wl; LAS float* scv = imp + 1040;
    const int kg = lane >> 4, c16 = lane & 15, tl = c16 >> 3, hh = c16 & 7;
    const int myrow = r0 + tl, qpos = pos0 + tl, head = g * 8 + hh;
    const bf16_t* QC = (const bf16_t*)(ws + WS_QC);
    bf16x8 qf[2];
#pragma unroll
    for (int ks = 0; ks < 2; ++ks) qf[ks] = *(const bf16x8*)(QC + (size_t)myrow * 1024 + head * 64 + 32 * ks + 8 * kg);
    const bf16_t* tb = (const bf16_t*)(ws + WS_KCF) + (size_t)(seq * 2 + g) * 16 * 4096;
    const int qlast = pos0 + 1, NV = qlast >= 31 ? ((qlast - 31) >> 4) + 1 : 0, nsteps = (NV + 31) >> 5;
    for (int i = lane; i < 1040; i += 64) imp[i] = 0.f;
    float m = -INFINITY, l = 0.f;
    for (int st = 0; st < nsteps; ++st) {
        const bf16_t* kt = tb + (size_t)st * 4096;
        f32x4 s0 = (f32x4){0.f, 0.f, 0.f, 0.f}, s1 = s0;
#pragma unroll
        for (int ks = 0; ks < 2; ++ks) { s0 = MFMA16(*(const bf16x8*)(kt + ((ks * 2) * 64 + lane) * 8), qf[ks], s0); s1 = MFMA16(*(const bf16x8*)(kt + ((ks * 2 + 1) * 64 + lane) * 8), qf[ks], s1); }
        float v[8];
#pragma unroll
        for (int j = 0; j < 4; ++j) { const int n = 32 * st + 4 * kg + j; v[j] = (16 * n + 31 <= qpos) ? s0[j] * 0.125f : -INFINITY; v[4 + j] = (16 * (n + 16) + 31 <= qpos) ? s1[j] * 0.125f : -INFINITY; }
        float mx = fmaxf(fmaxf(fmaxf(v[0], v[1]), fmaxf(v[2], v[3])), fmaxf(fmaxf(v[4], v[5]), fmaxf(v[6], v[7])));
        if (!__all(mx <= m + 8.f)) { mx = xmax32(xmax16(mx)); const float mnew = fmaxf(m, mx), msafe = (mnew == -INFINITY) ? 0.f : mnew; l *= __expf(m - msafe); m = mnew; }
        const float mref = (m == -INFINITY) ? 0.f : m;
#pragma unroll
        for (int e = 0; e < 8; ++e) l += __expf(v[e] - mref);
    }
    const float msafe = (m == -INFINITY) ? 0.f : m, linv = 1.f / fmaxf(xsum32(xsum16(l)), 1e-30f);
    f32x4 o[4];
#pragma unroll
    for (int dt = 0; dt < 4; ++dt) o[dt] = (f32x4){0.f, 0.f, 0.f, 0.f};
    for (int st = 0; st < nsteps; ++st) {
        const bf16_t* kt = tb + (size_t)st * 4096; const bf16_t* vt = kt + 2048;
        f32x4 s0 = (f32x4){0.f, 0.f, 0.f, 0.f}, s1 = s0;
#pragma unroll
        for (int ks = 0; ks < 2; ++ks) { s0 = MFMA16(*(const bf16x8*)(kt + ((ks * 2) * 64 + lane) * 8), qf[ks], s0); s1 = MFMA16(*(const bf16x8*)(kt + ((ks * 2 + 1) * 64 + lane) * 8), qf[ks], s1); }
        float p[8];
#pragma unroll
        for (int j = 0; j < 4; ++j) { const int n = 32 * st + 4 * kg + j;
            p[j] = (16 * n + 31 <= qpos) ? __expf(s0[j] * 0.125f - msafe) * linv : 0.f; p[4 + j] = (16 * (n + 16) + 31 <= qpos) ? __expf(s1[j] * 0.125f - msafe) * linv : 0.f; }
#pragma unroll
        for (int e = 0; e < 8; ++e) { const float t = sum8(p[e]); if (hh == 0) imp[tl * 520 + 32 * st + kslot(kg, e)] = t; }
        u32x4 w; w.x = cvt_pk_bf16(p[0], p[1]); w.y = cvt_pk_bf16(p[2], p[3]); w.z = cvt_pk_bf16(p[4], p[5]); w.w = cvt_pk_bf16(p[6], p[7]);
        const bf16x8 pb = __builtin_bit_cast(bf16x8, w);
#pragma unroll
        for (int dt = 0; dt < 4; ++dt) o[dt] = MFMA16(*(const bf16x8*)(vt + (dt * 64 + lane) * 8), pb, o[dt]);
    }
    float* OC = (float*)(ws + WS_OCMP) + (size_t)myrow * 1024 + head * 64 + 4 * kg;
#pragma unroll
    for (int dt = 0; dt < 4; ++dt) *(f32x4*)(OC + 16 * dt) = o[dt];
    LDS_WAIT();
    int* SEL = (int*)(ws + WS_SEL);
    for (int t2 = 0; t2 < 2; ++t2) {
        const int qp = pos0 + t2, cur = qp >> 6, nsb = cur + 1;
        int* selp = SEL + ((size_t)(r0 + t2) * 2 + g) * 16;
        if (nsb <= 16) { if (lane < 16) selp[lane] = lane < nsb ? lane : -1; }
        else {
            const LAS float* im = imp + t2 * 520;
            for (int j = lane; j < nsb; j += 64) { const float sc = (im[4 * j] + im[4 * j + 1]) + (im[4 * j + 2] + im[4 * j + 3]) + (j ? im[4 * j - 1] : 0.f);
                scv[j] = (j == 0 || j == cur || j == cur - 1) ? INFINITY : sc; }
            LDS_WAIT();
            for (int j = lane; j < nsb; j += 64) { const float vj = scv[j]; int rank = 0;
                for (int k = 0; k < nsb; ++k) { const float vk = scv[k]; rank += (vk > vj || (vk == vj && k < j)) ? 1 : 0; }
                if (rank < 16) selp[rank] = j; }
            LDS_WAIT();
        }
    }
}

DI const float* dsa_ptr(const Args& a, const RowInfo& ri, int idx) {
    if (ri.pr) return a.out + O_DSAP + ((size_t)ri.b * 4096 + idx) * 320;
    if (idx < 8192) return (const float*)a.in[I_CDSA] + ((size_t)((const int*)a.in[I_PT])[ri.db * NPAGES + (idx >> 7)] * 128 + (idx & 127)) * 320;
    return a.out + O_DSAS + ((size_t)ri.db * 4 + idx - 8192) * 320;
}
DI unsigned sortable(float x) { const unsigned u = __float_as_uint(x); return (u & 0x80000000u) ? ~u : (u | 0x80000000u); }
DI void idx_item_block(const Args& a, LAS unsigned char* lds, int r) {
    const int tid = threadIdx.x, lane = tid & 63, wave = __builtin_amdgcn_readfirstlane(tid >> 6);
    unsigned char* ws = a.ws;
    LAS unsigned* sc = (LAS unsigned*)lds; LAS unsigned* hist = sc + 8200; LAS unsigned* misc = hist + 256; LAS unsigned* wc = misc + 16;
    const RowInfo ri = rowinfo(r); const int n = ri.pos + 1;
    int* idxp = (int*)(ws + WS_IDX) + (size_t)r * 256;
    const int kg = lane >> 4, c16 = lane & 15;
    { const bf16_t* QI = (const bf16_t*)(ws + WS_QI); bf16x8 qf[2];
#pragma unroll
      for (int ks = 0; ks < 2; ++ks) qf[ks] = *(const bf16x8*)(QI + (size_t)r * 1024 + c16 * 64 + 32 * ks + 8 * kg);
      const float w = ((const float*)(ws + WS_WI))[(size_t)r * 16 + c16] * 0.03125f;
      const int nt32 = (n + 31) >> 5;
      for (int kt = wave; kt < nt32; kt += NWAVES) {
          const int p0 = min(32 * kt + c16, n - 1), p1 = min(32 * kt + 16 + c16, n - 1);
          const float* kp0 = dsa_ptr(a, ri, p0) + 256; const float* kp1 = dsa_ptr(a, ri, p1) + 256;
          f32x4 s0 = (f32x4){0.f, 0.f, 0.f, 0.f}, s1 = s0;
#pragma unroll
          for (int ks = 0; ks < 2; ++ks) { const bf16x8 a0 = ldk8(kp0 + 32 * ks + 8 * kg), a1 = ldk8(kp1 + 32 * ks + 8 * kg); s0 = MFMA16(a0, qf[ks], s0); s1 = MFMA16(a1, qf[ks], s1); }
#pragma unroll
          for (int e = 0; e < 8; ++e) { const float x = sum16r(fmaxf(e < 4 ? s0[e & 3] : s1[e & 3], 0.f) * w);
              const int key = 32 * kt + kslot(kg, e); if (c16 == 0 && key < n) sc[key] = sortable(x); }
      } }
    __syncthreads();
    unsigned prefix = 0u, mask = 0u; int need = 256;
    for (int pass = 0; pass < 4; ++pass) { const int shift = 24 - 8 * pass;
        if (tid < 256) hist[tid] = 0u;
        __syncthreads();
        for (int i = tid; i < n; i += NTHR) { const unsigned u = sc[i]; if ((u & mask) == prefix) __hip_atomic_fetch_add(&hist[(u >> shift) & 255u], 1u, __ATOMIC_RELAXED, __HIP_MEMORY_SCOPE_WORKGROUP); }
        __syncthreads();
        if (wave == 0) { const int h0 = hist[4 * lane], h1 = hist[4 * lane + 1], h2 = hist[4 * lane + 2], h3 = hist[4 * lane + 3]; const int ls = h0 + h1 + h2 + h3; int suf = ls;
#pragma unroll
            for (int o = 1; o < 64; o <<= 1) { const int t = __shfl_down(suf, o); if (lane + o < 64) suf += t; }
            int above = suf - ls;
            if (above < need && need <= above + h3) { misc[0] = 4 * lane + 3; misc[1] = need - above; } above += h3;
            if (above < need && need <= above + h2) { misc[0] = 4 * lane + 2; misc[1] = need - above; } above += h2;
            if (above < need && need <= above + h1) { misc[0] = 4 * lane + 1; misc[1] = need - above; } above += h1;
            if (above < need && need <= above + h0) { misc[0] = 4 * lane + 0; misc[1] = need - above; } }
        __syncthreads();
        const unsigned bin = misc[0]; need = (int)misc[1]; prefix |= bin << shift; mask |= 0xFFu << shift;
    }
    const unsigned thr = prefix; const int need_eq = need; int run_gt = 0, run_eq = 0;
    for (int base = 0; base < n; base += NTHR) {
        const int i = base + tid; const unsigned u = i < n ? sc[i] : 0u; const bool gt = i < n && u > thr, eq = i < n && u == thr;
        const unsigned long long bg = __ballot(gt), be = __ballot(eq);
        if (lane == 0) { wc[wave * 2] = (unsigned)__popcll(bg); wc[wave * 2 + 1] = (unsigned)__popcll(be); }
        __syncthreads();
        int pg = 0, pe = 0, tg = 0, te = 0;
#pragma unroll
        for (int w = 0; w < NWAVES; ++w) { const int cg = (int)wc[2 * w], ce = (int)wc[2 * w + 1]; if (w < wave) { pg += cg; pe += ce; } tg += cg; te += ce; }
        const unsigned long long lm = (1ull << lane) - 1ull;
        const int gb = run_gt + pg + __popcll(bg & lm), eb = run_eq + pe + __popcll(be & lm);
        const int opos = gb + min(eb, need_eq);
        if ((gt || (eq && eb < need_eq)) && opos < 256) idxp[opos] = i;
        run_gt += tg; run_eq += te;
        __syncthreads();
    }
}
DI void idx_item_wave(const Args& a, LAS unsigned char* wl, int r, int lane) {
    unsigned char* ws = a.ws;
    LAS unsigned* sc = (LAS unsigned*)wl; LAS unsigned* hist = sc + 4096;
    const int b = r >> 12, s = r & 4095, n = s + 1;
    int* idxp = (int*)(ws + WS_IDX) + (size_t)r * 256;
    if (n <= 256) { for (int i = lane; i < 256; i += 64) idxp[i] = i < n ? i : -1; return; }
    const int kg = lane >> 4, c16 = lane & 15;
    { const bf16_t* QI = (const bf16_t*)(ws + WS_QI); bf16x8 qa[2];
#pragma unroll
      for (int ks = 0; ks < 2; ++ks) qa[ks] = *(const bf16x8*)(QI + (size_t)r * 1024 + c16 * 64 + 32 * ks + 8 * kg);
      const f32x4 w4 = *(const f32x4*)((const float*)(ws + WS_WI) + (size_t)r * 16 + 4 * kg) * 0.03125f;
      const bf16_t* kb = (const bf16_t*)(ws + WS_KIF) + (size_t)b * 256 * 1024 + lane * 8;
      const int ntile = (n + 15) >> 4;
      bf16x8 c0 = *(const bf16x8*)kb, c1 = *(const bf16x8*)(kb + 512);
      for (int T = 0; T < ntile; ++T) {
          const int Tn = min(T + 1, ntile - 1);
          const bf16x8 n0 = *(const bf16x8*)(kb + (size_t)Tn * 1024), n1 = *(const bf16x8*)(kb + (size_t)Tn * 1024 + 512);
          f32x4 d = (f32x4){0.f, 0.f, 0.f, 0.f};
          d = MFMA16(qa[0], c0, d); d = MFMA16(qa[1], c1, d);
          float x = (fmaxf(d[0], 0.f) * w4[0] + fmaxf(d[1], 0.f) * w4[1]) + (fmaxf(d[2], 0.f) * w4[2] + fmaxf(d[3], 0.f) * w4[3]);
          x = xsum32(xsum16(x));
          const int key = 16 * T + c16; if (kg == 0 && key < n) sc[key] = sortable(x);
          c0 = n0; c1 = n1;
      } }
    LDS_WAIT();
    unsigned prefix = 0u, mask = 0u; int need = 256;
    for (int pass = 0; pass < 4; ++pass) { const int shift = 24 - 8 * pass;
#pragma unroll
        for (int q = 0; q < 4; ++q) hist[lane + 64 * q] = 0u;
        LDS_WAIT();
        for (int i = lane; i < n; i += 64) { const unsigned u = sc[i]; if ((u & mask) == prefix) __hip_atomic_fetch_add(&hist[(u >> shift) & 255u], 1u, __ATOMIC_RELAXED, __HIP_MEMORY_SCOPE_WAVEFRONT); }
        LDS_WAIT();
        const int h0 = hist[4 * lane], h1 = hist[4 * lane + 1], h2 = hist[4 * lane + 2], h3 = hist[4 * lane + 3]; const int ls = h0 + h1 + h2 + h3; int suf = ls;
#pragma unroll
        for (int o = 1; o < 64; o <<= 1) { const int t = __shfl_down(suf, o); if (lane + o < 64) suf += t; }
        int above = suf - ls, fb = -1, fn = 0;
        if (above < need && need <= above + h3) { fb = 4 * lane + 3; fn = need - above; } above += h3;
        if (above < need && need <= above + h2) { fb = 4 * lane + 2; fn = need - above; } above += h2;
        if (above < need && need <= above + h1) { fb = 4 * lane + 1; fn = need - above; } above += h1;
        if (above < need && need <= above + h0) { fb = 4 * lane + 0; fn = need - above; }
        const unsigned long long fm = __ballot(fb >= 0); const int src = fm ? __builtin_ctzll(fm) : 0;
        const unsigned bin = (unsigned)__builtin_amdgcn_readlane(fb, src); need = __builtin_amdgcn_readlane(fn, src);
        prefix |= bin << shift; mask |= 0xFFu << shift;
        LDS_WAIT();
    }
    const unsigned thr = prefix; const int need_eq = need; int run_gt = 0, run_eq = 0;
    for (int base = 0; base < n; base += 64) {
        const int i = base + lane; const unsigned u = i < n ? sc[i] : 0u; const bool gt = i < n && u > thr, eq = i < n && u == thr;
        const unsigned long long bg = __ballot(gt), be = __ballot(eq), lm = (1ull << lane) - 1ull;
        const int gb = run_gt + __popcll(bg & lm), eb = run_eq + __popcll(be & lm), opos = gb + min(eb, need_eq);
        if ((gt || (eq && eb < need_eq)) && opos < 256) idxp[opos] = i;
        run_gt += __popcll(bg); run_eq += __popcll(be);
    }
    LDS_WAIT();
}

constexpr int CW_Q0 = 8192;
DI void phase5(const Args& a, LAS unsigned char* lds, int qb = 0) {
    const int tid = threadIdx.x, lane = tid & 63, wave = __builtin_amdgcn_readfirstlane(tid >> 6);
    unsigned* ctl = (unsigned*)(a.ws + WS_CTL);
    { const int bid = blockIdx.x, G = gridDim.x;
#pragma unroll 1
      for (int j = bid; j < TS; j += G) { idx_item_block(a, lds, TP + j); __syncthreads(); } }
    { LAS unsigned char* wl = lds + wave * 8192;
#pragma unroll 1
      for (;;) { const int it = q_next(ctl + CW_Q0 + qb, lane); if (it >= 128 + 8192) break;
          if (it < 128) { const int g = it & 1, db = it >> 2, tp = (it >> 1) & 1; cmp_item(a, wl, 2 + db, TP + db * 4 + 2 * tp, 8192 + 2 * tp, g, lane); }
          else { const int j = it - 128, g = j & 1, b = (j >> 1) & 1, tp = 2047 - (j >> 2); cmp_item(a, wl, b, b * 4096 + 2 * tp, 2 * tp, g, lane); } } }
    __syncthreads();
    { LAS unsigned char* wl = lds + wave * 17408;
#pragma unroll 1
      for (;;) { const int it = q_next(ctl + CW_Q0 + qb + 64, lane); if (it >= TP) break; const int b = it & 1, s = 4095 - (it >> 1); idx_item_wave(a, wl, b * 4096 + s, lane); } }
}

DI const float* win_ptr(const Args& a, const RowInfo& ri, int pos, int kv, int g) {
    const float* KW = (const float*)(a.ws + WS_KW);
    if (ri.pr) return KW + ((size_t)ri.b * 4096 + pos) * 256 + kv * 128 + g * 64;
    if (pos < 8192) return (const float*)a.in[I_SWIN] + (((size_t)ri.db * 512 + (pos - 7680)) * 2 + kv) * 128 + g * 64;
    return KW + ((size_t)TP + ri.db * 4 + (pos - 8192)) * 256 + kv * 128 + g * 64;
}
DI const float* slc_ptr(const Args& a, const RowInfo& ri, int pos, int c, int g) {
    if (ri.pr) return a.out + O_NSAP + (((size_t)ri.b * 4096 + pos) * 4 + c) * 128 + g * 64;
    if (pos < 8192) return (const float*)a.in[I_CNSA] + (((size_t)((const int*)a.in[I_PT])[ri.db * NPAGES + (pos >> 7)] * 128 + (pos & 127)) * 4 + c) * 128 + g * 64;
    return a.out + O_NSAS + (((size_t)ri.db * 4 + pos - 8192) * 4 + c) * 128 + g * 64;
}
DI void nsa2_item(const Args& a, int r, int g, int lane) {
    unsigned char* ws = a.ws;
    const RowInfo ri = rowinfo(r); const int qpos = ri.pos;
    const int kg = lane >> 4, c16 = lane & 15, hh = c16 & 7, head = g * 8 + hh;
    bf16x8 qf[2];
    { const bf16_t* QR = (const bf16_t*)(ws + WS_QR);
#pragma unroll
      for (int ks = 0; ks < 2; ++ks) qf[ks] = *(const bf16x8*)(QR + (size_t)r * 1024 + head * 64 + 32 * ks + 8 * kg); }
    Flash<64> fw; flash_init(fw);
    Flash<64> fs; flash_init(fs);
    if (ri.pr) {
        const bf16_t* tb = (const bf16_t*)(ws + WS_NSAF) + (size_t)((ri.b * 2 + g) * 128) * 8192;
        Tile64 cur, nxt;
        { const int lo = max(0, qpos - 511), T0 = lo >> 5, T1 = qpos >> 5;
          load_tile64(cur, tb + (size_t)T0 * 8192 + 4096, tb + (size_t)T0 * 8192 + 6144, lane);
          for (int T = T0; T <= T1; ++T) {
              if (T < T1) load_tile64(nxt, tb + (size_t)(T + 1) * 8192 + 4096, tb + (size_t)(T + 1) * 8192 + 6144, lane);
              unsigned okm = 0u;
#pragma unroll
              for (int j = 0; j < 8; ++j) { const int p = 32 * T + kslot(kg, j); okm |= (p >= lo && p <= qpos) ? (1u << j) : 0u; }
              flash_tile64(fw, qf, cur, okm, 0.125f);
              cur = nxt;
          } }
        { const int* selp = (const int*)(ws + WS_SEL) + ((size_t)r * 2 + g) * 16;
          const int sbl = lane < 32 ? selp[lane >> 1] : -1; const int Tl = 2 * sbl + (lane & 1);
          unsigned long long m = __ballot(lane < 32 && sbl >= 0 && 32 * Tl <= qpos);
          if (m) {
              int l0 = __builtin_ctzll(m); m &= m - 1ull; int T = __builtin_amdgcn_readlane(Tl, l0);
              load_tile64(cur, tb + (size_t)T * 8192, tb + (size_t)T * 8192 + 2048, lane);
              for (;;) {
                  const bool more = m != 0ull; int Tn = 0;
                  if (more) { const int l1 = __builtin_ctzll(m); m &= m - 1ull; Tn = __builtin_amdgcn_readlane(Tl, l1); load_tile64(nxt, tb + (size_t)Tn * 8192, tb + (size_t)Tn * 8192 + 2048, lane); }
                  unsigned okm = 0u;
#pragma unroll
                  for (int j = 0; j < 8; ++j) { const int p = 32 * T + kslot(kg, j); okm |= (p <= qpos) ? (1u << j) : 0u; }
                  flash_tile64(fs, qf, cur, okm, 0.125f);
                  if (!more) break;
                  cur = nxt; T = Tn;
              }
          } }
    } else {
        { const int lo = max(0, qpos - 511);
          for (int base = lo & ~31; base <= qpos; base += 32) {
              const float* kp0 = win_ptr(a, ri, min(max(base + c16, lo), qpos), 0, g); const float* kp1 = win_ptr(a, ri, min(max(base + 16 + c16, lo), qpos), 0, g);
              const float* vp[8]; unsigned okm = 0u;
#pragma unroll
              for (int j = 0; j < 8; ++j) { const int p = base + kslot(kg, j); okm |= (p >= lo && p <= qpos) ? (1u << j) : 0u; vp[j] = win_ptr(a, ri, min(max(p, lo), qpos), 1, g); }
              flash_step<64>(fw, qf, kp0, kp1, vp, okm, 0.125f, lane);
          } }
        { const int* selp = (const int*)(ws + WS_SEL) + ((size_t)r * 2 + g) * 16;
          for (int i = 0; i < 16; ++i) { const int sb = __builtin_amdgcn_readfirstlane(selp[i]); if (sb < 0) continue;
              for (int h2 = 0; h2 < 2; ++h2) { const int base = sb * 64 + h2 * 32; if (base > qpos) continue;
                  const float* kp0 = slc_ptr(a, ri, min(base + c16, qpos), 2, g); const float* kp1 = slc_ptr(a, ri, min(base + 16 + c16, qpos), 2, g);
                  const float* vp[8]; unsigned okm = 0u;
#pragma unroll
                  for (int j = 0; j < 8; ++j) { const int p = base + kslot(kg, j); okm |= (p <= qpos) ? (1u << j) : 0u; vp[j] = slc_ptr(a, ri, min(p, qpos), 3, g); }
                  flash_step<64>(fs, qf, kp0, kp1, vp, okm, 0.125f, lane);
              } } }
    }
    const float* GN = (const float*)(ws + WS_GN) + (size_t)r * 48;
    const float g0 = GN[head], g1 = GN[16 + head] * flash_linv(fs), g2 = GN[32 + head] * flash_linv(fw);
    const float* OC = (const float*)(ws + WS_OCMP) + (size_t)r * 1024 + head * 64 + 4 * kg;
    bf16_t* ON = (bf16_t*)(ws + WS_ONSA) + (size_t)r * 1024 + head * 64 + 4 * kg;
#pragma unroll
    for (int dt = 0; dt < 4; ++dt) { const f32x4 oc = *(const f32x4*)(OC + 16 * dt); const f32x4 o = oc * g0 + fs.o[dt] * g1 + fw.o[dt] * g2; if (c16 < 8) *(u32x2*)(ON + 16 * dt) = cvt4(o); }
}
constexpr int DSA_LSTRIDE = 528;
DI void dsa_item(const Args& a, LAS unsigned char* wl, int r, int lane) {
    unsigned char* ws = a.ws;
    const RowInfo ri = rowinfo(r); const int nvalid = min(256, ri.pos + 1);
    const int kg = lane >> 4, c16 = lane & 15, hh = c16 & 7;
    bf16x8 qf[4];
    { const bf16_t* QB = (const bf16_t*)(ws + WS_QB);
#pragma unroll
      for (int ks = 0; ks < 4; ++ks) qf[ks] = *(const bf16x8*)(QB + (size_t)r * 1024 + hh * 128 + 32 * ks + 8 * kg); }
    const int* idxp = (const int*)(ws + WS_IDX) + (size_t)r * 256;
    Flash<128> f; flash_init(f);
    if (ri.pr) {
        const bf16_t* DB = (const bf16_t*)(ws + WS_DSAB) + (size_t)ri.b * 4096 * 256;
        const int nst = (nvalid + 31) >> 5, hr = lane >> 5, ch = lane & 31;
        u32x4 rg[16];
#pragma unroll
        for (int i = 0; i < 16; ++i) { const int id = idxp[2 * i + hr]; rg[i] = *(const u32x4*)(DB + (size_t)max(id, 0) * 256 + ch * 8); }
        for (int st = 0; st < nst; ++st) {
            LDS_WAIT();
#pragma unroll
            for (int i = 0; i < 16; ++i) *(LAS u32x4*)(wl + (2 * i + hr) * DSA_LSTRIDE + ch * 16) = rg[i];
            unsigned okm = 0u;
#pragma unroll
            for (int j = 0; j < 8; ++j) okm |= (idxp[32 * st + kslot(kg, j)] >= 0) ? (1u << j) : 0u;
            if (st + 1 < nst) {
#pragma unroll
                for (int i = 0; i < 16; ++i) { const int id = idxp[32 * (st + 1) + 2 * i + hr]; rg[i] = *(const u32x4*)(DB + (size_t)max(id, 0) * 256 + ch * 8); } }
            LDS_WAIT();
            f32x4 s0 = (f32x4){0.f, 0.f, 0.f, 0.f}, s1 = s0;
#pragma unroll
            for (int ks = 0; ks < 4; ++ks) { const bf16x8 a0 = *(const LAS bf16x8*)(wl + c16 * DSA_LSTRIDE + (32 * ks + 8 * kg) * 2), a1 = *(const LAS bf16x8*)(wl + (16 + c16) * DSA_LSTRIDE + (32 * ks + 8 * kg) * 2);
                s0 = MFMA16(a0, qf[ks], s0); s1 = MFMA16(a1, qf[ks], s1); }
            float v[8];
#pragma unroll
            for (int j = 0; j < 4; ++j) { v[j] = ((okm >> j) & 1u) ? s0[j] * 0.08838834764831845f : -INFINITY; v[4 + j] = ((okm >> (4 + j)) & 1u) ? s1[j] * 0.08838834764831845f : -INFINITY; }
            const bf16x8 pb = flash_update<128>(f, v);
#pragma unroll
            for (int dt = 0; dt < 8; ++dt) {
                unsigned short x[8];
#pragma unroll
                for (int j = 0; j < 8; ++j) x[j] = *(const LAS unsigned short*)(wl + kslot(kg, j) * DSA_LSTRIDE + 256 + (16 * dt + c16) * 2);
                u32x4 aw; aw.x = x[0] | ((unsigned)x[1] << 16); aw.y = x[2] | ((unsigned)x[3] << 16); aw.z = x[4] | ((unsigned)x[5] << 16); aw.w = x[6] | ((unsigned)x[7] << 16);
                f.o[dt] = MFMA16(__builtin_bit_cast(bf16x8, aw), pb, f.o[dt]);
            }
        }
        LDS_WAIT();
    } else {
        for (int st = 0; st * 32 < nvalid; ++st) {
            const int i0 = idxp[32 * st + c16], i1 = idxp[32 * st + 16 + c16];
            const float* kp0 = dsa_ptr(a, ri, max(i0, 0)); const float* kp1 = dsa_ptr(a, ri, max(i1, 0));
            const float* vp[8]; unsigned okm = 0u;
#pragma unroll
            for (int j = 0; j < 8; ++j) { const int id = idxp[32 * st + kslot(kg, j)]; okm |= (id >= 0) ? (1u << j) : 0u; vp[j] = dsa_ptr(a, ri, max(id, 0)) + 128; }
            flash_step<128>(f, qf, kp0, kp1, vp, okm, 0.08838834764831845f, lane);
        }
    }
    const float inv = flash_linv(f);
    bf16_t* OD = (bf16_t*)(ws + WS_ODSA) + (size_t)r * 1024 + hh * 128 + 4 * kg;
#pragma unroll
    for (int dt = 0; dt < 8; ++dt) if (c16 < 8) *(u32x2*)(OD + 16 * dt) = cvt4(f.o[dt] * inv);
}
DI void phase6(const Args& a, LAS unsigned char* lds, int qb = 0) {
    const int tid = threadIdx.x, lane = tid & 63, wave = __builtin_amdgcn_readfirstlane(tid >> 6);
    unsigned* ctl = (unsigned*)(a.ws + WS_CTL);
#pragma unroll 1
    for (;;) { const int it = q_next(ctl + CW_Q0 + qb + 128, lane); if (it >= 2 * TS + 2 * TP) break;
        if (it < 2 * TS) nsa2_item(a, TP + (it >> 1), it & 1, lane);
        else { const int j = it - 2 * TS, g = j & 1, b = (j >> 1) & 1, s = 4095 - (j >> 2); nsa2_item(a, b * 4096 + s, g, lane); } }
    { LAS unsigned char* wl = lds + wave * (32 * DSA_LSTRIDE);
#pragma unroll 1
      for (;;) { const int it = q_next(ctl + CW_Q0 + qb + 192, lane); if (it >= TT) break; dsa_item(a, wl, it < TS ? TP + it : it - TS, lane); } }
}

DI void phase11(const Args& a, LAS unsigned char* lds) {
    const int tid = threadIdx.x, lane = tid & 63, wave = __builtin_amdgcn_readfirstlane(tid >> 6);
    const int gw = blockIdx.x * NWAVES + wave, NGW = gridDim.x * NWAVES;
    unsigned char* ws = a.ws;
    const int kg = lane >> 4, c16 = lane & 15;
#pragma unroll 1
    for (int it = gw; it < 2048 + 128; it += NGW) {
        int myrow, h; const float* kvb; bool st_ok;
        if (it < 2048) { const int rg = it >> 2; h = it & 3; myrow = rg * 16 + c16; kvb = a.out + O_MEMP + (size_t)(rg >> 8) * 256 * 1024 + h * 128; st_ok = true; }
        else { const int j = it - 2048, db = j >> 2; h = j & 3; myrow = TP + db * 4 + (c16 & 3); kvb = (const float*)a.in[I_CMEM] + (size_t)db * 256 * 1024 + h * 128; st_ok = c16 < 4; }
        bf16x8 qf[4];
        { const bf16_t* QM = (const bf16_t*)(ws + WS_QMB);
#pragma unroll
          for (int ks = 0; ks < 4; ++ks) qf[ks] = *(const bf16x8*)(QM + (size_t)myrow * 512 + h * 128 + 32 * ks + 8 * kg); }
        Flash<128> f; flash_init(f);
        for (int st = 0; st < 8; ++st) {
            const float* kp0 = kvb + (size_t)(32 * st + c16) * 1024; const float* kp1 = kp0 + 16 * 1024;
            const float* vp[8];
#pragma unroll
            for (int j = 0; j < 8; ++j) vp[j] = kvb + (size_t)(32 * st + kslot(kg, j)) * 1024 + 512;
            flash_step<128>(f, qf, kp0, kp1, vp, 0xFFu, 0.08838834764831845f, lane);
        }
        const float inv = flash_linv(f);
        bf16_t* OM = (bf16_t*)(ws + WS_OM) + (size_t)myrow * 512 + h * 128 + 4 * kg;
#pragma unroll
        for (int dt = 0; dt < 8; ++dt) if (st_ok) *(u32x2*)(OM + 16 * dt) = cvt4(f.o[dt] * inv);
    }
}
DI f32x4 ldbf4(const bf16_t* p) { const u32x2 w = *(const u32x2*)p; f32x4 r; r.x = __uint_as_float(w.x << 16); r.y = __uint_as_float(w.x & 0xffff0000u); r.z = __uint_as_float(w.y << 16); r.w = __uint_as_float(w.y & 0xffff0000u); return r; }
struct FMergeA { const bf16_t* GAB; float* TMP; DI void operator()(const pg8::Unit& u, int row, int col, f32x4 v) const { const size_t r = (size_t)u.pm * 256 + row; const int c = u.pn * 256 + col;
    *(f32x4*)(TMP + r * DM + c) = v * ldbf4(GAB + r * 4096 + c); } };
struct FMergeB { const bf16_t* GAB; const float* TMP; bf16_t* MG; DI void operator()(const pg8::Unit& u, int row, int col, f32x4 v) const { const size_t r = (size_t)u.pm * 256 + row; const int c = u.pn * 256 + col;
    const f32x4 t = *(const f32x4*)(TMP + r * DM + c); *(u32x2*)(MG + r * DM + c) = cvt4(t + v * ldbf4(GAB + r * 4096 + 2048 + c)); } };
DI void phase7(const Args& a, LAS unsigned char* lds) {
    unsigned char* ws = a.ws;
    { pg8::Gemm g{(const bf16_t*)(ws + WS_ONSA), (const bf16_t*)(ws + WS_BT_OA), 1024, 1024, 1024};
      pg8::StaticOrder S; S.init(MP / 256, DM / 256, gridDim.x, blockIdx.x, 1024, 1024);
      pg8::EpiEach<FMergeA> E{FMergeA{(const bf16_t*)(ws + WS_GAB), (float*)(ws + WS_TMPG)}};
      pg8::gemm_phase(lds, g, S, E); }
    { pg8::Gemm g{(const bf16_t*)(ws + WS_ODSA), (const bf16_t*)(ws + WS_BT_OB), 1024, 1024, 1024};
      pg8::StaticOrder S; S.init(MP / 256, DM / 256, gridDim.x, blockIdx.x, 1024, 1024);
      pg8::EpiEach<FMergeB> E{FMergeB{(const bf16_t*)(ws + WS_GAB), (const float*)(ws + WS_TMPG), (bf16_t*)(ws + WS_MG)}};
      pg8::gemm_phase(lds, g, S, E); }
}
struct FResX { const float* xp; const float* xs; float* dst; DI void operator()(const pg8::Unit& u, int row, int col, f32x4 v) const { const int r = u.pm * 256 + row, c = u.pn * 256 + col;
    f32x4 o = (f32x4){0.f, 0.f, 0.f, 0.f}; if (r < TT) o = v + (r < TP ? *(const f32x4*)(xp + (size_t)r * DM + c) : *(const f32x4*)(xs + (size_t)(r - TP) * DM + c)); *(f32x4*)(dst + (size_t)r * DM + c) = o; } };
struct FResW { const float* base; float* dst; DI void operator()(const pg8::Unit& u, int row, int col, f32x4 v) const { const int r = u.pm * 256 + row, c = u.pn * 256 + col;
    f32x4 o = (f32x4){0.f, 0.f, 0.f, 0.f}; if (r < TT) o = v + *(const f32x4*)(base + (size_t)r * DM + c); *(f32x4*)(dst + (size_t)r * DM + c) = o; } };
struct FStoreBf { bf16_t* C; int ldc; DI void operator()(const pg8::Unit& u, int row, int col, f32x4 v) const { *(u32x2*)(C + (size_t)(u.pm * 256 + row) * ldc + u.pn * 256 + col) = cvt4(v); } };

struct SplitOrder { int G, c, n, lda, ldb, kslice;
    DI bool next(int i, pg8::Unit& u) const { const int L = i * G + c; if (L >= n) return false; u.pm = 32; u.pn = L & 7; u.ks = L >> 3; return true; }
    DI size_t offA(const pg8::Unit& u) const { return ((size_t)TP * lda + (size_t)u.ks * kslice) * 2; }
    DI size_t offB(const pg8::Unit& u) const { return ((size_t)u.pn * 256 * ldb + (size_t)u.ks * kslice) * 2; }
};
struct FPart { float* part; DI void operator()(const pg8::Unit& u, int row, int col, f32x4 v) const { if (row < 128) *(f32x4*)(part + ((size_t)u.ks * 128 + row) * DM + u.pn * 256 + col) = v; } };
template <class F> DI void gemm_n2048(const Args& a, LAS unsigned char* lds, size_t ws_a, size_t ws_bt, int K, const F& f) {
    unsigned char* ws = a.ws;
    { pg8::Gemm g{(const bf16_t*)(ws + ws_a), (const bf16_t*)(ws + ws_bt), K, K, K};
      pg8::StaticOrder S; S.init(TP / 256, DM / 256, gridDim.x, blockIdx.x, K, K);
      pg8::EpiEach<F> E{f};
      pg8::gemm_phase(lds, g, S, E); }
    { pg8::Gemm g{(const bf16_t*)(ws + ws_a), (const bf16_t*)(ws + ws_bt), K, K, 256};
      SplitOrder S{(int)gridDim.x, (int)blockIdx.x, 8 * (K / 256), K, K, 256};
      pg8::EpiEach<FPart> E{FPart{(float*)(ws + WS_PART)}};
      pg8::gemm_phase(lds, g, S, E); }
}
DI void phase8(const Args& a, LAS unsigned char* lds) {
    gemm_n2048(a, lds, WS_MG, WS_BT_O, DM, FResX{(const float*)a.in[I_XP], (const float*)a.in[I_XS], (float*)(a.ws + WS_X1)});
}
DI void sample_row_sum(const Args& a, const float* base_row, int q, int S, int lane, f32x4 (&v)[8]) {
    const f32x4* br = (const f32x4*)base_row + lane;
#pragma unroll
    for (int j = 0; j < 8; ++j) v[j] = br[64 * j];
    for (int k = 0; k < S; ++k) { const f32x4* pr = (const f32x4*)((const float*)(a.ws + WS_PART) + ((size_t)k * 128 + q) * DM) + lane;
#pragma unroll
        for (int j = 0; j < 8; ++j) v[j] += pr[64 * j]; }
}
DI void phase_norm(const Args& a, size_t ws_x, const float* sbase, int S, int gidx) {
    const int tid = threadIdx.x, lane = tid & 63, wave = __builtin_amdgcn_readfirstlane(tid >> 6);
    const int gw = blockIdx.x * NWAVES + wave, NGW = gridDim.x * NWAVES;
    float* X = (float*)(a.ws + ws_x); const float* g = (const float*)a.in[I_NG] + gidx * DM; bf16_t* XN = (bf16_t*)(a.ws + WS_XN);
    for (int r = gw; r < TT; r += NGW) {
        if (r < TP) { rms_row_bf16(X + (size_t)r * DM, g, XN + (size_t)r * DM, lane); continue; }
        f32x4 v[8]; sample_row_sum(a, sbase + (size_t)(r - TP) * DM, r - TP, S, lane, v);
        float ss = 0.f; f32x4* xo = (f32x4*)(X + (size_t)r * DM) + lane;
#pragma unroll
        for (int j = 0; j < 8; ++j) { xo[64 * j] = v[j]; ss += (v[j].x * v[j].x + v[j].y * v[j].y) + (v[j].z * v[j].z + v[j].w * v[j].w); }
        const float rstd = rsqrtf(wave_sum(ss) * (1.f / 2048.f) + 1e-6f);
        const f32x4* gr = (const f32x4*)g + lane; u32x2* o8 = (u32x2*)(XN + (size_t)r * DM) + lane;
#pragma unroll
        for (int j = 0; j < 8; ++j) o8[64 * j] = cvt4(v[j] * rstd * gr[64 * j]);
    }
}
DI void phase10(const Args& a, LAS unsigned char* lds) {
    unsigned char* ws = a.ws;
    pg8::Gemm g{(const bf16_t*)(ws + WS_XN), (const bf16_t*)(ws + WS_BT_MQ), DM, DM, DM};
    pg8::StaticOrder S; S.init(MP / 256, 2, gridDim.x, blockIdx.x, DM, DM);
    pg8::EpiEach<FStoreBf> E{FStoreBf{(bf16_t*)(ws + WS_QMB), 512}};
    pg8::gemm_phase(lds, g, S, E);
}
DI void phase12(const Args& a, LAS unsigned char* lds) {
    gemm_n2048(a, lds, WS_OM, WS_BT_MO, 512, FResW{(const float*)(a.ws + WS_X1), (float*)(a.ws + WS_X2)});
}
DI void phase14(const Args& a, LAS unsigned char* lds) {
    unsigned char* ws = a.ws;
    pg8::Gemm g{(const bf16_t*)(ws + WS_XN), (const bf16_t*)(ws + WS_BT_UP), DM, DM, DM};
    pg8::StaticOrder S; S.init(MP / 256, DFF2 / 256, gridDim.x, blockIdx.x, DM, DM);
    pg8::EpiEach<FStoreBf> E{FStoreBf{(bf16_t*)(ws + WS_UB), DFF2}};
    pg8::gemm_phase(lds, g, S, E);
}
DI void phase15(const Args& a, LAS unsigned char* lds) {
    const int tid = threadIdx.x, lane = tid & 63, wave = __builtin_amdgcn_readfirstlane(tid >> 6);
    const int gw = blockIdx.x * NWAVES + wave, NGW = gridDim.x * NWAVES;
    unsigned char* ws = a.ws;
    const bf16_t* U = (const bf16_t*)(ws + WS_UB); bf16_t* ACT = (bf16_t*)(ws + WS_ACT);
    const float* cw = (const float*)a.in[I_CVW]; const float* cb = (const float*)a.in[I_CVB];
    constexpr int NRUN = TP / 32 + 32, NCH = DFF / 256;
#pragma unroll 1
    for (int it = gw; it < NRUN * NCH; it += NGW) {
        const int run = it / NCH, ch = it % NCH, c = 256 * ch + 4 * lane;
        int r0, nrow, t0; const float* st = nullptr; float* cout = nullptr; int cfirst = 1 << 30;
        if (run < TP / 32) { r0 = run * 32; nrow = 32; t0 = r0 & 4095; if (t0 == SEQ - 32) { cfirst = 30; cout = a.out + O_CONVP + (size_t)(r0 >> 12) * 2 * DFF2; } }
        else { const int db = run - TP / 32; r0 = TP + db * 4; nrow = 4; t0 = 0; st = (const float*)a.in[I_SCONV] + (size_t)db * 2 * DFF2; cfirst = 2; cout = a.out + O_CONVS + (size_t)db * 2 * DFF2; }
        f32x4 pb[2], w0[2], w1[2], w2[2], u1[2], u2[2];
#pragma unroll
        for (int hf = 0; hf < 2; ++hf) { const int cc = c + hf * DFF;
            pb[hf] = *(const f32x4*)(cb + cc); w0[hf] = *(const f32x4*)(cw + cc); w1[hf] = *(const f32x4*)(cw + DFF2 + cc); w2[hf] = *(const f32x4*)(cw + 2 * DFF2 + cc);
            if (st) { u2[hf] = *(const f32x4*)(st + cc); u1[hf] = *(const f32x4*)(st + DFF2 + cc); }
            else { u1[hf] = t0 >= 1 ? ldbf4(U + (size_t)(r0 - 1) * DFF2 + cc) : (f32x4){0.f, 0.f, 0.f, 0.f}; u2[hf] = t0 >= 2 ? ldbf4(U + (size_t)(r0 - 2) * DFF2 + cc) : (f32x4){0.f, 0.f, 0.f, 0.f}; } }
        f32x4 nx[2] = {ldbf4(U + (size_t)r0 * DFF2 + c), ldbf4(U + (size_t)r0 * DFF2 + c + DFF)};
        for (int i = 0; i < nrow; ++i) {
            const f32x4 u0[2] = {nx[0], nx[1]};
            if (i + 1 < nrow) { nx[0] = ldbf4(U + (size_t)(r0 + i + 1) * DFF2 + c); nx[1] = ldbf4(U + (size_t)(r0 + i + 1) * DFF2 + c + DFF); }
            const f32x4 gt = pb[0] + u2[0] * w0[0] + u1[0] * w1[0] + u0[0] * w2[0], up = pb[1] + u2[1] * w0[1] + u1[1] * w1[1] + u0[1] * w2[1];
            f32x4 o; o.x = gt.x * sigmoidf_(gt.x) * up.x; o.y = gt.y * sigmoidf_(gt.y) * up.y; o.z = gt.z * sigmoidf_(gt.z) * up.z; o.w = gt.w * sigmoidf_(gt.w) * up.w;
            *(u32x2*)(ACT + (size_t)(r0 + i) * DFF + c) = cvt4(o);
            if (i >= cfirst) { *(f32x4*)(cout + (size_t)(i - cfirst) * DFF2 + c) = u0[0]; *(f32x4*)(cout + (size_t)(i - cfirst) * DFF2 + c + DFF) = u0[1]; }
            u2[0] = u1[0]; u2[1] = u1[1]; u1[0] = u0[0]; u1[1] = u0[1];
        }
    }
}
DI void phase16(const Args& a, LAS unsigned char* lds) {
    gemm_n2048(a, lds, WS_ACT, WS_BT_DN, DFF, FResW{(const float*)(a.ws + WS_X2), (float*)(a.ws + WS_X3)});
}
DI void phase17(const Args& a) {
    const int tid = threadIdx.x, lane = tid & 63, wave = __builtin_amdgcn_readfirstlane(tid >> 6);
    const int gw = blockIdx.x * NWAVES + wave, NGW = gridDim.x * NWAVES;
    const float* X3 = (const float*)(a.ws + WS_X3); const f32x4* gr = (const f32x4*)a.in[I_FG] + lane;
    for (int r = gw; r < TT; r += NGW) {
        const f32x4* xr = (const f32x4*)(X3 + (size_t)r * DM) + lane; f32x4 v[8]; float s = 0.f;
        if (r < TP) {
#pragma unroll
            for (int j = 0; j < 8; ++j) v[j] = xr[64 * j];
        } else sample_row_sum(a, (const float*)(a.ws + WS_X2) + (size_t)r * DM, r - TP, DFF / 256, lane, v);
#pragma unroll
        for (int j = 0; j < 8; ++j) s += (v[j].x * v[j].x + v[j].y * v[j].y) + (v[j].z * v[j].z + v[j].w * v[j].w);
        const float rstd = rsqrtf(wave_sum(s) * (1.f / 2048.f) + 1e-6f);
        f32x4* o = (f32x4*)(a.out + (r < TP ? O_YP + (size_t)r * DM : O_YS + (size_t)(r - TP) * DM)) + lane;
#pragma unroll
        for (int j = 0; j < 8; ++j) o[64 * j] = v[j] * rstd * gr[64 * j];
    }
}
#define PHASES_REST \
    if (IN(3)) { phase3(args, lds); } SEAM(3); \
    if (IN(4)) { phase4(args, lds); } SEAM(4); \
    if (IN(5)) { phase5(args, lds); } SEAM(5); \
    if (IN(6)) { phase6(args, lds); } SEAM(6); \
    if (IN(7)) { phase7(args, lds); } SEAM(7); \
    if (IN(8)) { phase8(args, lds); } SEAM(8); \
    if (IN(9)) { phase_norm(args, WS_X1, (const float*)args.in[I_XS], DM / 256, 1); } SEAM(9); \
    if (IN(10)) { phase10(args, lds); } SEAM(10); \
    if (IN(11)) { phase11(args, lds); } SEAM(11); \
    if (IN(12)) { phase12(args, lds); } SEAM(12); \
    if (IN(13)) { phase_norm(args, WS_X2, (const float*)(args.ws + WS_X1) + (size_t)TP * DM, 512 / 256, 3); } SEAM(13); \
    if (IN(14)) { phase14(args, lds); } SEAM(14); \
    if (IN(15)) { phase15(args, lds); } SEAM(15); \
    if (IN(16)) { phase16(args, lds); } SEAM(16); \
    if (IN(17)) { phase17(args); }
#ifndef MK_N_LAUNCHES
#define MK_N_LAUNCHES 1
#endif
constexpr int N_PHASES = 18;
__global__ void __launch_bounds__(NTHR, 2) mk_fwd(Args args) {
    extern __shared__ __attribute__((aligned(16))) unsigned char lds_raw[];
    LAS unsigned char* lds = (LAS unsigned char*)lds_raw;
    volatile LAS unsigned* MISC = (volatile LAS unsigned*)(lds + MISC_OFF);
    const int tid = threadIdx.x;
    for (int u = tid; u < 64; u += NTHR) ((LAS unsigned*)(lds + MISC_OFF))[u] = 0u;
    __syncthreads();
    unsigned* ctl = (unsigned*)(args.ws + WS_CTL);
    XcdBarrier bar; bar.bar = ctl + CW_BAR; bar.x = 0; bar.st = nullptr;
    const bool use_bar = (args.ph_hi - args.ph_lo) > 1;
    if (use_bar) bar = xcd_barrier_post(ctl + CW_BAR, MISC + 8);
    const int lo = args.ph_lo, hi = args.ph_hi;
#define IN(k) (lo <= (k) && (k) < hi)
#define SEAM(k) do { if (IN(k) && IN((k) + 1)) xcd_barrier(bar); } while (0)
    if (IN(0)) { phase0(args, lds); } SEAM(0);
    if (IN(1)) { phase1(args, lds); } SEAM(1);
    if (IN(2)) { phase2(args, lds); } SEAM(2);
    PHASES_REST
#undef IN
#undef SEAM
}

extern "C" void kernel_launch(void* const* d_in, const int* in_sizes, int n_in, void* d_out, int out_size, void* d_ws, size_t ws_size, hipStream_t stream) {
    static int grid = 0;
    if (grid == 0) {
        if (n_in != N_IN || (size_t)out_size != O_END || ws_size < WS_END) { fprintf(stderr, "kernel_launch: unexpected shapes: n_in %d out %d ws %zu (need %zu)\n", n_in, out_size, ws_size, (size_t)WS_END); grid = -1; return; }
        int dev = 0, cus = 0, per_cu = 0;
        if (hipGetDevice(&dev) != hipSuccess || hipDeviceGetAttribute(&cus, hipDeviceAttributeMultiprocessorCount, dev) != hipSuccess) { grid = -1; return; }
        if (hipFuncSetAttribute((const void*)mk_fwd, hipFuncAttributeMaxDynamicSharedMemorySize, LDS_BYTES) != hipSuccess) { fprintf(stderr, "kernel_launch: hipFuncSetAttribute failed\n"); grid = -1; return; }
        if (hipOccupancyMaxActiveBlocksPerMultiprocessor(&per_cu, (const void*)mk_fwd, NTHR, LDS_BYTES) != hipSuccess || per_cu < 1) fprintf(stderr, "kernel_launch: occupancy query reports %d\n", per_cu);
        (void)hipGetLastError();
        grid = cus;
    }
    if (grid < 0) return;
    (void)hipMemsetAsync((char*)d_ws + WS_CTL, 0, CTL_BYTES, stream);
    Args a{};
    for (int i = 0; i < N_IN; ++i) a.in[i] = d_in[i];
    a.out = (float*)d_out; a.ws = (unsigned char*)d_ws;
#if MK_N_LAUNCHES == 1
    a.ph_lo = 0; a.ph_hi = N_PHASES;
    hipLaunchKernelGGL(mk_fwd, dim3(grid), dim3(NTHR), LDS_BYTES, stream, a);
#else
    for (int p = 0; p < N_PHASES; ++p) { a.ph_lo = p; a.ph_hi = p + 1; hipLaunchKernelGGL(mk_fwd, dim3(grid), dim3(NTHR), LDS_BYTES, stream, a); }
#endif
}
```

```cpp
#include <hip/hip_runtime.h>
#include <cstdio>
#include <cstdint>

#define DI __device__ __forceinline__
#define LAS __attribute__((address_space(3)))
typedef unsigned short bf16_t;
typedef short bf16x8 __attribute__((ext_vector_type(8)));
typedef float f32x4 __attribute__((ext_vector_type(4)));
typedef float f32x2 __attribute__((ext_vector_type(2)));
typedef unsigned u32x4 __attribute__((ext_vector_type(4)));
typedef unsigned u32x2 __attribute__((ext_vector_type(2)));

constexpr int DM = 2048, SEQ = 4096, TP = 8192, TS = 128, TT = 8320, MP = 8448;
constexpr int DIN = 8320, DINP = 8448, DFF = 5632, DFF2 = 11264;
constexpr int NPAGES = 64;
constexpr int C_QA = 0, C_KVA = 1024, C_GA = 1792, C_QB = 1840, C_KVB = 2864, C_QI = 3120, C_KI = 4144, C_WI = 4208, C_GM = 4224;
constexpr size_t O_YP = 0, O_YS = O_YP + (size_t)TP * DM, O_NSAP = O_YS + (size_t)TS * DM, O_NSAS = O_NSAP + (size_t)TP * 512, O_WINP = O_NSAS + (size_t)TS * 512,
                 O_WINS = O_WINP + (size_t)2 * 512 * 256, O_DSAP = O_WINS + (size_t)32 * 512 * 256, O_DSAS = O_DSAP + (size_t)TP * 320, O_MEMP = O_DSAS + (size_t)TS * 320,
                 O_CONVP = O_MEMP + (size_t)512 * 1024, O_CONVS = O_CONVP + (size_t)2 * 2 * DFF2, O_END = O_CONVS + (size_t)32 * 2 * DFF2;
static_assert(O_END == 29708288, "output size");
enum { I_XP = 0, I_XS, I_MEM, I_CNSA, I_SWIN, I_CDSA, I_CMEM, I_SCONV, I_PT, I_NG, I_WIN, I_PE, I_CW1, I_CB1, I_CW2, I_WOA, I_WOB, I_WO, I_WMQ, I_WMKV, I_WMO, I_WUP, I_CVW, I_CVB, I_WDN, I_FG, N_IN };

constexpr size_t al256(size_t x) { return (x + 255) & ~(size_t)255; }
constexpr size_t WS_CTL = 0, CTL_BYTES = 1u << 20;
constexpr size_t WS_BT_IN = CTL_BYTES;
constexpr size_t WS_BT_OA = WS_BT_IN + (size_t)DINP * DM * 2;
constexpr size_t WS_BT_OB = WS_BT_OA + (size_t)DM * 1024 * 2;
constexpr size_t WS_BT_O = WS_BT_OB + (size_t)DM * 1024 * 2;
constexpr size_t WS_BT_MQ = WS_BT_O + (size_t)DM * DM * 2;
constexpr size_t WS_BT_MKV = WS_BT_MQ + (size_t)512 * DM * 2;
constexpr size_t WS_BT_MO = WS_BT_MKV + (size_t)1024 * DM * 2;
constexpr size_t WS_BT_UP = WS_BT_MO + (size_t)DM * 512 * 2;
constexpr size_t WS_BT_DN = WS_BT_UP + (size_t)DFF2 * DM * 2;
constexpr size_t WS_BT_C1 = WS_BT_DN + (size_t)DM * DFF * 2;
constexpr size_t WS_XN = WS_BT_C1 + (size_t)2 * 256 * 2048 * 2;
constexpr size_t WS_MEMN = WS_XN + (size_t)MP * DM * 2;
constexpr size_t WS_P = WS_MEMN + (size_t)512 * DM * 2;
constexpr size_t WS_QC = WS_P + (size_t)MP * DINP * 4;
constexpr size_t WS_QR = WS_QC + (size_t)MP * 1024 * 2;
constexpr size_t WS_QB = WS_QR + (size_t)MP * 1024 * 2;
constexpr size_t WS_QI = WS_QB + (size_t)MP * 1024 * 2;
constexpr size_t WS_GN = WS_QI + (size_t)MP * 1024 * 2;
constexpr size_t WS_WI = WS_GN + (size_t)MP * 48 * 4;
constexpr size_t WS_GAB = WS_WI + (size_t)MP * 16 * 4;
constexpr size_t WS_KW = WS_GAB + (size_t)MP * 4096 * 2;
constexpr int KCP_ROWS = SEQ + 32;
constexpr size_t WS_KCRAW = WS_KW + (size_t)MP * 256 * 4;
constexpr size_t KCS_OFF = (size_t)8 * KCP_ROWS * 64;
constexpr size_t WS_BPART = al256(WS_KCRAW + (KCS_OFF + (size_t)128 * 8192 * 64 + 64 * 64) * 2);
constexpr size_t WS_BIASC = WS_BPART + 16 * 512 * 4;
constexpr int HC_ROWS = 132 * 256;
constexpr size_t WS_HC = WS_BIASC + 512 * 4;
constexpr size_t WS_KCV = WS_HC + (size_t)2 * HC_ROWS * 256 * 2;
constexpr size_t WS_OCMP = WS_KCV + (size_t)34 * 4 * 512 * 64 * 4;
constexpr size_t WS_SEL = WS_OCMP + (size_t)MP * 1024 * 4;
constexpr size_t WS_IDX = WS_SEL + (size_t)MP * 32 * 4;
constexpr size_t WS_ONSA = WS_IDX + (size_t)MP * 256 * 4;
constexpr size_t WS_ODSA = WS_ONSA + (size_t)MP * 1024 * 2;
constexpr size_t WS_TMPG = WS_ODSA + (size_t)MP * 1024 * 2;
constexpr size_t WS_MG = WS_TMPG + (size_t)MP * DM * 4;
constexpr size_t WS_X1 = WS_MG + (size_t)MP * DM * 2;
constexpr size_t WS_X2 = WS_X1 + (size_t)MP * DM * 4;
constexpr size_t WS_X3 = WS_X2 + (size_t)MP * DM * 4;
constexpr size_t WS_QMB = WS_X3 + (size_t)MP * DM * 4;
constexpr size_t WS_OM = WS_QMB + (size_t)MP * 512 * 2;
constexpr size_t WS_UB = WS_OM + (size_t)MP * 512 * 2;
constexpr size_t WS_ACT = WS_UB + (size_t)MP * DFF2 * 2;
constexpr size_t WS_NSAF = WS_ACT + (size_t)MP * DFF * 2;
constexpr size_t WS_KCF = WS_NSAF + (size_t)4 * 128 * 8192 * 2;
constexpr size_t WS_KIF = WS_KCF + (size_t)34 * 2 * 16 * 4096 * 2;
constexpr size_t WS_DSAB = WS_KIF + (size_t)2 * 256 * 1024 * 2;
constexpr size_t WS_PART = WS_DSAB + (size_t)2 * 4096 * 256 * 2;
constexpr size_t WS_KIFS = WS_PART + (size_t)22 * 128 * DM * 4;
constexpr size_t WS_END = WS_KIFS + (size_t)32 * 513 * 1024 * 2;
static_assert(WS_END < (size_t)2400 * 1024 * 1024, "ws map too large");
constexpr int CW_BAR = 4096;

constexpr int RING_BYTES = 131072, LDS_BYTES = 147456, MISC_OFF = LDS_BYTES - 256;

#define LDS_WAIT() asm volatile("s_waitcnt lgkmcnt(0)" ::: "memory")
#define VM_WAIT() asm volatile("s_waitcnt vmcnt(0)" ::: "memory")
DI unsigned cvt_pk_bf16(float lo, float hi) { unsigned r; asm volatile("v_cvt_pk_bf16_f32 %0, %1, %2" : "=v"(r) : "v"(lo), "v"(hi)); return r; }
DI float bf2f(bf16_t b) { return __uint_as_float(((unsigned)b) << 16); }
DI bf16x8 cvt8(f32x4 a, f32x4 b) { u32x4 w; w.x = cvt_pk_bf16(a.x, a.y); w.y = cvt_pk_bf16(a.z, a.w); w.z = cvt_pk_bf16(b.x, b.y); w.w = cvt_pk_bf16(b.z, b.w); return __builtin_bit_cast(bf16x8, w); }
DI u32x2 cvt4(f32x4 a) { u32x2 w; w.x = cvt_pk_bf16(a.x, a.y); w.y = cvt_pk_bf16(a.z, a.w); return w; }
DI float wave_sum(float v) {
#pragma unroll
    for (int o = 1; o < 64; o <<= 1) v += __shfl_xor(v, o);
    return v;
}
DI f32x4 shfl_xor4(f32x4 v, int m) { f32x4 r; r.x = __shfl_xor(v.x, m); r.y = __shfl_xor(v.y, m); r.z = __shfl_xor(v.z, m); r.w = __shfl_xor(v.w, m); return r; }
DI float sigmoidf_(float x) { return 1.f / (1.f + __expf(-x)); }
#define MFMA16(a, b, c) __builtin_amdgcn_mfma_f32_16x16x32_bf16((a), (b), (c), 0, 0, 0)
namespace pg8 {
constexpr int BM = 256, BK = 64, HALF = 128, HTB = HALF * BK * 2  , STAGE_BYTES = 8 * HTB, NXCD = 8, WGM = 8;
__host__ __device__ __forceinline__ int lds_byte(int r, int c) { const int st = (r >> 4) * 2 + (c >> 5), rr = r & 15, cc = c & 31, ob = rr * 64 + cc * 2; return st * 1024 + (ob ^ (((ob >> 9) & 1) << 5)); }
__host__ __device__ __forceinline__ void stage_rc(int b, int& R, int& C) { const int st = b / 1024, sb = b % 1024, swz = sb ^ (((sb >> 9) & 1) << 5); R = (st >> 1) * 16 + swz / 64; C = (st & 1) * 32 + (swz % 64) / 2; }

struct Unit { int pm, pn, ks; };
struct Gemm { const bf16_t* A; const bf16_t* Bt; int lda, ldb, K; };

struct StaticOrder {
    int nM, nN, nwg, G, c, lda, ldb;
    __device__ void init(int nM_, int nN_, int G_, int c_, int lda_, int ldb_) { nM = nM_; nN = nN_; nwg = nM * nN; G = G_; c = c_; lda = lda_; ldb = ldb_; }
    __device__ bool next(int i, Unit& u) const { return at((long)i * G + c, u); }
    __device__ bool at(long L, Unit& u) const {
        if (L >= nwg) return false;
        int wgid = (int)L; { const int q = nwg / NXCD, r = nwg % NXCD, xcd = wgid % NXCD, off = wgid / NXCD; wgid = (xcd < r ? xcd * (q + 1) : r * (q + 1) + (xcd - r) * q) + off; }
        const int nig = WGM * nN, gid = wgid / nig, fm = gid * WGM, gsz = (nM - fm) < WGM ? (nM - fm) : WGM;
        u.pm = fm + ((wgid % nig) % gsz); u.pn = (wgid % nig) / gsz; u.ks = 0; return true;
    }
    __device__ __forceinline__ size_t offA(const Unit& u) const { return (size_t)u.pm * BM * lda * 2; }
    __device__ __forceinline__ size_t offB(const Unit& u) const { return (size_t)u.pn * BM * ldb * 2; }
};

template <class F> struct EpiEach {
    static constexpr bool HAS_MID = false;
    F f;
    __device__ __forceinline__ void operator()(const f32x4 (&acc)[2][2][4][2], const Unit& u, int wr, int wc, int fr, int fq) const {
#pragma unroll
        for (int ai = 0; ai < 2; ++ai)
#pragma unroll
            for (int m = 0; m < 4; ++m) { const int row = ai * HALF + wr * 64 + m * 16 + fr;
#pragma unroll
                for (int bj = 0; bj < 2; ++bj)
#pragma unroll
                    for (int n = 0; n < 2; ++n) f(u, row, bj * HALF + wc * 32 + n * 16 + 4 * fq, acc[ai][bj][m][n]); }
    }
};

template <class Epi, class Sched>
__device__ __forceinline__ void gemm_phase(LAS unsigned char* lds, const Gemm g, const Sched& S, const Epi& E) {
    const int tid = threadIdx.x, wid = __builtin_amdgcn_readfirstlane(tid >> 6), lane = tid & 63, wr = wid >> 2, wc = wid & 3, fr = lane & 15, fq = lane >> 4;
    const int nt = g.K / BK;
    unsigned voffA[2], voffB[2];
#pragma unroll
    for (int i = 0; i < 2; ++i) { int R, C; stage_rc(tid * 16 + i * 8192, R, C); voffA[i] = (unsigned)(R * g.lda + C) * 2u; voffB[i] = (unsigned)(R * g.ldb + C) * 2u; }
    const size_t kstep = (size_t)(BK * 2);
    const size_t hA = (size_t)HALF * g.lda * 2, hB = (size_t)HALF * g.ldb * 2;
    const unsigned ldsw = (unsigned)wid * 1024u;
    const int aoff = lds_byte(wr * 64 + fr, fq * 8), boff = lds_byte(wc * 32 + fr, fq * 8);
#define PG8_SA(b, h) (((b) * 2 + (h)) * HTB)
#define PG8_SB(b, h) ((4 + (b) * 2 + (h)) * HTB)
#define PG8_STAGE(bufoff, gbase, voff) do { _Pragma("unroll") for (int _i = 0; _i < 2; ++_i) \
        __builtin_amdgcn_global_load_lds((const unsigned*)((const char*)(gbase) + (voff)[_i]), (LAS unsigned*)(lds + (bufoff) + ldsw + _i * 8192), 16, 0, 0); } while (0)
#define PG8_LDA(dst, b, h) do { _Pragma("unroll") for (int m = 0; m < 4; ++m) _Pragma("unroll") for (int k = 0; k < 2; ++k) dst[m][k] = *(const LAS bf16x8*)(lds + PG8_SA(b, h) + aoff + m * 2048 + k * 1024); } while (0)
#define PG8_LDB(dst, b, h) do { _Pragma("unroll") for (int n = 0; n < 2; ++n) _Pragma("unroll") for (int k = 0; k < 2; ++k) dst[n][k] = *(const LAS bf16x8*)(lds + PG8_SB(b, h) + boff + n * 2048 + k * 1024); } while (0)
#define PG8_MMA(ai, bj, At, Bt) do { __builtin_amdgcn_s_setprio(1); _Pragma("unroll") for (int m = 0; m < 4; ++m) _Pragma("unroll") for (int n = 0; n < 2; ++n) _Pragma("unroll") for (int k = 0; k < 2; ++k) \
        acc[ai][bj][m][n] = __builtin_amdgcn_mfma_f32_16x16x32_bf16(Bt[n][k], At[m][k], acc[ai][bj][m][n], 0, 0, 0); __builtin_amdgcn_s_setprio(0); } while (0)
#define PG8_WAIT_V(n) asm volatile("s_waitcnt vmcnt(" #n ")" ::: "memory")
#define PG8_WAIT_L(n) asm volatile("s_waitcnt lgkmcnt(" #n ")" ::: "memory")
#define PG8_BAR __builtin_amdgcn_s_barrier()
#define PG8_SCHED __builtin_amdgcn_sched_barrier(0)
    Unit cur, nxt; int ui = 0;
    if (!S.next(0, cur)) return;
    f32x4 acc[2][2][4][2];
#pragma unroll
    for (int a = 0; a < 2; ++a)
#pragma unroll
        for (int b = 0; b < 2; ++b)
#pragma unroll
            for (int m = 0; m < 4; ++m)
#pragma unroll
                for (int n = 0; n < 2; ++n) acc[a][b][m][n] = (f32x4){0.f, 0.f, 0.f, 0.f};
    bf16x8 At[4][2], B0[2][2], B1[2][2];
    const char* cA = (const char*)g.A + S.offA(cur); const char* cB = (const char*)g.Bt + S.offB(cur);
    PG8_STAGE(PG8_SB(0, 0), cB, voffB); PG8_STAGE(PG8_SB(0, 1), cB + hB, voffB); PG8_STAGE(PG8_SA(0, 0), cA, voffA); PG8_STAGE(PG8_SA(0, 1), cA + hA, voffA);
    if (wr == 1) PG8_BAR;
    PG8_WAIT_V(2); PG8_BAR;
    PG8_STAGE(PG8_SB(1, 0), cB + kstep, voffB); PG8_STAGE(PG8_SA(1, 0), cA + kstep, voffA); PG8_STAGE(PG8_SB(1, 1), cB + hB + kstep, voffB);
    PG8_WAIT_V(6); PG8_BAR;
    for (;;) {
        const bool has_next = S.next(ui + 1, nxt);
        const char* nA = has_next ? (const char*)g.A + S.offA(nxt) : cA; const char* nB = has_next ? (const char*)g.Bt + S.offB(nxt) : cB;
        constexpr int NHALF = Epi::HAS_MID ? 2 : 1; const int tlen = nt / NHALF;
#pragma unroll 1
        for (int hf = 0; hf < NHALF; ++hf) {
#pragma unroll 1
        for (int t = hf * tlen; t < (hf + 1) * tlen; t += 2) {
            const bool last = (t == nt - 2);
            const char* a1 = cA + (size_t)(t + 1) * kstep;
            const char* a2 = last ? nA : cA + (size_t)(t + 2) * kstep; const char* b2 = last ? nB : cB + (size_t)(t + 2) * kstep;
            const char* a3 = a2 + kstep; const char* b3 = b2 + kstep;
            PG8_LDB(B0, 0, 0); PG8_LDB(B1, 0, 1); PG8_SCHED; PG8_LDA(At, 0, 0); PG8_STAGE(PG8_SA(1, 1), a1 + hA, voffA);
            PG8_WAIT_V(8); PG8_WAIT_L(0); PG8_BAR; PG8_MMA(0, 0, At, B0); PG8_MMA(0, 1, At, B1); PG8_BAR; PG8_SCHED;
            PG8_LDA(At, 0, 1); PG8_STAGE(PG8_SB(0, 0), b2, voffB); PG8_STAGE(PG8_SB(0, 1), b2 + hB, voffB); PG8_STAGE(PG8_SA(0, 0), a2, voffA);
            PG8_WAIT_V(8); PG8_WAIT_L(0); PG8_BAR; PG8_MMA(1, 0, At, B0); PG8_MMA(1, 1, At, B1); PG8_BAR; PG8_SCHED;
            PG8_LDB(B0, 1, 0); PG8_LDB(B1, 1, 1); PG8_SCHED; PG8_LDA(At, 1, 0); PG8_STAGE(PG8_SA(0, 1), a2 + hA, voffA);
            PG8_WAIT_V(8); PG8_WAIT_L(0); PG8_BAR; PG8_MMA(0, 0, At, B0); PG8_MMA(0, 1, At, B1); PG8_BAR; PG8_SCHED;
            PG8_LDA(At, 1, 1); PG8_STAGE(PG8_SB(1, 0), b3, voffB); PG8_STAGE(PG8_SB(1, 1), b3 + hB, voffB); PG8_STAGE(PG8_SA(1, 0), a3, voffA);
            PG8_WAIT_V(8); PG8_WAIT_L(0); PG8_BAR; PG8_MMA(1, 0, At, B0); PG8_MMA(1, 1, At, B1); PG8_BAR; PG8_SCHED;
        }
        if constexpr (Epi::HAS_MID) { if (hf == 0) E.mid(acc, cur, wr, wc, fr, fq); }
        }
        if (wr == 0) PG8_BAR;
        E(acc, cur, wr, wc, fr, fq);
        if (!has_next) break;
#pragma unroll
        for (int a = 0; a < 2; ++a)
#pragma unroll
            for (int b = 0; b < 2; ++b)
#pragma unroll
                for (int m = 0; m < 4; ++m)
#pragma unroll
                    for (int n = 0; n < 2; ++n) acc[a][b][m][n] = (f32x4){0.f, 0.f, 0.f, 0.f};
        cur = nxt; cA = nA; cB = nB; ++ui;
        if (wr == 1) PG8_BAR;
    }
    PG8_WAIT_V(0);
    PG8_BAR;
#undef PG8_SA
#undef PG8_SB
#undef PG8_STAGE
#undef PG8_LDA
#undef PG8_LDB
#undef PG8_MMA
#undef PG8_WAIT_V
#undef PG8_WAIT_L
#undef PG8_BAR
#undef PG8_SCHED
}
}
#define XB_TMO      128
#define XB_XCNT(j)  (256  + 64 * (j))
#define XB_XSUB(j)  (1280 + 64 * (j))
#define XB_XGEN(j)  (2304 + 64 * (j))
#define XB_TOP      3328
#define XB_TOPGEN   3392
#define XCD_BAR_WORDS 3456
#define XB_SPIN_CAP (1u << 18)

__device__ __forceinline__ unsigned xb_ld(unsigned* p)              { return __hip_atomic_load(p, __ATOMIC_RELAXED, __HIP_MEMORY_SCOPE_AGENT); }
__device__ __forceinline__ unsigned xb_add(unsigned* p, unsigned v) { return __hip_atomic_fetch_add(p, v, __ATOMIC_RELAXED, __HIP_MEMORY_SCOPE_AGENT); }
__device__ __forceinline__ unsigned xb_xcc_id() { return (unsigned)__builtin_amdgcn_s_getreg((3 << 11) | 20) & 0xFu; }
#define XB_SPIN(cond, bar) do { unsigned _sp = 0; while (cond) { __builtin_amdgcn_s_sleep(1); \
    if ((++_sp & 255u) == 0u) { if (xb_ld(&(bar)[XB_TMO])) break; if (_sp > XB_SPIN_CAP) { atomicAdd(&(bar)[XB_TMO], 1u); break; } } } } while (0)

struct XcdBarrier {
    unsigned* bar; unsigned x;
    volatile LAS unsigned* st;
};

__device__ __forceinline__ XcdBarrier xcd_barrier_post(unsigned* bar, volatile LAS unsigned* st) {
    XcdBarrier b; b.bar = bar; b.x = xb_xcc_id(); b.st = st;
    if (threadIdx.x == 0) (void)xb_add(&bar[XB_XCNT(b.x)], 1u);
    return b;
}
__device__ __forceinline__ void xcd_barrier_complete(unsigned* bar, unsigned x, unsigned& nloc, unsigned& nx) {
    const unsigned G = gridDim.x * gridDim.y * gridDim.z;
    unsigned sum, cnt, mine, sp = 0u;
    for (;;) {
        sum = 0u; cnt = 0u; mine = 0u;
#pragma unroll
        for (unsigned j = 0; j < 16; ++j) { const unsigned c = xb_ld(&bar[XB_XCNT(j)]); sum += c; cnt += (c > 0u) ? 1u : 0u; mine = (j == x) ? c : mine; }
        if (sum == G) break;
        __builtin_amdgcn_s_sleep(1);
        if ((++sp & 255u) == 0u) { if (xb_ld(&bar[XB_TMO])) break; if (sp > XB_SPIN_CAP) { atomicAdd(&bar[XB_TMO], 1u); break; } }
    }
    nloc = mine > 0u ? mine : 1u; nx = cnt > 0u ? cnt : 1u;
}

__device__ __forceinline__ void xcd_barrier(const XcdBarrier& b) {
    asm volatile("s_waitcnt vmcnt(0)" ::: "memory");
    __syncthreads();
    if (threadIdx.x == 0) {
        unsigned* bar = b.bar;
        __builtin_amdgcn_s_waitcnt(0);
        unsigned nloc = b.st[0], nx = b.st[1];
        if (nloc == 0u) { xcd_barrier_complete(bar, b.x, nloc, nx); b.st[0] = nloc; b.st[1] = nx; }
        const unsigned old = xb_add(&bar[XB_XSUB(b.x)], 1u);
        const unsigned gen = old / nloc;
        if (old + 1u == (gen + 1u) * nloc) {
            __builtin_amdgcn_fence(__ATOMIC_RELEASE, "agent");
            asm volatile("s_waitcnt vmcnt(0)" ::: "memory");
            const unsigned og = xb_add(&bar[XB_TOP], 1u);
            const unsigned tg = og / nx;
            if (og + 1u == (tg + 1u) * nx) xb_add(&bar[XB_TOPGEN], 1u);
            else XB_SPIN(xb_ld(&bar[XB_TOPGEN]) == tg, bar);
            __builtin_amdgcn_fence(__ATOMIC_ACQUIRE, "agent");
            xb_add(&bar[XB_XGEN(b.x)], 1u);
            asm volatile("s_waitcnt vmcnt(0)" ::: "memory");
        } else {
            XB_SPIN(xb_ld(&bar[XB_XGEN(b.x)]) == gen, bar);
            __builtin_amdgcn_fence(__ATOMIC_ACQUIRE, "agent");
            asm volatile("s_waitcnt vmcnt(0)" ::: "memory");
        }
    }
    __syncthreads();
}
struct Args { const void* in[N_IN]; float* out; unsigned char* ws; int ph_lo, ph_hi; };
constexpr int NWAVES = 8, NTHR = 512;

struct FStoreF32 { float* C; int ldc; DI void operator()(const pg8::Unit& u, int row, int col, f32x4 v) const { *(f32x4*)(C + (size_t)(u.pm * 256 + row) * ldc + u.pn * 256 + col) = v; } };

DI void p0_transpose_item(const float* W, int K, int N, bf16_t* WT, LAS float* scr, int item, int lane, int ldw = 0) {
    if (ldw == 0) ldw = K;
    const int nblk = N / 32, kb = item / nblk, nb = item % nblk, k0 = 64 * kb, n0 = 32 * nb;
#pragma unroll 8
    for (int i = 0; i < 32; ++i) { const int kk = 2 * i + (lane >> 5); scr[kk * 33 + (lane & 31)] = W[(size_t)(k0 + kk) * N + n0 + (lane & 31)]; }
    LDS_WAIT();
    const int c = lane & 7;
#pragma unroll
    for (int j = 0; j < 4; ++j) { const int n = (lane >> 3) + 8 * j; const LAS float* s = scr + (8 * c) * 33 + n;
        u32x4 o; o.x = cvt_pk_bf16(s[0 * 33], s[1 * 33]); o.y = cvt_pk_bf16(s[2 * 33], s[3 * 33]); o.z = cvt_pk_bf16(s[4 * 33], s[5 * 33]); o.w = cvt_pk_bf16(s[6 * 33], s[7 * 33]);
        *(u32x4*)(WT + (size_t)(n0 + n) * ldw + k0 + 8 * c) = o; }
    LDS_WAIT();
}
DI void rms_row_bf16(const float* xrow, const float* g, bf16_t* orow, int lane) {
    const f32x4* xr = (const f32x4*)xrow + lane; const f32x4* gr = (const f32x4*)g + lane;
    f32x4 v[8]; float s = 0.f;
#pragma unroll
    for (int j = 0; j < 8; ++j) { v[j] = xr[64 * j]; s += (v[j].x * v[j].x + v[j].y * v[j].y) + (v[j].z * v[j].z + v[j].w * v[j].w); }
    const float rstd = rsqrtf(wave_sum(s) * (1.f / 2048.f) + 1e-6f);
    u32x2* o8 = (u32x2*)orow + lane;
#pragma unroll
    for (int j = 0; j < 8; ++j) { const f32x4 gg = gr[64 * j]; o8[64 * j] = cvt4(v[j] * rstd * gg); }
}

constexpr int NT_IN = 32 * 260, NT_OA = 16 * 64, NT_O = 32 * 64, NT_MQ = 32 * 16, NT_MKV = 32 * 32, NT_MO = 8 * 64, NT_UP = 32 * 352, NT_DN = 88 * 64, NT_C1 = 32 * 8;
constexpr int N_PG = 32 * NPAGES, N_BP = 128, N_WC = 32 * 508;
constexpr int PI_A = NT_IN + NT_MKV + TT + 512;
constexpr int PI_B = PI_A + 2 * N_PG + 2 * NT_C1 + N_BP + N_WC;
constexpr int PI_C = PI_B + NT_UP + NT_DN + NT_O + 2 * NT_OA + NT_MQ + NT_MO;
DI void prologue_item(const Args& a, LAS float* scr, int lane, int it) {
    unsigned char* ws = a.ws; int r = it;
    if (r < NT_IN) { p0_transpose_item((const float*)a.in[I_WIN], DM, DIN, (bf16_t*)(ws + WS_BT_IN), scr, r, lane); return; } r -= NT_IN;
    if (r < NT_MKV) { p0_transpose_item((const float*)a.in[I_WMKV], DM, 1024, (bf16_t*)(ws + WS_BT_MKV), scr, r, lane); return; } r -= NT_MKV;
    if (r < TT) {
        const float* xrow = r < TP ? (const float*)a.in[I_XP] + (size_t)r * DM : (const float*)a.in[I_XS] + (size_t)(r - TP) * DM;
        rms_row_bf16(xrow, (const float*)a.in[I_NG], (bf16_t*)(ws + WS_XN) + (size_t)r * DM, lane); return; } r -= TT;
    if (r < 512) { rms_row_bf16((const float*)a.in[I_MEM] + (size_t)r * DM, (const float*)a.in[I_NG] + 2 * DM, (bf16_t*)(ws + WS_MEMN) + (size_t)r * DM, lane); return; } r -= 512;
    if (r < N_PG) {
        const int db = r >> 6, pj = r & 63; const int page = ((const int*)a.in[I_PT])[db * NPAGES + pj];
        const float* src = (const float*)a.in[I_CNSA] + (size_t)page * 128 * 512;
        bf16_t* dst = (bf16_t*)(ws + WS_KCRAW) + KCS_OFF;
        const int c = lane >> 5, g = (lane >> 4) & 1, d0 = (lane & 15) * 4;
        bf16_t* drow = dst + ((size_t)((db * 2 + c) * 2 + g) * 8192 + pj * 128) * 64 + d0;
#pragma unroll 8
        for (int s = 0; s < 128; ++s) { const f32x4 v = *(const f32x4*)(src + (size_t)s * 512 + lane * 4); *(u32x2*)(drow + (size_t)s * 64) = cvt4(v); }
        return; } r -= N_PG;
    if (r < N_PG) {
        const int db = r >> 6, pj = r & 63; const int page = ((const int*)a.in[I_PT])[db * NPAGES + pj];
        const float* src = (const float*)a.in[I_CDSA] + (size_t)page * 128 * 320 + 256;
        bf16_t* dst = (bf16_t*)(ws + WS_KIFS) + ((size_t)db * 513 + pj * 8) * 1024;
        const int sl = lane >> 4, d0 = (lane & 15) * 4;
#pragma unroll 8
        for (int i = 0; i < 32; ++i) { const int slot = 4 * i + sl; const f32x4 v = *(const f32x4*)(src + (size_t)slot * 320 + d0);
            *(u32x2*)(dst + ((size_t)(slot >> 4) * 2 + (d0 >> 5)) * 512 + (((d0 >> 3) & 3) * 16 + (slot & 15)) * 8 + ((d0 >> 2) & 1) * 4) = cvt4(v); }
        return; } r -= N_PG;
    if (r < NT_C1) { p0_transpose_item((const float*)a.in[I_CW1], 2048, 256, (bf16_t*)(ws + WS_BT_C1), scr, r, lane); return; } r -= NT_C1;
    if (r < NT_C1) { p0_transpose_item((const float*)a.in[I_CW1] + (size_t)2048 * 256, 2048, 256, (bf16_t*)(ws + WS_BT_C1) + (size_t)256 * 2048, scr, r, lane); return; } r -= NT_C1;
    if (r < N_BP) {
        const int kv = r >> 6, nch = (r >> 4) & 3, kch = r & 15, n = nch * 64 + lane;
        const float* pe = (const float*)a.in[I_PE] + (size_t)kv * 2048 + kch * 128; const float* w1 = (const float*)a.in[I_CW1] + ((size_t)kv * 2048 + kch * 128) * 256 + n;
        float acc = 0.f;
#pragma unroll 8
        for (int k = 0; k < 128; ++k) acc += pe[k] * w1[(size_t)k * 256];
        ((float*)(ws + WS_BPART))[(kch * 2 + kv) * 256 + n] = acc; return; } r -= N_BP;
    if (r < N_WC) {
        const int db = r / 508, j = r % 508;
        const f32x4 v = *((const f32x4*)((const float*)a.in[I_SWIN] + ((size_t)db * 512 + j + 4) * 256) + lane);
        *((f32x4*)(a.out + O_WINS + ((size_t)db * 512 + j) * 256) + lane) = v; return; } r -= N_WC;
    if (r < NT_UP) { p0_transpose_item((const float*)a.in[I_WUP], DM, DFF2, (bf16_t*)(ws + WS_BT_UP), scr, r, lane); return; } r -= NT_UP;
    if (r < NT_DN) { p0_transpose_item((const float*)a.in[I_WDN], DFF, DM, (bf16_t*)(ws + WS_BT_DN), scr, r, lane); return; } r -= NT_DN;
    if (r < NT_O) { p0_transpose_item((const float*)a.in[I_WO], DM, DM, (bf16_t*)(ws + WS_BT_O), scr, r, lane); return; } r -= NT_O;
    if (r < NT_OA) { p0_transpose_item((const float*)a.in[I_WOA], 1024, DM, (bf16_t*)(ws + WS_BT_OA), scr, r, lane, 2048); return; } r -= NT_OA;
    if (r < NT_OA) { p0_transpose_item((const float*)a.in[I_WOB], 1024, DM, (bf16_t*)(ws + WS_BT_OA) + 1024, scr, r, lane, 2048); return; } r -= NT_OA;
    if (r < NT_MQ) { p0_transpose_item((const float*)a.in[I_WMQ], DM, 512, (bf16_t*)(ws + WS_BT_MQ), scr, r, lane); return; } r -= NT_MQ;
    p0_transpose_item((const float*)a.in[I_WMO], 512, DM, (bf16_t*)(ws + WS_BT_MO), scr, r, lane);
}
DI void prologue_fill(const Args& a, LAS unsigned char* lds, unsigned* ctr, int lo, int hi) {
    const int tid = threadIdx.x, lane = tid & 63, wave = __builtin_amdgcn_readfirstlane(tid >> 6);
    LAS float* scr = (LAS float*)(lds + wave * 16384);
#pragma unroll 1
    for (;;) { int v = 0; if (lane == 0) v = (int)__hip_atomic_fetch_add(ctr, 1u, __ATOMIC_RELAXED, __HIP_MEMORY_SCOPE_AGENT); const int it = lo + __builtin_amdgcn_readfirstlane(v); if (it >= hi) break; prologue_item(a, scr, lane, it); }
}
DI void phase0(const Args& a, LAS unsigned char* lds) {
    const int tid = threadIdx.x, lane = tid & 63, wave = __builtin_amdgcn_readfirstlane(tid >> 6);
    const int gw = blockIdx.x * NWAVES + wave, NGW = gridDim.x * NWAVES;
    LAS float* scr = (LAS float*)(lds + wave * 16384);
    unsigned char* ws = a.ws;
#pragma unroll 1
    for (int it = gw; it < PI_C; it += NGW) prologue_item(a, scr, lane, it);
    { const size_t gt = (size_t)blockIdx.x * NTHR + tid, NG = (size_t)gridDim.x * NTHR; const u32x4 z = (u32x4){0u, 0u, 0u, 0u};
      u32x4* p1 = (u32x4*)((bf16_t*)(ws + WS_BT_IN) + (size_t)DIN * DM); u32x4* p2 = (u32x4*)((bf16_t*)(ws + WS_XN) + (size_t)TT * DM);
      for (size_t i = gt; i < (size_t)128 * DM / 8; i += NG) { p1[i] = z; p2[i] = z; } }
}

DI f32x4 rope4(f32x4 v, f32x4 pv, int d0, int half, int tb, float cv, float sv) {
    const int fi = tb + (d0 & (half - 1));
    f32x4 c, s;
    c.x = __shfl(cv, fi); c.y = __shfl(cv, fi + 1); c.z = __shfl(cv, fi + 2); c.w = __shfl(cv, fi + 3);
    s.x = __shfl(sv, fi); s.y = __shfl(sv, fi + 1); s.z = __shfl(sv, fi + 2); s.w = __shfl(sv, fi + 3);
    const f32x4 lo = v * c - pv * s, hi = v * c + pv * s;
    return d0 < half ? lo : (d0 < 2 * half ? hi : v);
}
DI f32x4 sig4(f32x4 v) { f32x4 r; r.x = sigmoidf_(v.x); r.y = sigmoidf_(v.y); r.z = sigmoidf_(v.z); r.w = sigmoidf_(v.w); return r; }

DI void phase2(const Args& a, LAS unsigned char* lds) {
    const int tid = threadIdx.x, lane = tid & 63, wave = __builtin_amdgcn_readfirstlane(tid >> 6);
    const int gw = blockIdx.x * NWAVES + wave, NGW = gridDim.x * NWAVES;
    unsigned char* ws = a.ws; float* out = a.out;
    const float* P = (const float*)(ws + WS_P);
    bf16_t* QC = (bf16_t*)(ws + WS_QC); bf16_t* QR = (bf16_t*)(ws + WS_QR); bf16_t* QB = (bf16_t*)(ws + WS_QB); bf16_t* QI = (bf16_t*)(ws + WS_QI);
    float* GN = (float*)(ws + WS_GN); float* WI = (float*)(ws + WS_WI); bf16_t* GAB = (bf16_t*)(ws + WS_GAB); float* KW = (float*)(ws + WS_KW);
    bf16_t* KCP = (bf16_t*)(ws + WS_KCRAW); bf16_t* NSAF = (bf16_t*)(ws + WS_NSAF);
    if (gw == 0) {
        for (int i = lane; i < 512; i += 64) { float s = ((const float*)a.in[I_CB1])[i];
            for (int k = 0; k < 16; ++k) s += ((const float*)(ws + WS_BPART))[k * 512 + i];
            ((float*)(ws + WS_BIASC))[i] = s; }
    }
    for (int r = gw; r < TT; r += NGW) {
        const bool pr = r < TP; const int b = r >> 12, s = r & 4095, q = r - TP, db = q >> 2, tt = q & 3;
        const int pos = pr ? s : 8192 + tt;
        float cv, sv; { const float e = lane < 8 ? -(float)lane / 8.f : -(float)((lane - 8) & 15) / 16.f; const float inv = powf(500000.f, e); const float ang = (float)pos * inv; cv = cosf(ang); sv = sinf(ang); }
        const float* Pr = P + (size_t)r * DINP;
        f32x4 L_qa[4], L_kva[3], L_qb[4], L_qi[4], L_gm[16];
#pragma unroll
        for (int i = 0; i < 4; ++i) { L_qa[i] = *(const f32x4*)(Pr + C_QA + 256 * i + 4 * lane); L_qb[i] = *(const f32x4*)(Pr + C_QB + 256 * i + 4 * lane); L_qi[i] = *(const f32x4*)(Pr + C_QI + 256 * i + 4 * lane); }
#pragma unroll
        for (int i = 0; i < 3; ++i) L_kva[i] = *(const f32x4*)(Pr + C_KVA + 256 * i + 4 * lane);
#pragma unroll
        for (int i = 0; i < 16; ++i) L_gm[i] = *(const f32x4*)(Pr + C_GM + 256 * i + 4 * lane);
        const f32x4 L_ga = lane < 12 ? *(const f32x4*)(Pr + C_GA + 4 * lane) : (f32x4){0.f, 0.f, 0.f, 0.f};
        const f32x4 L_kvb = *(const f32x4*)(Pr + C_KVB + 4 * lane);
        const f32x4 L_ki = lane < 16 ? *(const f32x4*)(Pr + C_KI + 4 * lane) : (f32x4){0.f, 0.f, 0.f, 0.f};
        const f32x4 L_wi = lane < 4 ? *(const f32x4*)(Pr + C_WI + 4 * lane) : (f32x4){0.f, 0.f, 0.f, 0.f};
#pragma unroll
        for (int i = 0; i < 4; ++i) { const int col = 256 * i + 4 * lane; const f32x4 v = L_qa[i]; const f32x4 pv = shfl_xor4(v, 2);
            const f32x4 rv = rope4(v, pv, (4 * lane) & 63, 8, 0, cv, sv);
            *(u32x2*)(QC + (size_t)r * 1024 + col) = cvt4(v); *(u32x2*)(QR + (size_t)r * 1024 + col) = cvt4(rv); }
#pragma unroll
        for (int i = 0; i < 3; ++i) { const int cl = 256 * i + 4 * lane; const f32x4 v = L_kva[i]; const f32x4 pv = shfl_xor4(v, 2);
            const int j = cl >> 7, g = (cl >> 6) & 1, d0 = cl & 63;
            const f32x4 rv = rope4(v, pv, d0, 8, 0, cv, sv); const f32x4 o = (j == 2 || j == 4) ? rv : v;
            if (pr && j >= 2) {
                bf16_t* tile = NSAF + ((size_t)((b * 2 + g) * 128 + (s >> 5)) * 4 + (j - 2)) * 2048; const int slot = s & 31;
                if ((j & 1) == 0) { *(u32x2*)(tile + (((d0 >> 5) * 2 + (slot >> 4)) * 64 + ((d0 >> 3) & 3) * 16 + (slot & 15)) * 8 + ((d0 >> 2) & 1) * 4) = cvt4(o); }
                else { const int kgv = (slot & 15) >> 2, jv = (slot & 3) + ((slot >> 4) << 2); const u32x2 w = cvt4(o);
                    bf16_t* t0 = tile + (((d0 >> 4) * 64 + kgv * 16 + (d0 & 15)) * 8) + jv;
                    t0[0] = (bf16_t)(w.x & 0xffffu); t0[8] = (bf16_t)(w.x >> 16); t0[16] = (bf16_t)(w.y & 0xffffu); t0[24] = (bf16_t)(w.y >> 16); }
            }
            if (j < 4) {
                float* dst = pr ? out + O_NSAP + ((size_t)r * 4 + j) * 128 + g * 64 + d0 : out + O_NSAS + ((size_t)q * 4 + j) * 128 + g * 64 + d0;
                *(f32x4*)dst = o;
                if (pr && j < 2) *(u32x2*)(KCP + ((size_t)((b * 2 + j) * 2 + g) * KCP_ROWS + s) * 64 + d0) = cvt4(o);
            } else {
                const int kv = j - 4;
                *(f32x4*)(KW + (size_t)r * 256 + kv * 128 + g * 64 + d0) = o;
                if (pr) { if (s >= SEQ - 512) *(f32x4*)(out + O_WINP + (((size_t)b * 512 + s - (SEQ - 512)) * 2 + kv) * 128 + g * 64 + d0) = o; }
                else *(f32x4*)(out + O_WINS + (((size_t)db * 512 + 508 + tt) * 2 + kv) * 128 + g * 64 + d0) = o;
            } }
        if (lane < 12) { const f32x4 v = L_ga; *(f32x4*)(GN + (size_t)r * 48 + 4 * lane) = sig4(v); }
#pragma unroll
        for (int i = 0; i < 4; ++i) { const int col = 256 * i + 4 * lane; const f32x4 v = L_qb[i]; const f32x4 pv = shfl_xor4(v, 4);
            const f32x4 rv = rope4(v, pv, (4 * lane) & 127, 16, 8, cv, sv);
            *(u32x2*)(QB + (size_t)r * 1024 + col) = cvt4(rv); }
        { const int cl = 4 * lane; const f32x4 v = L_kvb; const f32x4 pv = shfl_xor4(v, 4);
          const f32x4 rv = rope4(v, pv, cl & 127, 16, 8, cv, sv); const f32x4 o = cl < 128 ? rv : v;
          float* dst = pr ? out + O_DSAP + (size_t)r * 320 + cl : out + O_DSAS + (size_t)q * 320 + cl; *(f32x4*)dst = o;
          if (pr) *(u32x2*)((bf16_t*)(ws + WS_DSAB) + (size_t)r * 256 + cl) = cvt4(o); }
#pragma unroll
        for (int i = 0; i < 4; ++i) { const int col = 256 * i + 4 * lane; const f32x4 v = L_qi[i]; const f32x4 pv = shfl_xor4(v, 2);
            const f32x4 rv = rope4(v, pv, (4 * lane) & 63, 8, 0, cv, sv);
            *(u32x2*)(QI + (size_t)r * 1024 + col) = cvt4(rv); }
        { const f32x4 v = L_ki; const f32x4 pv = shfl_xor4(v, 2);
          const f32x4 rv = rope4(v, pv, (4 * lane) & 63, 8, 0, cv, sv);
          if (lane < 16) { float* dst = pr ? out + O_DSAP + (size_t)r * 320 + 256 + 4 * lane : out + O_DSAS + (size_t)q * 320 + 256 + 4 * lane; *(f32x4*)dst = rv;
              const int d0 = 4 * lane;
              if (pr) *(u32x2*)((bf16_t*)(ws + WS_KIF) + ((size_t)(b * 256 + (s >> 4)) * 2 + (d0 >> 5)) * 512 + (((d0 >> 3) & 3) * 16 + (s & 15)) * 8 + ((d0 >> 2) & 1) * 4) = cvt4(rv);
              else *(u32x2*)((bf16_t*)(ws + WS_KIFS) + ((size_t)(db * 513 + 512) * 2 + (d0 >> 5)) * 512 + (((d0 >> 3) & 3) * 16 + tt) * 8 + ((d0 >> 2) & 1) * 4) = cvt4(rv); }
          if (lane < 4) *(f32x4*)(WI + (size_t)r * 16 + 4 * lane) = L_wi; }
#pragma unroll
        for (int i = 0; i < 16; ++i) { const int col = 256 * i + 4 * lane; const f32x4 v = L_gm[i]; *(u32x2*)(GAB + (size_t)r * 4096 + col) = cvt4(sig4(v)); }
    }
}
struct P1Order { pg8::StaticOrder so;
    DI bool next(int i, pg8::Unit& u) const { const long L = (long)i * so.G + so.c; if (L < so.nwg) return so.at(L, u); const int j = (int)(L - so.nwg); if (j >= 8) return false; u.pm = j >> 2; u.pn = j & 3; u.ks = 1; return true; }
    DI size_t offA(const pg8::Unit& u) const { return (size_t)u.pm * 256 * DM * 2 + (u.ks ? (WS_MEMN - WS_XN) : 0); }
    DI size_t offB(const pg8::Unit& u) const { return (size_t)u.pn * 256 * DM * 2 + (u.ks ? (WS_BT_MKV - WS_BT_IN) : 0); }
};
struct FP1 { float* P; float* memkv; DI void operator()(const pg8::Unit& u, int row, int col, f32x4 v) const {
    if (u.ks) *(f32x4*)(memkv + (size_t)(u.pm * 256 + row) * 1024 + u.pn * 256 + col) = v; else *(f32x4*)(P + (size_t)(u.pm * 256 + row) * DINP + u.pn * 256 + col) = v; } };
DI void phase1(const Args& a, LAS unsigned char* lds) {
    unsigned char* ws = a.ws;
    pg8::Gemm g{(const bf16_t*)(ws + WS_XN), (const bf16_t*)(ws + WS_BT_IN), DM, DM, DM};
    P1Order S; S.so.init(MP / 256, DINP / 256, gridDim.x, blockIdx.x, DM, DM);
    pg8::EpiEach<FP1> E{FP1{(float*)(ws + WS_P), a.out + O_MEMP}};
    pg8::gemm_phase(lds, g, S, E);
}
struct CmpOrder { int G, c;
    DI bool next(int i, pg8::Unit& u) const { const int L = i * G + c; if (L >= 264) return false; u.pn = L / 132; u.pm = L % 132; u.ks = 0; return true; }
    DI size_t offA(const pg8::Unit& u) const { const int rt = u.pm, kv = u.pn; size_t e;
        if (rt < 4) { const int b = rt >> 1, g = rt & 1; e = (size_t)((b * 2 + kv) * 2 + g) * KCP_ROWS * 64; }
        else { const int s = rt - 4, db = s >> 2, g = (s >> 1) & 1, half = s & 1; e = KCS_OFF + ((size_t)((db * 2 + kv) * 2 + g) * 8192 + half * 4096) * 64; }
        return e * 2; }
    DI size_t offB(const pg8::Unit& u) const { return (size_t)u.pn * 256 * 2048 * 2; }
};
DI float gelu_tanh(float x) { const float u = 0.7978845608028654f * (x + 0.044715f * x * x * x); const float t = 1.f - 2.f / (1.f + __expf(2.f * u)); return 0.5f * x * (1.f + t); }
struct FCmpH { const float* biasc; bf16_t* HC;
    DI void operator()(const pg8::Unit& u, int row, int col, f32x4 v) const { const f32x4 bb = *(const f32x4*)(biasc + u.pn * 256 + col); f32x4 x = v + bb;
        x.x = gelu_tanh(x.x); x.y = gelu_tanh(x.y); x.z = gelu_tanh(x.z); x.w = gelu_tanh(x.w);
        *(u32x2*)(HC + ((size_t)(u.pn * 132 + u.pm) * 256 + row) * 256 + col) = cvt4(x); } };
DI void phase3(const Args& a, LAS unsigned char* lds) {
    unsigned char* ws = a.ws;
    pg8::Gemm g{(const bf16_t*)(ws + WS_KCRAW), (const bf16_t*)(ws + WS_BT_C1), 1024, 2048, 2048};
    CmpOrder S{(int)gridDim.x, (int)blockIdx.x};
    pg8::EpiEach<FCmpH> E{FCmpH{(const float*)(ws + WS_BIASC), (bf16_t*)(ws + WS_HC)}};
    pg8::gemm_phase(lds, g, S, E);
}
DI void phase4(const Args& a, LAS unsigned char* lds) {
    const int tid = threadIdx.x, lane = tid & 63, wave = __builtin_amdgcn_readfirstlane(tid >> 6);
    const int gw = blockIdx.x * NWAVES + wave, NGW = gridDim.x * NWAVES;
    unsigned char* ws = a.ws;
    LAS bf16_t* W2T = (LAS bf16_t*)lds;
    const float* w2 = (const float*)a.in[I_CW2];
    for (int idx = tid; idx < 2 * 256 * 64; idx += NTHR) { const int kv = idx >> 14, k = (idx >> 6) & 255, n = idx & 63; W2T[(kv * 64 + n) * 264 + k] = (bf16_t)(cvt_pk_bf16(w2[idx], 0.f) & 0xffffu); }
    __syncthreads();
    const bf16_t* HC = (const bf16_t*)(ws + WS_HC); bf16_t* KCF = (bf16_t*)(ws + WS_KCF);
    const int kg = lane >> 4, c16 = lane & 15;
    constexpr int NIT = 2 * HC_ROWS / 16;
    for (int it = gw; it < NIT; it += NGW) {
        const int kv = it / (HC_ROWS / 16), row0 = (it % (HC_ROWS / 16)) * 16;
        f32x4 acc[4];
#pragma unroll
        for (int nt = 0; nt < 4; ++nt) acc[nt] = (f32x4){0.f, 0.f, 0.f, 0.f};
#pragma unroll
        for (int ks = 0; ks < 8; ++ks) {
            const bf16x8 bfr = *(const bf16x8*)(HC + ((size_t)kv * HC_ROWS + row0 + c16) * 256 + 32 * ks + 8 * kg);
#pragma unroll
            for (int nt = 0; nt < 4; ++nt) { const bf16x8 afr = *(const LAS bf16x8*)(W2T + (kv * 64 + 16 * nt + c16) * 264 + 32 * ks + 8 * kg); acc[nt] = MFMA16(afr, bfr, acc[nt]); }
        }
        const int R = row0 + c16, rt = R >> 8, iin = R & 255; int seq, g, blk;
        if (rt < 4) { seq = rt >> 1; g = rt & 1; blk = iin; } else { const int s = rt - 4; seq = 2 + (s >> 2); g = (s >> 1) & 1; blk = (s & 1) * 256 + iin; }
        bf16_t* tile = KCF + ((size_t)(seq * 2 + g) * 16 + (blk >> 5)) * 4096; const int slot = blk & 31;
        if (kv == 0) {
#pragma unroll
            for (int nt = 0; nt < 4; ++nt) { const int d0 = 16 * nt + 4 * kg; *(u32x2*)(tile + (((d0 >> 5) * 2 + (slot >> 4)) * 64 + ((d0 >> 3) & 3) * 16 + (slot & 15)) * 8 + ((d0 >> 2) & 1) * 4) = cvt4(acc[nt]); }
        } else {
            const int kgv = (slot & 15) >> 2, jv = (slot & 3) + ((slot >> 4) << 2);
#pragma unroll
            for (int nt = 0; nt < 4; ++nt) { const u32x2 w = cvt4(acc[nt]); bf16_t* t0 = tile + 2048 + ((nt * 64 + kgv * 16 + 4 * kg) * 8) + jv;
                t0[0] = (bf16_t)(w.x & 0xffffu); t0[8] = (bf16_t)(w.x >> 16); t0[16] = (bf16_t)(w.y & 0xffffu); t0[24] = (bf16_t)(w.y >> 16); }
        }
    }
}

struct RowInfo { bool pr; int b, db, pos, seq; };
DI RowInfo rowinfo(int r) { RowInfo ri; ri.pr = r < TP; const int q = r - TP; ri.b = r >> 12; ri.db = q >> 2; ri.pos = ri.pr ? (r & 4095) : 8192 + (q & 3); ri.seq = ri.pr ? ri.b : 2 + ri.db; return ri; }
DI float xmax16(float x) { const auto r = __builtin_amdgcn_permlane16_swap(__float_as_uint(x), __float_as_uint(x), false, false); return fmaxf(__uint_as_float(r[0]), __uint_as_float(r[1])); }
DI float xmax32(float x) { const auto r = __builtin_amdgcn_permlane32_swap(__float_as_uint(x), __float_as_uint(x), false, false); return fmaxf(__uint_as_float(r[0]), __uint_as_float(r[1])); }
DI float xsum16(float x) { const auto r = __builtin_amdgcn_permlane16_swap(__float_as_uint(x), __float_as_uint(x), false, false); return __uint_as_float(r[0]) + __uint_as_float(r[1]); }
DI float xsum32(float x) { const auto r = __builtin_amdgcn_permlane32_swap(__float_as_uint(x), __float_as_uint(x), false, false); return __uint_as_float(r[0]) + __uint_as_float(r[1]); }
template <int CTRL> DI float dppf(float x) { return __int_as_float(__builtin_amdgcn_update_dpp(0, __float_as_int(x), CTRL, 0xF, 0xF, true)); }
DI float sum8(float x) { x += dppf<0xB1>(x); x += dppf<0x4E>(x); x += dppf<0x141>(x); return x; }
DI float sum16r(float x) { x = sum8(x); x += dppf<0x140>(x); return x; }
DI int q_next(unsigned* ctr, int lane) { int v = 0; if (lane == 0) v = (int)__hip_atomic_fetch_add(ctr, 1u, __ATOMIC_RELAXED, __HIP_MEMORY_SCOPE_AGENT); return __builtin_amdgcn_readfirstlane(v); }

template <int D> struct Flash { f32x4 o[D / 16]; float m, l; };
template <int D> DI void flash_init(Flash<D>& f) {
#pragma unroll
    for (int i = 0; i < D / 16; ++i) f.o[i] = (f32x4){0.f, 0.f, 0.f, 0.f};
    f.m = -INFINITY; f.l = 0.f; }
template <int D> DI float flash_linv(const Flash<D>& f) { return 1.f / fmaxf(xsum32(xsum16(f.l)), 1e-30f); }
DI bf16x8 ldk8(const float* p) { return cvt8(*(const f32x4*)p, *(const f32x4*)(p + 4)); }
DI int kslot(int kg, int j) { return j < 4 ? 4 * kg + j : 16 + 4 * kg + (j - 4); }
constexpr float LOG2E = 1.4426950408889634f;
DI float max8(const float (&v)[8]) { return fmaxf(fmaxf(fmaxf(v[0], v[1]), fmaxf(v[2], v[3])), fmaxf(fmaxf(v[4], v[5]), fmaxf(v[6], v[7]))); }
template <int D> DI void flash_rebase(Flash<D>& f, float mx) {
    mx = xmax32(xmax16(mx));
    const float mnew = fmaxf(f.m, mx), msafe = (mnew == -INFINITY) ? 0.f : mnew, alpha = __builtin_amdgcn_exp2f(f.m - msafe);
    f.l *= alpha; f.m = mnew;
#pragma unroll
    for (int dt = 0; dt < D / 16; ++dt) f.o[dt] *= alpha;
}
DI bf16x8 pack_p(const float (&p)[8]) { u32x4 w; w.x = cvt_pk_bf16(p[0], p[1]); w.y = cvt_pk_bf16(p[2], p[3]); w.z = cvt_pk_bf16(p[4], p[5]); w.w = cvt_pk_bf16(p[6], p[7]); return __builtin_bit_cast(bf16x8, w); }
template <int D> DI bf16x8 flash_update(Flash<D>& f, const float (&t)[8]) {
    const float mx = max8(t);
    if (!__all(mx <= f.m + 11.5f)) flash_rebase<D>(f, mx);
    const float mref = (f.m == -INFINITY) ? 0.f : f.m;
    float p[8], sum = 0.f;
#pragma unroll
    for (int e = 0; e < 8; ++e) { p[e] = __builtin_amdgcn_exp2f(t[e] - mref); sum += p[e]; }
    f.l += sum;
    return pack_p(p);
}
template <int D> DI bf16x8 flash_update_full(Flash<D>& f, const f32x4& s0, const f32x4& s1, float c) {
    const float r[8] = {s0[0], s0[1], s0[2], s0[3], s1[0], s1[1], s1[2], s1[3]};
    const float mx = max8(r) * c;
    if (!__all(mx <= f.m + 11.5f)) flash_rebase<D>(f, mx);
    const float nm = -f.m;
    float p[8], sum = 0.f;
#pragma unroll
    for (int e = 0; e < 8; ++e) { p[e] = __builtin_amdgcn_exp2f(fmaf(r[e], c, nm)); sum += p[e]; }
    f.l += sum;
    return pack_p(p);
}
template <int D> DI void flash_step(Flash<D>& f, const bf16x8 (&qf)[D / 32], const float* kp0, const float* kp1, const float* const (&vp)[8], unsigned okm, float c, int lane) {
    const int kg = lane >> 4, c16 = lane & 15;
    f32x4 s0 = (f32x4){0.f, 0.f, 0.f, 0.f}, s1 = s0;
#pragma unroll
    for (int ks = 0; ks < D / 32; ++ks) { const bf16x8 a0 = ldk8(kp0 + 32 * ks + 8 * kg), a1 = ldk8(kp1 + 32 * ks + 8 * kg); s0 = MFMA16(a0, qf[ks], s0); s1 = MFMA16(a1, qf[ks], s1); }
    float v[8];
#pragma unroll
    for (int j = 0; j < 4; ++j) { v[j] = ((okm >> j) & 1u) ? s0[j] * c : -INFINITY; v[4 + j] = ((okm >> (4 + j)) & 1u) ? s1[j] * c : -INFINITY; }
    const bf16x8 pb = flash_update<D>(f, v);
#pragma unroll
    for (int dt = 0; dt < D / 16; ++dt) {
        float x[8];
#pragma unroll
        for (int j = 0; j < 8; ++j) x[j] = vp[j][16 * dt + c16];
        u32x4 aw; aw.x = cvt_pk_bf16(x[0], x[1]); aw.y = cvt_pk_bf16(x[2], x[3]); aw.z = cvt_pk_bf16(x[4], x[5]); aw.w = cvt_pk_bf16(x[6], x[7]);
        f.o[dt] = MFMA16(__builtin_bit_cast(bf16x8, aw), pb, f.o[dt]);
    }
}
struct Tile64 { bf16x8 k[4]; bf16x8 v[4]; };
DI void load_tile64(Tile64& t, const bf16_t* kt, const bf16_t* vt, int lane) {
#pragma unroll
    for (int i = 0; i < 4; ++i) t.k[i] = *(const bf16x8*)(kt + (i * 64 + lane) * 8);
#pragma unroll
    for (int i = 0; i < 4; ++i) t.v[i] = *(const bf16x8*)(vt + (i * 64 + lane) * 8);
}
DI void flash_tile64(Flash<64>& f, const bf16x8 (&qf)[2], const Tile64& t, bool full, unsigned okm, float c) {
    f32x4 s0 = (f32x4){0.f, 0.f, 0.f, 0.f}, s1 = s0;
#pragma unroll
    for (int ks = 0; ks < 2; ++ks) { s0 = MFMA16(t.k[ks * 2], qf[ks], s0); s1 = MFMA16(t.k[ks * 2 + 1], qf[ks], s1); }
    bf16x8 pb;
    if (full) pb = flash_update_full<64>(f, s0, s1, c);
    else { float v[8];
#pragma unroll
        for (int j = 0; j < 4; ++j) { v[j] = ((okm >> j) & 1u) ? s0[j] * c : -INFINITY; v[4 + j] = ((okm >> (4 + j)) & 1u) ? s1[j] * c : -INFINITY; }
        pb = flash_update<64>(f, v); }
#pragma unroll
    for (int dt = 0; dt < 4; ++dt) f.o[dt] = MFMA16(t.v[dt], pb, f.o[dt]);
}

template <int OFF> DI void tr_read4(unsigned alo, unsigned ahi, u32x2 (&l)[4], u32x2 (&h)[4]) {
    asm volatile("ds_read_b64_tr_b16 %0, %8 offset:%10\n\tds_read_b64_tr_b16 %1, %9 offset:%10\n\tds_read_b64_tr_b16 %2, %8 offset:%11\n\tds_read_b64_tr_b16 %3, %9 offset:%11\n\t"
                 "ds_read_b64_tr_b16 %4, %8 offset:%12\n\tds_read_b64_tr_b16 %5, %9 offset:%12\n\tds_read_b64_tr_b16 %6, %8 offset:%13\n\tds_read_b64_tr_b16 %7, %9 offset:%13\n\ts_waitcnt lgkmcnt(0)"
                 : "=&v"(l[0]), "=&v"(h[0]), "=&v"(l[1]), "=&v"(h[1]), "=&v"(l[2]), "=&v"(h[2]), "=&v"(l[3]), "=&v"(h[3])
                 : "v"(alo), "v"(ahi), "i"(OFF), "i"(OFF + 32), "i"(OFF + 64), "i"(OFF + 96) : "memory");
}
template <int D> DI void lds_step(Flash<D>& f, const bf16x8 (&qf)[D / 32], LAS unsigned char* wl, unsigned okm, float c, int lane) {
    constexpr int P = 4 * D + 16;
    const int kg = lane >> 4, c16 = lane & 15;
    f32x4 s0 = (f32x4){0.f, 0.f, 0.f, 0.f}, s1 = s0;
#pragma unroll
    for (int ks = 0; ks < D / 32; ++ks) { const bf16x8 a0 = *(const LAS bf16x8*)(wl + c16 * P + (32 * ks + 8 * kg) * 2), a1 = *(const LAS bf16x8*)(wl + (16 + c16) * P + (32 * ks + 8 * kg) * 2);
        s0 = MFMA16(a0, qf[ks], s0); s1 = MFMA16(a1, qf[ks], s1); }
    float v[8];
#pragma unroll
    for (int j = 0; j < 4; ++j) { v[j] = ((okm >> j) & 1u) ? s0[j] * c : -INFINITY; v[4 + j] = ((okm >> (4 + j)) & 1u) ? s1[j] * c : -INFINITY; }
    const bf16x8 pb = flash_update<D>(f, v);
    const unsigned alo = (unsigned)(__SIZE_TYPE__)wl + (unsigned)((4 * kg + (c16 >> 2)) * P + 2 * D + 8 * (c16 & 3)), ahi = alo + 16u * P;
    { u32x2 vl[4], vh[4]; tr_read4<0>(alo, ahi, vl, vh);
#pragma unroll
      for (int dt = 0; dt < 4; ++dt) { u32x4 aw; aw.x = vl[dt].x; aw.y = vl[dt].y; aw.z = vh[dt].x; aw.w = vh[dt].y; f.o[dt] = MFMA16(__builtin_bit_cast(bf16x8, aw), pb, f.o[dt]); } }
    if constexpr (D == 128) { u32x2 vl[4], vh[4]; tr_read4<128>(alo, ahi, vl, vh);
#pragma unroll
      for (int dt = 0; dt < 4; ++dt) { u32x4 aw; aw.x = vl[dt].x; aw.y = vl[dt].y; aw.z = vh[dt].x; aw.w = vh[dt].y; f.o[4 + dt] = MFMA16(__builtin_bit_cast(bf16x8, aw), pb, f.o[4 + dt]); } }
}
DI void st128(LAS unsigned char* wl, const f32x4 (&rg)[32], int lane) {
#pragma unroll
    for (int i = 0; i < 32; ++i) *(LAS u32x2*)(wl + i * 528 + (lane >> 5) * 256 + (lane & 31) * 8) = cvt4(rg[i]);
}
DI void st64(LAS unsigned char* wl, const f32x4 (&rg)[16], int lane) {
#pragma unroll
    for (int j = 0; j < 16; ++j) *(LAS u32x2*)(wl + (2 * j + (lane >> 5)) * 272 + ((lane >> 4) & 1) * 128 + (lane & 15) * 8) = cvt4(rg[j]);
}

DI void cmp_item(const Args& a, LAS unsigned char* wl, int seq, int r0, int pos0, int g, int lane) {
    unsigned char* ws = a.ws;
    LAS float* imp = (LAS float*)wl; LAS float* scv = imp + 1040;
    const int kg = lane >> 4, c16 = lane & 15, tl = c16 >> 3, hh = c16 & 7;
    const int myrow = r0 + tl, qpos = pos0 + tl, head = g * 8 + hh;
    const bf16_t* QC = (const bf16_t*)(ws + WS_QC);
    bf16x8 qf[2];
#pragma unroll
    for (int ks = 0; ks < 2; ++ks) qf[ks] = *(const bf16x8*)(QC + (size_t)myrow * 1024 + head * 64 + 32 * ks + 8 * kg);
    const bf16_t* tb = (const bf16_t*)(ws + WS_KCF) + (size_t)(seq * 2 + g) * 16 * 4096;
    const int qlast = pos0 + 1, NV = qlast >= 31 ? ((qlast - 31) >> 4) + 1 : 0, nsteps = (NV + 31) >> 5;
    for (int i = lane; i < 1040; i += 64) imp[i] = 0.f;
    float m = -INFINITY, l = 0.f;
    { bf16x8 kc[4], kn[4];
#pragma unroll
      for (int i = 0; i < 4; ++i) { kc[i] = *(const bf16x8*)(tb + (i * 64 + lane) * 8); kn[i] = kc[i]; }
      for (int st = 0; st < nsteps; ++st) {
          if (st + 1 < nsteps) {
#pragma unroll
              for (int i = 0; i < 4; ++i) kn[i] = *(const bf16x8*)(tb + (size_t)(st + 1) * 4096 + (i * 64 + lane) * 8); }
          f32x4 s0 = (f32x4){0.f, 0.f, 0.f, 0.f}, s1 = s0;
#pragma unroll
          for (int ks = 0; ks < 2; ++ks) { s0 = MFMA16(kc[ks * 2], qf[ks], s0); s1 = MFMA16(kc[ks * 2 + 1], qf[ks], s1); }
          float v[8];
#pragma unroll
          for (int j = 0; j < 4; ++j) { const int n = 32 * st + 4 * kg + j; v[j] = (16 * n + 31 <= qpos) ? s0[j] * 0.125f : -INFINITY; v[4 + j] = (16 * (n + 16) + 31 <= qpos) ? s1[j] * 0.125f : -INFINITY; }
          float mx = fmaxf(fmaxf(fmaxf(v[0], v[1]), fmaxf(v[2], v[3])), fmaxf(fmaxf(v[4], v[5]), fmaxf(v[6], v[7])));
          if (!__all(mx <= m + 8.f)) { mx = xmax32(xmax16(mx)); const float mnew = fmaxf(m, mx), msafe = (mnew == -INFINITY) ? 0.f : mnew; l *= __expf(m - msafe); m = mnew; }
          const float mref = (m == -INFINITY) ? 0.f : m;
#pragma unroll
          for (int e = 0; e < 8; ++e) l += __expf(v[e] - mref);
#pragma unroll
          for (int i = 0; i < 4; ++i) kc[i] = kn[i];
      } }
    const float msafe = (m == -INFINITY) ? 0.f : m, linv = 1.f / fmaxf(xsum32(xsum16(l)), 1e-30f);
    f32x4 o[4];
#pragma unroll
    for (int dt = 0; dt < 4; ++dt) o[dt] = (f32x4){0.f, 0.f, 0.f, 0.f};
    { Tile64 tc, tn;
      if (nsteps) load_tile64(tc, tb, tb + 2048, lane);
      for (int st = 0; st < nsteps; ++st) {
          if (st + 1 < nsteps) load_tile64(tn, tb + (size_t)(st + 1) * 4096, tb + (size_t)(st + 1) * 4096 + 2048, lane);
          f32x4 s0 = (f32x4){0.f, 0.f, 0.f, 0.f}, s1 = s0;
#pragma unroll
          for (int ks = 0; ks < 2; ++ks) { s0 = MFMA16(tc.k[ks * 2], qf[ks], s0); s1 = MFMA16(tc.k[ks * 2 + 1], qf[ks], s1); }
          float p[8];
#pragma unroll
          for (int j = 0; j < 4; ++j) { const int n = 32 * st + 4 * kg + j;
              p[j] = (16 * n + 31 <= qpos) ? __expf(s0[j] * 0.125f - msafe) * linv : 0.f; p[4 + j] = (16 * (n + 16) + 31 <= qpos) ? __expf(s1[j] * 0.125f - msafe) * linv : 0.f; }
#pragma unroll
          for (int e = 0; e < 8; ++e) { const float t = sum8(p[e]); if (hh == 0) imp[tl * 520 + 32 * st + kslot(kg, e)] = t; }
          const bf16x8 pb = pack_p(p);
#pragma unroll
          for (int dt = 0; dt < 4; ++dt) o[dt] = MFMA16(tc.v[dt], pb, o[dt]);
          if (st + 1 < nsteps) tc = tn;
      } }
    float* OC = (float*)(ws + WS_OCMP) + (size_t)myrow * 1024 + head * 64 + 4 * kg;
#pragma unroll
    for (int dt = 0; dt < 4; ++dt) *(f32x4*)(OC + 16 * dt) = o[dt];
    LDS_WAIT();
    int* SEL = (int*)(ws + WS_SEL);
    for (int t2 = 0; t2 < 2; ++t2) {
        const int qp = pos0 + t2, cur = qp >> 6, nsb = cur + 1;
        int* selp = SEL + ((size_t)(r0 + t2) * 2 + g) * 16;
        if (nsb <= 16) { if (lane < 16) selp[lane] = lane < nsb ? lane : -1; }
        else {
            const LAS float* im = imp + t2 * 520;
            for (int j = lane; j < nsb; j += 64) { const float sc = (im[4 * j] + im[4 * j + 1]) + (im[4 * j + 2] + im[4 * j + 3]) + (j ? im[4 * j - 1] : 0.f);
                scv[j] = (j == 0 || j == cur || j == cur - 1) ? INFINITY : sc; }
            LDS_WAIT();
            for (int j = lane; j < nsb; j += 64) { const float vj = scv[j]; int rank = 0;
                for (int k = 0; k < nsb; ++k) { const float vk = scv[k]; rank += (vk > vj || (vk == vj && k < j)) ? 1 : 0; }
                if (rank < 16) selp[rank] = j; }
            LDS_WAIT();
        }
    }
}

DI const float* dsa_ptr(const Args& a, const RowInfo& ri, int idx) {
    if (ri.pr) return a.out + O_DSAP + ((size_t)ri.b * 4096 + idx) * 320;
    if (idx < 8192) return (const float*)a.in[I_CDSA] + ((size_t)((const int*)a.in[I_PT])[ri.db * NPAGES + (idx >> 7)] * 128 + (idx & 127)) * 320;
    return a.out + O_DSAS + ((size_t)ri.db * 4 + idx - 8192) * 320;
}
DI unsigned sortable(float x) { const unsigned u = __float_as_uint(x); return (u & 0x80000000u) ? ~u : (u | 0x80000000u); }
DI void idx_item_block(const Args& a, LAS unsigned char* lds, int r) {
    const int tid = threadIdx.x, lane = tid & 63, wave = __builtin_amdgcn_readfirstlane(tid >> 6);
    unsigned char* ws = a.ws;
    LAS unsigned* sc = (LAS unsigned*)lds; LAS unsigned* hist = sc + 8200; LAS unsigned* misc = hist + 256; LAS unsigned* wc = misc + 16;
    const RowInfo ri = rowinfo(r); const int n = ri.pos + 1;
    int* idxp = (int*)(ws + WS_IDX) + (size_t)r * 256;
    const int kg = lane >> 4, c16 = lane & 15;
    { const bf16_t* QI = (const bf16_t*)(ws + WS_QI); bf16x8 qa[2];
#pragma unroll
      for (int ks = 0; ks < 2; ++ks) qa[ks] = *(const bf16x8*)(QI + (size_t)r * 1024 + c16 * 64 + 32 * ks + 8 * kg);
      const f32x4 w4 = *(const f32x4*)((const float*)(ws + WS_WI) + (size_t)r * 16 + 4 * kg) * 0.03125f;
      const bf16_t* kb = (const bf16_t*)(ws + WS_KIFS) + (size_t)ri.db * 513 * 1024 + lane * 8;
      const int ntile = (n + 15) >> 4;
      constexpr int GT = 8;
      for (int T0 = wave; T0 < ntile; T0 += NWAVES * GT) {
          bf16x8 gk[GT][2];
#pragma unroll
          for (int i = 0; i < GT; ++i) { const int Tn = min(T0 + NWAVES * i, ntile - 1); gk[i][0] = *(const bf16x8*)(kb + (size_t)Tn * 1024); gk[i][1] = *(const bf16x8*)(kb + (size_t)Tn * 1024 + 512); }
#pragma unroll
          for (int i = 0; i < GT; ++i) { const int T = T0 + NWAVES * i; if (T < ntile) {
              f32x4 d = (f32x4){0.f, 0.f, 0.f, 0.f}; d = MFMA16(qa[0], gk[i][0], d); d = MFMA16(qa[1], gk[i][1], d);
              float x = (fmaxf(d[0], 0.f) * w4[0] + fmaxf(d[1], 0.f) * w4[1]) + (fmaxf(d[2], 0.f) * w4[2] + fmaxf(d[3], 0.f) * w4[3]);
              x = xsum32(xsum16(x)); const int key = 16 * T + c16; if (kg == 0 && key < n) sc[key] = sortable(x); } }
      } }
    __syncthreads();
    unsigned prefix = 0u, mask = 0u; int need = 256;
    for (int pass = 0; pass < 4; ++pass) { const int shift = 24 - 8 * pass;
        if (tid < 256) hist[tid] = 0u;
        __syncthreads();
        for (int i = tid; i < n; i += NTHR) { const unsigned u = sc[i]; if ((u & mask) == prefix) __hip_atomic_fetch_add(&hist[(u >> shift) & 255u], 1u, __ATOMIC_RELAXED, __HIP_MEMORY_SCOPE_WORKGROUP); }
        __syncthreads();
        if (wave == 0) { const int h0 = hist[4 * lane], h1 = hist[4 * lane + 1], h2 = hist[4 * lane + 2], h3 = hist[4 * lane + 3]; const int ls = h0 + h1 + h2 + h3; int suf = ls;
#pragma unroll
            for (int o = 1; o < 64; o <<= 1) { const int t = __shfl_down(suf, o); if (lane + o < 64) suf += t; }
            int above = suf - ls;
            if (above < need && need <= above + h3) { misc[0] = 4 * lane + 3; misc[1] = need - above; } above += h3;
            if (above < need && need <= above + h2) { misc[0] = 4 * lane + 2; misc[1] = need - above; } above += h2;
            if (above < need && need <= above + h1) { misc[0] = 4 * lane + 1; misc[1] = need - above; } above += h1;
            if (above < need && need <= above + h0) { misc[0] = 4 * lane + 0; misc[1] = need - above; } }
        __syncthreads();
        const unsigned bin = misc[0]; need = (int)misc[1]; prefix |= bin << shift; mask |= 0xFFu << shift;
    }
    const unsigned thr = prefix; const int need_eq = need; int run_gt = 0, run_eq = 0;
    for (int base = 0; base < n; base += NTHR) {
        const int i = base + tid; const unsigned u = i < n ? sc[i] : 0u; const bool gt = i < n && u > thr, eq = i < n && u == thr;
        const unsigned long long bg = __ballot(gt), be = __ballot(eq);
        if (lane == 0) { wc[wave * 2] = (unsigned)__popcll(bg); wc[wave * 2 + 1] = (unsigned)__popcll(be); }
        __syncthreads();
        int pg = 0, pe = 0, tg = 0, te = 0;
#pragma unroll
        for (int w = 0; w < NWAVES; ++w) { const int cg = (int)wc[2 * w], ce = (int)wc[2 * w + 1]; if (w < wave) { pg += cg; pe += ce; } tg += cg; te += ce; }
        const unsigned long long lm = (1ull << lane) - 1ull;
        const int gb = run_gt + pg + __popcll(bg & lm), eb = run_eq + pe + __popcll(be & lm);
        const int opos = gb + min(eb, need_eq);
        if ((gt || (eq && eb < need_eq)) && opos < 256) idxp[opos] = i;
        run_gt += tg; run_eq += te;
        __syncthreads();
    }
}
DI void idx_item_wave(const Args& a, LAS unsigned char* wl, int r, int lane) {
    unsigned char* ws = a.ws;
    LAS unsigned* sc = (LAS unsigned*)wl; LAS unsigned* hist = sc + 4096;
    const int b = r >> 12, s = r & 4095, n = s + 1;
    int* idxp = (int*)(ws + WS_IDX) + (size_t)r * 256;
    if (n <= 256) { for (int i = lane; i < 256; i += 64) idxp[i] = i < n ? i : -1; return; }
    const int kg = lane >> 4, c16 = lane & 15;
#pragma unroll
    for (int q = 0; q < 4; ++q) hist[lane + 64 * q] = 0u;
    LDS_WAIT();
    { const bf16_t* QI = (const bf16_t*)(ws + WS_QI); bf16x8 qa[2];
#pragma unroll
      for (int ks = 0; ks < 2; ++ks) qa[ks] = *(const bf16x8*)(QI + (size_t)r * 1024 + c16 * 64 + 32 * ks + 8 * kg);
      const f32x4 w4 = *(const f32x4*)((const float*)(ws + WS_WI) + (size_t)r * 16 + 4 * kg) * 0.03125f;
      const bf16_t* kb = (const bf16_t*)(ws + WS_KIF) + (size_t)b * 256 * 1024 + lane * 8;
      const int ntile = (n + 15) >> 4;
      constexpr int GT = 8;
      bf16x8 ga[GT][2], gb[GT][2];
#define IDX_LOAD(G, T0_) { _Pragma("unroll") for (int i = 0; i < GT; ++i) { const int Tn = min((T0_) + i, ntile - 1); G[i][0] = *(const bf16x8*)(kb + (size_t)Tn * 1024); G[i][1] = *(const bf16x8*)(kb + (size_t)Tn * 1024 + 512); } }
#define IDX_COMP(G, T0_) { _Pragma("unroll") for (int i = 0; i < GT; ++i) { const int T = (T0_) + i; if (T < ntile) { \
          f32x4 d = (f32x4){0.f, 0.f, 0.f, 0.f}; d = MFMA16(qa[0], G[i][0], d); d = MFMA16(qa[1], G[i][1], d); \
          float x = (fmaxf(d[0], 0.f) * w4[0] + fmaxf(d[1], 0.f) * w4[1]) + (fmaxf(d[2], 0.f) * w4[2] + fmaxf(d[3], 0.f) * w4[3]); \
          x = xsum32(xsum16(x)); const int key = 16 * T + c16; \
          if (kg == 0 && key < n) { const unsigned u = sortable(x); sc[key] = u; __hip_atomic_fetch_add(&hist[u >> 24], 1u, __ATOMIC_RELAXED, __HIP_MEMORY_SCOPE_WAVEFRONT); } } } }
      IDX_LOAD(ga, 0)
      for (int T0 = 0; T0 < ntile; T0 += 2 * GT) {
          IDX_LOAD(gb, T0 + GT) IDX_COMP(ga, T0)
          if (T0 + GT >= ntile) break;
          IDX_LOAD(ga, T0 + 2 * GT) IDX_COMP(gb, T0 + GT)
      }
#undef IDX_LOAD
#undef IDX_COMP
    }
    LDS_WAIT();
    const int n4 = (n + 3) >> 2;
    unsigned prefix = 0u, mask = 0u; int need = 256;
    for (int pass = 0; pass < 4; ++pass) { const int shift = 24 - 8 * pass;
        if (pass) {
#pragma unroll
            for (int q = 0; q < 4; ++q) hist[lane + 64 * q] = 0u;
            LDS_WAIT();
            for (int g = lane; g < n4; g += 64) { const u32x4 u4 = ((const LAS u32x4*)sc)[g];
#pragma unroll
                for (int e = 0; e < 4; ++e) { const unsigned u = u4[e]; if (4 * g + e < n && (u & mask) == prefix) __hip_atomic_fetch_add(&hist[(u >> shift) & 255u], 1u, __ATOMIC_RELAXED, __HIP_MEMORY_SCOPE_WAVEFRONT); } }
            LDS_WAIT();
        }
        const int h0 = hist[4 * lane], h1 = hist[4 * lane + 1], h2 = hist[4 * lane + 2], h3 = hist[4 * lane + 3]; const int ls = h0 + h1 + h2 + h3; int suf = ls;
#pragma unroll
        for (int o = 1; o < 64; o <<= 1) { const int t = __shfl_down(suf, o); if (lane + o < 64) suf += t; }
        int above = suf - ls, fb = -1, fn = 0;
        if (above < need && need <= above + h3) { fb = 4 * lane + 3; fn = need - above; } above += h3;
        if (above < need && need <= above + h2) { fb = 4 * lane + 2; fn = need - above; } above += h2;
        if (above < need && need <= above + h1) { fb = 4 * lane + 1; fn = need - above; } above += h1;
        if (above < need && need <= above + h0) { fb = 4 * lane + 0; fn = need - above; }
        const unsigned long long fm = __ballot(fb >= 0); const int src = fm ? __builtin_ctzll(fm) : 0;
        const unsigned bin = (unsigned)__builtin_amdgcn_readlane(fb, src); need = __builtin_amdgcn_readlane(fn, src);
        prefix |= bin << shift; mask |= 0xFFu << shift;
        LDS_WAIT();
    }
    const unsigned thr = prefix; const int need_eq = need; int run_gt = 0, run_eq = 0;
    const unsigned long long lm = (1ull << lane) - 1ull;
    for (int g0 = 0; g0 < n4; g0 += 64) {
        const int g = g0 + lane; u32x4 u4 = (u32x4){0u, 0u, 0u, 0u}; if (g < n4) u4 = ((const LAS u32x4*)sc)[g];
        bool gt[4], eq[4]; int pg = 0, pe = 0, tg = 0, te = 0;
#pragma unroll
        for (int e = 0; e < 4; ++e) { const bool in = 4 * g + e < n; gt[e] = in && u4[e] > thr; eq[e] = in && u4[e] == thr;
            const unsigned long long bg = __ballot(gt[e]), be = __ballot(eq[e]); pg += __popcll(bg & lm); pe += __popcll(be & lm); tg += __popcll(bg); te += __popcll(be); }
        int gb = run_gt + pg, eb = run_eq + pe;
#pragma unroll
        for (int e = 0; e < 4; ++e) { const int opos = gb + min(eb, need_eq); if ((gt[e] || (eq[e] && eb < need_eq)) && opos < 256) idxp[opos] = 4 * g + e; gb += gt[e] ? 1 : 0; eb += eq[e] ? 1 : 0; }
        run_gt += tg; run_eq += te;
    }
    LDS_WAIT();
}

constexpr int CW_Q0 = 8192;
DI void phase5(const Args& a, LAS unsigned char* lds, int qb = 0, int pm = 7) {
    const int tid = threadIdx.x, lane = tid & 63, wave = __builtin_amdgcn_readfirstlane(tid >> 6);
    unsigned* ctl = (unsigned*)(a.ws + WS_CTL);
    if (pm & 1) { const int bid = blockIdx.x, G = gridDim.x;
#pragma unroll 1
      for (int j = bid; j < TS; j += G) { idx_item_block(a, lds, TP + j); __syncthreads(); } }
    if (pm & 2) { LAS unsigned char* wl = lds + wave * 8192;
#pragma unroll 1
      for (;;) { const int it = q_next(ctl + CW_Q0 + qb, lane); if (it >= 128 + 8192) break;
          if (it < 128) { const int g = it & 1, db = it >> 2, tp = (it >> 1) & 1; cmp_item(a, wl, 2 + db, TP + db * 4 + 2 * tp, 8192 + 2 * tp, g, lane); }
          else { const int j = it - 128, g = j & 1, b = (j >> 1) & 1, tp = 2047 - (j >> 2); cmp_item(a, wl, b, b * 4096 + 2 * tp, 2 * tp, g, lane); } } }
    __syncthreads();
    if (pm & 4) { LAS unsigned char* wl = lds + wave * 17408;
#pragma unroll 1
      for (;;) { const int it = q_next(ctl + CW_Q0 + qb + 64, lane); if (it >= TP) break; const int b = it & 1, s = 4095 - (it >> 1); idx_item_wave(a, wl, b * 4096 + s, lane); } }
}

DI const float* win_ptr(const Args& a, const RowInfo& ri, int pos, int kv, int g) {
    const float* KW = (const float*)(a.ws + WS_KW);
    if (ri.pr) return KW + ((size_t)ri.b * 4096 + pos) * 256 + kv * 128 + g * 64;
    if (pos < 8192) return (const float*)a.in[I_SWIN] + (((size_t)ri.db * 512 + (pos - 7680)) * 2 + kv) * 128 + g * 64;
    return KW + ((size_t)TP + ri.db * 4 + (pos - 8192)) * 256 + kv * 128 + g * 64;
}
DI const float* slc_ptr(const Args& a, const RowInfo& ri, int pos, int c, int g) {
    if (ri.pr) return a.out + O_NSAP + (((size_t)ri.b * 4096 + pos) * 4 + c) * 128 + g * 64;
    if (pos < 8192) return (const float*)a.in[I_CNSA] + (((size_t)((const int*)a.in[I_PT])[ri.db * NPAGES + (pos >> 7)] * 128 + (pos & 127)) * 4 + c) * 128 + g * 64;
    return a.out + O_NSAS + (((size_t)ri.db * 4 + pos - 8192) * 4 + c) * 128 + g * 64;
}
constexpr float C64 = 0.125f * LOG2E, C128 = 0.08838834764831845f * LOG2E;
DI void nsa2_item_sample(const Args& a, LAS unsigned char* wl, int r, int g, int lane) {
    unsigned char* ws = a.ws;
    const RowInfo ri = rowinfo(r); const int qpos = ri.pos;
    const int kg = lane >> 4, c16 = lane & 15, hh = c16 & 7, head = g * 8 + hh;
    const int kpar = lane >> 5, kvoff = ((lane >> 4) & 1) * 128 + (lane & 15) * 4;
    bf16x8 qf[2];
    { const bf16_t* QR = (const bf16_t*)(ws + WS_QR);
#pragma unroll
      for (int ks = 0; ks < 2; ++ks) qf[ks] = *(const bf16x8*)(QR + (size_t)r * 1024 + head * 64 + 32 * ks + 8 * kg); }
    Flash<64> fw; flash_init(fw);
    Flash<64> fs; flash_init(fs);
    f32x4 rg[16];
    { const int lo = max(0, qpos - 511), b0 = lo & ~31, nst = ((qpos - b0) >> 5) + 1;
#define WLOAD(BASE) { _Pragma("unroll") for (int j = 0; j < 16; ++j) rg[j] = *(const f32x4*)(win_ptr(a, ri, min(max((BASE) + 2 * j + kpar, lo), qpos), 0, g) + kvoff); }
      WLOAD(b0)
      for (int st = 0; st < nst; ++st) { const int base = b0 + 32 * st;
          LDS_WAIT(); st64(wl, rg, lane);
          if (st + 1 < nst) WLOAD(base + 32)
          unsigned okm = 0u;
#pragma unroll
          for (int j = 0; j < 8; ++j) { const int p = base + kslot(kg, j); okm |= (p >= lo && p <= qpos) ? (1u << j) : 0u; }
          LDS_WAIT(); lds_step<64>(fw, qf, wl, okm, C64, lane);
      }
#undef WLOAD
    }
    { const int* selp = (const int*)(ws + WS_SEL) + ((size_t)r * 2 + g) * 16;
      const int sbl = lane < 16 ? selp[lane] : -1;
      const float* bptr = nullptr;
      if (sbl >= 0) { const int p0 = sbl * 64; bptr = p0 < 8192 ? (const float*)a.in[I_CNSA] + ((size_t)((const int*)a.in[I_PT])[ri.db * NPAGES + (p0 >> 7)] * 128 + (p0 & 127)) * 512 + 256 + g * 64
                                                                  : a.out + O_NSAS + (size_t)ri.db * 4 * 512 + 256 + g * 64; }
      const int sb2 = __shfl(sbl, lane >> 1); const int hbase = sb2 * 64 + (lane & 1) * 32;
      unsigned long long m = __ballot(lane < 32 && sb2 >= 0 && hbase <= qpos);
      int left = __popcll(m);
      if (left) {
          const unsigned long long plo = (unsigned long long)bptr;
#define SLOAD(L_) { const int L = (L_); const int bl = L >> 1; const unsigned long long pb64 = ((unsigned long long)(unsigned)__builtin_amdgcn_readlane((int)(plo >> 32), bl) << 32) | (unsigned)__builtin_amdgcn_readlane((int)plo, bl); \
          const int hb = __builtin_amdgcn_readlane(hbase, L); const float* bp = (const float*)pb64 + (size_t)(L & 1) * 32 * 512; \
          _Pragma("unroll") for (int j = 0; j < 16; ++j) { const int kk = min(2 * j + kpar, qpos - hb); rg[j] = *(const f32x4*)(bp + (size_t)kk * 512 + kvoff); } }
          int Lc = __builtin_ctzll(m); m &= m - 1ull;
          SLOAD(Lc)
          for (;;) {
              LDS_WAIT(); st64(wl, rg, lane);
              const int hb = __builtin_amdgcn_readlane(hbase, Lc);
              int Ln = 0; const bool more = m != 0ull;
              if (more) { Ln = __builtin_ctzll(m); m &= m - 1ull; SLOAD(Ln) }
              unsigned okm = 0u;
#pragma unroll
              for (int j = 0; j < 8; ++j) okm |= (hb + kslot(kg, j) <= qpos) ? (1u << j) : 0u;
              LDS_WAIT(); lds_step<64>(fs, qf, wl, okm, C64, lane);
              if (!more) break; Lc = Ln;
          }
#undef SLOAD
      } }
    LDS_WAIT();
    const float* GN = (const float*)(ws + WS_GN) + (size_t)r * 48;
    const float g0 = GN[head], g1 = GN[16 + head] * flash_linv(fs), g2 = GN[32 + head] * flash_linv(fw);
    const float* OC = (const float*)(ws + WS_OCMP) + (size_t)r * 1024 + head * 64 + 4 * kg;
    bf16_t* ON = (bf16_t*)(ws + WS_ONSA) + (size_t)r * 2048 + head * 64 + 4 * kg;
#pragma unroll
    for (int dt = 0; dt < 4; ++dt) { const f32x4 oc = *(const f32x4*)(OC + 16 * dt); const f32x4 o = oc * g0 + fs.o[dt] * g1 + fw.o[dt] * g2; if (c16 < 8) *(u32x2*)(ON + 16 * dt) = cvt4(o); }
}
DI void slc_walk(Flash<64>& fs, const bf16x8 (&qf)[2], const bf16_t* tb, const int* selp, int qpos, int lane) {
    const int kg = lane >> 4;
    const int sbl = lane < 32 ? selp[lane >> 1] : -1; const int Tl = 2 * sbl + (lane & 1);
    unsigned long long m = __ballot(lane < 32 && sbl >= 0 && 32 * Tl <= qpos);
    int left = __popcll(m);
    if (!left) return;
    Tile64 buf[3]; int Tq[3] = {0, 0, 0};
#define SLC_POP(i) { if (m) { Tq[i] = __builtin_amdgcn_readlane(Tl, __builtin_ctzll(m)); m &= m - 1ull; load_tile64(buf[i], tb + (size_t)Tq[i] * 8192, tb + (size_t)Tq[i] * 8192 + 2048, lane); } }
    SLC_POP(0) SLC_POP(1)
#define SLC_STEP(i) { SLC_POP(((i) + 2) % 3) const int T = Tq[i]; const bool full = 32 * T + 31 <= qpos; unsigned okm = 0xFFu; \
        if (!full) { okm = 0u; _Pragma("unroll") for (int j = 0; j < 8; ++j) okm |= (32 * T + kslot(kg, j) <= qpos) ? (1u << j) : 0u; } \
        flash_tile64(fs, qf, buf[i], full, okm, C64); if (--left == 0) break; }
    for (;;) { SLC_STEP(0) SLC_STEP(1) SLC_STEP(2) }
#undef SLC_STEP
#undef SLC_POP
}
DI void nsa2_item_pair(const Args& a, int r0, int g, int lane) {
    unsigned char* ws = a.ws;
    const int b = r0 >> 12, qpos0 = r0 & 4095;
    const int kg = lane >> 4, c16 = lane & 15, tl = c16 >> 3, hh = c16 & 7, head = g * 8 + hh, myrow = r0 + tl, qposc = qpos0 + tl;
    const bf16_t* QR = (const bf16_t*)(ws + WS_QR);
    const bf16_t* tb = (const bf16_t*)(ws + WS_NSAF) + (size_t)((b * 2 + g) * 128) * 8192;
    Flash<64> fw; flash_init(fw);
    { bf16x8 qf[2];
#pragma unroll
      for (int ks = 0; ks < 2; ++ks) qf[ks] = *(const bf16x8*)(QR + (size_t)myrow * 1024 + head * 64 + 32 * ks + 8 * kg);
      const int lo0 = max(0, qpos0 - 511), lo1 = max(0, qpos0 - 510), T0 = lo0 >> 5, T1 = (qpos0 + 1) >> 5, loc = max(0, qposc - 511);
      Tile64 buf[3]; int T = T0;
#define WIN_LD(i, TT_) { if ((TT_) <= T1) load_tile64(buf[i], tb + (size_t)(TT_) * 8192 + 4096, tb + (size_t)(TT_) * 8192 + 6144, lane); }
      WIN_LD(0, T0) WIN_LD(1, T0 + 1)
#define WIN_STEP(i) { WIN_LD(((i) + 2) % 3, T + 2) \
        const bool full = 32 * T >= lo1 && 32 * T + 31 <= qpos0; unsigned okm = 0xFFu; \
        if (!full) { okm = 0u; _Pragma("unroll") for (int j = 0; j < 8; ++j) { const int p = 32 * T + kslot(kg, j); okm |= (p >= loc && p <= qposc) ? (1u << j) : 0u; } } \
        flash_tile64(fw, qf, buf[i], full, okm, C64); if (++T > T1) break; }
      for (;;) { WIN_STEP(0) WIN_STEP(1) WIN_STEP(2) }
#undef WIN_LD
#undef WIN_STEP
    }
    Flash<64> fs0; flash_init(fs0);
    { bf16x8 qf[2];
#pragma unroll
      for (int ks = 0; ks < 2; ++ks) qf[ks] = *(const bf16x8*)(QR + (size_t)r0 * 1024 + head * 64 + 32 * ks + 8 * kg);
      slc_walk(fs0, qf, tb, (const int*)(ws + WS_SEL) + ((size_t)r0 * 2 + g) * 16, qpos0, lane); }
    Flash<64> fs1; flash_init(fs1);
    { bf16x8 qf[2];
#pragma unroll
      for (int ks = 0; ks < 2; ++ks) qf[ks] = *(const bf16x8*)(QR + (size_t)(r0 + 1) * 1024 + head * 64 + 32 * ks + 8 * kg);
      slc_walk(fs1, qf, tb, (const int*)(ws + WS_SEL) + ((size_t)(r0 + 1) * 2 + g) * 16, qpos0 + 1, lane); }
    const float* GN = (const float*)(ws + WS_GN) + (size_t)myrow * 48;
    const float li0 = flash_linv(fs0), li1 = flash_linv(fs1);
    const float g0 = GN[head], g1 = GN[16 + head] * (tl ? li1 : li0), g2 = GN[32 + head] * flash_linv(fw);
    const float* OC = (const float*)(ws + WS_OCMP) + (size_t)myrow * 1024 + head * 64 + 4 * kg;
    bf16_t* ON = (bf16_t*)(ws + WS_ONSA) + (size_t)myrow * 2048 + head * 64 + 4 * kg;
#pragma unroll
    for (int dt = 0; dt < 4; ++dt) { const f32x4 oc = *(const f32x4*)(OC + 16 * dt); const f32x4 os = tl ? fs1.o[dt] : fs0.o[dt]; *(u32x2*)(ON + 16 * dt) = cvt4(oc * g0 + os * g1 + fw.o[dt] * g2); }
}
constexpr int DSA_LSTRIDE = 528, DSA_WL = 32 * DSA_LSTRIDE + 1024 + 256;
DI void dsa_item(const Args& a, LAS unsigned char* wl, int r, int lane) {
    unsigned char* ws = a.ws;
    const RowInfo ri = rowinfo(r); const int nvalid = min(256, ri.pos + 1);
    const int kg = lane >> 4, c16 = lane & 15, hh = c16 & 7;
    bf16x8 qf[4];
    { const bf16_t* QB = (const bf16_t*)(ws + WS_QB);
#pragma unroll
      for (int ks = 0; ks < 4; ++ks) qf[ks] = *(const bf16x8*)(QB + (size_t)r * 1024 + hh * 128 + 32 * ks + 8 * kg); }
    const int* idxp = (const int*)(ws + WS_IDX) + (size_t)r * 256;
    Flash<128> f; flash_init(f);
    const int nst = (nvalid + 31) >> 5;
    LAS int* lidx = (LAS int*)(wl + 32 * DSA_LSTRIDE);
#pragma unroll
    for (int q = 0; q < 4; ++q) lidx[lane + 64 * q] = idxp[lane + 64 * q];
    LDS_WAIT();
    if (ri.pr) {
        const bf16_t* DB = (const bf16_t*)(ws + WS_DSAB) + (size_t)ri.b * 4096 * 256;
        const int hr = lane >> 5, ch = lane & 31;
        u32x4 rg[16];
#pragma unroll
        for (int i = 0; i < 16; ++i) { const int id = lidx[2 * i + hr]; rg[i] = *(const u32x4*)(DB + (size_t)max(id, 0) * 256 + ch * 8); }
        for (int st = 0; st < nst; ++st) {
            LDS_WAIT();
#pragma unroll
            for (int i = 0; i < 16; ++i) *(LAS u32x4*)(wl + (2 * i + hr) * DSA_LSTRIDE + ch * 16) = rg[i];
            unsigned okm = 0u;
#pragma unroll
            for (int j = 0; j < 8; ++j) okm |= (lidx[32 * st + kslot(kg, j)] >= 0) ? (1u << j) : 0u;
            if (st + 1 < nst) {
#pragma unroll
                for (int i = 0; i < 16; ++i) { const int id = lidx[32 * (st + 1) + 2 * i + hr]; rg[i] = *(const u32x4*)(DB + (size_t)max(id, 0) * 256 + ch * 8); } }
            LDS_WAIT();
            lds_step<128>(f, qf, wl, okm, C128, lane);
        }
    } else {
        LAS int* lpt = lidx + 256;
        lpt[lane] = ((const int*)a.in[I_PT])[ri.db * NPAGES + lane];
        LDS_WAIT();
        f32x4 rg[32];
#define DLOAD(ST) { _Pragma("unroll") for (int i = 0; i < 32; ++i) { const int id = max(lidx[32 * (ST) + i], 0); \
            const float* rp = id < 8192 ? (const float*)a.in[I_CDSA] + ((size_t)lpt[id >> 7] * 128 + (id & 127)) * 320 : a.out + O_DSAS + ((size_t)ri.db * 4 + id - 8192) * 320; rg[i] = *(const f32x4*)(rp + 4 * lane); } }
        DLOAD(0)
        for (int st = 0; st < nst; ++st) {
            LDS_WAIT(); st128(wl, rg, lane);
            unsigned okm = 0u;
#pragma unroll
            for (int j = 0; j < 8; ++j) okm |= (lidx[32 * st + kslot(kg, j)] >= 0) ? (1u << j) : 0u;
            if (st + 1 < nst) DLOAD(st + 1)
            LDS_WAIT();
            lds_step<128>(f, qf, wl, okm, C128, lane);
        }
#undef DLOAD
    }
    LDS_WAIT();
    const float inv = flash_linv(f);
    bf16_t* OD = (bf16_t*)(ws + WS_ONSA) + (size_t)r * 2048 + 1024 + hh * 128 + 4 * kg;
#pragma unroll
    for (int dt = 0; dt < 8; ++dt) if (c16 < 8) *(u32x2*)(OD + 16 * dt) = cvt4(f.o[dt] * inv);
}
DI void phase6(const Args& a, LAS unsigned char* lds, int qb = 0, int pm = 3) {
    const int tid = threadIdx.x, lane = tid & 63, wave = __builtin_amdgcn_readfirstlane(tid >> 6);
    unsigned* ctl = (unsigned*)(a.ws + WS_CTL);
#pragma unroll 1
    for (;;) { if (!(pm & 1)) break; const int it = q_next(ctl + CW_Q0 + qb + 128, lane); if (it >= 2 * TS + TP) break;
        if (it < 2 * TS) nsa2_item_sample(a, lds + wave * DSA_WL, TP + (it >> 1), it & 1, lane);
        else { const int j = it - 2 * TS, g = j & 1, b = (j >> 1) & 1, tp = 2047 - (j >> 2); nsa2_item_pair(a, b * 4096 + 2 * tp, g, lane); } }
    if (pm & 2) { LAS unsigned char* wl = lds + wave * DSA_WL;
#pragma unroll 1
      for (;;) { const int it = q_next(ctl + CW_Q0 + qb + 192, lane); if (it >= TT) break; dsa_item(a, wl, it < TS ? TP + it : it - TS, lane); } }
}

DI void phase11(const Args& a, LAS unsigned char* lds) {
    const int tid = threadIdx.x, lane = tid & 63, wave = __builtin_amdgcn_readfirstlane(tid >> 6);
    const int gw = blockIdx.x * NWAVES + wave, NGW = gridDim.x * NWAVES;
    unsigned char* ws = a.ws;
    const int kg = lane >> 4, c16 = lane & 15;
#pragma unroll 1
    for (int it = gw; it < 2048 + 128; it += NGW) {
        int myrow, h; const float* kvb; bool st_ok;
        if (it < 2048) { const int rg = it >> 2; h = it & 3; myrow = rg * 16 + c16; kvb = a.out + O_MEMP + (size_t)(rg >> 8) * 256 * 1024 + h * 128; st_ok = true; }
        else { const int j = it - 2048, db = j >> 2; h = j & 3; myrow = TP + db * 4 + (c16 & 3); kvb = (const float*)a.in[I_CMEM] + (size_t)db * 256 * 1024 + h * 128; st_ok = c16 < 4; }
        bf16x8 qf[4];
        { const bf16_t* QM = (const bf16_t*)(ws + WS_QMB);
#pragma unroll
          for (int ks = 0; ks < 4; ++ks) qf[ks] = *(const bf16x8*)(QM + (size_t)myrow * 512 + h * 128 + 32 * ks + 8 * kg); }
        Flash<128> f; flash_init(f);
        LAS unsigned char* wl = lds + wave * DSA_WL;
        f32x4 rg[32];
#define MLOAD(ST) { _Pragma("unroll") for (int i = 0; i < 32; ++i) rg[i] = *(const f32x4*)(kvb + (size_t)(32 * (ST) + i) * 1024 + (lane >> 5) * 512 + (lane & 31) * 4); }
        MLOAD(0)
        for (int st = 0; st < 8; ++st) {
            LDS_WAIT(); st128(wl, rg, lane);
            if (st + 1 < 8) MLOAD(st + 1)
            LDS_WAIT();
            lds_step<128>(f, qf, wl, 0xFFu, C128, lane);
        }
#undef MLOAD
        LDS_WAIT();
        const float inv = flash_linv(f);
        bf16_t* OM = (bf16_t*)(ws + WS_OM) + (size_t)myrow * 512 + h * 128 + 4 * kg;
#pragma unroll
        for (int dt = 0; dt < 8; ++dt) if (st_ok) *(u32x2*)(OM + 16 * dt) = cvt4(f.o[dt] * inv);
    }
}
DI f32x4 ldbf4(const bf16_t* p) { const u32x2 w = *(const u32x2*)p; f32x4 r; r.x = __uint_as_float(w.x << 16); r.y = __uint_as_float(w.x & 0xffff0000u); r.z = __uint_as_float(w.y << 16); r.w = __uint_as_float(w.y & 0xffff0000u); return r; }
struct EpiMerge {
    static constexpr bool HAS_MID = true;
    const bf16_t* GAB; bf16_t* MG;
    DI void mid(f32x4 (&acc)[2][2][4][2], const pg8::Unit& u, int wr, int wc, int fr, int fq) const {
        int z = 0; asm volatile("" : "+v"(z));
#pragma unroll
        for (int ai = 0; ai < 2; ++ai)
#pragma unroll
            for (int m = 0; m < 4; ++m) { const size_t r = (size_t)(u.pm * 256 + ai * 128 + wr * 64 + m * 16 + fr + z);
#pragma unroll
                for (int bj = 0; bj < 2; ++bj)
#pragma unroll
                    for (int n = 0; n < 2; ++n) { const int c = u.pn * 256 + bj * 128 + wc * 32 + n * 16 + 4 * fq;
                        const f32x4 ga = ldbf4(GAB + r * 4096 + c), gb = ldbf4(GAB + r * 4096 + 2048 + c); f32x4 q;
                        q.x = ga.x * __builtin_amdgcn_rcpf(fmaxf(gb.x, 1e-30f)); q.y = ga.y * __builtin_amdgcn_rcpf(fmaxf(gb.y, 1e-30f)); q.z = ga.z * __builtin_amdgcn_rcpf(fmaxf(gb.z, 1e-30f)); q.w = ga.w * __builtin_amdgcn_rcpf(fmaxf(gb.w, 1e-30f));
                        acc[ai][bj][m][n] *= q; }
                asm volatile("" ::: "memory"); }
    }
    DI void operator()(const f32x4 (&acc)[2][2][4][2], const pg8::Unit& u, int wr, int wc, int fr, int fq) const {
#pragma unroll
        for (int ai = 0; ai < 2; ++ai)
#pragma unroll
            for (int m = 0; m < 4; ++m) { const size_t r = (size_t)u.pm * 256 + ai * 128 + wr * 64 + m * 16 + fr;
#pragma unroll
                for (int bj = 0; bj < 2; ++bj)
#pragma unroll
                    for (int n = 0; n < 2; ++n) { const int c = u.pn * 256 + bj * 128 + wc * 32 + n * 16 + 4 * fq;
                        *(u32x2*)(MG + r * DM + c) = cvt4(acc[ai][bj][m][n] * ldbf4(GAB + r * 4096 + 2048 + c)); } }
    }
};
struct SplitOrder { int G, c, n, lda, ldb, kslice;
    DI bool next(int i, pg8::Unit& u) const { const int L = i * G + c; if (L >= n) return false; u.pm = 32; u.pn = L & 7; u.ks = L >> 3; return true; }
    DI size_t offA(const pg8::Unit& u) const { return ((size_t)TP * lda + (size_t)u.ks * kslice) * 2; }
    DI size_t offB(const pg8::Unit& u) const { return ((size_t)u.pn * 256 * ldb + (size_t)u.ks * kslice) * 2; }
};
struct FPartG { const bf16_t* GAB; float* part; DI void operator()(const pg8::Unit& u, int row, int col, f32x4 v) const { if (row < 128) { const int c = u.pn * 256 + col;
    const f32x4 g = ldbf4(GAB + (size_t)(TP + row) * 4096 + (u.ks < 4 ? 0 : 2048) + c); *(f32x4*)(part + ((size_t)u.ks * 128 + row) * DM + c) = v * g; } } };
DI void phase7(const Args& a, LAS unsigned char* lds) {
    unsigned char* ws = a.ws;
    { pg8::Gemm g{(const bf16_t*)(ws + WS_ONSA), (const bf16_t*)(ws + WS_BT_OA), DM, DM, DM};
      pg8::StaticOrder S; S.init(TP / 256, DM / 256, gridDim.x, blockIdx.x, DM, DM);
      EpiMerge E{(const bf16_t*)(ws + WS_GAB), (bf16_t*)(ws + WS_MG)};
      pg8::gemm_phase(lds, g, S, E); }
    { pg8::Gemm g{(const bf16_t*)(ws + WS_ONSA), (const bf16_t*)(ws + WS_BT_OA), DM, DM, 256};
      SplitOrder S{(int)gridDim.x, (int)blockIdx.x, 64, DM, DM, 256};
      pg8::EpiEach<FPartG> E{FPartG{(const bf16_t*)(ws + WS_GAB), (float*)(ws + WS_PART)}};
      pg8::gemm_phase(lds, g, S, E); }
}
DI void phase7b(const Args& a) {
    const int tid = threadIdx.x, lane = tid & 63, wave = __builtin_amdgcn_readfirstlane(tid >> 6);
    const int gw = blockIdx.x * NWAVES + wave, NGW = gridDim.x * NWAVES;
    for (int q = gw; q < TS; q += NGW) {
        f32x4 v[8];
#pragma unroll
        for (int j = 0; j < 8; ++j) v[j] = (f32x4){0.f, 0.f, 0.f, 0.f};
        for (int k = 0; k < 8; ++k) { const f32x4* pr = (const f32x4*)((const float*)(a.ws + WS_PART) + ((size_t)k * 128 + q) * DM) + lane;
#pragma unroll
            for (int j = 0; j < 8; ++j) v[j] += pr[64 * j]; }
        u32x2* o8 = (u32x2*)((bf16_t*)(a.ws + WS_MG) + (size_t)(TP + q) * DM) + lane;
#pragma unroll
        for (int j = 0; j < 8; ++j) o8[64 * j] = cvt4(v[j]);
    }
}
struct FResX { const float* xp; const float* xs; float* dst; DI void operator()(const pg8::Unit& u, int row, int col, f32x4 v) const { const int r = u.pm * 256 + row, c = u.pn * 256 + col;
    f32x4 o = (f32x4){0.f, 0.f, 0.f, 0.f}; if (r < TT) o = v + (r < TP ? *(const f32x4*)(xp + (size_t)r * DM + c) : *(const f32x4*)(xs + (size_t)(r - TP) * DM + c)); *(f32x4*)(dst + (size_t)r * DM + c) = o; } };
struct FResW { const float* base; float* dst; DI void operator()(const pg8::Unit& u, int row, int col, f32x4 v) const { const int r = u.pm * 256 + row, c = u.pn * 256 + col;
    f32x4 o = (f32x4){0.f, 0.f, 0.f, 0.f}; if (r < TT) o = v + *(const f32x4*)(base + (size_t)r * DM + c); *(f32x4*)(dst + (size_t)r * DM + c) = o; } };
struct FStoreBf { bf16_t* C; int ldc; DI void operator()(const pg8::Unit& u, int row, int col, f32x4 v) const { *(u32x2*)(C + (size_t)(u.pm * 256 + row) * ldc + u.pn * 256 + col) = cvt4(v); } };

struct FPart { float* part; DI void operator()(const pg8::Unit& u, int row, int col, f32x4 v) const { if (row < 128) *(f32x4*)(part + ((size_t)u.ks * 128 + row) * DM + u.pn * 256 + col) = v; } };
template <class F> DI void gemm_n2048(const Args& a, LAS unsigned char* lds, size_t ws_a, size_t ws_bt, int K, const F& f) {
    unsigned char* ws = a.ws;
    { pg8::Gemm g{(const bf16_t*)(ws + ws_a), (const bf16_t*)(ws + ws_bt), K, K, K};
      pg8::StaticOrder S; S.init(TP / 256, DM / 256, gridDim.x, blockIdx.x, K, K);
      pg8::EpiEach<F> E{f};
      pg8::gemm_phase(lds, g, S, E); }
    { pg8::Gemm g{(const bf16_t*)(ws + ws_a), (const bf16_t*)(ws + ws_bt), K, K, 256};
      SplitOrder S{(int)gridDim.x, (int)blockIdx.x, 8 * (K / 256), K, K, 256};
      pg8::EpiEach<FPart> E{FPart{(float*)(ws + WS_PART)}};
      pg8::gemm_phase(lds, g, S, E); }
}
DI void phase8(const Args& a, LAS unsigned char* lds) {
    gemm_n2048(a, lds, WS_MG, WS_BT_O, DM, FResX{(const float*)a.in[I_XP], (const float*)a.in[I_XS], (float*)(a.ws + WS_X1)});
}
DI void sample_row_sum(const Args& a, const float* base_row, int q, int S, int lane, f32x4 (&v)[8]) {
    const f32x4* br = (const f32x4*)base_row + lane;
#pragma unroll
    for (int j = 0; j < 8; ++j) v[j] = br[64 * j];
    for (int k = 0; k < S; ++k) { const f32x4* pr = (const f32x4*)((const float*)(a.ws + WS_PART) + ((size_t)k * 128 + q) * DM) + lane;
#pragma unroll
        for (int j = 0; j < 8; ++j) v[j] += pr[64 * j]; }
}
DI void phase_norm(const Args& a, size_t ws_x, const float* sbase, int S, int gidx) {
    const int tid = threadIdx.x, lane = tid & 63, wave = __builtin_amdgcn_readfirstlane(tid >> 6);
    const int gw = blockIdx.x * NWAVES + wave, NGW = gridDim.x * NWAVES;
    float* X = (float*)(a.ws + ws_x); const float* g = (const float*)a.in[I_NG] + gidx * DM; bf16_t* XN = (bf16_t*)(a.ws + WS_XN);
    for (int r = gw; r < TT; r += NGW) {
        if (r < TP) { rms_row_bf16(X + (size_t)r * DM, g, XN + (size_t)r * DM, lane); continue; }
        f32x4 v[8]; sample_row_sum(a, sbase + (size_t)(r - TP) * DM, r - TP, S, lane, v);
        float ss = 0.f; f32x4* xo = (f32x4*)(X + (size_t)r * DM) + lane;
#pragma unroll
        for (int j = 0; j < 8; ++j) { xo[64 * j] = v[j]; ss += (v[j].x * v[j].x + v[j].y * v[j].y) + (v[j].z * v[j].z + v[j].w * v[j].w); }
        const float rstd = rsqrtf(wave_sum(ss) * (1.f / 2048.f) + 1e-6f);
        const f32x4* gr = (const f32x4*)g + lane; u32x2* o8 = (u32x2*)(XN + (size_t)r * DM) + lane;
#pragma unroll
        for (int j = 0; j < 8; ++j) o8[64 * j] = cvt4(v[j] * rstd * gr[64 * j]);
    }
}
DI void phase10(const Args& a, LAS unsigned char* lds) {
    unsigned char* ws = a.ws;
    pg8::Gemm g{(const bf16_t*)(ws + WS_XN), (const bf16_t*)(ws + WS_BT_MQ), DM, DM, DM};
    pg8::StaticOrder S; S.init(MP / 256, 2, gridDim.x, blockIdx.x, DM, DM);
    pg8::EpiEach<FStoreBf> E{FStoreBf{(bf16_t*)(ws + WS_QMB), 512}};
    pg8::gemm_phase(lds, g, S, E);
}
DI void phase12(const Args& a, LAS unsigned char* lds) {
    gemm_n2048(a, lds, WS_OM, WS_BT_MO, 512, FResW{(const float*)(a.ws + WS_X1), (float*)(a.ws + WS_X2)});
}
DI void phase14(const Args& a, LAS unsigned char* lds) {
    unsigned char* ws = a.ws;
    pg8::Gemm g{(const bf16_t*)(ws + WS_XN), (const bf16_t*)(ws + WS_BT_UP), DM, DM, DM};
    pg8::StaticOrder S; S.init(MP / 256, DFF2 / 256, gridDim.x, blockIdx.x, DM, DM);
    pg8::EpiEach<FStoreBf> E{FStoreBf{(bf16_t*)(ws + WS_UB), DFF2}};
    pg8::gemm_phase(lds, g, S, E);
}
DI void phase15(const Args& a, LAS unsigned char* lds) {
    const int tid = threadIdx.x, lane = tid & 63, wave = __builtin_amdgcn_readfirstlane(tid >> 6);
    const int gw = blockIdx.x * NWAVES + wave, NGW = gridDim.x * NWAVES;
    unsigned char* ws = a.ws;
    const bf16_t* U = (const bf16_t*)(ws + WS_UB); bf16_t* ACT = (bf16_t*)(ws + WS_ACT);
    const float* cw = (const float*)a.in[I_CVW]; const float* cb = (const float*)a.in[I_CVB];
    constexpr int NRUN = TP / 32 + 32, NCH = DFF / 256;
#pragma unroll 1
    for (int it = gw; it < NRUN * NCH; it += NGW) {
        const int run = it / NCH, ch = it % NCH, c = 256 * ch + 4 * lane;
        int r0, nrow, t0; const float* st = nullptr; float* cout = nullptr; int cfirst = 1 << 30;
        if (run < TP / 32) { r0 = run * 32; nrow = 32; t0 = r0 & 4095; if (t0 == SEQ - 32) { cfirst = 30; cout = a.out + O_CONVP + (size_t)(r0 >> 12) * 2 * DFF2; } }
        else { const int db = run - TP / 32; r0 = TP + db * 4; nrow = 4; t0 = 0; st = (const float*)a.in[I_SCONV] + (size_t)db * 2 * DFF2; cfirst = 2; cout = a.out + O_CONVS + (size_t)db * 2 * DFF2; }
        f32x4 pb[2], w0[2], w1[2], w2[2], u1[2], u2[2];
#pragma unroll
        for (int hf = 0; hf < 2; ++hf) { const int cc = c + hf * DFF;
            pb[hf] = *(const f32x4*)(cb + cc); w0[hf] = *(const f32x4*)(cw + cc); w1[hf] = *(const f32x4*)(cw + DFF2 + cc); w2[hf] = *(const f32x4*)(cw + 2 * DFF2 + cc);
            if (st) { u2[hf] = *(const f32x4*)(st + cc); u1[hf] = *(const f32x4*)(st + DFF2 + cc); }
            else { u1[hf] = t0 >= 1 ? ldbf4(U + (size_t)(r0 - 1) * DFF2 + cc) : (f32x4){0.f, 0.f, 0.f, 0.f}; u2[hf] = t0 >= 2 ? ldbf4(U + (size_t)(r0 - 2) * DFF2 + cc) : (f32x4){0.f, 0.f, 0.f, 0.f}; } }
        f32x4 nx[2] = {ldbf4(U + (size_t)r0 * DFF2 + c), ldbf4(U + (size_t)r0 * DFF2 + c + DFF)};
        for (int i = 0; i < nrow; ++i) {
            const f32x4 u0[2] = {nx[0], nx[1]};
            if (i + 1 < nrow) { nx[0] = ldbf4(U + (size_t)(r0 + i + 1) * DFF2 + c); nx[1] = ldbf4(U + (size_t)(r0 + i + 1) * DFF2 + c + DFF); }
            const f32x4 gt = pb[0] + u2[0] * w0[0] + u1[0] * w1[0] + u0[0] * w2[0], up = pb[1] + u2[1] * w0[1] + u1[1] * w1[1] + u0[1] * w2[1];
            f32x4 o; o.x = gt.x * sigmoidf_(gt.x) * up.x; o.y = gt.y * sigmoidf_(gt.y) * up.y; o.z = gt.z * sigmoidf_(gt.z) * up.z; o.w = gt.w * sigmoidf_(gt.w) * up.w;
            *(u32x2*)(ACT + (size_t)(r0 + i) * DFF + c) = cvt4(o);
            if (i >= cfirst) { *(f32x4*)(cout + (size_t)(i - cfirst) * DFF2 + c) = u0[0]; *(f32x4*)(cout + (size_t)(i - cfirst) * DFF2 + c + DFF) = u0[1]; }
            u2[0] = u1[0]; u2[1] = u1[1]; u1[0] = u0[0]; u1[1] = u0[1];
        }
    }
}
DI void phase16(const Args& a, LAS unsigned char* lds) {
    gemm_n2048(a, lds, WS_ACT, WS_BT_DN, DFF, FResW{(const float*)(a.ws + WS_X2), (float*)(a.ws + WS_X3)});
}
DI void phase17(const Args& a) {
    const int tid = threadIdx.x, lane = tid & 63, wave = __builtin_amdgcn_readfirstlane(tid >> 6);
    const int gw = blockIdx.x * NWAVES + wave, NGW = gridDim.x * NWAVES;
    const float* X3 = (const float*)(a.ws + WS_X3); const f32x4* gr = (const f32x4*)a.in[I_FG] + lane;
    for (int r = gw; r < TT; r += NGW) {
        const f32x4* xr = (const f32x4*)(X3 + (size_t)r * DM) + lane; f32x4 v[8]; float s = 0.f;
        if (r < TP) {
#pragma unroll
            for (int j = 0; j < 8; ++j) v[j] = xr[64 * j];
        } else sample_row_sum(a, (const float*)(a.ws + WS_X2) + (size_t)r * DM, r - TP, DFF / 256, lane, v);
#pragma unroll
        for (int j = 0; j < 8; ++j) s += (v[j].x * v[j].x + v[j].y * v[j].y) + (v[j].z * v[j].z + v[j].w * v[j].w);
        const float rstd = rsqrtf(wave_sum(s) * (1.f / 2048.f) + 1e-6f);
        f32x4* o = (f32x4*)(a.out + (r < TP ? O_YP + (size_t)r * DM : O_YS + (size_t)(r - TP) * DM)) + lane;
#pragma unroll
        for (int j = 0; j < 8; ++j) o[64 * j] = v[j] * rstd * gr[64 * j];
    }
}
#define PHASES_REST \
    if (IN(3)) { phase3(args, lds); } SEAM(3); \
    if (IN(4)) { phase4(args, lds); } SEAM(4); \
    if (IN(5)) { phase5(args, lds); } SEAM(5); \
    if (IN(6)) { phase6(args, lds); } SEAM(6); \
    if (IN(7)) { phase7(args, lds); } SEAM(7); \
    if (IN(8)) { phase7b(args); } SEAM(8); \
    if (IN(9)) { phase8(args, lds); } SEAM(9); \
    if (IN(10)) { phase_norm(args, WS_X1, (const float*)args.in[I_XS], DM / 256, 1); } SEAM(10); \
    if (IN(11)) { phase10(args, lds); } SEAM(11); \
    if (IN(12)) { phase11(args, lds); } SEAM(12); \
    if (IN(13)) { phase12(args, lds); } SEAM(13); \
    if (IN(14)) { phase_norm(args, WS_X2, (const float*)(args.ws + WS_X1) + (size_t)TP * DM, 512 / 256, 3); } SEAM(14); \
    if (IN(15)) { phase14(args, lds); } SEAM(15); \
    if (IN(16)) { phase15(args, lds); } SEAM(16); \
    if (IN(17)) { phase16(args, lds); } SEAM(17); \
    if (IN(18)) { phase17(args); }
#ifndef MK_N_LAUNCHES
#define MK_N_LAUNCHES 1
#endif
constexpr int N_PHASES = 19;
__global__ void __launch_bounds__(NTHR, 2) mk_fwd(Args args) {
    extern __shared__ __attribute__((aligned(16))) unsigned char lds_raw[];
    LAS unsigned char* lds = (LAS unsigned char*)lds_raw;
    volatile LAS unsigned* MISC = (volatile LAS unsigned*)(lds + MISC_OFF);
    const int tid = threadIdx.x;
    for (int u = tid; u < 64; u += NTHR) ((LAS unsigned*)(lds + MISC_OFF))[u] = 0u;
    __syncthreads();
    unsigned* ctl = (unsigned*)(args.ws + WS_CTL);
    XcdBarrier bar; bar.bar = ctl + CW_BAR; bar.x = 0; bar.st = nullptr;
    const bool use_bar = (args.ph_hi - args.ph_lo) > 1;
    if (use_bar) bar = xcd_barrier_post(ctl + CW_BAR, MISC + 8);
    const int lo = args.ph_lo, hi = args.ph_hi;
#define IN(k) (lo <= (k) && (k) < hi)
#define SEAM(k) do { if (IN(k) && IN((k) + 1)) xcd_barrier(bar); } while (0)
    if (IN(0)) { phase0(args, lds); } SEAM(0);
    if (IN(1)) { phase1(args, lds); } SEAM(1);
    if (IN(2)) { phase2(args, lds); } SEAM(2);
    PHASES_REST
#undef IN
#undef SEAM
}

extern "C" void kernel_launch(void* const* d_in, const int* in_sizes, int n_in, void* d_out, int out_size, void* d_ws, size_t ws_size, hipStream_t stream) {
    static int grid = 0;
    if (grid == 0) {
        if (n_in != N_IN || (size_t)out_size != O_END || ws_size < WS_END) { fprintf(stderr, "kernel_launch: unexpected shapes: n_in %d out %d ws %zu (need %zu)\n", n_in, out_size, ws_size, (size_t)WS_END); grid = -1; return; }
        int dev = 0, cus = 0, per_cu = 0;
        if (hipGetDevice(&dev) != hipSuccess || hipDeviceGetAttribute(&cus, hipDeviceAttributeMultiprocessorCount, dev) != hipSuccess) { grid = -1; return; }
        if (hipFuncSetAttribute((const void*)mk_fwd, hipFuncAttributeMaxDynamicSharedMemorySize, LDS_BYTES) != hipSuccess) { fprintf(stderr, "kernel_launch: hipFuncSetAttribute failed\n"); grid = -1; return; }
        if (hipOccupancyMaxActiveBlocksPerMultiprocessor(&per_cu, (const void*)mk_fwd, NTHR, LDS_BYTES) != hipSuccess || per_cu < 1) fprintf(stderr, "kernel_launch: occupancy query reports %d\n", per_cu);
        (void)hipGetLastError();
        grid = cus;
    }
    if (grid < 0) return;
    (void)hipMemsetAsync((char*)d_ws + WS_CTL, 0, CTL_BYTES, stream);
    Args a{};
    for (int i = 0; i < N_IN; ++i) a.in[i] = d_in[i];
    a.out = (float*)d_out; a.ws = (unsigned char*)d_ws;
#if MK_N_LAUNCHES == 1
    a.ph_lo = 0; a.ph_hi = N_PHASES;
    hipLaunchKernelGGL(mk_fwd, dim3(grid), dim3(NTHR), LDS_BYTES, stream, a);
#else
    for (int p = 0; p < N_PHASES; ++p) { a.ph_lo = p; a.ph_hi = p + 1; hipLaunchKernelGGL(mk_fwd, dim3(grid), dim3(NTHR), LDS_BYTES, stream, a); }
#endif
}
```

```cpp
#include <hip/hip_runtime.h>
#include <cstdio>
#include <cstdint>

#define DI __device__ __forceinline__
#define LAS __attribute__((address_space(3)))
typedef unsigned short bf16_t;
typedef short bf16x8 __attribute__((ext_vector_type(8)));
typedef float f32x4 __attribute__((ext_vector_type(4)));
typedef float f32x2 __attribute__((ext_vector_type(2)));
typedef unsigned u32x4 __attribute__((ext_vector_type(4)));
typedef unsigned u32x2 __attribute__((ext_vector_type(2)));

constexpr int DM = 2048, SEQ = 4096, TP = 8192, TS = 128, TT = 8320, MP = 8448;
constexpr int DIN = 8320, DINP = 8448, DFF = 5632, DFF2 = 11264;
constexpr int NPAGES = 64;
constexpr int C_QA = 0, C_KVA = 1024, C_GA = 1792, C_QB = 1840, C_KVB = 2864, C_QI = 3120, C_KI = 4144, C_WI = 4208, C_GM = 4224;
constexpr size_t O_YP = 0, O_YS = O_YP + (size_t)TP * DM, O_NSAP = O_YS + (size_t)TS * DM, O_NSAS = O_NSAP + (size_t)TP * 512, O_WINP = O_NSAS + (size_t)TS * 512,
                 O_WINS = O_WINP + (size_t)2 * 512 * 256, O_DSAP = O_WINS + (size_t)32 * 512 * 256, O_DSAS = O_DSAP + (size_t)TP * 320, O_MEMP = O_DSAS + (size_t)TS * 320,
                 O_CONVP = O_MEMP + (size_t)512 * 1024, O_CONVS = O_CONVP + (size_t)2 * 2 * DFF2, O_END = O_CONVS + (size_t)32 * 2 * DFF2;
static_assert(O_END == 29708288, "output size");
enum { I_XP = 0, I_XS, I_MEM, I_CNSA, I_SWIN, I_CDSA, I_CMEM, I_SCONV, I_PT, I_NG, I_WIN, I_PE, I_CW1, I_CB1, I_CW2, I_WOA, I_WOB, I_WO, I_WMQ, I_WMKV, I_WMO, I_WUP, I_CVW, I_CVB, I_WDN, I_FG, N_IN };

constexpr size_t al256(size_t x) { return (x + 255) & ~(size_t)255; }
constexpr size_t WS_CTL = 0, CTL_BYTES = 1u << 20;
constexpr size_t WS_BT_IN = CTL_BYTES;
constexpr size_t WS_BT_OA = WS_BT_IN + (size_t)DINP * DM * 2;
constexpr size_t WS_BT_OB = WS_BT_OA + (size_t)DM * 1024 * 2;
constexpr size_t WS_BT_O = WS_BT_OB + (size_t)DM * 1024 * 2;
constexpr size_t WS_BT_MQ = WS_BT_O + (size_t)DM * DM * 2;
constexpr size_t WS_BT_MKV = WS_BT_MQ + (size_t)512 * DM * 2;
constexpr size_t WS_BT_MO = WS_BT_MKV + (size_t)1024 * DM * 2;
constexpr size_t WS_BT_UP = WS_BT_MO + (size_t)DM * 512 * 2;
constexpr size_t WS_BT_DN = WS_BT_UP + (size_t)DFF2 * DM * 2;
constexpr size_t WS_BT_C1 = WS_BT_DN + (size_t)DM * DFF * 2;
constexpr size_t WS_XN = WS_BT_C1 + (size_t)2 * 256 * 2048 * 2;
constexpr size_t WS_MEMN = WS_XN + (size_t)MP * DM * 2;
constexpr size_t WS_P = WS_MEMN + (size_t)512 * DM * 2;
constexpr size_t WS_QC = WS_P + (size_t)MP * DINP * 4;
constexpr size_t WS_QR = WS_QC + (size_t)MP * 1024 * 2;
constexpr size_t WS_QB = WS_QR + (size_t)MP * 1024 * 2;
constexpr size_t WS_QI = WS_QB + (size_t)MP * 1024 * 2;
constexpr size_t WS_GN = WS_QI + (size_t)MP * 1024 * 2;
constexpr size_t WS_WI = WS_GN + (size_t)MP * 48 * 4;
constexpr size_t WS_GAB = WS_WI + (size_t)MP * 16 * 4;
constexpr size_t WS_KW = WS_GAB + (size_t)MP * 4096 * 2;
constexpr int KCP_ROWS = SEQ + 32;
constexpr size_t WS_KCRAW = WS_KW + (size_t)MP * 256 * 4;
constexpr size_t KCS_OFF = (size_t)8 * KCP_ROWS * 64;
constexpr size_t WS_BPART = al256(WS_KCRAW + (KCS_OFF + (size_t)128 * 8192 * 64 + 64 * 64) * 2);
constexpr size_t WS_BIASC = WS_BPART + 16 * 512 * 4;
constexpr int HC_ROWS = 132 * 256;
constexpr size_t WS_HC = WS_BIASC + 512 * 4;
constexpr size_t WS_KCV = WS_HC + (size_t)2 * HC_ROWS * 256 * 2;
constexpr size_t WS_OCMP = WS_KCV + (size_t)34 * 4 * 512 * 64 * 4;
constexpr size_t WS_SEL = WS_OCMP + (size_t)MP * 1024 * 4;
constexpr size_t WS_IDX = WS_SEL + (size_t)MP * 32 * 4;
constexpr size_t WS_ONSA = WS_IDX + (size_t)MP * 256 * 4;
constexpr size_t WS_ODSA = WS_ONSA + (size_t)MP * 1024 * 2;
constexpr size_t WS_TMPG = WS_ODSA + (size_t)MP * 1024 * 2;
constexpr size_t WS_MG = WS_TMPG + (size_t)MP * DM * 4;
constexpr size_t WS_X1 = WS_MG + (size_t)MP * DM * 2;
constexpr size_t WS_X2 = WS_X1 + (size_t)MP * DM * 4;
constexpr size_t WS_X3 = WS_X2 + (size_t)MP * DM * 4;
constexpr size_t WS_QMB = WS_X3 + (size_t)MP * DM * 4;
constexpr size_t WS_OM = WS_QMB + (size_t)MP * 512 * 2;
constexpr size_t WS_UB = WS_OM + (size_t)MP * 512 * 2;
constexpr size_t WS_ACT = WS_UB + (size_t)MP * DFF2 * 2;
constexpr size_t WS_NSAF = WS_ACT + (size_t)MP * DFF * 2;
constexpr size_t WS_KCF = WS_NSAF + (size_t)4 * 128 * 8192 * 2;
constexpr size_t WS_KIF = WS_KCF + (size_t)34 * 2 * 16 * 4096 * 2;
constexpr size_t WS_DSAB = WS_KIF + (size_t)2 * 256 * 1024 * 2;
constexpr size_t WS_PART = WS_DSAB + (size_t)2 * 4096 * 256 * 2;
constexpr size_t WS_KIFS = WS_PART + (size_t)22 * 128 * DM * 4;
constexpr size_t WS_SS = WS_KIFS + (size_t)32 * 513 * 1024 * 2;
constexpr size_t WS_RS = WS_SS + (size_t)2 * TP * 4;
constexpr size_t WS_END = WS_RS + (size_t)2 * MP * 4;
static_assert(WS_END < (size_t)2400 * 1024 * 1024, "ws map too large");
constexpr int CW_BAR = 4096;

constexpr int RING_BYTES = 131072, LDS_BYTES = 147456, MISC_OFF = LDS_BYTES - 256;

#define LDS_WAIT() asm volatile("s_waitcnt lgkmcnt(0)" ::: "memory")
#define VM_WAIT() asm volatile("s_waitcnt vmcnt(0)" ::: "memory")
DI unsigned cvt_pk_bf16(float lo, float hi) { unsigned r; asm volatile("v_cvt_pk_bf16_f32 %0, %1, %2" : "=v"(r) : "v"(lo), "v"(hi)); return r; }
DI float bf2f(bf16_t b) { return __uint_as_float(((unsigned)b) << 16); }
DI bf16x8 cvt8(f32x4 a, f32x4 b) { u32x4 w; w.x = cvt_pk_bf16(a.x, a.y); w.y = cvt_pk_bf16(a.z, a.w); w.z = cvt_pk_bf16(b.x, b.y); w.w = cvt_pk_bf16(b.z, b.w); return __builtin_bit_cast(bf16x8, w); }
DI u32x2 cvt4(f32x4 a) { u32x2 w; w.x = cvt_pk_bf16(a.x, a.y); w.y = cvt_pk_bf16(a.z, a.w); return w; }
template <int CTRL> DI float dpp_f_(float x) { return __int_as_float(__builtin_amdgcn_update_dpp(0, __float_as_int(x), CTRL, 0xF, 0xF, true)); }
DI float wave_sum(float v) {
    v += dpp_f_<0xB1>(v); v += dpp_f_<0x4E>(v); v += dpp_f_<0x141>(v); v += dpp_f_<0x140>(v);
    { const auto r = __builtin_amdgcn_permlane16_swap(__float_as_uint(v), __float_as_uint(v), false, false); v = __uint_as_float(r[0]) + __uint_as_float(r[1]); }
    { const auto r = __builtin_amdgcn_permlane32_swap(__float_as_uint(v), __float_as_uint(v), false, false); v = __uint_as_float(r[0]) + __uint_as_float(r[1]); }
    return v;
}
DI f32x4 shfl_xor4(f32x4 v, int m) { f32x4 r; r.x = __shfl_xor(v.x, m); r.y = __shfl_xor(v.y, m); r.z = __shfl_xor(v.z, m); r.w = __shfl_xor(v.w, m); return r; }
DI float sigmoidf_(float x) { return 1.f / (1.f + __expf(-x)); }
#define MFMA16(a, b, c) __builtin_amdgcn_mfma_f32_16x16x32_bf16((a), (b), (c), 0, 0, 0)
namespace pg8 {
constexpr int BM = 256, BK = 64, HALF = 128, HTB = HALF * BK * 2  , STAGE_BYTES = 8 * HTB, NXCD = 8, WGM = 8;
__host__ __device__ __forceinline__ int lds_byte(int r, int c) { const int st = (r >> 4) * 2 + (c >> 5), rr = r & 15, cc = c & 31, ob = rr * 64 + cc * 2; return st * 1024 + (ob ^ (((ob >> 9) & 1) << 5)); }
__host__ __device__ __forceinline__ void stage_rc(int b, int& R, int& C) { const int st = b / 1024, sb = b % 1024, swz = sb ^ (((sb >> 9) & 1) << 5); R = (st >> 1) * 16 + swz / 64; C = (st & 1) * 32 + (swz % 64) / 2; }

struct Unit { int pm, pn, ks; };
struct Gemm { const bf16_t* A; const bf16_t* Bt; int lda, ldb, K; };

struct StaticOrder {
    int nM, nN, nwg, G, c, lda, ldb;
    __device__ void init(int nM_, int nN_, int G_, int c_, int lda_, int ldb_) { nM = nM_; nN = nN_; nwg = nM * nN; G = G_; c = c_; lda = lda_; ldb = ldb_; }
    __device__ bool next(int i, Unit& u) const { return at((long)i * G + c, u); }
    __device__ bool at(long L, Unit& u) const {
        if (L >= nwg) return false;
        int wgid = (int)L; { const int q = nwg / NXCD, r = nwg % NXCD, xcd = wgid % NXCD, off = wgid / NXCD; wgid = (xcd < r ? xcd * (q + 1) : r * (q + 1) + (xcd - r) * q) + off; }
        const int nig = WGM * nN, gid = wgid / nig, fm = gid * WGM, gsz = (nM - fm) < WGM ? (nM - fm) : WGM;
        u.pm = fm + ((wgid % nig) % gsz); u.pn = (wgid % nig) / gsz; u.ks = 0; return true;
    }
    __device__ __forceinline__ size_t offA(const Unit& u) const { return (size_t)u.pm * BM * lda * 2; }
    __device__ __forceinline__ size_t offB(const Unit& u) const { return (size_t)u.pn * BM * ldb * 2; }
    __device__ __forceinline__ int ktiles(const Unit&, int K) const { return K; }
};

template <class F> struct EpiEach {
    static constexpr bool HAS_MID = false;
    F f;
    __device__ __forceinline__ void operator()(const f32x4 (&acc)[2][2][4][2], const Unit& u, int wr, int wc, int fr, int fq) const {
#pragma unroll
        for (int ai = 0; ai < 2; ++ai)
#pragma unroll
            for (int m = 0; m < 4; ++m) { const int row = ai * HALF + wr * 64 + m * 16 + fr;
#pragma unroll
                for (int bj = 0; bj < 2; ++bj)
#pragma unroll
                    for (int n = 0; n < 2; ++n) f(u, row, bj * HALF + wc * 32 + n * 16 + 4 * fq, acc[ai][bj][m][n]); }
    }
};

template <class Epi, class Sched>
__device__ __forceinline__ void gemm_phase(LAS unsigned char* lds, const Gemm g, const Sched& S, const Epi& E) {
    const int tid = threadIdx.x, wid = __builtin_amdgcn_readfirstlane(tid >> 6), lane = tid & 63, wr = wid >> 2, wc = wid & 3, fr = lane & 15, fq = lane >> 4;
    unsigned voffA[2], voffB[2];
#pragma unroll
    for (int i = 0; i < 2; ++i) { int R, C; stage_rc(tid * 16 + i * 8192, R, C); voffA[i] = (unsigned)(R * g.lda + C) * 2u; voffB[i] = (unsigned)(R * g.ldb + C) * 2u; }
    const size_t kstep = (size_t)(BK * 2);
    const size_t hA = (size_t)HALF * g.lda * 2, hB = (size_t)HALF * g.ldb * 2;
    const unsigned ldsw = (unsigned)wid * 1024u;
    const int aoff = lds_byte(wr * 64 + fr, fq * 8), boff = lds_byte(wc * 32 + fr, fq * 8);
#define PG8_SA(b, h) (((b) * 2 + (h)) * HTB)
#define PG8_SB(b, h) ((4 + (b) * 2 + (h)) * HTB)
#define PG8_STAGE(bufoff, gbase, voff) do { _Pragma("unroll") for (int _i = 0; _i < 2; ++_i) \
        __builtin_amdgcn_global_load_lds((const unsigned*)((const char*)(gbase) + (voff)[_i]), (LAS unsigned*)(lds + (bufoff) + ldsw + _i * 8192), 16, 0, 0); } while (0)
#define PG8_LDA(dst, b, h) do { _Pragma("unroll") for (int m = 0; m < 4; ++m) _Pragma("unroll") for (int k = 0; k < 2; ++k) dst[m][k] = *(const LAS bf16x8*)(lds + PG8_SA(b, h) + aoff + m * 2048 + k * 1024); } while (0)
#define PG8_LDB(dst, b, h) do { _Pragma("unroll") for (int n = 0; n < 2; ++n) _Pragma("unroll") for (int k = 0; k < 2; ++k) dst[n][k] = *(const LAS bf16x8*)(lds + PG8_SB(b, h) + boff + n * 2048 + k * 1024); } while (0)
#define PG8_MMA(ai, bj, At, Bt) do { __builtin_amdgcn_s_setprio(1); _Pragma("unroll") for (int m = 0; m < 4; ++m) _Pragma("unroll") for (int n = 0; n < 2; ++n) _Pragma("unroll") for (int k = 0; k < 2; ++k) \
        acc[ai][bj][m][n] = __builtin_amdgcn_mfma_f32_16x16x32_bf16(Bt[n][k], At[m][k], acc[ai][bj][m][n], 0, 0, 0); __builtin_amdgcn_s_setprio(0); } while (0)
#define PG8_WAIT_V(n) asm volatile("s_waitcnt vmcnt(" #n ")" ::: "memory")
#define PG8_WAIT_L(n) asm volatile("s_waitcnt lgkmcnt(" #n ")" ::: "memory")
#define PG8_BAR __builtin_amdgcn_s_barrier()
#define PG8_SCHED __builtin_amdgcn_sched_barrier(0)
    Unit cur, nxt; int ui = 0;
    if (!S.next(0, cur)) return;
    f32x4 acc[2][2][4][2];
#pragma unroll
    for (int a = 0; a < 2; ++a)
#pragma unroll
        for (int b = 0; b < 2; ++b)
#pragma unroll
            for (int m = 0; m < 4; ++m)
#pragma unroll
                for (int n = 0; n < 2; ++n) acc[a][b][m][n] = (f32x4){0.f, 0.f, 0.f, 0.f};
    bf16x8 At[4][2], B0[2][2], B1[2][2];
    const char* cA = (const char*)g.A + S.offA(cur); const char* cB = (const char*)g.Bt + S.offB(cur);
    PG8_STAGE(PG8_SB(0, 0), cB, voffB); PG8_STAGE(PG8_SB(0, 1), cB + hB, voffB); PG8_STAGE(PG8_SA(0, 0), cA, voffA); PG8_STAGE(PG8_SA(0, 1), cA + hA, voffA);
    if (wr == 1) PG8_BAR;
    PG8_WAIT_V(2); PG8_BAR;
    PG8_STAGE(PG8_SB(1, 0), cB + kstep, voffB); PG8_STAGE(PG8_SA(1, 0), cA + kstep, voffA); PG8_STAGE(PG8_SB(1, 1), cB + hB + kstep, voffB);
    PG8_WAIT_V(6); PG8_BAR;
    for (;;) {
        const bool has_next = S.next(ui + 1, nxt);
        const int nt = S.ktiles(cur, g.K) / BK;
        const char* nA = has_next ? (const char*)g.A + S.offA(nxt) : cA; const char* nB = has_next ? (const char*)g.Bt + S.offB(nxt) : cB;
        constexpr int NHALF = Epi::HAS_MID ? 2 : 1; const int tlen = nt / NHALF;
#pragma unroll 1
        for (int hf = 0; hf < NHALF; ++hf) {
#pragma unroll 1
        for (int t = hf * tlen; t < (hf + 1) * tlen; t += 2) {
            const bool last = (t == nt - 2);
            const char* a1 = cA + (size_t)(t + 1) * kstep;
            const char* a2 = last ? nA : cA + (size_t)(t + 2) * kstep; const char* b2 = last ? nB : cB + (size_t)(t + 2) * kstep;
            const char* a3 = a2 + kstep; const char* b3 = b2 + kstep;
            PG8_LDB(B0, 0, 0); PG8_LDB(B1, 0, 1); PG8_SCHED; PG8_LDA(At, 0, 0); PG8_STAGE(PG8_SA(1, 1), a1 + hA, voffA);
            PG8_WAIT_V(8); PG8_WAIT_L(0); PG8_BAR; PG8_MMA(0, 0, At, B0); PG8_MMA(0, 1, At, B1); PG8_BAR; PG8_SCHED;
            PG8_LDA(At, 0, 1); PG8_STAGE(PG8_SB(0, 0), b2, voffB); PG8_STAGE(PG8_SB(0, 1), b2 + hB, voffB); PG8_STAGE(PG8_SA(0, 0), a2, voffA);
            PG8_WAIT_V(8); PG8_WAIT_L(0); PG8_BAR; PG8_MMA(1, 0, At, B0); PG8_MMA(1, 1, At, B1); PG8_BAR; PG8_SCHED;
            PG8_LDB(B0, 1, 0); PG8_LDB(B1, 1, 1); PG8_SCHED; PG8_LDA(At, 1, 0); PG8_STAGE(PG8_SA(0, 1), a2 + hA, voffA);
            PG8_WAIT_V(8); PG8_WAIT_L(0); PG8_BAR; PG8_MMA(0, 0, At, B0); PG8_MMA(0, 1, At, B1); PG8_BAR; PG8_SCHED;
            PG8_LDA(At, 1, 1); PG8_STAGE(PG8_SB(1, 0), b3, voffB); PG8_STAGE(PG8_SB(1, 1), b3 + hB, voffB); PG8_STAGE(PG8_SA(1, 0), a3, voffA);
            PG8_WAIT_V(8); PG8_WAIT_L(0); PG8_BAR; PG8_MMA(1, 0, At, B0); PG8_MMA(1, 1, At, B1); PG8_BAR; PG8_SCHED;
        }
        if constexpr (Epi::HAS_MID) { if (hf == 0) E.mid(acc, cur, wr, wc, fr, fq); }
        }
        if (wr == 0) PG8_BAR;
        E(acc, cur, wr, wc, fr, fq);
        if (!has_next) break;
#pragma unroll
        for (int a = 0; a < 2; ++a)
#pragma unroll
            for (int b = 0; b < 2; ++b)
#pragma unroll
                for (int m = 0; m < 4; ++m)
#pragma unroll
                    for (int n = 0; n < 2; ++n) acc[a][b][m][n] = (f32x4){0.f, 0.f, 0.f, 0.f};
        cur = nxt; cA = nA; cB = nB; ++ui;
        if (wr == 1) PG8_BAR;
    }
    PG8_WAIT_V(0);
    PG8_BAR;
#undef PG8_SA
#undef PG8_SB
#undef PG8_STAGE
#undef PG8_LDA
#undef PG8_LDB
#undef PG8_MMA
#undef PG8_WAIT_V
#undef PG8_WAIT_L
#undef PG8_BAR
#undef PG8_SCHED
}
}
#define XB_TMO      128
#define XB_XCNT(j)  (256  + 64 * (j))
#define XB_XSUB(j)  (1280 + 64 * (j))
#define XB_XGEN(j)  (2304 + 64 * (j))
#define XB_TOP      3328
#define XB_TOPGEN   3392
#define XCD_BAR_WORDS 3456
#define XB_SPIN_CAP (1u << 18)

__device__ __forceinline__ unsigned xb_ld(unsigned* p)              { return __hip_atomic_load(p, __ATOMIC_RELAXED, __HIP_MEMORY_SCOPE_AGENT); }
__device__ __forceinline__ unsigned xb_add(unsigned* p, unsigned v) { return __hip_atomic_fetch_add(p, v, __ATOMIC_RELAXED, __HIP_MEMORY_SCOPE_AGENT); }
__device__ __forceinline__ unsigned xb_xcc_id() { return (unsigned)__builtin_amdgcn_s_getreg((3 << 11) | 20) & 0xFu; }
#define XB_SPIN(cond, bar) do { unsigned _sp = 0; while (cond) { __builtin_amdgcn_s_sleep(1); \
    if ((++_sp & 255u) == 0u) { if (xb_ld(&(bar)[XB_TMO])) break; if (_sp > XB_SPIN_CAP) { atomicAdd(&(bar)[XB_TMO], 1u); break; } } } } while (0)

struct XcdBarrier {
    unsigned* bar; unsigned x;
    volatile LAS unsigned* st;
};

__device__ __forceinline__ XcdBarrier xcd_barrier_post(unsigned* bar, volatile LAS unsigned* st) {
    XcdBarrier b; b.bar = bar; b.x = xb_xcc_id(); b.st = st;
    if (threadIdx.x == 0) (void)xb_add(&bar[XB_XCNT(b.x)], 1u);
    return b;
}
__device__ __forceinline__ void xcd_barrier_complete(unsigned* bar, unsigned x, unsigned& nloc, unsigned& nx) {
    const unsigned G = gridDim.x * gridDim.y * gridDim.z;
    unsigned sum, cnt, mine, sp = 0u;
    for (;;) {
        sum = 0u; cnt = 0u; mine = 0u;
#pragma unroll
        for (unsigned j = 0; j < 16; ++j) { const unsigned c = xb_ld(&bar[XB_XCNT(j)]); sum += c; cnt += (c > 0u) ? 1u : 0u; mine = (j == x) ? c : mine; }
        if (sum == G) break;
        __builtin_amdgcn_s_sleep(1);
        if ((++sp & 255u) == 0u) { if (xb_ld(&bar[XB_TMO])) break; if (sp > XB_SPIN_CAP) { atomicAdd(&bar[XB_TMO], 1u); break; } }
    }
    nloc = mine > 0u ? mine : 1u; nx = cnt > 0u ? cnt : 1u;
}

__device__ __forceinline__ void xcd_barrier(const XcdBarrier& b) {
    asm volatile("s_waitcnt vmcnt(0)" ::: "memory");
    __syncthreads();
    if (threadIdx.x == 0) {
        unsigned* bar = b.bar;
        __builtin_amdgcn_s_waitcnt(0);
        unsigned nloc = b.st[0], nx = b.st[1];
        if (nloc == 0u) { xcd_barrier_complete(bar, b.x, nloc, nx); b.st[0] = nloc; b.st[1] = nx; }
        const unsigned old = xb_add(&bar[XB_XSUB(b.x)], 1u);
        const unsigned gen = old / nloc;
        if (old + 1u == (gen + 1u) * nloc) {
            __builtin_amdgcn_fence(__ATOMIC_RELEASE, "agent");
            asm volatile("s_waitcnt vmcnt(0)" ::: "memory");
            const unsigned og = xb_add(&bar[XB_TOP], 1u);
            const unsigned tg = og / nx;
            if (og + 1u == (tg + 1u) * nx) xb_add(&bar[XB_TOPGEN], 1u);
            else XB_SPIN(xb_ld(&bar[XB_TOPGEN]) == tg, bar);
            __builtin_amdgcn_fence(__ATOMIC_ACQUIRE, "agent");
            xb_add(&bar[XB_XGEN(b.x)], 1u);
            asm volatile("s_waitcnt vmcnt(0)" ::: "memory");
        } else {
            XB_SPIN(xb_ld(&bar[XB_XGEN(b.x)]) == gen, bar);
            __builtin_amdgcn_fence(__ATOMIC_ACQUIRE, "agent");
            asm volatile("s_waitcnt vmcnt(0)" ::: "memory");
        }
    }
    __syncthreads();
}
struct Args { const void* in[N_IN]; float* out; unsigned char* ws; int ph_lo, ph_hi; };
constexpr int NWAVES = 8, NTHR = 512;

struct FStoreF32 { float* C; int ldc; DI void operator()(const pg8::Unit& u, int row, int col, f32x4 v) const { *(f32x4*)(C + (size_t)(u.pm * 256 + row) * ldc + u.pn * 256 + col) = v; } };

DI void p0_transpose_item(const float* W, int K, int N, bf16_t* WT, LAS float* scr, int item, int lane, int ldw = 0) {
    if (ldw == 0) ldw = K;
    const int nblk = N / 32, kb = item / nblk, nb = item % nblk, k0 = 64 * kb, n0 = 32 * nb;
#pragma unroll 8
    for (int i = 0; i < 32; ++i) { const int kk = 2 * i + (lane >> 5); scr[kk * 33 + (lane & 31)] = W[(size_t)(k0 + kk) * N + n0 + (lane & 31)]; }
    LDS_WAIT();
    const int c = lane & 7;
#pragma unroll
    for (int j = 0; j < 4; ++j) { const int n = (lane >> 3) + 8 * j; const LAS float* s = scr + (8 * c) * 33 + n;
        u32x4 o; o.x = cvt_pk_bf16(s[0 * 33], s[1 * 33]); o.y = cvt_pk_bf16(s[2 * 33], s[3 * 33]); o.z = cvt_pk_bf16(s[4 * 33], s[5 * 33]); o.w = cvt_pk_bf16(s[6 * 33], s[7 * 33]);
        *(u32x4*)(WT + (size_t)(n0 + n) * ldw + k0 + 8 * c) = o; }
    LDS_WAIT();
}
struct TrItem { const float* W; bf16_t* WT; int N, ldw, k0, n0; };
DI void tr_load(const TrItem& t, int lane, float (&v)[32]) {
#pragma unroll
    for (int i = 0; i < 32; ++i) v[i] = t.W[(size_t)(t.k0 + 2 * i + (lane >> 5)) * t.N + t.n0 + (lane & 31)];
}
DI void tr_store(const TrItem& t, LAS float* scr, int lane, const float (&v)[32]) {
#pragma unroll
    for (int i = 0; i < 32; ++i) scr[(2 * i + (lane >> 5)) * 33 + (lane & 31)] = v[i];
    LDS_WAIT();
    const int c = lane & 7;
#pragma unroll
    for (int j = 0; j < 4; ++j) { const int n = (lane >> 3) + 8 * j; const LAS float* s = scr + (8 * c) * 33 + n;
        u32x4 o; o.x = cvt_pk_bf16(s[0 * 33], s[1 * 33]); o.y = cvt_pk_bf16(s[2 * 33], s[3 * 33]); o.z = cvt_pk_bf16(s[4 * 33], s[5 * 33]); o.w = cvt_pk_bf16(s[6 * 33], s[7 * 33]);
        *(u32x4*)(t.WT + (size_t)(t.n0 + n) * t.ldw + t.k0 + 8 * c) = o; }
    LDS_WAIT();
}
DI void rms_row_bf16(const float* xrow, const float* g, bf16_t* orow, int lane) {
    const f32x4* xr = (const f32x4*)xrow + lane; const f32x4* gr = (const f32x4*)g + lane;
    f32x4 v[8]; float s = 0.f;
#pragma unroll
    for (int j = 0; j < 8; ++j) { v[j] = xr[64 * j]; s += (v[j].x * v[j].x + v[j].y * v[j].y) + (v[j].z * v[j].z + v[j].w * v[j].w); }
    const float rstd = rsqrtf(wave_sum(s) * (1.f / 2048.f) + 1e-6f);
    u32x2* o8 = (u32x2*)orow + lane;
#pragma unroll
    for (int j = 0; j < 8; ++j) { const f32x4 gg = gr[64 * j]; o8[64 * j] = cvt4(v[j] * rstd * gg); }
}

constexpr int NT_IN = 32 * 260, NT_OA = 16 * 64, NT_O = 32 * 64, NT_MQ = 32 * 16, NT_MKV = 32 * 32, NT_MO = 8 * 64, NT_UP = 32 * 352, NT_DN = 88 * 64, NT_C1 = 32 * 8;
constexpr int N_PG = 32 * NPAGES, N_BP = 128, N_WC = 32 * 508;
constexpr int NT_ALL = NT_UP + NT_IN + NT_DN + NT_O + 2 * NT_OA + NT_MQ + NT_MKV + NT_MO + 2 * NT_C1;
constexpr int PI_REST = TT + 512 + 2 * N_PG + N_BP + N_WC;
DI TrItem tr_decode(const Args& a, int tix) {
    unsigned char* ws = a.ws; int r = tix; const float* W; bf16_t* WT; int K, N, ldw;
    if (r < NT_UP) { W = (const float*)a.in[I_WUP]; K = DM; N = DFF2; WT = (bf16_t*)(ws + WS_BT_UP); ldw = K; }
    else if ((r -= NT_UP) < NT_IN) { W = (const float*)a.in[I_WIN]; K = DM; N = DIN; WT = (bf16_t*)(ws + WS_BT_IN); ldw = K; }
    else if ((r -= NT_IN) < NT_DN) { W = (const float*)a.in[I_WDN]; K = DFF; N = DM; WT = (bf16_t*)(ws + WS_BT_DN); ldw = K; }
    else if ((r -= NT_DN) < NT_O) { W = (const float*)a.in[I_WO]; K = DM; N = DM; WT = (bf16_t*)(ws + WS_BT_O); ldw = K; }
    else if ((r -= NT_O) < NT_OA) { W = (const float*)a.in[I_WOA]; K = 1024; N = DM; WT = (bf16_t*)(ws + WS_BT_OA); ldw = 2048; }
    else if ((r -= NT_OA) < NT_OA) { W = (const float*)a.in[I_WOB]; K = 1024; N = DM; WT = (bf16_t*)(ws + WS_BT_OA) + 1024; ldw = 2048; }
    else if ((r -= NT_OA) < NT_MQ) { W = (const float*)a.in[I_WMQ]; K = DM; N = 512; WT = (bf16_t*)(ws + WS_BT_MQ); ldw = K; }
    else if ((r -= NT_MQ) < NT_MKV) { W = (const float*)a.in[I_WMKV]; K = DM; N = 1024; WT = (bf16_t*)(ws + WS_BT_MKV); ldw = K; }
    else if ((r -= NT_MKV) < NT_MO) { W = (const float*)a.in[I_WMO]; K = 512; N = DM; WT = (bf16_t*)(ws + WS_BT_MO); ldw = K; }
    else if ((r -= NT_MO) < NT_C1) { W = (const float*)a.in[I_CW1]; K = 2048; N = 256; WT = (bf16_t*)(ws + WS_BT_C1); ldw = K; }
    else { r -= NT_C1; W = (const float*)a.in[I_CW1] + (size_t)2048 * 256; K = 2048; N = 256; WT = (bf16_t*)(ws + WS_BT_C1) + (size_t)256 * 2048; ldw = K; }
    const int nblk = N / 32; TrItem t; t.W = W; t.WT = WT; t.N = N; t.ldw = ldw; t.k0 = 64 * (r / nblk); t.n0 = 32 * (r % nblk); return t;
}
DI void prologue_item(const Args& a, LAS float* scr, int lane, int it) {
    unsigned char* ws = a.ws; int r = it;
    if (r < TT) {
        const float* xrow = r < TP ? (const float*)a.in[I_XP] + (size_t)r * DM : (const float*)a.in[I_XS] + (size_t)(r - TP) * DM;
        rms_row_bf16(xrow, (const float*)a.in[I_NG], (bf16_t*)(ws + WS_XN) + (size_t)r * DM, lane); return; } r -= TT;
    if (r < 512) { rms_row_bf16((const float*)a.in[I_MEM] + (size_t)r * DM, (const float*)a.in[I_NG] + 2 * DM, (bf16_t*)(ws + WS_MEMN) + (size_t)r * DM, lane); return; } r -= 512;
    if (r < N_PG) {
        const int db = r >> 6, pj = r & 63; const int page = ((const int*)a.in[I_PT])[db * NPAGES + pj];
        const float* src = (const float*)a.in[I_CNSA] + (size_t)page * 128 * 512;
        bf16_t* dst = (bf16_t*)(ws + WS_KCRAW) + KCS_OFF;
        const int c = lane >> 5, g = (lane >> 4) & 1, d0 = (lane & 15) * 4;
        bf16_t* drow = dst + ((size_t)((db * 2 + c) * 2 + g) * 8192 + pj * 128) * 64 + d0;
#pragma unroll 16
        for (int s = 0; s < 128; ++s) { const f32x4 v = *(const f32x4*)(src + (size_t)s * 512 + lane * 4); *(u32x2*)(drow + (size_t)s * 64) = cvt4(v); }
        return; } r -= N_PG;
    if (r < N_PG) {
        const int db = r >> 6, pj = r & 63; const int page = ((const int*)a.in[I_PT])[db * NPAGES + pj];
        const float* src = (const float*)a.in[I_CDSA] + (size_t)page * 128 * 320 + 256;
        bf16_t* dst = (bf16_t*)(ws + WS_KIFS) + ((size_t)db * 513 + pj * 8) * 1024;
        const int sl = lane >> 4, d0 = (lane & 15) * 4;
#pragma unroll 16
        for (int i = 0; i < 32; ++i) { const int slot = 4 * i + sl; const f32x4 v = *(const f32x4*)(src + (size_t)slot * 320 + d0);
            *(u32x2*)(dst + ((size_t)(slot >> 4) * 2 + (d0 >> 5)) * 512 + (((d0 >> 3) & 3) * 16 + (slot & 15)) * 8 + ((d0 >> 2) & 1) * 4) = cvt4(v); }
        return; } r -= N_PG;
    if (r < N_BP) {
        const int kv = r >> 6, nch = (r >> 4) & 3, kch = r & 15, n = nch * 64 + lane;
        const float* pe = (const float*)a.in[I_PE] + (size_t)kv * 2048 + kch * 128; const float* w1 = (const float*)a.in[I_CW1] + ((size_t)kv * 2048 + kch * 128) * 256 + n;
        float acc = 0.f;
#pragma unroll 8
        for (int k = 0; k < 128; ++k) acc += pe[k] * w1[(size_t)k * 256];
        ((float*)(ws + WS_BPART))[(kch * 2 + kv) * 256 + n] = acc; return; } r -= N_BP;
    {
        const int db = r / 508, j = r % 508;
        const f32x4 v = *((const f32x4*)((const float*)a.in[I_SWIN] + ((size_t)db * 512 + j + 4) * 256) + lane);
        *((f32x4*)(a.out + O_WINS + ((size_t)db * 512 + j) * 256) + lane) = v; }
}
DI void phase0(const Args& a, LAS unsigned char* lds, int pm = 3, int r0 = 0, int r1 = PI_REST) {
    const int tid = threadIdx.x, lane = tid & 63, wave = __builtin_amdgcn_readfirstlane(tid >> 6);
    const int gw = blockIdx.x * NWAVES + wave, NGW = gridDim.x * NWAVES;
    LAS float* scr = (LAS float*)(lds + wave * 16384);
    unsigned char* ws = a.ws;
    if ((pm & 1) && gw < NT_ALL) {
        float va[32], vb[32]; TrItem ta = tr_decode(a, gw), tb = ta; tr_load(ta, lane, va);
#pragma unroll 1
        for (int tix = gw; tix < NT_ALL; tix += 2 * NGW) {
            const bool h1 = tix + NGW < NT_ALL; if (h1) { tb = tr_decode(a, tix + NGW); tr_load(tb, lane, vb); }
            tr_store(ta, scr, lane, va);
            if (!h1) break;
            const bool h2 = tix + 2 * NGW < NT_ALL; if (h2) { ta = tr_decode(a, tix + 2 * NGW); tr_load(ta, lane, va); }
            tr_store(tb, scr, lane, vb);
        }
    }
    if (pm & 2) {
#pragma unroll 1
        for (int it = r0 + gw; it < r1; it += NGW) prologue_item(a, scr, lane, it); }
    { const size_t gt = (size_t)blockIdx.x * NTHR + tid, NG = (size_t)gridDim.x * NTHR; const u32x4 z = (u32x4){0u, 0u, 0u, 0u};
      u32x4* p1 = (u32x4*)((bf16_t*)(ws + WS_BT_IN) + (size_t)DIN * DM); u32x4* p2 = (u32x4*)((bf16_t*)(ws + WS_XN) + (size_t)TT * DM);
      for (size_t i = gt; i < (size_t)128 * DM / 8; i += NG) { p1[i] = z; p2[i] = z; }
      float* ss = (float*)(ws + WS_SS); for (size_t i = gt; i < (size_t)2 * TP; i += NG) ss[i] = 0.f; }
}

DI f32x4 rope4(f32x4 v, f32x4 pv, int d0, int half, int tb, float cv, float sv) {
    const int fi = tb + (d0 & (half - 1));
    f32x4 c, s;
    c.x = __shfl(cv, fi); c.y = __shfl(cv, fi + 1); c.z = __shfl(cv, fi + 2); c.w = __shfl(cv, fi + 3);
    s.x = __shfl(sv, fi); s.y = __shfl(sv, fi + 1); s.z = __shfl(sv, fi + 2); s.w = __shfl(sv, fi + 3);
    const f32x4 lo = v * c - pv * s, hi = v * c + pv * s;
    return d0 < half ? lo : (d0 < 2 * half ? hi : v);
}
DI f32x4 ldbf4p(const bf16_t* p) { const u32x2 w = *(const u32x2*)p; f32x4 r; r.x = __uint_as_float(w.x << 16); r.y = __uint_as_float(w.x & 0xffff0000u); r.z = __uint_as_float(w.y << 16); r.w = __uint_as_float(w.y & 0xffff0000u); return r; }
DI f32x4 sig4(f32x4 v) { f32x4 r; r.x = sigmoidf_(v.x); r.y = sigmoidf_(v.y); r.z = sigmoidf_(v.z); r.w = sigmoidf_(v.w); return r; }

DI void phase2(const Args& a, LAS unsigned char* lds) {
    const int tid = threadIdx.x, lane = tid & 63, wave = __builtin_amdgcn_readfirstlane(tid >> 6);
    const int gw = blockIdx.x * NWAVES + wave, NGW = gridDim.x * NWAVES;
    unsigned char* ws = a.ws; float* out = a.out;
    const bf16_t* P = (const bf16_t*)(ws + WS_P);
    bf16_t* QC = (bf16_t*)(ws + WS_QC); bf16_t* QR = (bf16_t*)(ws + WS_QR); bf16_t* QB = (bf16_t*)(ws + WS_QB); bf16_t* QI = (bf16_t*)(ws + WS_QI);
    float* GN = (float*)(ws + WS_GN); float* WI = (float*)(ws + WS_WI); bf16_t* GAB = (bf16_t*)(ws + WS_GAB); float* KW = (float*)(ws + WS_KW);
    bf16_t* KCP = (bf16_t*)(ws + WS_KCRAW); bf16_t* NSAF = (bf16_t*)(ws + WS_NSAF);
    if (gw == 0) {
        for (int i = lane; i < 512; i += 64) { float s = ((const float*)a.in[I_CB1])[i];
            for (int k = 0; k < 16; ++k) s += ((const float*)(ws + WS_BPART))[k * 512 + i];
            ((float*)(ws + WS_BIASC))[i] = s; }
    }
    for (int r = gw; r < TT; r += NGW) {
        const bool pr = r < TP; const int b = r >> 12, s = r & 4095, q = r - TP, db = q >> 2, tt = q & 3;
        const int pos = pr ? s : 8192 + tt;
        float cv, sv; { const float e = lane < 8 ? -(float)lane / 8.f : -(float)((lane - 8) & 15) / 16.f; const float inv = powf(500000.f, e); const float ang = (float)pos * inv; cv = cosf(ang); sv = sinf(ang); }
        const bf16_t* Pr = P + (size_t)r * DINP;
        f32x4 L_qa[4], L_kva[3], L_qb[4], L_qi[4], L_gm[16];
#pragma unroll
        for (int i = 0; i < 4; ++i) { L_qa[i] = ldbf4p(Pr + C_QA + 256 * i + 4 * lane); L_qb[i] = ldbf4p(Pr + C_QB + 256 * i + 4 * lane); L_qi[i] = ldbf4p(Pr + C_QI + 256 * i + 4 * lane); }
#pragma unroll
        for (int i = 0; i < 3; ++i) L_kva[i] = ldbf4p(Pr + C_KVA + 256 * i + 4 * lane);
#pragma unroll
        for (int i = 0; i < 16; ++i) L_gm[i] = ldbf4p(Pr + C_GM + 256 * i + 4 * lane);
        const f32x4 L_ga = lane < 12 ? ldbf4p(Pr + C_GA + 4 * lane) : (f32x4){0.f, 0.f, 0.f, 0.f};
        const f32x4 L_kvb = ldbf4p(Pr + C_KVB + 4 * lane);
        const f32x4 L_ki = lane < 16 ? ldbf4p(Pr + C_KI + 4 * lane) : (f32x4){0.f, 0.f, 0.f, 0.f};
        const f32x4 L_wi = lane < 4 ? ldbf4p(Pr + C_WI + 4 * lane) : (f32x4){0.f, 0.f, 0.f, 0.f};
#pragma unroll
        for (int i = 0; i < 4; ++i) { const int col = 256 * i + 4 * lane; const f32x4 v = L_qa[i]; const f32x4 pv = shfl_xor4(v, 2);
            const f32x4 rv = rope4(v, pv, (4 * lane) & 63, 8, 0, cv, sv);
            *(u32x2*)(QC + (size_t)r * 1024 + col) = cvt4(v); *(u32x2*)(QR + (size_t)r * 1024 + col) = cvt4(rv); }
#pragma unroll
        for (int i = 0; i < 3; ++i) { const int cl = 256 * i + 4 * lane; const f32x4 v = L_kva[i]; const f32x4 pv = shfl_xor4(v, 2);
            const int j = cl >> 7, g = (cl >> 6) & 1, d0 = cl & 63;
            const f32x4 rv = rope4(v, pv, d0, 8, 0, cv, sv); const f32x4 o = (j == 2 || j == 4) ? rv : v;
            if (pr && j >= 2) {
                bf16_t* tile = NSAF + ((size_t)((b * 2 + g) * 128 + (s >> 5)) * 4 + (j - 2)) * 2048; const int slot = s & 31;
                if ((j & 1) == 0) { *(u32x2*)(tile + (((d0 >> 5) * 2 + (slot >> 4)) * 64 + ((d0 >> 3) & 3) * 16 + (slot & 15)) * 8 + ((d0 >> 2) & 1) * 4) = cvt4(o); }
                else { const int kgv = (slot & 15) >> 2, jv = (slot & 3) + ((slot >> 4) << 2); const u32x2 w = cvt4(o);
                    bf16_t* t0 = tile + (((d0 >> 4) * 64 + kgv * 16 + (d0 & 15)) * 8) + jv;
                    t0[0] = (bf16_t)(w.x & 0xffffu); t0[8] = (bf16_t)(w.x >> 16); t0[16] = (bf16_t)(w.y & 0xffffu); t0[24] = (bf16_t)(w.y >> 16); }
            }
            if (j < 4) {
                float* dst = pr ? out + O_NSAP + ((size_t)r * 4 + j) * 128 + g * 64 + d0 : out + O_NSAS + ((size_t)q * 4 + j) * 128 + g * 64 + d0;
                *(f32x4*)dst = o;
                if (pr && j < 2) *(u32x2*)(KCP + ((size_t)((b * 2 + j) * 2 + g) * KCP_ROWS + s) * 64 + d0) = cvt4(o);
            } else {
                const int kv = j - 4;
                *(f32x4*)(KW + (size_t)r * 256 + kv * 128 + g * 64 + d0) = o;
                if (pr) { if (s >= SEQ - 512) *(f32x4*)(out + O_WINP + (((size_t)b * 512 + s - (SEQ - 512)) * 2 + kv) * 128 + g * 64 + d0) = o; }
                else *(f32x4*)(out + O_WINS + (((size_t)db * 512 + 508 + tt) * 2 + kv) * 128 + g * 64 + d0) = o;
            } }
        if (lane < 12) { const f32x4 v = L_ga; *(f32x4*)(GN + (size_t)r * 48 + 4 * lane) = sig4(v); }
#pragma unroll
        for (int i = 0; i < 4; ++i) { const int col = 256 * i + 4 * lane; const f32x4 v = L_qb[i]; const f32x4 pv = shfl_xor4(v, 4);
            const f32x4 rv = rope4(v, pv, (4 * lane) & 127, 16, 8, cv, sv);
            *(u32x2*)(QB + (size_t)r * 1024 + col) = cvt4(rv); }
        { const int cl = 4 * lane; const f32x4 v = L_kvb; const f32x4 pv = shfl_xor4(v, 4);
          const f32x4 rv = rope4(v, pv, cl & 127, 16, 8, cv, sv); const f32x4 o = cl < 128 ? rv : v;
          float* dst = pr ? out + O_DSAP + (size_t)r * 320 + cl : out + O_DSAS + (size_t)q * 320 + cl; *(f32x4*)dst = o;
          if (pr) *(u32x2*)((bf16_t*)(ws + WS_DSAB) + (size_t)r * 256 + cl) = cvt4(o); }
#pragma unroll
        for (int i = 0; i < 4; ++i) { const int col = 256 * i + 4 * lane; const f32x4 v = L_qi[i]; const f32x4 pv = shfl_xor4(v, 2);
            const f32x4 rv = rope4(v, pv, (4 * lane) & 63, 8, 0, cv, sv);
            *(u32x2*)(QI + (size_t)r * 1024 + col) = cvt4(rv); }
        { const f32x4 v = L_ki; const f32x4 pv = shfl_xor4(v, 2);
          const f32x4 rv = rope4(v, pv, (4 * lane) & 63, 8, 0, cv, sv);
          if (lane < 16) { float* dst = pr ? out + O_DSAP + (size_t)r * 320 + 256 + 4 * lane : out + O_DSAS + (size_t)q * 320 + 256 + 4 * lane; *(f32x4*)dst = rv;
              const int d0 = 4 * lane;
              if (pr) *(u32x2*)((bf16_t*)(ws + WS_KIF) + ((size_t)(b * 256 + (s >> 4)) * 2 + (d0 >> 5)) * 512 + (((d0 >> 3) & 3) * 16 + (s & 15)) * 8 + ((d0 >> 2) & 1) * 4) = cvt4(rv);
              else *(u32x2*)((bf16_t*)(ws + WS_KIFS) + ((size_t)(db * 513 + 512) * 2 + (d0 >> 5)) * 512 + (((d0 >> 3) & 3) * 16 + tt) * 8 + ((d0 >> 2) & 1) * 4) = cvt4(rv); }
          if (lane < 4) *(f32x4*)(WI + (size_t)r * 16 + 4 * lane) = L_wi; }
#pragma unroll
        for (int i = 0; i < 16; ++i) { const int col = 256 * i + 4 * lane; const f32x4 v = L_gm[i]; *(u32x2*)(GAB + (size_t)r * 4096 + col) = cvt4(sig4(v)); }
    }
}
struct P1Order { pg8::StaticOrder so;
    DI bool next(int i, pg8::Unit& u) const { const long L = (long)i * so.G + so.c; if (L < so.nwg) return so.at(L, u); const int j = (int)(L - so.nwg); if (j >= 8) return false; u.pm = j >> 2; u.pn = j & 3; u.ks = 1; return true; }
    DI size_t offA(const pg8::Unit& u) const { return (size_t)u.pm * 256 * DM * 2 + (u.ks ? (WS_MEMN - WS_XN) : 0); }
    DI size_t offB(const pg8::Unit& u) const { return (size_t)u.pn * 256 * DM * 2 + (u.ks ? (WS_BT_MKV - WS_BT_IN) : 0); }
    DI int ktiles(const pg8::Unit&, int K) const { return K; }
};
struct FP1 { bf16_t* P; float* memkv; DI void operator()(const pg8::Unit& u, int row, int col, f32x4 v) const {
    if (u.ks) *(f32x4*)(memkv + (size_t)(u.pm * 256 + row) * 1024 + u.pn * 256 + col) = v; else *(u32x2*)(P + (size_t)(u.pm * 256 + row) * DINP + u.pn * 256 + col) = cvt4(v); } };
DI void phase1(const Args& a, LAS unsigned char* lds) {
    unsigned char* ws = a.ws;
    pg8::Gemm g{(const bf16_t*)(ws + WS_XN), (const bf16_t*)(ws + WS_BT_IN), DM, DM, DM};
    P1Order S; S.so.init(MP / 256, DINP / 256, gridDim.x, blockIdx.x, DM, DM);
    pg8::EpiEach<FP1> E{FP1{(bf16_t*)(ws + WS_P), a.out + O_MEMP}};
    pg8::gemm_phase(lds, g, S, E);
}
struct CmpOrder { int G, c;
    DI bool next(int i, pg8::Unit& u) const { const int L = i * G + c; if (L >= 264) return false; u.pn = L / 132; u.pm = L % 132; u.ks = 0; return true; }
    DI size_t offA(const pg8::Unit& u) const { const int rt = u.pm, kv = u.pn; size_t e;
        if (rt < 4) { const int b = rt >> 1, g = rt & 1; e = (size_t)((b * 2 + kv) * 2 + g) * KCP_ROWS * 64; }
        else { const int s = rt - 4, db = s >> 2, g = (s >> 1) & 1, half = s & 1; e = KCS_OFF + ((size_t)((db * 2 + kv) * 2 + g) * 8192 + half * 4096) * 64; }
        return e * 2; }
    DI size_t offB(const pg8::Unit& u) const { return (size_t)u.pn * 256 * 2048 * 2; }
    DI int ktiles(const pg8::Unit&, int K) const { return K; }
};
DI float gelu_tanh(float x) { const float u = 0.7978845608028654f * (x + 0.044715f * x * x * x); const float t = 1.f - 2.f / (1.f + __expf(2.f * u)); return 0.5f * x * (1.f + t); }
struct FCmpH { const float* biasc; bf16_t* HC;
    DI void operator()(const pg8::Unit& u, int row, int col, f32x4 v) const { const f32x4 bb = *(const f32x4*)(biasc + u.pn * 256 + col); f32x4 x = v + bb;
        x.x = gelu_tanh(x.x); x.y = gelu_tanh(x.y); x.z = gelu_tanh(x.z); x.w = gelu_tanh(x.w);
        *(u32x2*)(HC + ((size_t)(u.pn * 132 + u.pm) * 256 + row) * 256 + col) = cvt4(x); } };
DI void phase3(const Args& a, LAS unsigned char* lds) {
    unsigned char* ws = a.ws;
    pg8::Gemm g{(const bf16_t*)(ws + WS_KCRAW), (const bf16_t*)(ws + WS_BT_C1), 1024, 2048, 2048};
    CmpOrder S{(int)gridDim.x, (int)blockIdx.x};
    pg8::EpiEach<FCmpH> E{FCmpH{(const float*)(ws + WS_BIASC), (bf16_t*)(ws + WS_HC)}};
    pg8::gemm_phase(lds, g, S, E);
}
DI void phase4(const Args& a, LAS unsigned char* lds) {
    const int tid = threadIdx.x, lane = tid & 63, wave = __builtin_amdgcn_readfirstlane(tid >> 6);
    const int gw = blockIdx.x * NWAVES + wave, NGW = gridDim.x * NWAVES;
    unsigned char* ws = a.ws;
    LAS bf16_t* W2T = (LAS bf16_t*)lds;
    const float* w2 = (const float*)a.in[I_CW2];
    for (int idx = tid; idx < 2 * 256 * 64; idx += NTHR) { const int kv = idx >> 14, k = (idx >> 6) & 255, n = idx & 63; W2T[(kv * 64 + n) * 264 + k] = (bf16_t)(cvt_pk_bf16(w2[idx], 0.f) & 0xffffu); }
    __syncthreads();
    const bf16_t* HC = (const bf16_t*)(ws + WS_HC); bf16_t* KCF = (bf16_t*)(ws + WS_KCF);
    const int kg = lane >> 4, c16 = lane & 15;
    constexpr int NIT = 2 * HC_ROWS / 16;
    for (int it = gw; it < NIT; it += NGW) {
        const int kv = it / (HC_ROWS / 16), row0 = (it % (HC_ROWS / 16)) * 16;
        f32x4 acc[4];
#pragma unroll
        for (int nt = 0; nt < 4; ++nt) acc[nt] = (f32x4){0.f, 0.f, 0.f, 0.f};
#pragma unroll
        for (int ks = 0; ks < 8; ++ks) {
            const bf16x8 bfr = *(const bf16x8*)(HC + ((size_t)kv * HC_ROWS + row0 + c16) * 256 + 32 * ks + 8 * kg);
#pragma unroll
            for (int nt = 0; nt < 4; ++nt) { const bf16x8 afr = *(const LAS bf16x8*)(W2T + (kv * 64 + 16 * nt + c16) * 264 + 32 * ks + 8 * kg); acc[nt] = MFMA16(afr, bfr, acc[nt]); }
        }
        const int R = row0 + c16, rt = R >> 8, iin = R & 255; int seq, g, blk;
        if (rt < 4) { seq = rt >> 1; g = rt & 1; blk = iin; } else { const int s = rt - 4; seq = 2 + (s >> 2); g = (s >> 1) & 1; blk = (s & 1) * 256 + iin; }
        bf16_t* tile = KCF + ((size_t)(seq * 2 + g) * 16 + (blk >> 5)) * 4096; const int slot = blk & 31;
        if (kv == 0) {
#pragma unroll
            for (int nt = 0; nt < 4; ++nt) { const int d0 = 16 * nt + 4 * kg; *(u32x2*)(tile + (((d0 >> 5) * 2 + (slot >> 4)) * 64 + ((d0 >> 3) & 3) * 16 + (slot & 15)) * 8 + ((d0 >> 2) & 1) * 4) = cvt4(acc[nt]); }
        } else {
            const int kgv = (slot & 15) >> 2, jv = (slot & 3) + ((slot >> 4) << 2);
#pragma unroll
            for (int nt = 0; nt < 4; ++nt) { const u32x2 w = cvt4(acc[nt]); bf16_t* t0 = tile + 2048 + ((nt * 64 + kgv * 16 + 4 * kg) * 8) + jv;
                t0[0] = (bf16_t)(w.x & 0xffffu); t0[8] = (bf16_t)(w.x >> 16); t0[16] = (bf16_t)(w.y & 0xffffu); t0[24] = (bf16_t)(w.y >> 16); }
        }
    }
}

struct RowInfo { bool pr; int b, db, pos, seq; };
DI RowInfo rowinfo(int r) { RowInfo ri; ri.pr = r < TP; const int q = r - TP; ri.b = r >> 12; ri.db = q >> 2; ri.pos = ri.pr ? (r & 4095) : 8192 + (q & 3); ri.seq = ri.pr ? ri.b : 2 + ri.db; return ri; }
DI float xmax16(float x) { const auto r = __builtin_amdgcn_permlane16_swap(__float_as_uint(x), __float_as_uint(x), false, false); return fmaxf(__uint_as_float(r[0]), __uint_as_float(r[1])); }
DI float xmax32(float x) { const auto r = __builtin_amdgcn_permlane32_swap(__float_as_uint(x), __float_as_uint(x), false, false); return fmaxf(__uint_as_float(r[0]), __uint_as_float(r[1])); }
DI float xsum16(float x) { const auto r = __builtin_amdgcn_permlane16_swap(__float_as_uint(x), __float_as_uint(x), false, false); return __uint_as_float(r[0]) + __uint_as_float(r[1]); }
DI float xsum32(float x) { const auto r = __builtin_amdgcn_permlane32_swap(__float_as_uint(x), __float_as_uint(x), false, false); return __uint_as_float(r[0]) + __uint_as_float(r[1]); }
template <int CTRL> DI float dppf(float x) { return __int_as_float(__builtin_amdgcn_update_dpp(0, __float_as_int(x), CTRL, 0xF, 0xF, true)); }
DI float sum8(float x) { x += dppf<0xB1>(x); x += dppf<0x4E>(x); x += dppf<0x141>(x); return x; }
DI float sum16r(float x) { x = sum8(x); x += dppf<0x140>(x); return x; }
DI int q_next(unsigned* ctr, int lane) { int v = 0; if (lane == 0) v = (int)__hip_atomic_fetch_add(ctr, 1u, __ATOMIC_RELAXED, __HIP_MEMORY_SCOPE_AGENT); return __builtin_amdgcn_readfirstlane(v); }

template <int D> struct Flash { f32x4 o[D / 16]; float m, l; };
template <int D> DI void flash_init(Flash<D>& f) {
#pragma unroll
    for (int i = 0; i < D / 16; ++i) f.o[i] = (f32x4){0.f, 0.f, 0.f, 0.f};
    f.m = -INFINITY; f.l = 0.f; }
template <int D> DI float flash_linv(const Flash<D>& f) { return 1.f / fmaxf(xsum32(xsum16(f.l)), 1e-30f); }
DI bf16x8 ldk8(const float* p) { return cvt8(*(const f32x4*)p, *(const f32x4*)(p + 4)); }
DI int kslot(int kg, int j) { return j < 4 ? 4 * kg + j : 16 + 4 * kg + (j - 4); }
constexpr float LOG2E = 1.4426950408889634f;
DI float max8(const float (&v)[8]) { return fmaxf(fmaxf(fmaxf(v[0], v[1]), fmaxf(v[2], v[3])), fmaxf(fmaxf(v[4], v[5]), fmaxf(v[6], v[7]))); }
template <int D> DI void flash_rebase(Flash<D>& f, float mx) {
    mx = xmax32(xmax16(mx));
    const float mnew = fmaxf(f.m, mx), msafe = (mnew == -INFINITY) ? 0.f : mnew, alpha = __builtin_amdgcn_exp2f(f.m - msafe);
    f.l *= alpha; f.m = mnew;
#pragma unroll
    for (int dt = 0; dt < D / 16; ++dt) f.o[dt] *= alpha;
}
DI bf16x8 pack_p(const float (&p)[8]) { u32x4 w; w.x = cvt_pk_bf16(p[0], p[1]); w.y = cvt_pk_bf16(p[2], p[3]); w.z = cvt_pk_bf16(p[4], p[5]); w.w = cvt_pk_bf16(p[6], p[7]); return __builtin_bit_cast(bf16x8, w); }
template <int D> DI bf16x8 flash_update(Flash<D>& f, const float (&t)[8]) {
    const float mx = max8(t);
    if (!__all(mx <= f.m + 11.5f)) flash_rebase<D>(f, mx);
    const float mref = (f.m == -INFINITY) ? 0.f : f.m;
    float p[8], sum = 0.f;
#pragma unroll
    for (int e = 0; e < 8; ++e) { p[e] = __builtin_amdgcn_exp2f(t[e] - mref); sum += p[e]; }
    f.l += sum;
    return pack_p(p);
}
template <int D> DI bf16x8 flash_update_full(Flash<D>& f, const f32x4& s0, const f32x4& s1, float c) {
    const float r[8] = {s0[0], s0[1], s0[2], s0[3], s1[0], s1[1], s1[2], s1[3]};
    const float mx = max8(r) * c;
    if (!__all(mx <= f.m + 11.5f)) flash_rebase<D>(f, mx);
    const float nm = -f.m;
    float p[8], sum = 0.f;
#pragma unroll
    for (int e = 0; e < 8; ++e) { p[e] = __builtin_amdgcn_exp2f(fmaf(r[e], c, nm)); sum += p[e]; }
    f.l += sum;
    return pack_p(p);
}
template <int D> DI void flash_step(Flash<D>& f, const bf16x8 (&qf)[D / 32], const float* kp0, const float* kp1, const float* const (&vp)[8], unsigned okm, float c, int lane) {
    const int kg = lane >> 4, c16 = lane & 15;
    f32x4 s0 = (f32x4){0.f, 0.f, 0.f, 0.f}, s1 = s0;
#pragma unroll
    for (int ks = 0; ks < D / 32; ++ks) { const bf16x8 a0 = ldk8(kp0 + 32 * ks + 8 * kg), a1 = ldk8(kp1 + 32 * ks + 8 * kg); s0 = MFMA16(a0, qf[ks], s0); s1 = MFMA16(a1, qf[ks], s1); }
    float v[8];
#pragma unroll
    for (int j = 0; j < 4; ++j) { v[j] = ((okm >> j) & 1u) ? s0[j] * c : -INFINITY; v[4 + j] = ((okm >> (4 + j)) & 1u) ? s1[j] * c : -INFINITY; }
    const bf16x8 pb = flash_update<D>(f, v);
#pragma unroll
    for (int dt = 0; dt < D / 16; ++dt) {
        float x[8];
#pragma unroll
        for (int j = 0; j < 8; ++j) x[j] = vp[j][16 * dt + c16];
        u32x4 aw; aw.x = cvt_pk_bf16(x[0], x[1]); aw.y = cvt_pk_bf16(x[2], x[3]); aw.z = cvt_pk_bf16(x[4], x[5]); aw.w = cvt_pk_bf16(x[6], x[7]);
        f.o[dt] = MFMA16(__builtin_bit_cast(bf16x8, aw), pb, f.o[dt]);
    }
}
struct Tile64 { bf16x8 k[4]; bf16x8 v[4]; };
DI void load_tile64(Tile64& t, const bf16_t* kt, const bf16_t* vt, int lane) {
#pragma unroll
    for (int i = 0; i < 4; ++i) t.k[i] = *(const bf16x8*)(kt + (i * 64 + lane) * 8);
#pragma unroll
    for (int i = 0; i < 4; ++i) t.v[i] = *(const bf16x8*)(vt + (i * 64 + lane) * 8);
}
DI void flash_tile64(Flash<64>& f, const bf16x8 (&qf)[2], const Tile64& t, bool full, unsigned okm, float c) {
    f32x4 s0 = (f32x4){0.f, 0.f, 0.f, 0.f}, s1 = s0;
#pragma unroll
    for (int ks = 0; ks < 2; ++ks) { s0 = MFMA16(t.k[ks * 2], qf[ks], s0); s1 = MFMA16(t.k[ks * 2 + 1], qf[ks], s1); }
    bf16x8 pb;
    if (full) pb = flash_update_full<64>(f, s0, s1, c);
    else { float v[8];
#pragma unroll
        for (int j = 0; j < 4; ++j) { v[j] = ((okm >> j) & 1u) ? s0[j] * c : -INFINITY; v[4 + j] = ((okm >> (4 + j)) & 1u) ? s1[j] * c : -INFINITY; }
        pb = flash_update<64>(f, v); }
#pragma unroll
    for (int dt = 0; dt < 4; ++dt) f.o[dt] = MFMA16(t.v[dt], pb, f.o[dt]);
}

template <int OFF> DI void tr_read4(unsigned alo, unsigned ahi, u32x2 (&l)[4], u32x2 (&h)[4]) {
    asm volatile("ds_read_b64_tr_b16 %0, %8 offset:%10\n\tds_read_b64_tr_b16 %1, %9 offset:%10\n\tds_read_b64_tr_b16 %2, %8 offset:%11\n\tds_read_b64_tr_b16 %3, %9 offset:%11\n\t"
                 "ds_read_b64_tr_b16 %4, %8 offset:%12\n\tds_read_b64_tr_b16 %5, %9 offset:%12\n\tds_read_b64_tr_b16 %6, %8 offset:%13\n\tds_read_b64_tr_b16 %7, %9 offset:%13\n\ts_waitcnt lgkmcnt(0)"
                 : "=&v"(l[0]), "=&v"(h[0]), "=&v"(l[1]), "=&v"(h[1]), "=&v"(l[2]), "=&v"(h[2]), "=&v"(l[3]), "=&v"(h[3])
                 : "v"(alo), "v"(ahi), "i"(OFF), "i"(OFF + 32), "i"(OFF + 64), "i"(OFF + 96) : "memory");
}
template <int D> DI void lds_step(Flash<D>& f, const bf16x8 (&qf)[D / 32], LAS unsigned char* wl, unsigned okm, float c, int lane) {
    constexpr int P = 4 * D + 16;
    const int kg = lane >> 4, c16 = lane & 15;
    f32x4 s0 = (f32x4){0.f, 0.f, 0.f, 0.f}, s1 = s0;
#pragma unroll
    for (int ks = 0; ks < D / 32; ++ks) { const bf16x8 a0 = *(const LAS bf16x8*)(wl + c16 * P + (32 * ks + 8 * kg) * 2), a1 = *(const LAS bf16x8*)(wl + (16 + c16) * P + (32 * ks + 8 * kg) * 2);
        s0 = MFMA16(a0, qf[ks], s0); s1 = MFMA16(a1, qf[ks], s1); }
    float v[8];
#pragma unroll
    for (int j = 0; j < 4; ++j) { v[j] = ((okm >> j) & 1u) ? s0[j] * c : -INFINITY; v[4 + j] = ((okm >> (4 + j)) & 1u) ? s1[j] * c : -INFINITY; }
    const bf16x8 pb = flash_update<D>(f, v);
    const unsigned alo = (unsigned)(__SIZE_TYPE__)wl + (unsigned)((4 * kg + (c16 >> 2)) * P + 2 * D + 8 * (c16 & 3)), ahi = alo + 16u * P;
    { u32x2 vl[4], vh[4]; tr_read4<0>(alo, ahi, vl, vh);
#pragma unroll
      for (int dt = 0; dt < 4; ++dt) { u32x4 aw; aw.x = vl[dt].x; aw.y = vl[dt].y; aw.z = vh[dt].x; aw.w = vh[dt].y; f.o[dt] = MFMA16(__builtin_bit_cast(bf16x8, aw), pb, f.o[dt]); } }
    if constexpr (D == 128) { u32x2 vl[4], vh[4]; tr_read4<128>(alo, ahi, vl, vh);
#pragma unroll
      for (int dt = 0; dt < 4; ++dt) { u32x4 aw; aw.x = vl[dt].x; aw.y = vl[dt].y; aw.z = vh[dt].x; aw.w = vh[dt].y; f.o[4 + dt] = MFMA16(__builtin_bit_cast(bf16x8, aw), pb, f.o[4 + dt]); } }
}
DI void st128(LAS unsigned char* wl, const f32x4 (&rg)[32], int lane) {
#pragma unroll
    for (int i = 0; i < 32; ++i) *(LAS u32x2*)(wl + i * 528 + (lane >> 5) * 256 + (lane & 31) * 8) = cvt4(rg[i]);
}
DI void st64(LAS unsigned char* wl, const f32x4 (&rg)[16], int lane) {
#pragma unroll
    for (int j = 0; j < 16; ++j) *(LAS u32x2*)(wl + (2 * j + (lane >> 5)) * 272 + ((lane >> 4) & 1) * 128 + (lane & 15) * 8) = cvt4(rg[j]);
}

DI void cmp_item(const Args& a, LAS unsigned char* wl, int seq, int r0, int pos0, int g, int lane) {
    unsigned char* ws = a.ws;
    LAS float* imp = (LAS float*)wl; LAS float* scv = imp + 1040;
    const int kg = lane >> 4, c16 = lane & 15, tl = c16 >> 3, hh = c16 & 7;
    const int myrow = r0 + tl, qpos = pos0 + tl, head = g * 8 + hh;
    const bf16_t* QC = (const bf16_t*)(ws + WS_QC);
    bf16x8 qf[2];
#pragma unroll
    for (int ks = 0; ks < 2; ++ks) qf[ks] = *(const bf16x8*)(QC + (size_t)myrow * 1024 + head * 64 + 32 * ks + 8 * kg);
    const bf16_t* tb = (const bf16_t*)(ws + WS_KCF) + (size_t)(seq * 2 + g) * 16 * 4096;
    const int qlast = pos0 + 1, NV = qlast >= 31 ? ((qlast - 31) >> 4) + 1 : 0, nsteps = (NV + 31) >> 5;
    for (int i = lane; i < 1040; i += 64) imp[i] = 0.f;
    float m = -INFINITY, l = 0.f;
    { bf16x8 kc[4], kn[4];
#pragma unroll
      for (int i = 0; i < 4; ++i) { kc[i] = *(const bf16x8*)(tb + (i * 64 + lane) * 8); kn[i] = kc[i]; }
      for (int st = 0; st < nsteps; ++st) {
          if (st + 1 < nsteps) {
#pragma unroll
              for (int i = 0; i < 4; ++i) kn[i] = *(const bf16x8*)(tb + (size_t)(st + 1) * 4096 + (i * 64 + lane) * 8); }
          f32x4 s0 = (f32x4){0.f, 0.f, 0.f, 0.f}, s1 = s0;
#pragma unroll
          for (int ks = 0; ks < 2; ++ks) { s0 = MFMA16(kc[ks * 2], qf[ks], s0); s1 = MFMA16(kc[ks * 2 + 1], qf[ks], s1); }
          float v[8];
#pragma unroll
          for (int j = 0; j < 4; ++j) { const int n = 32 * st + 4 * kg + j; v[j] = (16 * n + 31 <= qpos) ? s0[j] * 0.125f : -INFINITY; v[4 + j] = (16 * (n + 16) + 31 <= qpos) ? s1[j] * 0.125f : -INFINITY; }
          float mx = fmaxf(fmaxf(fmaxf(v[0], v[1]), fmaxf(v[2], v[3])), fmaxf(fmaxf(v[4], v[5]), fmaxf(v[6], v[7])));
          if (!__all(mx <= m + 8.f)) { mx = xmax32(xmax16(mx)); const float mnew = fmaxf(m, mx), msafe = (mnew == -INFINITY) ? 0.f : mnew; l *= __expf(m - msafe); m = mnew; }
          const float mref = (m == -INFINITY) ? 0.f : m;
#pragma unroll
          for (int e = 0; e < 8; ++e) l += __expf(v[e] - mref);
#pragma unroll
          for (int i = 0; i < 4; ++i) kc[i] = kn[i];
      } }
    const float msafe = (m == -INFINITY) ? 0.f : m, linv = 1.f / fmaxf(xsum32(xsum16(l)), 1e-30f);
    f32x4 o[4];
#pragma unroll
    for (int dt = 0; dt < 4; ++dt) o[dt] = (f32x4){0.f, 0.f, 0.f, 0.f};
    { Tile64 tc, tn;
      if (nsteps) load_tile64(tc, tb, tb + 2048, lane);
      for (int st = 0; st < nsteps; ++st) {
          if (st + 1 < nsteps) load_tile64(tn, tb + (size_t)(st + 1) * 4096, tb + (size_t)(st + 1) * 4096 + 2048, lane);
          f32x4 s0 = (f32x4){0.f, 0.f, 0.f, 0.f}, s1 = s0;
#pragma unroll
          for (int ks = 0; ks < 2; ++ks) { s0 = MFMA16(tc.k[ks * 2], qf[ks], s0); s1 = MFMA16(tc.k[ks * 2 + 1], qf[ks], s1); }
          float p[8];
#pragma unroll
          for (int j = 0; j < 4; ++j) { const int n = 32 * st + 4 * kg + j;
              p[j] = (16 * n + 31 <= qpos) ? __expf(s0[j] * 0.125f - msafe) * linv : 0.f; p[4 + j] = (16 * (n + 16) + 31 <= qpos) ? __expf(s1[j] * 0.125f - msafe) * linv : 0.f; }
#pragma unroll
          for (int e = 0; e < 8; ++e) { const float t = sum8(p[e]); if (hh == 0) imp[tl * 520 + 32 * st + kslot(kg, e)] = t; }
          const bf16x8 pb = pack_p(p);
#pragma unroll
          for (int dt = 0; dt < 4; ++dt) o[dt] = MFMA16(tc.v[dt], pb, o[dt]);
          if (st + 1 < nsteps) tc = tn;
      } }
    float* OC = (float*)(ws + WS_OCMP) + (size_t)myrow * 1024 + head * 64 + 4 * kg;
#pragma unroll
    for (int dt = 0; dt < 4; ++dt) *(f32x4*)(OC + 16 * dt) = o[dt];
    LDS_WAIT();
    int* SEL = (int*)(ws + WS_SEL);
    for (int t2 = 0; t2 < 2; ++t2) {
        const int qp = pos0 + t2, cur = qp >> 6, nsb = cur + 1;
        int* selp = SEL + ((size_t)(r0 + t2) * 2 + g) * 16;
        if (nsb <= 16) { if (lane < 16) selp[lane] = lane < nsb ? lane : -1; }
        else {
            const LAS float* im = imp + t2 * 520;
            for (int j = lane; j < nsb; j += 64) { const float sc = (im[4 * j] + im[4 * j + 1]) + (im[4 * j + 2] + im[4 * j + 3]) + (j ? im[4 * j - 1] : 0.f);
                scv[j] = (j == 0 || j == cur || j == cur - 1) ? INFINITY : sc; }
            LDS_WAIT();
            for (int j = lane; j < nsb; j += 64) { const float vj = scv[j]; int rank = 0;
                for (int k = 0; k < nsb; ++k) { const float vk = scv[k]; rank += (vk > vj || (vk == vj && k < j)) ? 1 : 0; }
                if (rank < 16) selp[rank] = j; }
            LDS_WAIT();
        }
    }
}

DI const float* dsa_ptr(const Args& a, const RowInfo& ri, int idx) {
    if (ri.pr) return a.out + O_DSAP + ((size_t)ri.b * 4096 + idx) * 320;
    if (idx < 8192) return (const float*)a.in[I_CDSA] + ((size_t)((const int*)a.in[I_PT])[ri.db * NPAGES + (idx >> 7)] * 128 + (idx & 127)) * 320;
    return a.out + O_DSAS + ((size_t)ri.db * 4 + idx - 8192) * 320;
}
DI unsigned sortable(float x) { const unsigned u = __float_as_uint(x); return (u & 0x80000000u) ? ~u : (u | 0x80000000u); }
DI void idx_item_block(const Args& a, LAS unsigned char* lds, int r) {
    const int tid = threadIdx.x, lane = tid & 63, wave = __builtin_amdgcn_readfirstlane(tid >> 6);
    unsigned char* ws = a.ws;
    LAS unsigned* sc = (LAS unsigned*)lds; LAS unsigned* hist = sc + 8200; LAS unsigned* misc = hist + 256; LAS unsigned* wc = misc + 16;
    const RowInfo ri = rowinfo(r); const int n = ri.pos + 1;
    int* idxp = (int*)(ws + WS_IDX) + (size_t)r * 256;
    const int kg = lane >> 4, c16 = lane & 15;
    { const bf16_t* QI = (const bf16_t*)(ws + WS_QI); bf16x8 qa[2];
#pragma unroll
      for (int ks = 0; ks < 2; ++ks) qa[ks] = *(const bf16x8*)(QI + (size_t)r * 1024 + c16 * 64 + 32 * ks + 8 * kg);
      const f32x4 w4 = *(const f32x4*)((const float*)(ws + WS_WI) + (size_t)r * 16 + 4 * kg) * 0.03125f;
      const bf16_t* kb = (const bf16_t*)(ws + WS_KIFS) + (size_t)ri.db * 513 * 1024 + lane * 8;
      const int ntile = (n + 15) >> 4;
      constexpr int GT = 8;
      for (int T0 = wave; T0 < ntile; T0 += NWAVES * GT) {
          bf16x8 gk[GT][2];
#pragma unroll
          for (int i = 0; i < GT; ++i) { const int Tn = min(T0 + NWAVES * i, ntile - 1); gk[i][0] = *(const bf16x8*)(kb + (size_t)Tn * 1024); gk[i][1] = *(const bf16x8*)(kb + (size_t)Tn * 1024 + 512); }
#pragma unroll
          for (int i = 0; i < GT; ++i) { const int T = T0 + NWAVES * i; if (T < ntile) {
              f32x4 d = (f32x4){0.f, 0.f, 0.f, 0.f}; d = MFMA16(qa[0], gk[i][0], d); d = MFMA16(qa[1], gk[i][1], d);
              float x = (fmaxf(d[0], 0.f) * w4[0] + fmaxf(d[1], 0.f) * w4[1]) + (fmaxf(d[2], 0.f) * w4[2] + fmaxf(d[3], 0.f) * w4[3]);
              x = xsum32(xsum16(x)); const int key = 16 * T + c16; if (kg == 0 && key < n) sc[key] = sortable(x); } }
      } }
    __syncthreads();
    unsigned prefix = 0u, mask = 0u; int need = 256;
    for (int pass = 0; pass < 4; ++pass) { const int shift = 24 - 8 * pass;
        if (tid < 256) hist[tid] = 0u;
        __syncthreads();
        for (int i = tid; i < n; i += NTHR) { const unsigned u = sc[i]; if ((u & mask) == prefix) __hip_atomic_fetch_add(&hist[(u >> shift) & 255u], 1u, __ATOMIC_RELAXED, __HIP_MEMORY_SCOPE_WORKGROUP); }
        __syncthreads();
        if (wave == 0) { const int h0 = hist[4 * lane], h1 = hist[4 * lane + 1], h2 = hist[4 * lane + 2], h3 = hist[4 * lane + 3]; const int ls = h0 + h1 + h2 + h3; int suf = ls;
#pragma unroll
            for (int o = 1; o < 64; o <<= 1) { const int t = __shfl_down(suf, o); if (lane + o < 64) suf += t; }
            int above = suf - ls;
            if (above < need && need <= above + h3) { misc[0] = 4 * lane + 3; misc[1] = need - above; } above += h3;
            if (above < need && need <= above + h2) { misc[0] = 4 * lane + 2; misc[1] = need - above; } above += h2;
            if (above < need && need <= above + h1) { misc[0] = 4 * lane + 1; misc[1] = need - above; } above += h1;
            if (above < need && need <= above + h0) { misc[0] = 4 * lane + 0; misc[1] = need - above; } }
        __syncthreads();
        const unsigned bin = misc[0]; need = (int)misc[1]; prefix |= bin << shift; mask |= 0xFFu << shift;
    }
    const unsigned thr = prefix; const int need_eq = need; int run_gt = 0, run_eq = 0;
    for (int base = 0; base < n; base += NTHR) {
        const int i = base + tid; const unsigned u = i < n ? sc[i] : 0u; const bool gt = i < n && u > thr, eq = i < n && u == thr;
        const unsigned long long bg = __ballot(gt), be = __ballot(eq);
        if (lane == 0) { wc[wave * 2] = (unsigned)__popcll(bg); wc[wave * 2 + 1] = (unsigned)__popcll(be); }
        __syncthreads();
        int pg = 0, pe = 0, tg = 0, te = 0;
#pragma unroll
        for (int w = 0; w < NWAVES; ++w) { const int cg = (int)wc[2 * w], ce = (int)wc[2 * w + 1]; if (w < wave) { pg += cg; pe += ce; } tg += cg; te += ce; }
        const unsigned long long lm = (1ull << lane) - 1ull;
        const int gb = run_gt + pg + __popcll(bg & lm), eb = run_eq + pe + __popcll(be & lm);
        const int opos = gb + min(eb, need_eq);
        if ((gt || (eq && eb < need_eq)) && opos < 256) idxp[opos] = i;
        run_gt += tg; run_eq += te;
        __syncthreads();
    }
}
DI void idx_item_wave(const Args& a, LAS unsigned char* wl, int r, int lane) {
    unsigned char* ws = a.ws;
    LAS unsigned* sc = (LAS unsigned*)wl; LAS unsigned* hist = sc + 4096;
    const int b = r >> 12, s = r & 4095, n = s + 1;
    int* idxp = (int*)(ws + WS_IDX) + (size_t)r * 256;
    if (n <= 256) { for (int i = lane; i < 256; i += 64) idxp[i] = i < n ? i : -1; return; }
    const int kg = lane >> 4, c16 = lane & 15;
#pragma unroll
    for (int q = 0; q < 4; ++q) hist[lane + 64 * q] = 0u;
    LDS_WAIT();
    { const bf16_t* QI = (const bf16_t*)(ws + WS_QI); bf16x8 qa[2];
#pragma unroll
      for (int ks = 0; ks < 2; ++ks) qa[ks] = *(const bf16x8*)(QI + (size_t)r * 1024 + c16 * 64 + 32 * ks + 8 * kg);
      const f32x4 w4 = *(const f32x4*)((const float*)(ws + WS_WI) + (size_t)r * 16 + 4 * kg) * 0.03125f;
      const bf16_t* kb = (const bf16_t*)(ws + WS_KIF) + (size_t)b * 256 * 1024 + lane * 8;
      const int ntile = (n + 15) >> 4;
      constexpr int GT = 8;
      bf16x8 ga[GT][2], gb[GT][2];
#define IDX_LOAD(G, T0_) { _Pragma("unroll") for (int i = 0; i < GT; ++i) { const int Tn = min((T0_) + i, ntile - 1); G[i][0] = *(const bf16x8*)(kb + (size_t)Tn * 1024); G[i][1] = *(const bf16x8*)(kb + (size_t)Tn * 1024 + 512); } }
#define IDX_COMP(G, T0_) { _Pragma("unroll") for (int i = 0; i < GT; ++i) { const int T = (T0_) + i; if (T < ntile) { \
          f32x4 d = (f32x4){0.f, 0.f, 0.f, 0.f}; d = MFMA16(qa[0], G[i][0], d); d = MFMA16(qa[1], G[i][1], d); \
          float x = (fmaxf(d[0], 0.f) * w4[0] + fmaxf(d[1], 0.f) * w4[1]) + (fmaxf(d[2], 0.f) * w4[2] + fmaxf(d[3], 0.f) * w4[3]); \
          x = xsum32(xsum16(x)); const int key = 16 * T + c16; \
          if (kg == 0 && key < n) { const unsigned u = sortable(x); sc[key] = u; __hip_atomic_fetch_add(&hist[u >> 24], 1u, __ATOMIC_RELAXED, __HIP_MEMORY_SCOPE_WAVEFRONT); } } } }
      IDX_LOAD(ga, 0)
      for (int T0 = 0; T0 < ntile; T0 += 2 * GT) {
          IDX_LOAD(gb, T0 + GT) IDX_COMP(ga, T0)
          if (T0 + GT >= ntile) break;
          IDX_LOAD(ga, T0 + 2 * GT) IDX_COMP(gb, T0 + GT)
      }
#undef IDX_LOAD
#undef IDX_COMP
    }
    LDS_WAIT();
    const int n4 = (n + 3) >> 2;
    unsigned prefix = 0u, mask = 0u; int need = 256;
    for (int pass = 0; pass < 4; ++pass) { const int shift = 24 - 8 * pass;
        if (pass) {
#pragma unroll
            for (int q = 0; q < 4; ++q) hist[lane + 64 * q] = 0u;
            LDS_WAIT();
            for (int g = lane; g < n4; g += 64) { const u32x4 u4 = ((const LAS u32x4*)sc)[g];
#pragma unroll
                for (int e = 0; e < 4; ++e) { const unsigned u = u4[e]; if (4 * g + e < n && (u & mask) == prefix) __hip_atomic_fetch_add(&hist[(u >> shift) & 255u], 1u, __ATOMIC_RELAXED, __HIP_MEMORY_SCOPE_WAVEFRONT); } }
            LDS_WAIT();
        }
        const int h0 = hist[4 * lane], h1 = hist[4 * lane + 1], h2 = hist[4 * lane + 2], h3 = hist[4 * lane + 3]; const int ls = h0 + h1 + h2 + h3; int suf = ls;
#pragma unroll
        for (int o = 1; o < 64; o <<= 1) { const int t = __shfl_down(suf, o); if (lane + o < 64) suf += t; }
        int above = suf - ls, fb = -1, fn = 0;
        if (above < need && need <= above + h3) { fb = 4 * lane + 3; fn = need - above; } above += h3;
        if (above < need && need <= above + h2) { fb = 4 * lane + 2; fn = need - above; } above += h2;
        if (above < need && need <= above + h1) { fb = 4 * lane + 1; fn = need - above; } above += h1;
        if (above < need && need <= above + h0) { fb = 4 * lane + 0; fn = need - above; }
        const unsigned long long fm = __ballot(fb >= 0); const int src = fm ? __builtin_ctzll(fm) : 0;
        const unsigned bin = (unsigned)__builtin_amdgcn_readlane(fb, src); need = __builtin_amdgcn_readlane(fn, src);
        prefix |= bin << shift; mask |= 0xFFu << shift;
        LDS_WAIT();
    }
    const unsigned thr = prefix; const int need_eq = need; int run_gt = 0, run_eq = 0;
    const unsigned long long lm = (1ull << lane) - 1ull;
    for (int g0 = 0; g0 < n4; g0 += 64) {
        const int g = g0 + lane; u32x4 u4 = (u32x4){0u, 0u, 0u, 0u}; if (g < n4) u4 = ((const LAS u32x4*)sc)[g];
        bool gt[4], eq[4]; int pg = 0, pe = 0, tg = 0, te = 0;
#pragma unroll
        for (int e = 0; e < 4; ++e) { const bool in = 4 * g + e < n; gt[e] = in && u4[e] > thr; eq[e] = in && u4[e] == thr;
            const unsigned long long bg = __ballot(gt[e]), be = __ballot(eq[e]); pg += __popcll(bg & lm); pe += __popcll(be & lm); tg += __popcll(bg); te += __popcll(be); }
        int gb = run_gt + pg, eb = run_eq + pe;
#pragma unroll
        for (int e = 0; e < 4; ++e) { const int opos = gb + min(eb, need_eq); if ((gt[e] || (eq[e] && eb < need_eq)) && opos < 256) idxp[opos] = 4 * g + e; gb += gt[e] ? 1 : 0; eb += eq[e] ? 1 : 0; }
        run_gt += tg; run_eq += te;
    }
    LDS_WAIT();
}

constexpr int CW_Q0 = 8192;
DI void phase5(const Args& a, LAS unsigned char* lds, int qb = 0, int pm = 7) {
    const int tid = threadIdx.x, lane = tid & 63, wave = __builtin_amdgcn_readfirstlane(tid >> 6);
    unsigned* ctl = (unsigned*)(a.ws + WS_CTL);
    if (pm & 1) { const int bid = blockIdx.x, G = gridDim.x;
#pragma unroll 1
      for (int j = bid; j < TS; j += G) { idx_item_block(a, lds, TP + j); __syncthreads(); } }
    if (pm & 2) { LAS unsigned char* wl = lds + wave * 8192;
#pragma unroll 1
      for (;;) { const int it = q_next(ctl + CW_Q0 + qb, lane); if (it >= 128 + 8192) break;
          if (it < 128) { const int g = it & 1, db = it >> 2, tp = (it >> 1) & 1; cmp_item(a, wl, 2 + db, TP + db * 4 + 2 * tp, 8192 + 2 * tp, g, lane); }
          else { const int j = it - 128, g = j & 1, b = (j >> 1) & 1, tp = 2047 - (j >> 2); cmp_item(a, wl, b, b * 4096 + 2 * tp, 2 * tp, g, lane); } } }
    __syncthreads();
    if (pm & 4) { LAS unsigned char* wl = lds + wave * 17408;
#pragma unroll 1
      for (;;) { const int it = q_next(ctl + CW_Q0 + qb + 64, lane); if (it >= TP) break; const int b = it & 1, s = 4095 - (it >> 1); idx_item_wave(a, wl, b * 4096 + s, lane); } }
}

DI const float* win_ptr(const Args& a, const RowInfo& ri, int pos, int kv, int g) {
    const float* KW = (const float*)(a.ws + WS_KW);
    if (ri.pr) return KW + ((size_t)ri.b * 4096 + pos) * 256 + kv * 128 + g * 64;
    if (pos < 8192) return (const float*)a.in[I_SWIN] + (((size_t)ri.db * 512 + (pos - 7680)) * 2 + kv) * 128 + g * 64;
    return KW + ((size_t)TP + ri.db * 4 + (pos - 8192)) * 256 + kv * 128 + g * 64;
}
DI const float* slc_ptr(const Args& a, const RowInfo& ri, int pos, int c, int g) {
    if (ri.pr) return a.out + O_NSAP + (((size_t)ri.b * 4096 + pos) * 4 + c) * 128 + g * 64;
    if (pos < 8192) return (const float*)a.in[I_CNSA] + (((size_t)((const int*)a.in[I_PT])[ri.db * NPAGES + (pos >> 7)] * 128 + (pos & 127)) * 4 + c) * 128 + g * 64;
    return a.out + O_NSAS + (((size_t)ri.db * 4 + pos - 8192) * 4 + c) * 128 + g * 64;
}
constexpr float C64 = 0.125f * LOG2E, C128 = 0.08838834764831845f * LOG2E;
DI void nsa2_item_sample(const Args& a, LAS unsigned char* wl, int r, int g, int lane) {
    unsigned char* ws = a.ws;
    const RowInfo ri = rowinfo(r); const int qpos = ri.pos;
    const int kg = lane >> 4, c16 = lane & 15, hh = c16 & 7, head = g * 8 + hh;
    const int kpar = lane >> 5, kvoff = ((lane >> 4) & 1) * 128 + (lane & 15) * 4;
    bf16x8 qf[2];
    { const bf16_t* QR = (const bf16_t*)(ws + WS_QR);
#pragma unroll
      for (int ks = 0; ks < 2; ++ks) qf[ks] = *(const bf16x8*)(QR + (size_t)r * 1024 + head * 64 + 32 * ks + 8 * kg); }
    Flash<64> fw; flash_init(fw);
    Flash<64> fs; flash_init(fs);
    f32x4 rg[16];
    { const int lo = max(0, qpos - 511), b0 = lo & ~31, nst = ((qpos - b0) >> 5) + 1;
#define WLOAD(BASE) { _Pragma("unroll") for (int j = 0; j < 16; ++j) rg[j] = *(const f32x4*)(win_ptr(a, ri, min(max((BASE) + 2 * j + kpar, lo), qpos), 0, g) + kvoff); }
      WLOAD(b0)
      for (int st = 0; st < nst; ++st) { const int base = b0 + 32 * st;
          LDS_WAIT(); st64(wl, rg, lane);
          if (st + 1 < nst) WLOAD(base + 32)
          unsigned okm = 0u;
#pragma unroll
          for (int j = 0; j < 8; ++j) { const int p = base + kslot(kg, j); okm |= (p >= lo && p <= qpos) ? (1u << j) : 0u; }
          LDS_WAIT(); lds_step<64>(fw, qf, wl, okm, C64, lane);
      }
#undef WLOAD
    }
    { const int* selp = (const int*)(ws + WS_SEL) + ((size_t)r * 2 + g) * 16;
      const int sbl = lane < 16 ? selp[lane] : -1;
      const float* bptr = nullptr;
      if (sbl >= 0) { const int p0 = sbl * 64; bptr = p0 < 8192 ? (const float*)a.in[I_CNSA] + ((size_t)((const int*)a.in[I_PT])[ri.db * NPAGES + (p0 >> 7)] * 128 + (p0 & 127)) * 512 + 256 + g * 64
                                                                  : a.out + O_NSAS + (size_t)ri.db * 4 * 512 + 256 + g * 64; }
      const int sb2 = __shfl(sbl, lane >> 1); const int hbase = sb2 * 64 + (lane & 1) * 32;
      unsigned long long m = __ballot(lane < 32 && sb2 >= 0 && hbase <= qpos);
      int left = __popcll(m);
      if (left) {
          const unsigned long long plo = (unsigned long long)bptr;
#define SLOAD(L_) { const int L = (L_); const int bl = L >> 1; const unsigned long long pb64 = ((unsigned long long)(unsigned)__builtin_amdgcn_readlane((int)(plo >> 32), bl) << 32) | (unsigned)__builtin_amdgcn_readlane((int)plo, bl); \
          const int hb = __builtin_amdgcn_readlane(hbase, L); const float* bp = (const float*)pb64 + (size_t)(L & 1) * 32 * 512; \
          _Pragma("unroll") for (int j = 0; j < 16; ++j) { const int kk = min(2 * j + kpar, qpos - hb); rg[j] = *(const f32x4*)(bp + (size_t)kk * 512 + kvoff); } }
          int Lc = __builtin_ctzll(m); m &= m - 1ull;
          SLOAD(Lc)
          for (;;) {
              LDS_WAIT(); st64(wl, rg, lane);
              const int hb = __builtin_amdgcn_readlane(hbase, Lc);
              int Ln = 0; const bool more = m != 0ull;
              if (more) { Ln = __builtin_ctzll(m); m &= m - 1ull; SLOAD(Ln) }
              unsigned okm = 0u;
#pragma unroll
              for (int j = 0; j < 8; ++j) okm |= (hb + kslot(kg, j) <= qpos) ? (1u << j) : 0u;
              LDS_WAIT(); lds_step<64>(fs, qf, wl, okm, C64, lane);
              if (!more) break; Lc = Ln;
          }
#undef SLOAD
      } }
    LDS_WAIT();
    const float* GN = (const float*)(ws + WS_GN) + (size_t)r * 48;
    const float g0 = GN[head], g1 = GN[16 + head] * flash_linv(fs), g2 = GN[32 + head] * flash_linv(fw);
    const float* OC = (const float*)(ws + WS_OCMP) + (size_t)r * 1024 + head * 64 + 4 * kg;
    bf16_t* ON = (bf16_t*)(ws + WS_ONSA) + (size_t)r * 2048 + head * 64 + 4 * kg;
#pragma unroll
    for (int dt = 0; dt < 4; ++dt) { const f32x4 oc = *(const f32x4*)(OC + 16 * dt); const f32x4 o = oc * g0 + fs.o[dt] * g1 + fw.o[dt] * g2; if (c16 < 8) *(u32x2*)(ON + 16 * dt) = cvt4(o); }
}
DI void slc_walk(Flash<64>& fs, const bf16x8 (&qf)[2], const bf16_t* tb, const int* selp, int qpos, int lane) {
    const int kg = lane >> 4;
    const int sbl = lane < 32 ? selp[lane >> 1] : -1; const int Tl = 2 * sbl + (lane & 1);
    unsigned long long m = __ballot(lane < 32 && sbl >= 0 && 32 * Tl <= qpos);
    int left = __popcll(m);
    if (!left) return;
    Tile64 buf[3]; int Tq[3] = {0, 0, 0};
#define SLC_POP(i) { if (m) { Tq[i] = __builtin_amdgcn_readlane(Tl, __builtin_ctzll(m)); m &= m - 1ull; load_tile64(buf[i], tb + (size_t)Tq[i] * 8192, tb + (size_t)Tq[i] * 8192 + 2048, lane); } }
    SLC_POP(0) SLC_POP(1)
#define SLC_STEP(i) { SLC_POP(((i) + 2) % 3) const int T = Tq[i]; const bool full = 32 * T + 31 <= qpos; unsigned okm = 0xFFu; \
        if (!full) { okm = 0u; _Pragma("unroll") for (int j = 0; j < 8; ++j) okm |= (32 * T + kslot(kg, j) <= qpos) ? (1u << j) : 0u; } \
        flash_tile64(fs, qf, buf[i], full, okm, C64); if (--left == 0) break; }
    for (;;) { SLC_STEP(0) SLC_STEP(1) SLC_STEP(2) }
#undef SLC_STEP
#undef SLC_POP
}
DI void nsa2_item_pair(const Args& a, int r0, int g, int lane) {
    unsigned char* ws = a.ws;
    const int b = r0 >> 12, qpos0 = r0 & 4095;
    const int kg = lane >> 4, c16 = lane & 15, tl = c16 >> 3, hh = c16 & 7, head = g * 8 + hh, myrow = r0 + tl, qposc = qpos0 + tl;
    const bf16_t* QR = (const bf16_t*)(ws + WS_QR);
    const bf16_t* tb = (const bf16_t*)(ws + WS_NSAF) + (size_t)((b * 2 + g) * 128) * 8192;
    Flash<64> fw; flash_init(fw);
    { bf16x8 qf[2];
#pragma unroll
      for (int ks = 0; ks < 2; ++ks) qf[ks] = *(const bf16x8*)(QR + (size_t)myrow * 1024 + head * 64 + 32 * ks + 8 * kg);
      const int lo0 = max(0, qpos0 - 511), lo1 = max(0, qpos0 - 510), T0 = lo0 >> 5, T1 = (qpos0 + 1) >> 5, loc = max(0, qposc - 511);
      Tile64 buf[3]; int T = T0;
#define WIN_LD(i, TT_) { if ((TT_) <= T1) load_tile64(buf[i], tb + (size_t)(TT_) * 8192 + 4096, tb + (size_t)(TT_) * 8192 + 6144, lane); }
      WIN_LD(0, T0) WIN_LD(1, T0 + 1)
#define WIN_STEP(i) { WIN_LD(((i) + 2) % 3, T + 2) \
        const bool full = 32 * T >= lo1 && 32 * T + 31 <= qpos0; unsigned okm = 0xFFu; \
        if (!full) { okm = 0u; _Pragma("unroll") for (int j = 0; j < 8; ++j) { const int p = 32 * T + kslot(kg, j); okm |= (p >= loc && p <= qposc) ? (1u << j) : 0u; } } \
        flash_tile64(fw, qf, buf[i], full, okm, C64); if (++T > T1) break; }
      for (;;) { WIN_STEP(0) WIN_STEP(1) WIN_STEP(2) }
#undef WIN_LD
#undef WIN_STEP
    }
    Flash<64> fs0; flash_init(fs0);
    { bf16x8 qf[2];
#pragma unroll
      for (int ks = 0; ks < 2; ++ks) qf[ks] = *(const bf16x8*)(QR + (size_t)r0 * 1024 + head * 64 + 32 * ks + 8 * kg);
      slc_walk(fs0, qf, tb, (const int*)(ws + WS_SEL) + ((size_t)r0 * 2 + g) * 16, qpos0, lane); }
    Flash<64> fs1; flash_init(fs1);
    { bf16x8 qf[2];
#pragma unroll
      for (int ks = 0; ks < 2; ++ks) qf[ks] = *(const bf16x8*)(QR + (size_t)(r0 + 1) * 1024 + head * 64 + 32 * ks + 8 * kg);
      slc_walk(fs1, qf, tb, (const int*)(ws + WS_SEL) + ((size_t)(r0 + 1) * 2 + g) * 16, qpos0 + 1, lane); }
    const float* GN = (const float*)(ws + WS_GN) + (size_t)myrow * 48;
    const float li0 = flash_linv(fs0), li1 = flash_linv(fs1);
    const float g0 = GN[head], g1 = GN[16 + head] * (tl ? li1 : li0), g2 = GN[32 + head] * flash_linv(fw);
    const float* OC = (const float*)(ws + WS_OCMP) + (size_t)myrow * 1024 + head * 64 + 4 * kg;
    bf16_t* ON = (bf16_t*)(ws + WS_ONSA) + (size_t)myrow * 2048 + head * 64 + 4 * kg;
#pragma unroll
    for (int dt = 0; dt < 4; ++dt) { const f32x4 oc = *(const f32x4*)(OC + 16 * dt); const f32x4 os = tl ? fs1.o[dt] : fs0.o[dt]; *(u32x2*)(ON + 16 * dt) = cvt4(oc * g0 + os * g1 + fw.o[dt] * g2); }
}
constexpr int DSA_LSTRIDE = 528, DSA_WL = 32 * DSA_LSTRIDE + 1024 + 256;
DI void dsa_item(const Args& a, LAS unsigned char* wl, int r, int lane) {
    unsigned char* ws = a.ws;
    const RowInfo ri = rowinfo(r); const int nvalid = min(256, ri.pos + 1);
    const int kg = lane >> 4, c16 = lane & 15, hh = c16 & 7;
    bf16x8 qf[4];
    { const bf16_t* QB = (const bf16_t*)(ws + WS_QB);
#pragma unroll
      for (int ks = 0; ks < 4; ++ks) qf[ks] = *(const bf16x8*)(QB + (size_t)r * 1024 + hh * 128 + 32 * ks + 8 * kg); }
    const int* idxp = (const int*)(ws + WS_IDX) + (size_t)r * 256;
    Flash<128> f; flash_init(f);
    const int nst = (nvalid + 31) >> 5;
    LAS int* lidx = (LAS int*)(wl + 32 * DSA_LSTRIDE);
#pragma unroll
    for (int q = 0; q < 4; ++q) lidx[lane + 64 * q] = idxp[lane + 64 * q];
    LDS_WAIT();
    if (ri.pr) {
        const bf16_t* DB = (const bf16_t*)(ws + WS_DSAB) + (size_t)ri.b * 4096 * 256;
        const int hr = lane >> 5, ch = lane & 31;
        u32x4 rg[16];
#pragma unroll
        for (int i = 0; i < 16; ++i) { const int id = lidx[2 * i + hr]; rg[i] = *(const u32x4*)(DB + (size_t)max(id, 0) * 256 + ch * 8); }
        for (int st = 0; st < nst; ++st) {
            LDS_WAIT();
#pragma unroll
            for (int i = 0; i < 16; ++i) *(LAS u32x4*)(wl + (2 * i + hr) * DSA_LSTRIDE + ch * 16) = rg[i];
            unsigned okm = 0u;
#pragma unroll
            for (int j = 0; j < 8; ++j) okm |= (lidx[32 * st + kslot(kg, j)] >= 0) ? (1u << j) : 0u;
            if (st + 1 < nst) {
#pragma unroll
                for (int i = 0; i < 16; ++i) { const int id = lidx[32 * (st + 1) + 2 * i + hr]; rg[i] = *(const u32x4*)(DB + (size_t)max(id, 0) * 256 + ch * 8); } }
            LDS_WAIT();
            lds_step<128>(f, qf, wl, okm, C128, lane);
        }
    } else {
        LAS int* lpt = lidx + 256;
        lpt[lane] = ((const int*)a.in[I_PT])[ri.db * NPAGES + lane];
        LDS_WAIT();
        f32x4 rg[32];
#define DLOAD(ST) { _Pragma("unroll") for (int i = 0; i < 32; ++i) { const int id = max(lidx[32 * (ST) + i], 0); \
            const float* rp = id < 8192 ? (const float*)a.in[I_CDSA] + ((size_t)lpt[id >> 7] * 128 + (id & 127)) * 320 : a.out + O_DSAS + ((size_t)ri.db * 4 + id - 8192) * 320; rg[i] = *(const f32x4*)(rp + 4 * lane); } }
        DLOAD(0)
        for (int st = 0; st < nst; ++st) {
            LDS_WAIT(); st128(wl, rg, lane);
            unsigned okm = 0u;
#pragma unroll
            for (int j = 0; j < 8; ++j) okm |= (lidx[32 * st + kslot(kg, j)] >= 0) ? (1u << j) : 0u;
            if (st + 1 < nst) DLOAD(st + 1)
            LDS_WAIT();
            lds_step<128>(f, qf, wl, okm, C128, lane);
        }
#undef DLOAD
    }
    LDS_WAIT();
    const float inv = flash_linv(f);
    bf16_t* OD = (bf16_t*)(ws + WS_ONSA) + (size_t)r * 2048 + 1024 + hh * 128 + 4 * kg;
#pragma unroll
    for (int dt = 0; dt < 8; ++dt) if (c16 < 8) *(u32x2*)(OD + 16 * dt) = cvt4(f.o[dt] * inv);
}
DI void phase6(const Args& a, LAS unsigned char* lds, int qb = 0, int pm = 3) {
    const int tid = threadIdx.x, lane = tid & 63, wave = __builtin_amdgcn_readfirstlane(tid >> 6);
    unsigned* ctl = (unsigned*)(a.ws + WS_CTL);
#pragma unroll 1
    for (;;) { if (!(pm & 1)) break; const int it = q_next(ctl + CW_Q0 + qb + 128, lane); if (it >= 2 * TS + TP) break;
        if (it < 2 * TS) nsa2_item_sample(a, lds + wave * DSA_WL, TP + (it >> 1), it & 1, lane);
        else { const int j = it - 2 * TS, g = j & 1, b = (j >> 1) & 1, tp = 2047 - (j >> 2); nsa2_item_pair(a, b * 4096 + 2 * tp, g, lane); } }
    if (pm & 2) { LAS unsigned char* wl = lds + wave * DSA_WL;
#pragma unroll 1
      for (;;) { const int it = q_next(ctl + CW_Q0 + qb + 192, lane); if (it >= TT) break; dsa_item(a, wl, it < TS ? TP + it : it - TS, lane); } }
}

DI void phase11(const Args& a, LAS unsigned char* lds) {
    const int tid = threadIdx.x, lane = tid & 63, wave = __builtin_amdgcn_readfirstlane(tid >> 6);
    const int gw = blockIdx.x * NWAVES + wave, NGW = gridDim.x * NWAVES;
    unsigned char* ws = a.ws;
    const int kg = lane >> 4, c16 = lane & 15;
#pragma unroll 1
    for (int it = gw; it < 2048 + 128; it += NGW) {
        int myrow, h; const float* kvb; bool st_ok;
        if (it < 2048) { const int rg = it >> 2; h = it & 3; myrow = rg * 16 + c16; kvb = a.out + O_MEMP + (size_t)(rg >> 8) * 256 * 1024 + h * 128; st_ok = true; }
        else { const int j = it - 2048, db = j >> 2; h = j & 3; myrow = TP + db * 4 + (c16 & 3); kvb = (const float*)a.in[I_CMEM] + (size_t)db * 256 * 1024 + h * 128; st_ok = c16 < 4; }
        bf16x8 qf[4];
        { const bf16_t* QM = (const bf16_t*)(ws + WS_QMB);
#pragma unroll
          for (int ks = 0; ks < 4; ++ks) qf[ks] = *(const bf16x8*)(QM + (size_t)myrow * 512 + h * 128 + 32 * ks + 8 * kg); }
        Flash<128> f; flash_init(f);
        LAS unsigned char* wl = lds + wave * DSA_WL;
        f32x4 rg[32];
#define MLOAD(ST) { _Pragma("unroll") for (int i = 0; i < 32; ++i) rg[i] = *(const f32x4*)(kvb + (size_t)(32 * (ST) + i) * 1024 + (lane >> 5) * 512 + (lane & 31) * 4); }
        MLOAD(0)
        for (int st = 0; st < 8; ++st) {
            LDS_WAIT(); st128(wl, rg, lane);
            if (st + 1 < 8) MLOAD(st + 1)
            LDS_WAIT();
            lds_step<128>(f, qf, wl, 0xFFu, C128, lane);
        }
#undef MLOAD
        LDS_WAIT();
        const float inv = flash_linv(f);
        bf16_t* OM = (bf16_t*)(ws + WS_OM) + (size_t)myrow * 512 + h * 128 + 4 * kg;
#pragma unroll
        for (int dt = 0; dt < 8; ++dt) if (st_ok) *(u32x2*)(OM + 16 * dt) = cvt4(f.o[dt] * inv);
    }
}
DI f32x4 ldbf4(const bf16_t* p) { const u32x2 w = *(const u32x2*)p; f32x4 r; r.x = __uint_as_float(w.x << 16); r.y = __uint_as_float(w.x & 0xffff0000u); r.z = __uint_as_float(w.y << 16); r.w = __uint_as_float(w.y & 0xffff0000u); return r; }
struct EpiMerge {
    static constexpr bool HAS_MID = true;
    const bf16_t* GAB; bf16_t* MG; float* part;
    DI void mid(f32x4 (&acc)[2][2][4][2], const pg8::Unit& u, int wr, int wc, int fr, int fq) const {
        if (u.pm >= 32) return;
        int z = 0; asm volatile("" : "+v"(z));
#pragma unroll
        for (int ai = 0; ai < 2; ++ai)
#pragma unroll
            for (int m = 0; m < 4; ++m) { const size_t r = (size_t)(u.pm * 256 + ai * 128 + wr * 64 + m * 16 + fr + z);
#pragma unroll
                for (int bj = 0; bj < 2; ++bj)
#pragma unroll
                    for (int n = 0; n < 2; ++n) { const int c = u.pn * 256 + bj * 128 + wc * 32 + n * 16 + 4 * fq;
                        const f32x4 ga = ldbf4(GAB + r * 4096 + c), gb = ldbf4(GAB + r * 4096 + 2048 + c); f32x4 q;
                        q.x = ga.x * __builtin_amdgcn_rcpf(fmaxf(gb.x, 1e-30f)); q.y = ga.y * __builtin_amdgcn_rcpf(fmaxf(gb.y, 1e-30f)); q.z = ga.z * __builtin_amdgcn_rcpf(fmaxf(gb.z, 1e-30f)); q.w = ga.w * __builtin_amdgcn_rcpf(fmaxf(gb.w, 1e-30f));
                        acc[ai][bj][m][n] *= q; }
                asm volatile("" ::: "memory"); }
    }
    DI void operator()(const f32x4 (&acc)[2][2][4][2], const pg8::Unit& u, int wr, int wc, int fr, int fq) const {
        if (u.pm >= 32) {
#pragma unroll
            for (int m = 0; m < 4; ++m) { const int row = wr * 64 + m * 16 + fr;
#pragma unroll
                for (int bj = 0; bj < 2; ++bj)
#pragma unroll
                    for (int n = 0; n < 2; ++n) { const int c = u.pn * 256 + bj * 128 + wc * 32 + n * 16 + 4 * fq;
                        const f32x4 g = ldbf4(GAB + (size_t)(TP + row) * 4096 + (u.ks < 4 ? 0 : 2048) + c); *(f32x4*)(part + ((size_t)u.ks * 128 + row) * DM + c) = acc[0][bj][m][n] * g; } }
            return; }
#pragma unroll
        for (int ai = 0; ai < 2; ++ai)
#pragma unroll
            for (int m = 0; m < 4; ++m) { const size_t r = (size_t)u.pm * 256 + ai * 128 + wr * 64 + m * 16 + fr;
#pragma unroll
                for (int bj = 0; bj < 2; ++bj)
#pragma unroll
                    for (int n = 0; n < 2; ++n) { const int c = u.pn * 256 + bj * 128 + wc * 32 + n * 16 + 4 * fq;
                        *(u32x2*)(MG + r * DM + c) = cvt4(acc[ai][bj][m][n] * ldbf4(GAB + r * 4096 + 2048 + c)); } }
    }
};
struct ComboOrder { pg8::StaticOrder so; int n, ld;
    DI void init(int G, int c, int K) { so.init(TP / 256, DM / 256, G, c, K, K); n = 256 + 8 * (K / 256); ld = K; }
    DI bool next(int i, pg8::Unit& u) const { const long L = (long)i * so.G + so.c; if (L < 256) return so.at(L, u); if (L >= n) return false; const int j = (int)L - 256; u.pm = 32; u.pn = j & 7; u.ks = j >> 3; return true; }
    DI size_t offA(const pg8::Unit& u) const { return u.pm < 32 ? so.offA(u) : ((size_t)TP * ld + (size_t)u.ks * 256) * 2; }
    DI size_t offB(const pg8::Unit& u) const { return u.pm < 32 ? so.offB(u) : ((size_t)u.pn * 256 * ld + (size_t)u.ks * 256) * 2; }
    DI int ktiles(const pg8::Unit& u, int K) const { return u.pm < 32 ? K : 256; }
};
DI void phase7(const Args& a, LAS unsigned char* lds) {
    unsigned char* ws = a.ws;
    pg8::Gemm g{(const bf16_t*)(ws + WS_ONSA), (const bf16_t*)(ws + WS_BT_OA), DM, DM, DM};
    ComboOrder S; S.init(gridDim.x, blockIdx.x, DM);
    EpiMerge E{(const bf16_t*)(ws + WS_GAB), (bf16_t*)(ws + WS_MG), (float*)(ws + WS_PART)};
    pg8::gemm_phase(lds, g, S, E);
}
DI void phase7b(const Args& a) {
    const int tid = threadIdx.x, lane = tid & 63, wave = __builtin_amdgcn_readfirstlane(tid >> 6);
    const int gw = blockIdx.x * NWAVES + wave, NGW = gridDim.x * NWAVES;
    for (int q = gw; q < TS; q += NGW) {
        f32x4 v[8];
#pragma unroll
        for (int j = 0; j < 8; ++j) v[j] = (f32x4){0.f, 0.f, 0.f, 0.f};
#pragma unroll 2
        for (int k = 0; k < 8; ++k) { const f32x4* pr = (const f32x4*)((const float*)(a.ws + WS_PART) + ((size_t)k * 128 + q) * DM) + lane;
#pragma unroll
            for (int j = 0; j < 8; ++j) v[j] += pr[64 * j]; }
        u32x2* o8 = (u32x2*)((bf16_t*)(a.ws + WS_MG) + (size_t)(TP + q) * DM) + lane;
#pragma unroll
        for (int j = 0; j < 8; ++j) o8[64 * j] = cvt4(v[j]);
    }
}
struct FResX { const float* xp; const float* xs; float* dst; DI void operator()(const pg8::Unit& u, int row, int col, f32x4 v) const { const int r = u.pm * 256 + row, c = u.pn * 256 + col;
    f32x4 o = (f32x4){0.f, 0.f, 0.f, 0.f}; if (r < TT) o = v + (r < TP ? *(const f32x4*)(xp + (size_t)r * DM + c) : *(const f32x4*)(xs + (size_t)(r - TP) * DM + c)); *(f32x4*)(dst + (size_t)r * DM + c) = o; } };
struct FResW { const float* base; float* dst; DI void operator()(const pg8::Unit& u, int row, int col, f32x4 v) const { const int r = u.pm * 256 + row, c = u.pn * 256 + col;
    f32x4 o = (f32x4){0.f, 0.f, 0.f, 0.f}; if (r < TT) o = v + *(const f32x4*)(base + (size_t)r * DM + c); *(f32x4*)(dst + (size_t)r * DM + c) = o; } };
struct FStoreBf { bf16_t* C; int ldc; DI void operator()(const pg8::Unit& u, int row, int col, f32x4 v) const { *(u32x2*)(C + (size_t)(u.pm * 256 + row) * ldc + u.pn * 256 + col) = cvt4(v); } };

struct EpiResNorm {
    static constexpr bool HAS_MID = false;
    const float* base; float* dst; bf16_t* an; const float* gain; float* ss; float* part;
    DI void operator()(const f32x4 (&acc)[2][2][4][2], const pg8::Unit& u, int wr, int wc, int fr, int fq) const {
        if (u.pm >= 32) {
#pragma unroll
            for (int m = 0; m < 4; ++m) { const int row = wr * 64 + m * 16 + fr;
#pragma unroll
                for (int bj = 0; bj < 2; ++bj)
#pragma unroll
                    for (int n = 0; n < 2; ++n) *(f32x4*)(part + ((size_t)u.ks * 128 + row) * DM + u.pn * 256 + bj * 128 + wc * 32 + n * 16 + 4 * fq) = acc[0][bj][m][n]; }
            return; }
        const int c0 = u.pn * 256 + wc * 32 + 4 * fq;
#pragma unroll
        for (int ai = 0; ai < 2; ++ai)
#pragma unroll
            for (int m = 0; m < 4; ++m) { const size_t r = (size_t)u.pm * 256 + ai * 128 + wr * 64 + m * 16 + fr; float s = 0.f;
#pragma unroll
                for (int bj = 0; bj < 2; ++bj)
#pragma unroll
                    for (int n = 0; n < 2; ++n) { const size_t o = r * DM + c0 + bj * 128 + n * 16; const f32x4 x = acc[ai][bj][m][n] + *(const f32x4*)(base + o);
                        *(f32x4*)(dst + o) = x; *(u32x2*)(an + o) = cvt4(x * *(const f32x4*)(gain + c0 + bj * 128 + n * 16)); s += (x.x * x.x + x.y * x.y) + (x.z * x.z + x.w * x.w); }
                s = xsum32(xsum16(s));
                if (fq == 0) __hip_atomic_fetch_add(ss + r, s, __ATOMIC_RELAXED, __HIP_MEMORY_SCOPE_AGENT);
                asm volatile("" ::: "memory"); }
    }
};
DI void gemm_resnorm(const Args& a, LAS unsigned char* lds, size_t ws_a, size_t ws_bt, int K, const float* base, size_t ws_dst, int gidx, int which) {
    unsigned char* ws = a.ws;
    pg8::Gemm g{(const bf16_t*)(ws + ws_a), (const bf16_t*)(ws + ws_bt), K, K, K};
    ComboOrder S; S.init(gridDim.x, blockIdx.x, K);
    EpiResNorm E{base, (float*)(ws + ws_dst), (bf16_t*)(ws + WS_XN), (const float*)a.in[I_NG] + gidx * DM, (float*)(ws + WS_SS) + (size_t)which * TP, (float*)(ws + WS_PART)};
    pg8::gemm_phase(lds, g, S, E);
}
struct FStoreBfRs { bf16_t* C; int ldc; const float* rs; DI void operator()(const pg8::Unit& u, int row, int col, f32x4 v) const { const int r = u.pm * 256 + row;
    *(u32x2*)(C + (size_t)r * ldc + u.pn * 256 + col) = cvt4(v * rs[r]); } };
template <class F> struct FCombo { F f; float* part; DI void operator()(const pg8::Unit& u, int row, int col, f32x4 v) const {
    if (u.pm < 32) f(u, row, col, v); else if (row < 128) *(f32x4*)(part + ((size_t)u.ks * 128 + row) * DM + u.pn * 256 + col) = v; } };
template <class F> DI void gemm_n2048(const Args& a, LAS unsigned char* lds, size_t ws_a, size_t ws_bt, int K, const F& f) {
    unsigned char* ws = a.ws;
    pg8::Gemm g{(const bf16_t*)(ws + ws_a), (const bf16_t*)(ws + ws_bt), K, K, K};
    ComboOrder S; S.init(gridDim.x, blockIdx.x, K);
    pg8::EpiEach<FCombo<F>> E{FCombo<F>{f, (float*)(ws + WS_PART)}};
    pg8::gemm_phase(lds, g, S, E);
}
DI void phase8(const Args& a, LAS unsigned char* lds) {
    gemm_n2048(a, lds, WS_MG, WS_BT_O, DM, FResX{(const float*)a.in[I_XP], (const float*)a.in[I_XS], (float*)(a.ws + WS_X1)});
}
DI void sample_row_sum(const Args& a, const float* base_row, int q, int S, int lane, f32x4 (&v)[8]) {
    const f32x4* br = (const f32x4*)base_row + lane;
#pragma unroll
    for (int j = 0; j < 8; ++j) v[j] = br[64 * j];
#pragma unroll 2
    for (int k = 0; k < S; ++k) { const f32x4* pr = (const f32x4*)((const float*)(a.ws + WS_PART) + ((size_t)k * 128 + q) * DM) + lane;
#pragma unroll
        for (int j = 0; j < 8; ++j) v[j] += pr[64 * j]; }
}
DI void phase_norm(const Args& a, size_t ws_x, const float* sbase, int S, int gidx, int which) {
    const int tid = threadIdx.x, lane = tid & 63, wave = __builtin_amdgcn_readfirstlane(tid >> 6);
    const int gw = blockIdx.x * NWAVES + wave, NGW = gridDim.x * NWAVES;
    float* X = (float*)(a.ws + ws_x); const float* g = (const float*)a.in[I_NG] + gidx * DM; bf16_t* XN = (bf16_t*)(a.ws + WS_XN);
    for (int r = gw; r < TT; r += NGW) {
        if (r < TP) { rms_row_bf16(X + (size_t)r * DM, g, XN + (size_t)r * DM, lane); continue; }
        f32x4 v[8]; sample_row_sum(a, sbase + (size_t)(r - TP) * DM, r - TP, S, lane, v);
        float ss = 0.f; f32x4* xo = (f32x4*)(X + (size_t)r * DM) + lane;
#pragma unroll
        for (int j = 0; j < 8; ++j) { xo[64 * j] = v[j]; ss += (v[j].x * v[j].x + v[j].y * v[j].y) + (v[j].z * v[j].z + v[j].w * v[j].w); }
        const float rstd = rsqrtf(wave_sum(ss) * (1.f / 2048.f) + 1e-6f);
        const f32x4* gr = (const f32x4*)g + lane; u32x2* o8 = (u32x2*)(XN + (size_t)r * DM) + lane;
#pragma unroll
        for (int j = 0; j < 8; ++j) o8[64 * j] = cvt4(v[j] * rstd * gr[64 * j]);
    }
}
DI void phase10(const Args& a, LAS unsigned char* lds) {
    unsigned char* ws = a.ws;
    pg8::Gemm g{(const bf16_t*)(ws + WS_XN), (const bf16_t*)(ws + WS_BT_MQ), DM, DM, DM};
    pg8::StaticOrder S; S.init(MP / 256, 2, gridDim.x, blockIdx.x, DM, DM);
    pg8::EpiEach<FStoreBf> E{FStoreBf{(bf16_t*)(ws + WS_QMB), 512}};
    pg8::gemm_phase(lds, g, S, E);
}
DI void phase12(const Args& a, LAS unsigned char* lds) {
    gemm_n2048(a, lds, WS_OM, WS_BT_MO, 512, FResW{(const float*)(a.ws + WS_X1), (float*)(a.ws + WS_X2)});
}
DI void phase14(const Args& a, LAS unsigned char* lds) {
    unsigned char* ws = a.ws;
    pg8::Gemm g{(const bf16_t*)(ws + WS_XN), (const bf16_t*)(ws + WS_BT_UP), DM, DM, DM};
    pg8::StaticOrder S; S.init(MP / 256, DFF2 / 256, gridDim.x, blockIdx.x, DM, DM);
    pg8::EpiEach<FStoreBf> E{FStoreBf{(bf16_t*)(ws + WS_UB), DFF2}};
    pg8::gemm_phase(lds, g, S, E);
}
DI void phase15(const Args& a, LAS unsigned char* lds) {
    const int tid = threadIdx.x, lane = tid & 63, wave = __builtin_amdgcn_readfirstlane(tid >> 6);
    const int gw = blockIdx.x * NWAVES + wave, NGW = gridDim.x * NWAVES;
    unsigned char* ws = a.ws;
    const bf16_t* U = (const bf16_t*)(ws + WS_UB); bf16_t* ACT = (bf16_t*)(ws + WS_ACT);
    const float* cw = (const float*)a.in[I_CVW]; const float* cb = (const float*)a.in[I_CVB];
    constexpr int NRUN = TP / 32 + 32, NCH = DFF / 256;
#pragma unroll 1
    for (int it = gw; it < NRUN * NCH; it += NGW) {
        const int run = it / NCH, ch = it % NCH, c = 256 * ch + 4 * lane;
        int r0, nrow, t0; const float* st = nullptr; float* cout = nullptr; int cfirst = 1 << 30;
        if (run < TP / 32) { r0 = run * 32; nrow = 32; t0 = r0 & 4095; if (t0 == SEQ - 32) { cfirst = 30; cout = a.out + O_CONVP + (size_t)(r0 >> 12) * 2 * DFF2; } }
        else { const int db = run - TP / 32; r0 = TP + db * 4; nrow = 4; t0 = 0; st = (const float*)a.in[I_SCONV] + (size_t)db * 2 * DFF2; cfirst = 2; cout = a.out + O_CONVS + (size_t)db * 2 * DFF2; }
        f32x4 pb[2], w0[2], w1[2], w2[2], u1[2], u2[2];
#pragma unroll
        for (int hf = 0; hf < 2; ++hf) { const int cc = c + hf * DFF;
            pb[hf] = *(const f32x4*)(cb + cc); w0[hf] = *(const f32x4*)(cw + cc); w1[hf] = *(const f32x4*)(cw + DFF2 + cc); w2[hf] = *(const f32x4*)(cw + 2 * DFF2 + cc);
            if (st) { u2[hf] = *(const f32x4*)(st + cc); u1[hf] = *(const f32x4*)(st + DFF2 + cc); }
            else { u1[hf] = t0 >= 1 ? ldbf4(U + (size_t)(r0 - 1) * DFF2 + cc) : (f32x4){0.f, 0.f, 0.f, 0.f}; u2[hf] = t0 >= 2 ? ldbf4(U + (size_t)(r0 - 2) * DFF2 + cc) : (f32x4){0.f, 0.f, 0.f, 0.f}; } }
        f32x4 nx[2] = {ldbf4(U + (size_t)r0 * DFF2 + c), ldbf4(U + (size_t)r0 * DFF2 + c + DFF)};
        for (int i = 0; i < nrow; ++i) {
            const f32x4 u0[2] = {nx[0], nx[1]};
            if (i + 1 < nrow) { nx[0] = ldbf4(U + (size_t)(r0 + i + 1) * DFF2 + c); nx[1] = ldbf4(U + (size_t)(r0 + i + 1) * DFF2 + c + DFF); }
            const f32x4 gt = pb[0] + u2[0] * w0[0] + u1[0] * w1[0] + u0[0] * w2[0], up = pb[1] + u2[1] * w0[1] + u1[1] * w1[1] + u0[1] * w2[1];
            f32x4 o; o.x = gt.x * sigmoidf_(gt.x) * up.x; o.y = gt.y * sigmoidf_(gt.y) * up.y; o.z = gt.z * sigmoidf_(gt.z) * up.z; o.w = gt.w * sigmoidf_(gt.w) * up.w;
            *(u32x2*)(ACT + (size_t)(r0 + i) * DFF + c) = cvt4(o);
            if (i >= cfirst) { *(f32x4*)(cout + (size_t)(i - cfirst) * DFF2 + c) = u0[0]; *(f32x4*)(cout + (size_t)(i - cfirst) * DFF2 + c + DFF) = u0[1]; }
            u2[0] = u1[0]; u2[1] = u1[1]; u1[0] = u0[0]; u1[1] = u0[1];
        }
    }
}
DI void phase16(const Args& a, LAS unsigned char* lds) {
    gemm_n2048(a, lds, WS_ACT, WS_BT_DN, DFF, FResW{(const float*)(a.ws + WS_X2), (float*)(a.ws + WS_X3)});
}
DI void phase17(const Args& a) {
    const int tid = threadIdx.x, lane = tid & 63, wave = __builtin_amdgcn_readfirstlane(tid >> 6);
    const int gw = blockIdx.x * NWAVES + wave, NGW = gridDim.x * NWAVES;
    const float* X3 = (const float*)(a.ws + WS_X3); const f32x4* gr = (const f32x4*)a.in[I_FG] + lane;
    for (int r = gw; r < TT; r += NGW) {
        const f32x4* xr = (const f32x4*)(X3 + (size_t)r * DM) + lane; f32x4 v[8]; float s = 0.f;
        if (r < TP) {
#pragma unroll
            for (int j = 0; j < 8; ++j) v[j] = xr[64 * j];
        } else sample_row_sum(a, (const float*)(a.ws + WS_X2) + (size_t)r * DM, r - TP, DFF / 256, lane, v);
#pragma unroll
        for (int j = 0; j < 8; ++j) s += (v[j].x * v[j].x + v[j].y * v[j].y) + (v[j].z * v[j].z + v[j].w * v[j].w);
        const float rstd = rsqrtf(wave_sum(s) * (1.f / 2048.f) + 1e-6f);
        f32x4* o = (f32x4*)(a.out + (r < TP ? O_YP + (size_t)r * DM : O_YS + (size_t)(r - TP) * DM)) + lane;
#pragma unroll
        for (int j = 0; j < 8; ++j) o[64 * j] = v[j] * rstd * gr[64 * j];
    }
}
#define PHASES_REST \
    if (IN(3)) { phase3(args, lds); } SEAM(3); \
    if (IN(4)) { phase4(args, lds); } SEAM(4); \
    if (IN(5)) { phase5(args, lds); } SEAM(5); \
    if (IN(6)) { phase6(args, lds); } SEAM(6); \
    if (IN(7)) { phase7(args, lds); } SEAM(7); \
    if (IN(8)) { phase7b(args); } SEAM(8); \
    if (IN(9)) { phase8(args, lds); } SEAM(9); \
    if (IN(10)) { phase_norm(args, WS_X1, (const float*)args.in[I_XS], DM / 256, 1, 0); } SEAM(10); \
    if (IN(11)) { phase10(args, lds); } SEAM(11); \
    if (IN(12)) { phase11(args, lds); } SEAM(12); \
    if (IN(13)) { phase12(args, lds); } SEAM(13); \
    if (IN(14)) { phase_norm(args, WS_X2, (const float*)(args.ws + WS_X1) + (size_t)TP * DM, 512 / 256, 3, 1); } SEAM(14); \
    if (IN(15)) { phase14(args, lds); } SEAM(15); \
    if (IN(16)) { phase15(args, lds); } SEAM(16); \
    if (IN(17)) { phase16(args, lds); } SEAM(17); \
    if (IN(18)) { phase17(args); }
#ifndef MK_N_LAUNCHES
#define MK_N_LAUNCHES 1
#endif
constexpr int N_PHASES = 19;
__global__ void __launch_bounds__(NTHR, 2) mk_fwd(Args args) {
    extern __shared__ __attribute__((aligned(16))) unsigned char lds_raw[];
    LAS unsigned char* lds = (LAS unsigned char*)lds_raw;
    volatile LAS unsigned* MISC = (volatile LAS unsigned*)(lds + MISC_OFF);
    const int tid = threadIdx.x;
    for (int u = tid; u < 64; u += NTHR) ((LAS unsigned*)(lds + MISC_OFF))[u] = 0u;
    __syncthreads();
    unsigned* ctl = (unsigned*)(args.ws + WS_CTL);
    XcdBarrier bar; bar.bar = ctl + CW_BAR; bar.x = 0; bar.st = nullptr;
    const bool use_bar = (args.ph_hi - args.ph_lo) > 1;
    if (use_bar) bar = xcd_barrier_post(ctl + CW_BAR, MISC + 8);
    const int lo = args.ph_lo, hi = args.ph_hi;
#define IN(k) (lo <= (k) && (k) < hi)
#define SEAM(k) do { if (IN(k) && IN((k) + 1)) xcd_barrier(bar); } while (0)
    if (IN(0)) { phase0(args, lds); } SEAM(0);
    if (IN(1)) { phase1(args, lds); } SEAM(1);
    if (IN(2)) { phase2(args, lds); } SEAM(2);
    PHASES_REST
#undef IN
#undef SEAM
}

extern "C" void kernel_launch(void* const* d_in, const int* in_sizes, int n_in, void* d_out, int out_size, void* d_ws, size_t ws_size, hipStream_t stream) {
    static int grid = 0;
    if (grid == 0) {
        if (n_in != N_IN || (size_t)out_size != O_END || ws_size < WS_END) { fprintf(stderr, "kernel_launch: unexpected shapes: n_in %d out %d ws %zu (need %zu)\n", n_in, out_size, ws_size, (size_t)WS_END); grid = -1; return; }
        int dev = 0, cus = 0, per_cu = 0;
        if (hipGetDevice(&dev) != hipSuccess || hipDeviceGetAttribute(&cus, hipDeviceAttributeMultiprocessorCount, dev) != hipSuccess) { grid = -1; return; }
        if (hipFuncSetAttribute((const void*)mk_fwd, hipFuncAttributeMaxDynamicSharedMemorySize, LDS_BYTES) != hipSuccess) { fprintf(stderr, "kernel_launch: hipFuncSetAttribute failed\n"); grid = -1; return; }
        if (hipOccupancyMaxActiveBlocksPerMultiprocessor(&per_cu, (const void*)mk_fwd, NTHR, LDS_BYTES) != hipSuccess || per_cu < 1) fprintf(stderr, "kernel_launch: occupancy query reports %d\n", per_cu);
        (void)hipGetLastError();
        grid = cus;
    }
    if (grid < 0) return;
    (void)hipMemsetAsync((char*)d_ws + WS_CTL, 0, CTL_BYTES, stream);
    Args a{};
    for (int i = 0; i < N_IN; ++i) a.in[i] = d_in[i];
    a.out = (float*)d_out; a.ws = (unsigned char*)d_ws;
#if MK_N_LAUNCHES == 1
    a.ph_lo = 0; a.ph_hi = N_PHASES;
    hipLaunchKernelGGL(mk_fwd, dim3(grid), dim3(NTHR), LDS_BYTES, stream, a);
#else
    for (int p = 0; p < N_PHASES; ++p) { a.ph_lo = p; a.ph_hi = p + 1; hipLaunchKernelGGL(mk_fwd, dim3(grid), dim3(NTHR), LDS_BYTES, stream, a); }
#endif
}
```

```cpp
#include <hip/hip_runtime.h>
#include <cstdio>
#include <cstdint>

#define DI __device__ __forceinline__
#define LAS __attribute__((address_space(3)))
typedef unsigned short bf16_t;
typedef short bf16x8 __attribute__((ext_vector_type(8)));
typedef float f32x4 __attribute__((ext_vector_type(4)));
typedef float f32x2 __attribute__((ext_vector_type(2)));
typedef unsigned u32x4 __attribute__((ext_vector_type(4)));
typedef unsigned u32x2 __attribute__((ext_vector_type(2)));

constexpr int DM = 2048, SEQ = 4096, TP = 8192, TS = 128, TT = 8320, MP = 8448;
constexpr int DIN = 8320, DINP = 8448, DFF = 5632, DFF2 = 11264;
constexpr int NPAGES = 64;
constexpr int C_QA = 0, C_KVA = 1024, C_GA = 1792, C_QB = 1840, C_KVB = 2864, C_QI = 3120, C_KI = 4144, C_WI = 4208, C_GM = 4224;
constexpr size_t O_YP = 0, O_YS = O_YP + (size_t)TP * DM, O_NSAP = O_YS + (size_t)TS * DM, O_NSAS = O_NSAP + (size_t)TP * 512, O_WINP = O_NSAS + (size_t)TS * 512,
                 O_WINS = O_WINP + (size_t)2 * 512 * 256, O_DSAP = O_WINS + (size_t)32 * 512 * 256, O_DSAS = O_DSAP + (size_t)TP * 320, O_MEMP = O_DSAS + (size_t)TS * 320,
                 O_CONVP = O_MEMP + (size_t)512 * 1024, O_CONVS = O_CONVP + (size_t)2 * 2 * DFF2, O_END = O_CONVS + (size_t)32 * 2 * DFF2;
static_assert(O_END == 29708288, "output size");
enum { I_XP = 0, I_XS, I_MEM, I_CNSA, I_SWIN, I_CDSA, I_CMEM, I_SCONV, I_PT, I_NG, I_WIN, I_PE, I_CW1, I_CB1, I_CW2, I_WOA, I_WOB, I_WO, I_WMQ, I_WMKV, I_WMO, I_WUP, I_CVW, I_CVB, I_WDN, I_FG, N_IN };

constexpr size_t al256(size_t x) { return (x + 255) & ~(size_t)255; }
constexpr size_t WS_CTL = 0, CTL_BYTES = 1u << 20;
constexpr size_t WS_BT_IN = CTL_BYTES;
constexpr size_t WS_BT_OA = WS_BT_IN + (size_t)DINP * DM * 2;
constexpr size_t WS_BT_OB = WS_BT_OA + (size_t)DM * 1024 * 2;
constexpr size_t WS_BT_O = WS_BT_OB + (size_t)DM * 1024 * 2;
constexpr size_t WS_BT_MQ = WS_BT_O + (size_t)DM * DM * 2;
constexpr size_t WS_BT_MKV = WS_BT_MQ + (size_t)512 * DM * 2;
constexpr size_t WS_BT_MO = WS_BT_MKV + (size_t)1024 * DM * 2;
constexpr size_t WS_BT_UP = WS_BT_MO + (size_t)DM * 512 * 2;
constexpr size_t WS_BT_DN = WS_BT_UP + (size_t)DFF2 * DM * 2;
constexpr size_t WS_BT_C1 = WS_BT_DN + (size_t)DM * DFF * 2;
constexpr size_t WS_XN = WS_BT_C1 + (size_t)2 * 256 * 2048 * 2;
constexpr size_t WS_MEMN = WS_XN + (size_t)MP * DM * 2;
constexpr size_t WS_P = WS_MEMN + (size_t)512 * DM * 2;
constexpr size_t WS_QC = WS_P + (size_t)MP * DINP * 4;
constexpr size_t WS_QR = WS_QC + (size_t)MP * 1024 * 2;
constexpr size_t WS_QB = WS_QR + (size_t)MP * 1024 * 2;
constexpr size_t WS_QI = WS_QB + (size_t)MP * 1024 * 2;
constexpr size_t WS_GN = WS_QI + (size_t)MP * 1024 * 2;
constexpr size_t WS_WI = WS_GN + (size_t)MP * 48 * 4;
constexpr size_t WS_GAB = WS_WI + (size_t)MP * 16 * 4;
constexpr size_t WS_KW = WS_GAB + (size_t)MP * 4096 * 2;
constexpr int KCP_ROWS = SEQ + 32;
constexpr size_t WS_KCRAW = WS_KW + (size_t)MP * 256 * 4;
constexpr size_t KCS_OFF = (size_t)8 * KCP_ROWS * 64;
constexpr size_t WS_BPART = al256(WS_KCRAW + (KCS_OFF + (size_t)128 * 8192 * 64 + 64 * 64) * 2);
constexpr size_t WS_BIASC = WS_BPART + 16 * 512 * 4;
constexpr int HC_ROWS = 132 * 256;
constexpr size_t WS_HC = WS_BIASC + 512 * 4;
constexpr size_t WS_KCV = WS_HC + (size_t)2 * HC_ROWS * 256 * 2;
constexpr size_t WS_OCMP = WS_KCV + (size_t)34 * 4 * 512 * 64 * 4;
constexpr size_t WS_SEL = WS_OCMP + (size_t)MP * 1024 * 4;
constexpr size_t WS_IDX = WS_SEL + (size_t)MP * 32 * 4;
constexpr size_t WS_ONSA = WS_IDX + (size_t)MP * 256 * 4;
constexpr size_t WS_ODSA = WS_ONSA + (size_t)MP * 1024 * 2;
constexpr size_t WS_TMPG = WS_ODSA + (size_t)MP * 1024 * 2;
constexpr size_t WS_MG = WS_TMPG + (size_t)MP * DM * 4;
constexpr size_t WS_X1 = WS_MG + (size_t)MP * DM * 2;
constexpr size_t WS_X2 = WS_X1 + (size_t)MP * DM * 4;
constexpr size_t WS_X3 = WS_X2 + (size_t)MP * DM * 4;
constexpr size_t WS_QMB = WS_X3 + (size_t)MP * DM * 4;
constexpr size_t WS_OM = WS_QMB + (size_t)MP * 512 * 2;
constexpr size_t WS_UB = WS_OM + (size_t)MP * 512 * 2;
constexpr size_t WS_ACT = WS_UB + (size_t)MP * DFF2 * 2;
constexpr size_t WS_NSAF = WS_ACT + (size_t)MP * DFF * 2;
constexpr size_t WS_KCF = WS_NSAF + (size_t)4 * 128 * 8192 * 2;
constexpr size_t WS_KIF = WS_KCF + (size_t)34 * 2 * 16 * 4096 * 2;
constexpr size_t WS_DSAB = WS_KIF + (size_t)2 * 256 * 1024 * 2;
constexpr size_t WS_PART = WS_DSAB + (size_t)2 * 4096 * 256 * 2;
constexpr size_t WS_KIFS = WS_PART + (size_t)22 * 128 * DM * 4;
constexpr size_t WS_SS = WS_KIFS + (size_t)32 * 513 * 1024 * 2;
constexpr size_t WS_RS = WS_SS + (size_t)2 * TP * 4;
constexpr size_t WS_END = WS_RS + (size_t)2 * MP * 4;
static_assert(WS_END < (size_t)2400 * 1024 * 1024, "ws map too large");
constexpr int CW_BAR = 4096;

constexpr int RING_BYTES = 131072, LDS_BYTES = 147456, MISC_OFF = LDS_BYTES - 256;

#define LDS_WAIT() asm volatile("s_waitcnt lgkmcnt(0)" ::: "memory")
#define VM_WAIT() asm volatile("s_waitcnt vmcnt(0)" ::: "memory")
DI unsigned cvt_pk_bf16(float lo, float hi) { unsigned r; asm volatile("v_cvt_pk_bf16_f32 %0, %1, %2" : "=v"(r) : "v"(lo), "v"(hi)); return r; }
DI float bf2f(bf16_t b) { return __uint_as_float(((unsigned)b) << 16); }
DI bf16x8 cvt8(f32x4 a, f32x4 b) { u32x4 w; w.x = cvt_pk_bf16(a.x, a.y); w.y = cvt_pk_bf16(a.z, a.w); w.z = cvt_pk_bf16(b.x, b.y); w.w = cvt_pk_bf16(b.z, b.w); return __builtin_bit_cast(bf16x8, w); }
DI u32x2 cvt4(f32x4 a) { u32x2 w; w.x = cvt_pk_bf16(a.x, a.y); w.y = cvt_pk_bf16(a.z, a.w); return w; }
template <int CTRL> DI float dpp_f_(float x) { return __int_as_float(__builtin_amdgcn_update_dpp(0, __float_as_int(x), CTRL, 0xF, 0xF, true)); }
DI float wave_sum(float v) {
    v += dpp_f_<0xB1>(v); v += dpp_f_<0x4E>(v); v += dpp_f_<0x141>(v); v += dpp_f_<0x140>(v);
    { const auto r = __builtin_amdgcn_permlane16_swap(__float_as_uint(v), __float_as_uint(v), false, false); v = __uint_as_float(r[0]) + __uint_as_float(r[1]); }
    { const auto r = __builtin_amdgcn_permlane32_swap(__float_as_uint(v), __float_as_uint(v), false, false); v = __uint_as_float(r[0]) + __uint_as_float(r[1]); }
    return v;
}
DI f32x4 shfl_xor4(f32x4 v, int m) { f32x4 r; r.x = __shfl_xor(v.x, m); r.y = __shfl_xor(v.y, m); r.z = __shfl_xor(v.z, m); r.w = __shfl_xor(v.w, m); return r; }
DI float sigmoidf_(float x) { return 1.f / (1.f + __expf(-x)); }
#define MFMA16(a, b, c) __builtin_amdgcn_mfma_f32_16x16x32_bf16((a), (b), (c), 0, 0, 0)
namespace pg8 {
constexpr int BM = 256, BK = 64, HALF = 128, HTB = HALF * BK * 2  , STAGE_BYTES = 8 * HTB, NXCD = 8, WGM = 8;
__host__ __device__ __forceinline__ int lds_byte(int r, int c) { const int st = (r >> 4) * 2 + (c >> 5), rr = r & 15, cc = c & 31, ob = rr * 64 + cc * 2; return st * 1024 + (ob ^ (((ob >> 9) & 1) << 5)); }
__host__ __device__ __forceinline__ void stage_rc(int b, int& R, int& C) { const int st = b / 1024, sb = b % 1024, swz = sb ^ (((sb >> 9) & 1) << 5); R = (st >> 1) * 16 + swz / 64; C = (st & 1) * 32 + (swz % 64) / 2; }

struct Unit { int pm, pn, ks; };
struct Gemm { const bf16_t* A; const bf16_t* Bt; int lda, ldb, K; };

struct StaticOrder {
    int nM, nN, nwg, G, c, lda, ldb;
    __device__ void init(int nM_, int nN_, int G_, int c_, int lda_, int ldb_) { nM = nM_; nN = nN_; nwg = nM * nN; G = G_; c = c_; lda = lda_; ldb = ldb_; }
    __device__ bool next(int i, Unit& u) const { return at((long)i * G + c, u); }
    __device__ bool at(long L, Unit& u) const {
        if (L >= nwg) return false;
        int wgid = (int)L; { const int q = nwg / NXCD, r = nwg % NXCD, xcd = wgid % NXCD, off = wgid / NXCD; wgid = (xcd < r ? xcd * (q + 1) : r * (q + 1) + (xcd - r) * q) + off; }
        const int nig = WGM * nN, gid = wgid / nig, fm = gid * WGM, gsz = (nM - fm) < WGM ? (nM - fm) : WGM;
        u.pm = fm + ((wgid % nig) % gsz); u.pn = (wgid % nig) / gsz; u.ks = 0; return true;
    }
    __device__ __forceinline__ size_t offA(const Unit& u) const { return (size_t)u.pm * BM * lda * 2; }
    __device__ __forceinline__ size_t offB(const Unit& u) const { return (size_t)u.pn * BM * ldb * 2; }
    __device__ __forceinline__ int ktiles(const Unit&, int K) const { return K; }
};

template <class F> struct EpiEach {
    static constexpr bool HAS_MID = false;
    F f;
    __device__ __forceinline__ void operator()(const f32x4 (&acc)[2][2][4][2], const Unit& u, int wr, int wc, int fr, int fq) const {
#pragma unroll
        for (int ai = 0; ai < 2; ++ai)
#pragma unroll
            for (int m = 0; m < 4; ++m) { const int row = ai * HALF + wr * 64 + m * 16 + fr;
#pragma unroll
                for (int bj = 0; bj < 2; ++bj)
#pragma unroll
                    for (int n = 0; n < 2; ++n) f(u, row, bj * HALF + wc * 32 + n * 16 + 4 * fq, acc[ai][bj][m][n]); }
    }
};

template <class Epi, class Sched>
__device__ __forceinline__ void gemm_phase(LAS unsigned char* lds, const Gemm g, const Sched& S, const Epi& E) {
    const int tid = threadIdx.x, wid = __builtin_amdgcn_readfirstlane(tid >> 6), lane = tid & 63, wr = wid >> 2, wc = wid & 3, fr = lane & 15, fq = lane >> 4;
    unsigned voffA[2], voffB[2];
#pragma unroll
    for (int i = 0; i < 2; ++i) { int R, C; stage_rc(tid * 16 + i * 8192, R, C); voffA[i] = (unsigned)(R * g.lda + C) * 2u; voffB[i] = (unsigned)(R * g.ldb + C) * 2u; }
    const size_t kstep = (size_t)(BK * 2);
    const size_t hA = (size_t)HALF * g.lda * 2, hB = (size_t)HALF * g.ldb * 2;
    const unsigned ldsw = (unsigned)wid * 1024u;
    const int aoff = lds_byte(wr * 64 + fr, fq * 8), boff = lds_byte(wc * 32 + fr, fq * 8);
#define PG8_SA(b, h) (((b) * 2 + (h)) * HTB)
#define PG8_SB(b, h) ((4 + (b) * 2 + (h)) * HTB)
#define PG8_STAGE(bufoff, gbase, voff) do { _Pragma("unroll") for (int _i = 0; _i < 2; ++_i) \
        __builtin_amdgcn_global_load_lds((const unsigned*)((const char*)(gbase) + (voff)[_i]), (LAS unsigned*)(lds + (bufoff) + ldsw + _i * 8192), 16, 0, 0); } while (0)
#define PG8_LDA(dst, b, h) do { _Pragma("unroll") for (int m = 0; m < 4; ++m) _Pragma("unroll") for (int k = 0; k < 2; ++k) dst[m][k] = *(const LAS bf16x8*)(lds + PG8_SA(b, h) + aoff + m * 2048 + k * 1024); } while (0)
#define PG8_LDB(dst, b, h) do { _Pragma("unroll") for (int n = 0; n < 2; ++n) _Pragma("unroll") for (int k = 0; k < 2; ++k) dst[n][k] = *(const LAS bf16x8*)(lds + PG8_SB(b, h) + boff + n * 2048 + k * 1024); } while (0)
#define PG8_MMA(ai, bj, At, Bt) do { __builtin_amdgcn_s_setprio(1); _Pragma("unroll") for (int m = 0; m < 4; ++m) _Pragma("unroll") for (int n = 0; n < 2; ++n) _Pragma("unroll") for (int k = 0; k < 2; ++k) \
        acc[ai][bj][m][n] = __builtin_amdgcn_mfma_f32_16x16x32_bf16(Bt[n][k], At[m][k], acc[ai][bj][m][n], 0, 0, 0); __builtin_amdgcn_s_setprio(0); } while (0)
#define PG8_WAIT_V(n) asm volatile("s_waitcnt vmcnt(" #n ")" ::: "memory")
#define PG8_WAIT_L(n) asm volatile("s_waitcnt lgkmcnt(" #n ")" ::: "memory")
#define PG8_BAR __builtin_amdgcn_s_barrier()
#define PG8_SCHED __builtin_amdgcn_sched_barrier(0)
    Unit cur, nxt; int ui = 0;
    if (!S.next(0, cur)) return;
    f32x4 acc[2][2][4][2];
#pragma unroll
    for (int a = 0; a < 2; ++a)
#pragma unroll
        for (int b = 0; b < 2; ++b)
#pragma unroll
            for (int m = 0; m < 4; ++m)
#pragma unroll
                for (int n = 0; n < 2; ++n) acc[a][b][m][n] = (f32x4){0.f, 0.f, 0.f, 0.f};
    bf16x8 At[4][2], B0[2][2], B1[2][2];
    const char* cA = (const char*)g.A + S.offA(cur); const char* cB = (const char*)g.Bt + S.offB(cur);
    PG8_STAGE(PG8_SB(0, 0), cB, voffB); PG8_STAGE(PG8_SB(0, 1), cB + hB, voffB); PG8_STAGE(PG8_SA(0, 0), cA, voffA); PG8_STAGE(PG8_SA(0, 1), cA + hA, voffA);
    if (wr == 1) PG8_BAR;
    PG8_WAIT_V(2); PG8_BAR;
    PG8_STAGE(PG8_SB(1, 0), cB + kstep, voffB); PG8_STAGE(PG8_SA(1, 0), cA + kstep, voffA); PG8_STAGE(PG8_SB(1, 1), cB + hB + kstep, voffB);
    PG8_WAIT_V(6); PG8_BAR;
    for (;;) {
        const bool has_next = S.next(ui + 1, nxt);
        const int nt = S.ktiles(cur, g.K) / BK;
        const char* nA = has_next ? (const char*)g.A + S.offA(nxt) : cA; const char* nB = has_next ? (const char*)g.Bt + S.offB(nxt) : cB;
        constexpr int NHALF = Epi::HAS_MID ? 2 : 1; const int tlen = nt / NHALF;
#pragma unroll 1
        for (int hf = 0; hf < NHALF; ++hf) {
#pragma unroll 1
        for (int t = hf * tlen; t < (hf + 1) * tlen; t += 2) {
            const bool last = (t == nt - 2);
            const char* a1 = cA + (size_t)(t + 1) * kstep;
            const char* a2 = last ? nA : cA + (size_t)(t + 2) * kstep; const char* b2 = last ? nB : cB + (size_t)(t + 2) * kstep;
            const char* a3 = a2 + kstep; const char* b3 = b2 + kstep;
            PG8_LDB(B0, 0, 0); PG8_LDB(B1, 0, 1); PG8_SCHED; PG8_LDA(At, 0, 0); PG8_STAGE(PG8_SA(1, 1), a1 + hA, voffA);
            PG8_WAIT_V(8); PG8_WAIT_L(0); PG8_BAR; PG8_MMA(0, 0, At, B0); PG8_MMA(0, 1, At, B1); PG8_BAR; PG8_SCHED;
            PG8_LDA(At, 0, 1); PG8_STAGE(PG8_SB(0, 0), b2, voffB); PG8_STAGE(PG8_SB(0, 1), b2 + hB, voffB); PG8_STAGE(PG8_SA(0, 0), a2, voffA);
            PG8_WAIT_V(8); PG8_WAIT_L(0); PG8_BAR; PG8_MMA(1, 0, At, B0); PG8_MMA(1, 1, At, B1); PG8_BAR; PG8_SCHED;
            PG8_LDB(B0, 1, 0); PG8_LDB(B1, 1, 1); PG8_SCHED; PG8_LDA(At, 1, 0); PG8_STAGE(PG8_SA(0, 1), a2 + hA, voffA);
            PG8_WAIT_V(8); PG8_WAIT_L(0); PG8_BAR; PG8_MMA(0, 0, At, B0); PG8_MMA(0, 1, At, B1); PG8_BAR; PG8_SCHED;
            PG8_LDA(At, 1, 1); PG8_STAGE(PG8_SB(1, 0), b3, voffB); PG8_STAGE(PG8_SB(1, 1), b3 + hB, voffB); PG8_STAGE(PG8_SA(1, 0), a3, voffA);
            PG8_WAIT_V(8); PG8_WAIT_L(0); PG8_BAR; PG8_MMA(1, 0, At, B0); PG8_MMA(1, 1, At, B1); PG8_BAR; PG8_SCHED;
        }
        if constexpr (Epi::HAS_MID) { if (hf == 0) E.mid(acc, cur, wr, wc, fr, fq); }
        }
        if (wr == 0) PG8_BAR;
        E(acc, cur, wr, wc, fr, fq);
        if (!has_next) break;
#pragma unroll
        for (int a = 0; a < 2; ++a)
#pragma unroll
            for (int b = 0; b < 2; ++b)
#pragma unroll
                for (int m = 0; m < 4; ++m)
#pragma unroll
                    for (int n = 0; n < 2; ++n) acc[a][b][m][n] = (f32x4){0.f, 0.f, 0.f, 0.f};
        cur = nxt; cA = nA; cB = nB; ++ui;
        if (wr == 1) PG8_BAR;
    }
    PG8_WAIT_V(0);
    PG8_BAR;
#undef PG8_SA
#undef PG8_SB
#undef PG8_STAGE
#undef PG8_LDA
#undef PG8_LDB
#undef PG8_MMA
#undef PG8_WAIT_V
#undef PG8_WAIT_L
#undef PG8_BAR
#undef PG8_SCHED
}
}
#define XB_TMO      128
#define XB_XCNT(j)  (256  + 64 * (j))
#define XB_XSUB(j)  (1280 + 64 * (j))
#define XB_XGEN(j)  (2304 + 64 * (j))
#define XB_TOP      3328
#define XB_TOPGEN   3392
#define XCD_BAR_WORDS 3456
#define XB_SPIN_CAP (1u << 18)

__device__ __forceinline__ unsigned xb_ld(unsigned* p)              { return __hip_atomic_load(p, __ATOMIC_RELAXED, __HIP_MEMORY_SCOPE_AGENT); }
__device__ __forceinline__ unsigned xb_add(unsigned* p, unsigned v) { return __hip_atomic_fetch_add(p, v, __ATOMIC_RELAXED, __HIP_MEMORY_SCOPE_AGENT); }
__device__ __forceinline__ unsigned xb_xcc_id() { return (unsigned)__builtin_amdgcn_s_getreg((3 << 11) | 20) & 0xFu; }
#define XB_SPIN(cond, bar) do { unsigned _sp = 0; while (cond) { __builtin_amdgcn_s_sleep(1); \
    if ((++_sp & 255u) == 0u) { if (xb_ld(&(bar)[XB_TMO])) break; if (_sp > XB_SPIN_CAP) { atomicAdd(&(bar)[XB_TMO], 1u); break; } } } } while (0)

struct XcdBarrier {
    unsigned* bar; unsigned x;
    volatile LAS unsigned* st;
};

__device__ __forceinline__ XcdBarrier xcd_barrier_post(unsigned* bar, volatile LAS unsigned* st) {
    XcdBarrier b; b.bar = bar; b.x = xb_xcc_id(); b.st = st;
    if (threadIdx.x == 0) (void)xb_add(&bar[XB_XCNT(b.x)], 1u);
    return b;
}
__device__ __forceinline__ void xcd_barrier_complete(unsigned* bar, unsigned x, unsigned& nloc, unsigned& nx) {
    const unsigned G = gridDim.x * gridDim.y * gridDim.z;
    unsigned sum, cnt, mine, sp = 0u;
    for (;;) {
        sum = 0u; cnt = 0u; mine = 0u;
#pragma unroll
        for (unsigned j = 0; j < 16; ++j) { const unsigned c = xb_ld(&bar[XB_XCNT(j)]); sum += c; cnt += (c > 0u) ? 1u : 0u; mine = (j == x) ? c : mine; }
        if (sum == G) break;
        __builtin_amdgcn_s_sleep(1);
        if ((++sp & 255u) == 0u) { if (xb_ld(&bar[XB_TMO])) break; if (sp > XB_SPIN_CAP) { atomicAdd(&bar[XB_TMO], 1u); break; } }
    }
    nloc = mine > 0u ? mine : 1u; nx = cnt > 0u ? cnt : 1u;
}

__device__ __forceinline__ void xcd_barrier(const XcdBarrier& b) {
    asm volatile("s_waitcnt vmcnt(0)" ::: "memory");
    __syncthreads();
    if (threadIdx.x == 0) {
        unsigned* bar = b.bar;
        __builtin_amdgcn_s_waitcnt(0);
        unsigned nloc = b.st[0], nx = b.st[1];
        if (nloc == 0u) { xcd_barrier_complete(bar, b.x, nloc, nx); b.st[0] = nloc; b.st[1] = nx; }
        const unsigned old = xb_add(&bar[XB_XSUB(b.x)], 1u);
        const unsigned gen = old / nloc;
        if (old + 1u == (gen + 1u) * nloc) {
            __builtin_amdgcn_fence(__ATOMIC_RELEASE, "agent");
            asm volatile("s_waitcnt vmcnt(0)" ::: "memory");
            const unsigned og = xb_add(&bar[XB_TOP], 1u);
            const unsigned tg = og / nx;
            if (og + 1u == (tg + 1u) * nx) xb_add(&bar[XB_TOPGEN], 1u);
            else XB_SPIN(xb_ld(&bar[XB_TOPGEN]) == tg, bar);
            __builtin_amdgcn_fence(__ATOMIC_ACQUIRE, "agent");
            xb_add(&bar[XB_XGEN(b.x)], 1u);
            asm volatile("s_waitcnt vmcnt(0)" ::: "memory");
        } else {
            XB_SPIN(xb_ld(&bar[XB_XGEN(b.x)]) == gen, bar);
            __builtin_amdgcn_fence(__ATOMIC_ACQUIRE, "agent");
            asm volatile("s_waitcnt vmcnt(0)" ::: "memory");
        }
    }
    __syncthreads();
}
struct Args { const void* in[N_IN]; float* out; unsigned char* ws; int ph_lo, ph_hi; };
constexpr int NWAVES = 8, NTHR = 512;

struct FStoreF32 { float* C; int ldc; DI void operator()(const pg8::Unit& u, int row, int col, f32x4 v) const { *(f32x4*)(C + (size_t)(u.pm * 256 + row) * ldc + u.pn * 256 + col) = v; } };

DI void p0_transpose_item(const float* W, int K, int N, bf16_t* WT, LAS float* scr, int item, int lane, int ldw = 0) {
    if (ldw == 0) ldw = K;
    const int nblk = N / 32, kb = item / nblk, nb = item % nblk, k0 = 64 * kb, n0 = 32 * nb;
#pragma unroll 8
    for (int i = 0; i < 32; ++i) { const int kk = 2 * i + (lane >> 5); scr[kk * 33 + (lane & 31)] = W[(size_t)(k0 + kk) * N + n0 + (lane & 31)]; }
    LDS_WAIT();
    const int c = lane & 7;
#pragma unroll
    for (int j = 0; j < 4; ++j) { const int n = (lane >> 3) + 8 * j; const LAS float* s = scr + (8 * c) * 33 + n;
        u32x4 o; o.x = cvt_pk_bf16(s[0 * 33], s[1 * 33]); o.y = cvt_pk_bf16(s[2 * 33], s[3 * 33]); o.z = cvt_pk_bf16(s[4 * 33], s[5 * 33]); o.w = cvt_pk_bf16(s[6 * 33], s[7 * 33]);
        *(u32x4*)(WT + (size_t)(n0 + n) * ldw + k0 + 8 * c) = o; }
    LDS_WAIT();
}
struct TrItem { const float* W; bf16_t* WT; int N, ldw, k0, n0; };
DI void tr_load(const TrItem& t, int lane, float (&v)[32]) {
#pragma unroll
    for (int i = 0; i < 32; ++i) v[i] = t.W[(size_t)(t.k0 + 2 * i + (lane >> 5)) * t.N + t.n0 + (lane & 31)];
}
DI void tr_store(const TrItem& t, LAS float* scr, int lane, const float (&v)[32]) {
#pragma unroll
    for (int i = 0; i < 32; ++i) scr[(2 * i + (lane >> 5)) * 33 + (lane & 31)] = v[i];
    LDS_WAIT();
    const int c = lane & 7;
#pragma unroll
    for (int j = 0; j < 4; ++j) { const int n = (lane >> 3) + 8 * j; const LAS float* s = scr + (8 * c) * 33 + n;
        u32x4 o; o.x = cvt_pk_bf16(s[0 * 33], s[1 * 33]); o.y = cvt_pk_bf16(s[2 * 33], s[3 * 33]); o.z = cvt_pk_bf16(s[4 * 33], s[5 * 33]); o.w = cvt_pk_bf16(s[6 * 33], s[7 * 33]);
        *(u32x4*)(t.WT + (size_t)(t.n0 + n) * t.ldw + t.k0 + 8 * c) = o; }
    LDS_WAIT();
}
DI void rms_row_bf16(const float* xrow, const float* g, bf16_t* orow, int lane) {
    const f32x4* xr = (const f32x4*)xrow + lane; const f32x4* gr = (const f32x4*)g + lane;
    f32x4 v[8]; float s = 0.f;
#pragma unroll
    for (int j = 0; j < 8; ++j) { v[j] = xr[64 * j]; s += (v[j].x * v[j].x + v[j].y * v[j].y) + (v[j].z * v[j].z + v[j].w * v[j].w); }
    const float rstd = rsqrtf(wave_sum(s) * (1.f / 2048.f) + 1e-6f);
    u32x2* o8 = (u32x2*)orow + lane;
#pragma unroll
    for (int j = 0; j < 8; ++j) { const f32x4 gg = gr[64 * j]; o8[64 * j] = cvt4(v[j] * rstd * gg); }
}

constexpr int NT_IN = 32 * 260, NT_OA = 16 * 64, NT_O = 32 * 64, NT_MQ = 32 * 16, NT_MKV = 32 * 32, NT_MO = 8 * 64, NT_UP = 32 * 352, NT_DN = 88 * 64, NT_C1 = 32 * 8;
constexpr int N_PG = 32 * NPAGES, N_BP = 128, N_WC = 32 * 508;
constexpr int NT_ALL = NT_UP + NT_IN + NT_DN + NT_O + 2 * NT_OA + NT_MQ + NT_MKV + NT_MO + 2 * NT_C1;
constexpr int PI_REST = TT + 512 + 2 * N_PG + N_BP + N_WC;
constexpr int NT_FIRST = NT_IN + NT_MKV + 2 * NT_C1;
DI TrItem tr_decode(const Args& a, int tix) {
    unsigned char* ws = a.ws; int r = tix; const float* W; bf16_t* WT; int K, N, ldw;
    if (r < NT_IN) { W = (const float*)a.in[I_WIN]; K = DM; N = DIN; WT = (bf16_t*)(ws + WS_BT_IN); ldw = K; }
    else if ((r -= NT_IN) < NT_MKV) { W = (const float*)a.in[I_WMKV]; K = DM; N = 1024; WT = (bf16_t*)(ws + WS_BT_MKV); ldw = K; }
    else if ((r -= NT_MKV) < NT_C1) { W = (const float*)a.in[I_CW1]; K = 2048; N = 256; WT = (bf16_t*)(ws + WS_BT_C1); ldw = K; }
    else if ((r -= NT_C1) < NT_C1) { W = (const float*)a.in[I_CW1] + (size_t)2048 * 256; K = 2048; N = 256; WT = (bf16_t*)(ws + WS_BT_C1) + (size_t)256 * 2048; ldw = K; }
    else if ((r -= NT_C1) < NT_UP) { W = (const float*)a.in[I_WUP]; K = DM; N = DFF2; WT = (bf16_t*)(ws + WS_BT_UP); ldw = K; }
    else if ((r -= NT_UP) < NT_DN) { W = (const float*)a.in[I_WDN]; K = DFF; N = DM; WT = (bf16_t*)(ws + WS_BT_DN); ldw = K; }
    else if ((r -= NT_DN) < NT_O) { W = (const float*)a.in[I_WO]; K = DM; N = DM; WT = (bf16_t*)(ws + WS_BT_O); ldw = K; }
    else if ((r -= NT_O) < NT_OA) { W = (const float*)a.in[I_WOA]; K = 1024; N = DM; WT = (bf16_t*)(ws + WS_BT_OA); ldw = 2048; }
    else if ((r -= NT_OA) < NT_OA) { W = (const float*)a.in[I_WOB]; K = 1024; N = DM; WT = (bf16_t*)(ws + WS_BT_OA) + 1024; ldw = 2048; }
    else if ((r -= NT_OA) < NT_MQ) { W = (const float*)a.in[I_WMQ]; K = DM; N = 512; WT = (bf16_t*)(ws + WS_BT_MQ); ldw = K; }
    else { r -= NT_MQ; W = (const float*)a.in[I_WMO]; K = 512; N = DM; WT = (bf16_t*)(ws + WS_BT_MO); ldw = K; }
    const int nblk = N / 32; TrItem t; t.W = W; t.WT = WT; t.N = N; t.ldw = ldw; t.k0 = 64 * (r / nblk); t.n0 = 32 * (r % nblk); return t;
}
DI void tr_fill(const Args& a, LAS unsigned char* lds, unsigned* ctr, int lo, int hi) {
    const int tid = threadIdx.x, lane = tid & 63, wave = __builtin_amdgcn_readfirstlane(tid >> 6);
    LAS float* scr = (LAS float*)(lds + wave * 16384);
    unsigned* sctr = ctr + 64 * (blockIdx.x & 31);
#define TRQ() ({ int v_ = 0; if (lane == 0) v_ = (int)__hip_atomic_fetch_add(sctr, 1u, __ATOMIC_RELAXED, __HIP_MEMORY_SCOPE_AGENT); lo + (int)(blockIdx.x & 31) + 32 * __builtin_amdgcn_readfirstlane(v_); })
    int i0 = TRQ(); if (i0 >= hi) return;
    float va[32], vb[32]; TrItem ta = tr_decode(a, i0), tb = ta; tr_load(ta, lane, va);
#pragma unroll 1
    for (;;) {
        const int i1 = TRQ(); const bool h1 = i1 < hi; if (h1) { tb = tr_decode(a, i1); tr_load(tb, lane, vb); }
        tr_store(ta, scr, lane, va);
        if (!h1) break;
        const int i2 = TRQ(); const bool h2 = i2 < hi; if (h2) { ta = tr_decode(a, i2); tr_load(ta, lane, va); }
        tr_store(tb, scr, lane, vb);
        if (!h2) break;
    }
#undef TRQ
}
DI void prologue_item(const Args& a, LAS float* scr, int lane, int it) {
    unsigned char* ws = a.ws; int r = it;
    if (r < TT) {
        const float* xrow = r < TP ? (const float*)a.in[I_XP] + (size_t)r * DM : (const float*)a.in[I_XS] + (size_t)(r - TP) * DM;
        rms_row_bf16(xrow, (const float*)a.in[I_NG], (bf16_t*)(ws + WS_XN) + (size_t)r * DM, lane); return; } r -= TT;
    if (r < 512) { rms_row_bf16((const float*)a.in[I_MEM] + (size_t)r * DM, (const float*)a.in[I_NG] + 2 * DM, (bf16_t*)(ws + WS_MEMN) + (size_t)r * DM, lane); return; } r -= 512;
    if (r < N_PG) {
        const int db = r >> 6, pj = r & 63; const int page = ((const int*)a.in[I_PT])[db * NPAGES + pj];
        const float* src = (const float*)a.in[I_CNSA] + (size_t)page * 128 * 512;
        bf16_t* dst = (bf16_t*)(ws + WS_KCRAW) + KCS_OFF;
        const int c = lane >> 5, g = (lane >> 4) & 1, d0 = (lane & 15) * 4;
        bf16_t* drow = dst + ((size_t)((db * 2 + c) * 2 + g) * 8192 + pj * 128) * 64 + d0;
#pragma unroll 16
        for (int s = 0; s < 128; ++s) { const f32x4 v = *(const f32x4*)(src + (size_t)s * 512 + lane * 4); *(u32x2*)(drow + (size_t)s * 64) = cvt4(v); }
        return; } r -= N_PG;
    if (r < N_PG) {
        const int db = r >> 6, pj = r & 63; const int page = ((const int*)a.in[I_PT])[db * NPAGES + pj];
        const float* src = (const float*)a.in[I_CDSA] + (size_t)page * 128 * 320 + 256;
        bf16_t* dst = (bf16_t*)(ws + WS_KIFS) + ((size_t)db * 513 + pj * 8) * 1024;
        const int sl = lane >> 4, d0 = (lane & 15) * 4;
#pragma unroll 16
        for (int i = 0; i < 32; ++i) { const int slot = 4 * i + sl; const f32x4 v = *(const f32x4*)(src + (size_t)slot * 320 + d0);
            *(u32x2*)(dst + ((size_t)(slot >> 4) * 2 + (d0 >> 5)) * 512 + (((d0 >> 3) & 3) * 16 + (slot & 15)) * 8 + ((d0 >> 2) & 1) * 4) = cvt4(v); }
        return; } r -= N_PG;
    if (r < N_BP) {
        const int kv = r >> 6, nch = (r >> 4) & 3, kch = r & 15, n = nch * 64 + lane;
        const float* pe = (const float*)a.in[I_PE] + (size_t)kv * 2048 + kch * 128; const float* w1 = (const float*)a.in[I_CW1] + ((size_t)kv * 2048 + kch * 128) * 256 + n;
        float acc = 0.f;
#pragma unroll 8
        for (int k = 0; k < 128; ++k) acc += pe[k] * w1[(size_t)k * 256];
        ((float*)(ws + WS_BPART))[(kch * 2 + kv) * 256 + n] = acc; return; } r -= N_BP;
    {
        const int db = r / 508, j = r % 508;
        const f32x4 v = *((const f32x4*)((const float*)a.in[I_SWIN] + ((size_t)db * 512 + j + 4) * 256) + lane);
        *((f32x4*)(a.out + O_WINS + ((size_t)db * 512 + j) * 256) + lane) = v; }
}
DI void tr_strided(const Args& a, LAS float* scr, int lane, int lo, int hi, int widx, int nw) {
    if (lo + widx >= hi) return;
    float va[32], vb[32]; TrItem ta = tr_decode(a, lo + widx), tb = ta; tr_load(ta, lane, va);
#pragma unroll 1
    for (int tix = lo + widx; tix < hi; tix += 2 * nw) {
        const bool h1 = tix + nw < hi; if (h1) { tb = tr_decode(a, tix + nw); tr_load(tb, lane, vb); }
        tr_store(ta, scr, lane, va);
        if (!h1) break;
        const bool h2 = tix + 2 * nw < hi; if (h2) { ta = tr_decode(a, tix + 2 * nw); tr_load(ta, lane, va); }
        tr_store(tb, scr, lane, vb);
    }
}
DI void phase0(const Args& a, LAS unsigned char* lds, int pm = 3, int r0 = 0, int r1 = PI_REST) {
    const int tid = threadIdx.x, lane = tid & 63, wave = __builtin_amdgcn_readfirstlane(tid >> 6);
    const int gw = blockIdx.x * NWAVES + wave, NGW = gridDim.x * NWAVES;
    LAS float* scr = (LAS float*)(lds + wave * 16384);
    unsigned char* ws = a.ws;
    if (pm & 1) tr_strided(a, scr, lane, 0, NT_FIRST, gw, NGW);
    if (pm & 2) {
#pragma unroll 1
        for (int it = r0 + gw; it < r1; it += NGW) prologue_item(a, scr, lane, it); }
    { const size_t gt = (size_t)blockIdx.x * NTHR + tid, NG = (size_t)gridDim.x * NTHR; const u32x4 z = (u32x4){0u, 0u, 0u, 0u};
      u32x4* p1 = (u32x4*)((bf16_t*)(ws + WS_BT_IN) + (size_t)DIN * DM); u32x4* p2 = (u32x4*)((bf16_t*)(ws + WS_XN) + (size_t)TT * DM);
      for (size_t i = gt; i < (size_t)128 * DM / 8; i += NG) { p1[i] = z; p2[i] = z; }
      float* ss = (float*)(ws + WS_SS); for (size_t i = gt; i < (size_t)2 * TP; i += NG) ss[i] = 0.f; }
}

DI f32x4 rope4(f32x4 v, f32x4 pv, int d0, int half, int tb, float cv, float sv) {
    const int fi = tb + (d0 & (half - 1));
    f32x4 c, s;
    c.x = __shfl(cv, fi); c.y = __shfl(cv, fi + 1); c.z = __shfl(cv, fi + 2); c.w = __shfl(cv, fi + 3);
    s.x = __shfl(sv, fi); s.y = __shfl(sv, fi + 1); s.z = __shfl(sv, fi + 2); s.w = __shfl(sv, fi + 3);
    const f32x4 lo = v * c - pv * s, hi = v * c + pv * s;
    return d0 < half ? lo : (d0 < 2 * half ? hi : v);
}
DI f32x4 ldbf4p(const bf16_t* p) { const u32x2 w = *(const u32x2*)p; f32x4 r; r.x = __uint_as_float(w.x << 16); r.y = __uint_as_float(w.x & 0xffff0000u); r.z = __uint_as_float(w.y << 16); r.w = __uint_as_float(w.y & 0xffff0000u); return r; }
DI f32x4 sig4(f32x4 v) { f32x4 r; r.x = sigmoidf_(v.x); r.y = sigmoidf_(v.y); r.z = sigmoidf_(v.z); r.w = sigmoidf_(v.w); return r; }

DI void phase2(const Args& a, LAS unsigned char* lds) {
    const int tid = threadIdx.x, lane = tid & 63, wave = __builtin_amdgcn_readfirstlane(tid >> 6);
    const int gw = blockIdx.x * NWAVES + wave, NGW = gridDim.x * NWAVES;
    unsigned char* ws = a.ws; float* out = a.out;
    const bf16_t* P = (const bf16_t*)(ws + WS_P);
    bf16_t* QC = (bf16_t*)(ws + WS_QC); bf16_t* QR = (bf16_t*)(ws + WS_QR); bf16_t* QB = (bf16_t*)(ws + WS_QB); bf16_t* QI = (bf16_t*)(ws + WS_QI);
    float* GN = (float*)(ws + WS_GN); float* WI = (float*)(ws + WS_WI); bf16_t* GAB = (bf16_t*)(ws + WS_GAB); float* KW = (float*)(ws + WS_KW);
    bf16_t* KCP = (bf16_t*)(ws + WS_KCRAW); bf16_t* NSAF = (bf16_t*)(ws + WS_NSAF);
    if (gw == 0) {
        for (int i = lane; i < 512; i += 64) { float s = ((const float*)a.in[I_CB1])[i];
            for (int k = 0; k < 16; ++k) s += ((const float*)(ws + WS_BPART))[k * 512 + i];
            ((float*)(ws + WS_BIASC))[i] = s; }
    }
    for (int r = gw; r < TT; r += NGW) {
        const bool pr = r < TP; const int b = r >> 12, s = r & 4095, q = r - TP, db = q >> 2, tt = q & 3;
        const int pos = pr ? s : 8192 + tt;
        float cv, sv; { const float e = lane < 8 ? -(float)lane / 8.f : -(float)((lane - 8) & 15) / 16.f; const float inv = powf(500000.f, e); const float ang = (float)pos * inv; cv = cosf(ang); sv = sinf(ang); }
        const bf16_t* Pr = P + (size_t)r * DINP;
        f32x4 L_qa[4], L_kva[3], L_qb[4], L_qi[4], L_gm[16];
#pragma unroll
        for (int i = 0; i < 4; ++i) { L_qa[i] = ldbf4p(Pr + C_QA + 256 * i + 4 * lane); L_qb[i] = ldbf4p(Pr + C_QB + 256 * i + 4 * lane); L_qi[i] = ldbf4p(Pr + C_QI + 256 * i + 4 * lane); }
#pragma unroll
        for (int i = 0; i < 3; ++i) L_kva[i] = ldbf4p(Pr + C_KVA + 256 * i + 4 * lane);
#pragma unroll
        for (int i = 0; i < 16; ++i) L_gm[i] = ldbf4p(Pr + C_GM + 256 * i + 4 * lane);
        const f32x4 L_ga = lane < 12 ? ldbf4p(Pr + C_GA + 4 * lane) : (f32x4){0.f, 0.f, 0.f, 0.f};
        const f32x4 L_kvb = ldbf4p(Pr + C_KVB + 4 * lane);
        const f32x4 L_ki = lane < 16 ? ldbf4p(Pr + C_KI + 4 * lane) : (f32x4){0.f, 0.f, 0.f, 0.f};
        const f32x4 L_wi = lane < 4 ? ldbf4p(Pr + C_WI + 4 * lane) : (f32x4){0.f, 0.f, 0.f, 0.f};
#pragma unroll
        for (int i = 0; i < 4; ++i) { const int col = 256 * i + 4 * lane; const f32x4 v = L_qa[i]; const f32x4 pv = shfl_xor4(v, 2);
            const f32x4 rv = rope4(v, pv, (4 * lane) & 63, 8, 0, cv, sv);
            *(u32x2*)(QC + (size_t)r * 1024 + col) = cvt4(v); *(u32x2*)(QR + (size_t)r * 1024 + col) = cvt4(rv); }
#pragma unroll
        for (int i = 0; i < 3; ++i) { const int cl = 256 * i + 4 * lane; const f32x4 v = L_kva[i]; const f32x4 pv = shfl_xor4(v, 2);
            const int j = cl >> 7, g = (cl >> 6) & 1, d0 = cl & 63;
            const f32x4 rv = rope4(v, pv, d0, 8, 0, cv, sv); const f32x4 o = (j == 2 || j == 4) ? rv : v;
            if (pr && j >= 2) {
                bf16_t* tile = NSAF + ((size_t)((b * 2 + g) * 128 + (s >> 5)) * 4 + (j - 2)) * 2048; const int slot = s & 31;
                if ((j & 1) == 0) { *(u32x2*)(tile + (((d0 >> 5) * 2 + (slot >> 4)) * 64 + ((d0 >> 3) & 3) * 16 + (slot & 15)) * 8 + ((d0 >> 2) & 1) * 4) = cvt4(o); }
                else { const int kgv = (slot & 15) >> 2, jv = (slot & 3) + ((slot >> 4) << 2); const u32x2 w = cvt4(o);
                    bf16_t* t0 = tile + (((d0 >> 4) * 64 + kgv * 16 + (d0 & 15)) * 8) + jv;
                    t0[0] = (bf16_t)(w.x & 0xffffu); t0[8] = (bf16_t)(w.x >> 16); t0[16] = (bf16_t)(w.y & 0xffffu); t0[24] = (bf16_t)(w.y >> 16); }
            }
            if (j < 4) {
                float* dst = pr ? out + O_NSAP + ((size_t)r * 4 + j) * 128 + g * 64 + d0 : out + O_NSAS + ((size_t)q * 4 + j) * 128 + g * 64 + d0;
                *(f32x4*)dst = o;
                if (pr && j < 2) *(u32x2*)(KCP + ((size_t)((b * 2 + j) * 2 + g) * KCP_ROWS + s) * 64 + d0) = cvt4(o);
            } else {
                const int kv = j - 4;
                *(f32x4*)(KW + (size_t)r * 256 + kv * 128 + g * 64 + d0) = o;
                if (pr) { if (s >= SEQ - 512) *(f32x4*)(out + O_WINP + (((size_t)b * 512 + s - (SEQ - 512)) * 2 + kv) * 128 + g * 64 + d0) = o; }
                else *(f32x4*)(out + O_WINS + (((size_t)db * 512 + 508 + tt) * 2 + kv) * 128 + g * 64 + d0) = o;
            } }
        if (lane < 12) { const f32x4 v = L_ga; *(f32x4*)(GN + (size_t)r * 48 + 4 * lane) = sig4(v); }
#pragma unroll
        for (int i = 0; i < 4; ++i) { const int col = 256 * i + 4 * lane; const f32x4 v = L_qb[i]; const f32x4 pv = shfl_xor4(v, 4);
            const f32x4 rv = rope4(v, pv, (4 * lane) & 127, 16, 8, cv, sv);
            *(u32x2*)(QB + (size_t)r * 1024 + col) = cvt4(rv); }
        { const int cl = 4 * lane; const f32x4 v = L_kvb; const f32x4 pv = shfl_xor4(v, 4);
          const f32x4 rv = rope4(v, pv, cl & 127, 16, 8, cv, sv); const f32x4 o = cl < 128 ? rv : v;
          float* dst = pr ? out + O_DSAP + (size_t)r * 320 + cl : out + O_DSAS + (size_t)q * 320 + cl; *(f32x4*)dst = o;
          if (pr) *(u32x2*)((bf16_t*)(ws + WS_DSAB) + (size_t)r * 256 + cl) = cvt4(o); }
#pragma unroll
        for (int i = 0; i < 4; ++i) { const int col = 256 * i + 4 * lane; const f32x4 v = L_qi[i]; const f32x4 pv = shfl_xor4(v, 2);
            const f32x4 rv = rope4(v, pv, (4 * lane) & 63, 8, 0, cv, sv);
            *(u32x2*)(QI + (size_t)r * 1024 + col) = cvt4(rv); }
        { const f32x4 v = L_ki; const f32x4 pv = shfl_xor4(v, 2);
          const f32x4 rv = rope4(v, pv, (4 * lane) & 63, 8, 0, cv, sv);
          if (lane < 16) { float* dst = pr ? out + O_DSAP + (size_t)r * 320 + 256 + 4 * lane : out + O_DSAS + (size_t)q * 320 + 256 + 4 * lane; *(f32x4*)dst = rv;
              const int d0 = 4 * lane;
              if (pr) *(u32x2*)((bf16_t*)(ws + WS_KIF) + ((size_t)(b * 256 + (s >> 4)) * 2 + (d0 >> 5)) * 512 + (((d0 >> 3) & 3) * 16 + (s & 15)) * 8 + ((d0 >> 2) & 1) * 4) = cvt4(rv);
              else *(u32x2*)((bf16_t*)(ws + WS_KIFS) + ((size_t)(db * 513 + 512) * 2 + (d0 >> 5)) * 512 + (((d0 >> 3) & 3) * 16 + tt) * 8 + ((d0 >> 2) & 1) * 4) = cvt4(rv); }
          if (lane < 4) *(f32x4*)(WI + (size_t)r * 16 + 4 * lane) = L_wi; }
#pragma unroll
        for (int i = 0; i < 16; ++i) { const int col = 256 * i + 4 * lane; const f32x4 v = L_gm[i]; *(u32x2*)(GAB + (size_t)r * 4096 + col) = cvt4(sig4(v)); }
    }
}
struct P1Order { pg8::StaticOrder so;
    DI bool next(int i, pg8::Unit& u) const { const long L = (long)i * so.G + so.c; if (L < so.nwg) return so.at(L, u); const int j = (int)(L - so.nwg); if (j >= 8) return false; u.pm = j >> 2; u.pn = j & 3; u.ks = 1; return true; }
    DI size_t offA(const pg8::Unit& u) const { return (size_t)u.pm * 256 * DM * 2 + (u.ks ? (WS_MEMN - WS_XN) : 0); }
    DI size_t offB(const pg8::Unit& u) const { return (size_t)u.pn * 256 * DM * 2 + (u.ks ? (WS_BT_MKV - WS_BT_IN) : 0); }
    DI int ktiles(const pg8::Unit&, int K) const { return K; }
};
struct FP1 { bf16_t* P; float* memkv; DI void operator()(const pg8::Unit& u, int row, int col, f32x4 v) const {
    if (u.ks) *(f32x4*)(memkv + (size_t)(u.pm * 256 + row) * 1024 + u.pn * 256 + col) = v; else *(u32x2*)(P + (size_t)(u.pm * 256 + row) * DINP + u.pn * 256 + col) = cvt4(v); } };
DI void phase1(const Args& a, LAS unsigned char* lds) {
    unsigned char* ws = a.ws;
    pg8::Gemm g{(const bf16_t*)(ws + WS_XN), (const bf16_t*)(ws + WS_BT_IN), DM, DM, DM};
    P1Order S; S.so.init(MP / 256, DINP / 256, gridDim.x, blockIdx.x, DM, DM);
    pg8::EpiEach<FP1> E{FP1{(bf16_t*)(ws + WS_P), a.out + O_MEMP}};
    pg8::gemm_phase(lds, g, S, E);
}
struct CmpOrder { int G, c;
    DI bool next(int i, pg8::Unit& u) const { const int L = i * G + c; if (L >= 264) return false; u.pn = L / 132; u.pm = L % 132; u.ks = 0; return true; }
    DI size_t offA(const pg8::Unit& u) const { const int rt = u.pm, kv = u.pn; size_t e;
        if (rt < 4) { const int b = rt >> 1, g = rt & 1; e = (size_t)((b * 2 + kv) * 2 + g) * KCP_ROWS * 64; }
        else { const int s = rt - 4, db = s >> 2, g = (s >> 1) & 1, half = s & 1; e = KCS_OFF + ((size_t)((db * 2 + kv) * 2 + g) * 8192 + half * 4096) * 64; }
        return e * 2; }
    DI size_t offB(const pg8::Unit& u) const { return (size_t)u.pn * 256 * 2048 * 2; }
    DI int ktiles(const pg8::Unit&, int K) const { return K; }
};
DI float gelu_tanh(float x) { const float u = 0.7978845608028654f * (x + 0.044715f * x * x * x); const float t = 1.f - 2.f / (1.f + __expf(2.f * u)); return 0.5f * x * (1.f + t); }
struct FCmpH { const float* biasc; bf16_t* HC;
    DI void operator()(const pg8::Unit& u, int row, int col, f32x4 v) const { const f32x4 bb = *(const f32x4*)(biasc + u.pn * 256 + col); f32x4 x = v + bb;
        x.x = gelu_tanh(x.x); x.y = gelu_tanh(x.y); x.z = gelu_tanh(x.z); x.w = gelu_tanh(x.w);
        *(u32x2*)(HC + ((size_t)(u.pn * 132 + u.pm) * 256 + row) * 256 + col) = cvt4(x); } };
DI void phase3(const Args& a, LAS unsigned char* lds) {
    unsigned char* ws = a.ws;
    pg8::Gemm g{(const bf16_t*)(ws + WS_KCRAW), (const bf16_t*)(ws + WS_BT_C1), 1024, 2048, 2048};
    CmpOrder S{(int)gridDim.x, (int)blockIdx.x};
    pg8::EpiEach<FCmpH> E{FCmpH{(const float*)(ws + WS_BIASC), (bf16_t*)(ws + WS_HC)}};
    pg8::gemm_phase(lds, g, S, E);
    if (blockIdx.x >= 8) { const int wave = __builtin_amdgcn_readfirstlane(threadIdx.x >> 6);
        tr_strided(a, (LAS float*)(lds + wave * 16384), threadIdx.x & 63, NT_FIRST, NT_ALL, (blockIdx.x - 8) * NWAVES + wave, (gridDim.x - 8) * NWAVES); }
}
DI void phase4(const Args& a, LAS unsigned char* lds) {
    const int tid = threadIdx.x, lane = tid & 63, wave = __builtin_amdgcn_readfirstlane(tid >> 6);
    const int gw = blockIdx.x * NWAVES + wave, NGW = gridDim.x * NWAVES;
    unsigned char* ws = a.ws;
    LAS bf16_t* W2T = (LAS bf16_t*)lds;
    const float* w2 = (const float*)a.in[I_CW2];
    for (int idx = tid; idx < 2 * 256 * 64; idx += NTHR) { const int kv = idx >> 14, k = (idx >> 6) & 255, n = idx & 63; W2T[(kv * 64 + n) * 264 + k] = (bf16_t)(cvt_pk_bf16(w2[idx], 0.f) & 0xffffu); }
    __syncthreads();
    const bf16_t* HC = (const bf16_t*)(ws + WS_HC); bf16_t* KCF = (bf16_t*)(ws + WS_KCF);
    const int kg = lane >> 4, c16 = lane & 15;
    constexpr int NIT = 2 * HC_ROWS / 16;
    for (int it = gw; it < NIT; it += NGW) {
        const int kv = it / (HC_ROWS / 16), row0 = (it % (HC_ROWS / 16)) * 16;
        f32x4 acc[4];
#pragma unroll
        for (int nt = 0; nt < 4; ++nt) acc[nt] = (f32x4){0.f, 0.f, 0.f, 0.f};
#pragma unroll
        for (int ks = 0; ks < 8; ++ks) {
            const bf16x8 bfr = *(const bf16x8*)(HC + ((size_t)kv * HC_ROWS + row0 + c16) * 256 + 32 * ks + 8 * kg);
#pragma unroll
            for (int nt = 0; nt < 4; ++nt) { const bf16x8 afr = *(const LAS bf16x8*)(W2T + (kv * 64 + 16 * nt + c16) * 264 + 32 * ks + 8 * kg); acc[nt] = MFMA16(afr, bfr, acc[nt]); }
        }
        const int R = row0 + c16, rt = R >> 8, iin = R & 255; int seq, g, blk;
        if (rt < 4) { seq = rt >> 1; g = rt & 1; blk = iin; } else { const int s = rt - 4; seq = 2 + (s >> 2); g = (s >> 1) & 1; blk = (s & 1) * 256 + iin; }
        bf16_t* tile = KCF + ((size_t)(seq * 2 + g) * 16 + (blk >> 5)) * 4096; const int slot = blk & 31;
        if (kv == 0) {
#pragma unroll
            for (int nt = 0; nt < 4; ++nt) { const int d0 = 16 * nt + 4 * kg; *(u32x2*)(tile + (((d0 >> 5) * 2 + (slot >> 4)) * 64 + ((d0 >> 3) & 3) * 16 + (slot & 15)) * 8 + ((d0 >> 2) & 1) * 4) = cvt4(acc[nt]); }
        } else {
            const int kgv = (slot & 15) >> 2, jv = (slot & 3) + ((slot >> 4) << 2);
#pragma unroll
            for (int nt = 0; nt < 4; ++nt) { const u32x2 w = cvt4(acc[nt]); bf16_t* t0 = tile + 2048 + ((nt * 64 + kgv * 16 + 4 * kg) * 8) + jv;
                t0[0] = (bf16_t)(w.x & 0xffffu); t0[8] = (bf16_t)(w.x >> 16); t0[16] = (bf16_t)(w.y & 0xffffu); t0[24] = (bf16_t)(w.y >> 16); }
        }
    }
}

constexpr int DSA_LSTRIDE = 528, DSA_WL = 32 * DSA_LSTRIDE + 1024 + 256;
struct RowInfo { bool pr; int b, db, pos, seq; };
DI RowInfo rowinfo(int r) { RowInfo ri; ri.pr = r < TP; const int q = r - TP; ri.b = r >> 12; ri.db = q >> 2; ri.pos = ri.pr ? (r & 4095) : 8192 + (q & 3); ri.seq = ri.pr ? ri.b : 2 + ri.db; return ri; }
DI float xmax16(float x) { const auto r = __builtin_amdgcn_permlane16_swap(__float_as_uint(x), __float_as_uint(x), false, false); return fmaxf(__uint_as_float(r[0]), __uint_as_float(r[1])); }
DI float xmax32(float x) { const auto r = __builtin_amdgcn_permlane32_swap(__float_as_uint(x), __float_as_uint(x), false, false); return fmaxf(__uint_as_float(r[0]), __uint_as_float(r[1])); }
DI float xsum16(float x) { const auto r = __builtin_amdgcn_permlane16_swap(__float_as_uint(x), __float_as_uint(x), false, false); return __uint_as_float(r[0]) + __uint_as_float(r[1]); }
DI float xsum32(float x) { const auto r = __builtin_amdgcn_permlane32_swap(__float_as_uint(x), __float_as_uint(x), false, false); return __uint_as_float(r[0]) + __uint_as_float(r[1]); }
template <int CTRL> DI float dppf(float x) { return __int_as_float(__builtin_amdgcn_update_dpp(0, __float_as_int(x), CTRL, 0xF, 0xF, true)); }
DI float sum8(float x) { x += dppf<0xB1>(x); x += dppf<0x4E>(x); x += dppf<0x141>(x); return x; }
DI float sum16r(float x) { x = sum8(x); x += dppf<0x140>(x); return x; }
DI int q_next(unsigned* ctr, int lane) { int v = 0; if (lane == 0) v = (int)__hip_atomic_fetch_add(ctr, 1u, __ATOMIC_RELAXED, __HIP_MEMORY_SCOPE_AGENT); return __builtin_amdgcn_readfirstlane(v); }
constexpr int QSH = 32;
DI int qs_next(unsigned* ctr, int lane) { const int sh = blockIdx.x & (QSH - 1); return sh + QSH * q_next(ctr + 64 * sh, lane); }

template <int D> struct Flash { f32x4 o[D / 16]; float m, l; };
template <int D> DI void flash_init(Flash<D>& f) {
#pragma unroll
    for (int i = 0; i < D / 16; ++i) f.o[i] = (f32x4){0.f, 0.f, 0.f, 0.f};
    f.m = -INFINITY; f.l = 0.f; }
template <int D> DI float flash_linv(const Flash<D>& f) { return 1.f / fmaxf(xsum32(xsum16(f.l)), 1e-30f); }
DI bf16x8 ldk8(const float* p) { return cvt8(*(const f32x4*)p, *(const f32x4*)(p + 4)); }
DI int kslot(int kg, int j) { return j < 4 ? 4 * kg + j : 16 + 4 * kg + (j - 4); }
constexpr float LOG2E = 1.4426950408889634f;
DI float max8(const float (&v)[8]) { return fmaxf(fmaxf(fmaxf(v[0], v[1]), fmaxf(v[2], v[3])), fmaxf(fmaxf(v[4], v[5]), fmaxf(v[6], v[7]))); }
template <int D> DI void flash_rebase(Flash<D>& f, float mx) {
    mx = xmax32(xmax16(mx));
    const float mnew = fmaxf(f.m, mx), msafe = (mnew == -INFINITY) ? 0.f : mnew, alpha = __builtin_amdgcn_exp2f(f.m - msafe);
    f.l *= alpha; f.m = mnew;
#pragma unroll
    for (int dt = 0; dt < D / 16; ++dt) f.o[dt] *= alpha;
}
DI bf16x8 pack_p(const float (&p)[8]) { u32x4 w; w.x = cvt_pk_bf16(p[0], p[1]); w.y = cvt_pk_bf16(p[2], p[3]); w.z = cvt_pk_bf16(p[4], p[5]); w.w = cvt_pk_bf16(p[6], p[7]); return __builtin_bit_cast(bf16x8, w); }
template <int D> DI bf16x8 flash_update(Flash<D>& f, const float (&t)[8]) {
    const float mx = max8(t);
    if (!__all(mx <= f.m + 11.5f)) flash_rebase<D>(f, mx);
    const float mref = (f.m == -INFINITY) ? 0.f : f.m;
    float p[8], sum = 0.f;
#pragma unroll
    for (int e = 0; e < 8; ++e) { p[e] = __builtin_amdgcn_exp2f(t[e] - mref); sum += p[e]; }
    f.l += sum;
    return pack_p(p);
}
template <int D> DI bf16x8 flash_update_full(Flash<D>& f, const f32x4& s0, const f32x4& s1, float c) {
    const float r[8] = {s0[0], s0[1], s0[2], s0[3], s1[0], s1[1], s1[2], s1[3]};
    const float mx = max8(r) * c;
    if (!__all(mx <= f.m + 11.5f)) flash_rebase<D>(f, mx);
    const float nm = -f.m;
    float p[8], sum = 0.f;
#pragma unroll
    for (int e = 0; e < 8; ++e) { p[e] = __builtin_amdgcn_exp2f(fmaf(r[e], c, nm)); sum += p[e]; }
    f.l += sum;
    return pack_p(p);
}
template <int D> DI void flash_step(Flash<D>& f, const bf16x8 (&qf)[D / 32], const float* kp0, const float* kp1, const float* const (&vp)[8], unsigned okm, float c, int lane) {
    const int kg = lane >> 4, c16 = lane & 15;
    f32x4 s0 = (f32x4){0.f, 0.f, 0.f, 0.f}, s1 = s0;
#pragma unroll
    for (int ks = 0; ks < D / 32; ++ks) { const bf16x8 a0 = ldk8(kp0 + 32 * ks + 8 * kg), a1 = ldk8(kp1 + 32 * ks + 8 * kg); s0 = MFMA16(a0, qf[ks], s0); s1 = MFMA16(a1, qf[ks], s1); }
    float v[8];
#pragma unroll
    for (int j = 0; j < 4; ++j) { v[j] = ((okm >> j) & 1u) ? s0[j] * c : -INFINITY; v[4 + j] = ((okm >> (4 + j)) & 1u) ? s1[j] * c : -INFINITY; }
    const bf16x8 pb = flash_update<D>(f, v);
#pragma unroll
    for (int dt = 0; dt < D / 16; ++dt) {
        float x[8];
#pragma unroll
        for (int j = 0; j < 8; ++j) x[j] = vp[j][16 * dt + c16];
        u32x4 aw; aw.x = cvt_pk_bf16(x[0], x[1]); aw.y = cvt_pk_bf16(x[2], x[3]); aw.z = cvt_pk_bf16(x[4], x[5]); aw.w = cvt_pk_bf16(x[6], x[7]);
        f.o[dt] = MFMA16(__builtin_bit_cast(bf16x8, aw), pb, f.o[dt]);
    }
}
struct Tile64 { bf16x8 k[4]; bf16x8 v[4]; };
DI void load_tile64(Tile64& t, const bf16_t* kt, const bf16_t* vt, int lane) {
#pragma unroll
    for (int i = 0; i < 4; ++i) t.k[i] = *(const bf16x8*)(kt + (i * 64 + lane) * 8);
#pragma unroll
    for (int i = 0; i < 4; ++i) t.v[i] = *(const bf16x8*)(vt + (i * 64 + lane) * 8);
}
DI void flash_tile64(Flash<64>& f, const bf16x8 (&qf)[2], const Tile64& t, bool full, unsigned okm, float c) {
    f32x4 s0 = (f32x4){0.f, 0.f, 0.f, 0.f}, s1 = s0;
#pragma unroll
    for (int ks = 0; ks < 2; ++ks) { s0 = MFMA16(t.k[ks * 2], qf[ks], s0); s1 = MFMA16(t.k[ks * 2 + 1], qf[ks], s1); }
    bf16x8 pb;
    if (full) pb = flash_update_full<64>(f, s0, s1, c);
    else { float v[8];
#pragma unroll
        for (int j = 0; j < 4; ++j) { v[j] = ((okm >> j) & 1u) ? s0[j] * c : -INFINITY; v[4 + j] = ((okm >> (4 + j)) & 1u) ? s1[j] * c : -INFINITY; }
        pb = flash_update<64>(f, v); }
#pragma unroll
    for (int dt = 0; dt < 4; ++dt) f.o[dt] = MFMA16(t.v[dt], pb, f.o[dt]);
}

template <int OFF> DI void tr_read4(unsigned alo, unsigned ahi, u32x2 (&l)[4], u32x2 (&h)[4]) {
    asm volatile("ds_read_b64_tr_b16 %0, %8 offset:%10\n\tds_read_b64_tr_b16 %1, %9 offset:%10\n\tds_read_b64_tr_b16 %2, %8 offset:%11\n\tds_read_b64_tr_b16 %3, %9 offset:%11\n\t"
                 "ds_read_b64_tr_b16 %4, %8 offset:%12\n\tds_read_b64_tr_b16 %5, %9 offset:%12\n\tds_read_b64_tr_b16 %6, %8 offset:%13\n\tds_read_b64_tr_b16 %7, %9 offset:%13\n\ts_waitcnt lgkmcnt(0)"
                 : "=&v"(l[0]), "=&v"(h[0]), "=&v"(l[1]), "=&v"(h[1]), "=&v"(l[2]), "=&v"(h[2]), "=&v"(l[3]), "=&v"(h[3])
                 : "v"(alo), "v"(ahi), "i"(OFF), "i"(OFF + 32), "i"(OFF + 64), "i"(OFF + 96) : "memory");
}
template <int D> DI void lds_step(Flash<D>& f, const bf16x8 (&qf)[D / 32], LAS unsigned char* wl, unsigned okm, float c, int lane) {
    constexpr int P = 4 * D + 16;
    const int kg = lane >> 4, c16 = lane & 15;
    f32x4 s0 = (f32x4){0.f, 0.f, 0.f, 0.f}, s1 = s0;
#pragma unroll
    for (int ks = 0; ks < D / 32; ++ks) { const bf16x8 a0 = *(const LAS bf16x8*)(wl + c16 * P + (32 * ks + 8 * kg) * 2), a1 = *(const LAS bf16x8*)(wl + (16 + c16) * P + (32 * ks + 8 * kg) * 2);
        s0 = MFMA16(a0, qf[ks], s0); s1 = MFMA16(a1, qf[ks], s1); }
    float v[8];
#pragma unroll
    for (int j = 0; j < 4; ++j) { v[j] = ((okm >> j) & 1u) ? s0[j] * c : -INFINITY; v[4 + j] = ((okm >> (4 + j)) & 1u) ? s1[j] * c : -INFINITY; }
    const bf16x8 pb = flash_update<D>(f, v);
    const unsigned alo = (unsigned)(__SIZE_TYPE__)wl + (unsigned)((4 * kg + (c16 >> 2)) * P + 2 * D + 8 * (c16 & 3)), ahi = alo + 16u * P;
    { u32x2 vl[4], vh[4]; tr_read4<0>(alo, ahi, vl, vh);
#pragma unroll
      for (int dt = 0; dt < 4; ++dt) { u32x4 aw; aw.x = vl[dt].x; aw.y = vl[dt].y; aw.z = vh[dt].x; aw.w = vh[dt].y; f.o[dt] = MFMA16(__builtin_bit_cast(bf16x8, aw), pb, f.o[dt]); } }
    if constexpr (D == 128) { u32x2 vl[4], vh[4]; tr_read4<128>(alo, ahi, vl, vh);
#pragma unroll
      for (int dt = 0; dt < 4; ++dt) { u32x4 aw; aw.x = vl[dt].x; aw.y = vl[dt].y; aw.z = vh[dt].x; aw.w = vh[dt].y; f.o[4 + dt] = MFMA16(__builtin_bit_cast(bf16x8, aw), pb, f.o[4 + dt]); } }
}
DI void st128(LAS unsigned char* wl, const f32x4 (&rg)[32], int lane) {
#pragma unroll
    for (int i = 0; i < 32; ++i) *(LAS u32x2*)(wl + i * 528 + (lane >> 5) * 256 + (lane & 31) * 8) = cvt4(rg[i]);
}
DI void st64(LAS unsigned char* wl, const f32x4 (&rg)[16], int lane) {
#pragma unroll
    for (int j = 0; j < 16; ++j) *(LAS u32x2*)(wl + (2 * j + (lane >> 5)) * 272 + ((lane >> 4) & 1) * 128 + (lane & 15) * 8) = cvt4(rg[j]);
}

DI void cmp_item(const Args& a, LAS unsigned char* wl, int seq, int r0, int pos0, int g, int lane) {
    unsigned char* ws = a.ws;
    LAS float* imp = (LAS float*)wl; LAS float* scv = imp + 1040;
    const int kg = lane >> 4, c16 = lane & 15, tl = c16 >> 3, hh = c16 & 7;
    const int myrow = r0 + tl, qpos = pos0 + tl, head = g * 8 + hh;
    const bf16_t* QC = (const bf16_t*)(ws + WS_QC);
    bf16x8 qf[2];
#pragma unroll
    for (int ks = 0; ks < 2; ++ks) qf[ks] = *(const bf16x8*)(QC + (size_t)myrow * 1024 + head * 64 + 32 * ks + 8 * kg);
    const bf16_t* tb = (const bf16_t*)(ws + WS_KCF) + (size_t)(seq * 2 + g) * 16 * 4096;
    const int qlast = pos0 + 1, NV = qlast >= 31 ? ((qlast - 31) >> 4) + 1 : 0, nsteps = (NV + 31) >> 5;
    for (int i = lane; i < 1040; i += 64) imp[i] = 0.f;
    float m = -INFINITY, l = 0.f;
    { bf16x8 kc[4], kn[4];
#pragma unroll
      for (int i = 0; i < 4; ++i) { kc[i] = *(const bf16x8*)(tb + (i * 64 + lane) * 8); kn[i] = kc[i]; }
      for (int st = 0; st < nsteps; ++st) {
          if (st + 1 < nsteps) {
#pragma unroll
              for (int i = 0; i < 4; ++i) kn[i] = *(const bf16x8*)(tb + (size_t)(st + 1) * 4096 + (i * 64 + lane) * 8); }
          f32x4 s0 = (f32x4){0.f, 0.f, 0.f, 0.f}, s1 = s0;
#pragma unroll
          for (int ks = 0; ks < 2; ++ks) { s0 = MFMA16(kc[ks * 2], qf[ks], s0); s1 = MFMA16(kc[ks * 2 + 1], qf[ks], s1); }
          float v[8];
#pragma unroll
          for (int j = 0; j < 4; ++j) { const int n = 32 * st + 4 * kg + j; v[j] = (16 * n + 31 <= qpos) ? s0[j] * 0.125f : -INFINITY; v[4 + j] = (16 * (n + 16) + 31 <= qpos) ? s1[j] * 0.125f : -INFINITY; }
          float mx = fmaxf(fmaxf(fmaxf(v[0], v[1]), fmaxf(v[2], v[3])), fmaxf(fmaxf(v[4], v[5]), fmaxf(v[6], v[7])));
          if (!__all(mx <= m + 8.f)) { mx = xmax32(xmax16(mx)); const float mnew = fmaxf(m, mx), msafe = (mnew == -INFINITY) ? 0.f : mnew; l *= __expf(m - msafe); m = mnew; }
          const float mref = (m == -INFINITY) ? 0.f : m;
#pragma unroll
          for (int e = 0; e < 8; ++e) l += __expf(v[e] - mref);
#pragma unroll
          for (int i = 0; i < 4; ++i) kc[i] = kn[i];
      } }
    const float msafe = (m == -INFINITY) ? 0.f : m, linv = 1.f / fmaxf(xsum32(xsum16(l)), 1e-30f);
    f32x4 o[4];
#pragma unroll
    for (int dt = 0; dt < 4; ++dt) o[dt] = (f32x4){0.f, 0.f, 0.f, 0.f};
    { Tile64 tc, tn;
      if (nsteps) load_tile64(tc, tb, tb + 2048, lane);
      for (int st = 0; st < nsteps; ++st) {
          if (st + 1 < nsteps) load_tile64(tn, tb + (size_t)(st + 1) * 4096, tb + (size_t)(st + 1) * 4096 + 2048, lane);
          f32x4 s0 = (f32x4){0.f, 0.f, 0.f, 0.f}, s1 = s0;
#pragma unroll
          for (int ks = 0; ks < 2; ++ks) { s0 = MFMA16(tc.k[ks * 2], qf[ks], s0); s1 = MFMA16(tc.k[ks * 2 + 1], qf[ks], s1); }
          float p[8];
#pragma unroll
          for (int j = 0; j < 4; ++j) { const int n = 32 * st + 4 * kg + j;
              p[j] = (16 * n + 31 <= qpos) ? __expf(s0[j] * 0.125f - msafe) * linv : 0.f; p[4 + j] = (16 * (n + 16) + 31 <= qpos) ? __expf(s1[j] * 0.125f - msafe) * linv : 0.f; }
#pragma unroll
          for (int e = 0; e < 8; ++e) { const float t = sum8(p[e]); if (hh == 0) imp[tl * 520 + 32 * st + kslot(kg, e)] = t; }
          const bf16x8 pb = pack_p(p);
#pragma unroll
          for (int dt = 0; dt < 4; ++dt) o[dt] = MFMA16(tc.v[dt], pb, o[dt]);
          if (st + 1 < nsteps) tc = tn;
      } }
    float* OC = (float*)(ws + WS_OCMP) + (size_t)myrow * 1024 + head * 64 + 4 * kg;
#pragma unroll
    for (int dt = 0; dt < 4; ++dt) *(f32x4*)(OC + 16 * dt) = o[dt];
    LDS_WAIT();
    int* SEL = (int*)(ws + WS_SEL);
    for (int t2 = 0; t2 < 2; ++t2) {
        const int qp = pos0 + t2, cur = qp >> 6, nsb = cur + 1;
        int* selp = SEL + ((size_t)(r0 + t2) * 2 + g) * 16;
        if (nsb <= 16) { if (lane < 16) selp[lane] = lane < nsb ? lane : -1; }
        else {
            const LAS float* im = imp + t2 * 520;
            for (int j = lane; j < nsb; j += 64) { const float sc = (im[4 * j] + im[4 * j + 1]) + (im[4 * j + 2] + im[4 * j + 3]) + (j ? im[4 * j - 1] : 0.f);
                scv[j] = (j == 0 || j == cur || j == cur - 1) ? INFINITY : sc; }
            LDS_WAIT();
            for (int j = lane; j < nsb; j += 64) { const float vj = scv[j]; int rank = 0;
                for (int k = 0; k < nsb; ++k) { const float vk = scv[k]; rank += (vk > vj || (vk == vj && k < j)) ? 1 : 0; }
                if (rank < 16) selp[rank] = j; }
            LDS_WAIT();
        }
    }
}

DI const float* dsa_ptr(const Args& a, const RowInfo& ri, int idx) {
    if (ri.pr) return a.out + O_DSAP + ((size_t)ri.b * 4096 + idx) * 320;
    if (idx < 8192) return (const float*)a.in[I_CDSA] + ((size_t)((const int*)a.in[I_PT])[ri.db * NPAGES + (idx >> 7)] * 128 + (idx & 127)) * 320;
    return a.out + O_DSAS + ((size_t)ri.db * 4 + idx - 8192) * 320;
}
DI unsigned sortable(float x) { const unsigned u = __float_as_uint(x); return (u & 0x80000000u) ? ~u : (u | 0x80000000u); }
DI void idx_item_block(const Args& a, LAS unsigned char* lds, int r) {
    const int tid = threadIdx.x, lane = tid & 63, wave = __builtin_amdgcn_readfirstlane(tid >> 6);
    unsigned char* ws = a.ws;
    LAS unsigned* sc = (LAS unsigned*)lds; LAS unsigned* hist = sc + 8200; LAS unsigned* misc = hist + 256; LAS unsigned* wc = misc + 16;
    const RowInfo ri = rowinfo(r); const int n = ri.pos + 1;
    int* idxp = (int*)(ws + WS_IDX) + (size_t)r * 256;
    const int kg = lane >> 4, c16 = lane & 15;
    { const bf16_t* QI = (const bf16_t*)(ws + WS_QI); bf16x8 qa[2];
#pragma unroll
      for (int ks = 0; ks < 2; ++ks) qa[ks] = *(const bf16x8*)(QI + (size_t)r * 1024 + c16 * 64 + 32 * ks + 8 * kg);
      const f32x4 w4 = *(const f32x4*)((const float*)(ws + WS_WI) + (size_t)r * 16 + 4 * kg) * 0.03125f;
      const bf16_t* kb = (const bf16_t*)(ws + WS_KIFS) + (size_t)ri.db * 513 * 1024 + lane * 8;
      const int ntile = (n + 15) >> 4;
      constexpr int GT = 8;
      for (int T0 = wave; T0 < ntile; T0 += NWAVES * GT) {
          bf16x8 gk[GT][2];
#pragma unroll
          for (int i = 0; i < GT; ++i) { const int Tn = min(T0 + NWAVES * i, ntile - 1); gk[i][0] = *(const bf16x8*)(kb + (size_t)Tn * 1024); gk[i][1] = *(const bf16x8*)(kb + (size_t)Tn * 1024 + 512); }
#pragma unroll
          for (int i = 0; i < GT; ++i) { const int T = T0 + NWAVES * i; if (T < ntile) {
              f32x4 d = (f32x4){0.f, 0.f, 0.f, 0.f}; d = MFMA16(qa[0], gk[i][0], d); d = MFMA16(qa[1], gk[i][1], d);
              float x = (fmaxf(d[0], 0.f) * w4[0] + fmaxf(d[1], 0.f) * w4[1]) + (fmaxf(d[2], 0.f) * w4[2] + fmaxf(d[3], 0.f) * w4[3]);
              x = xsum32(xsum16(x)); const int key = 16 * T + c16; if (kg == 0 && key < n) sc[key] = sortable(x); } }
      } }
    __syncthreads();
    unsigned prefix = 0u, mask = 0u; int need = 256;
    for (int pass = 0; pass < 4; ++pass) { const int shift = 24 - 8 * pass;
        if (tid < 256) hist[tid] = 0u;
        __syncthreads();
        for (int i = tid; i < n; i += NTHR) { const unsigned u = sc[i]; if ((u & mask) == prefix) __hip_atomic_fetch_add(&hist[(u >> shift) & 255u], 1u, __ATOMIC_RELAXED, __HIP_MEMORY_SCOPE_WORKGROUP); }
        __syncthreads();
        if (wave == 0) { const int h0 = hist[4 * lane], h1 = hist[4 * lane + 1], h2 = hist[4 * lane + 2], h3 = hist[4 * lane + 3]; const int ls = h0 + h1 + h2 + h3; int suf = ls;
#pragma unroll
            for (int o = 1; o < 64; o <<= 1) { const int t = __shfl_down(suf, o); if (lane + o < 64) suf += t; }
            int above = suf - ls;
            if (above < need && need <= above + h3) { misc[0] = 4 * lane + 3; misc[1] = need - above; } above += h3;
            if (above < need && need <= above + h2) { misc[0] = 4 * lane + 2; misc[1] = need - above; } above += h2;
            if (above < need && need <= above + h1) { misc[0] = 4 * lane + 1; misc[1] = need - above; } above += h1;
            if (above < need && need <= above + h0) { misc[0] = 4 * lane + 0; misc[1] = need - above; } }
        __syncthreads();
        const unsigned bin = misc[0]; need = (int)misc[1]; prefix |= bin << shift; mask |= 0xFFu << shift;
    }
    const unsigned thr = prefix; const int need_eq = need; int run_gt = 0, run_eq = 0;
    for (int base = 0; base < n; base += NTHR) {
        const int i = base + tid; const unsigned u = i < n ? sc[i] : 0u; const bool gt = i < n && u > thr, eq = i < n && u == thr;
        const unsigned long long bg = __ballot(gt), be = __ballot(eq);
        if (lane == 0) { wc[wave * 2] = (unsigned)__popcll(bg); wc[wave * 2 + 1] = (unsigned)__popcll(be); }
        __syncthreads();
        int pg = 0, pe = 0, tg = 0, te = 0;
#pragma unroll
        for (int w = 0; w < NWAVES; ++w) { const int cg = (int)wc[2 * w], ce = (int)wc[2 * w + 1]; if (w < wave) { pg += cg; pe += ce; } tg += cg; te += ce; }
        const unsigned long long lm = (1ull << lane) - 1ull;
        const int gb = run_gt + pg + __popcll(bg & lm), eb = run_eq + pe + __popcll(be & lm);
        const int opos = gb + min(eb, need_eq);
        if ((gt || (eq && eb < need_eq)) && opos < 256) idxp[opos] = i;
        run_gt += tg; run_eq += te;
        __syncthreads();
    }
}
DI void idx_item_wave(const Args& a, LAS unsigned char* wl, int r, int lane) {
    unsigned char* ws = a.ws;
    LAS unsigned* sc = (LAS unsigned*)wl; LAS unsigned* hist = sc + 4096;
    const int b = r >> 12, s = r & 4095, n = s + 1;
    int* idxp = (int*)(ws + WS_IDX) + (size_t)r * 256;
    if (n <= 256) { for (int i = lane; i < 256; i += 64) idxp[i] = i < n ? i : -1; return; }
    const int kg = lane >> 4, c16 = lane & 15;
#pragma unroll
    for (int q = 0; q < 4; ++q) hist[lane + 64 * q] = 0u;
    LDS_WAIT();
    { const bf16_t* QI = (const bf16_t*)(ws + WS_QI); bf16x8 qa[2];
#pragma unroll
      for (int ks = 0; ks < 2; ++ks) qa[ks] = *(const bf16x8*)(QI + (size_t)r * 1024 + c16 * 64 + 32 * ks + 8 * kg);
      const f32x4 w4 = *(const f32x4*)((const float*)(ws + WS_WI) + (size_t)r * 16 + 4 * kg) * 0.03125f;
      const bf16_t* kb = (const bf16_t*)(ws + WS_KIF) + (size_t)b * 256 * 1024 + lane * 8;
      const int ntile = (n + 15) >> 4;
      constexpr int GT = 8;
      bf16x8 ga[GT][2], gb[GT][2];
#define IDX_LOAD(G, T0_) { _Pragma("unroll") for (int i = 0; i < GT; ++i) { const int Tn = min((T0_) + i, ntile - 1); G[i][0] = *(const bf16x8*)(kb + (size_t)Tn * 1024); G[i][1] = *(const bf16x8*)(kb + (size_t)Tn * 1024 + 512); } }
#define IDX_COMP(G, T0_) { _Pragma("unroll") for (int i = 0; i < GT; ++i) { const int T = (T0_) + i; if (T < ntile) { \
          f32x4 d = (f32x4){0.f, 0.f, 0.f, 0.f}; d = MFMA16(qa[0], G[i][0], d); d = MFMA16(qa[1], G[i][1], d); \
          float x = (fmaxf(d[0], 0.f) * w4[0] + fmaxf(d[1], 0.f) * w4[1]) + (fmaxf(d[2], 0.f) * w4[2] + fmaxf(d[3], 0.f) * w4[3]); \
          x = xsum32(xsum16(x)); const int key = 16 * T + c16; \
          if (kg == 0 && key < n) { const unsigned u = sortable(x); sc[key] = u; __hip_atomic_fetch_add(&hist[u >> 24], 1u, __ATOMIC_RELAXED, __HIP_MEMORY_SCOPE_WAVEFRONT); } } } }
      IDX_LOAD(ga, 0)
      for (int T0 = 0; T0 < ntile; T0 += 2 * GT) {
          IDX_LOAD(gb, T0 + GT) IDX_COMP(ga, T0)
          if (T0 + GT >= ntile) break;
          IDX_LOAD(ga, T0 + 2 * GT) IDX_COMP(gb, T0 + GT)
      }
#undef IDX_LOAD
#undef IDX_COMP
    }
    LDS_WAIT();
    const int n4 = (n + 3) >> 2;
    unsigned prefix = 0u, mask = 0u; int need = 256;
    for (int pass = 0; pass < 4; ++pass) { const int shift = 24 - 8 * pass;
        if (pass) {
#pragma unroll
            for (int q = 0; q < 4; ++q) hist[lane + 64 * q] = 0u;
            LDS_WAIT();
            for (int g = lane; g < n4; g += 64) { const u32x4 u4 = ((const LAS u32x4*)sc)[g];
#pragma unroll
                for (int e = 0; e < 4; ++e) { const unsigned u = u4[e]; if (4 * g + e < n && (u & mask) == prefix) __hip_atomic_fetch_add(&hist[(u >> shift) & 255u], 1u, __ATOMIC_RELAXED, __HIP_MEMORY_SCOPE_WAVEFRONT); } }
            LDS_WAIT();
        }
        const int h0 = hist[4 * lane], h1 = hist[4 * lane + 1], h2 = hist[4 * lane + 2], h3 = hist[4 * lane + 3]; const int ls = h0 + h1 + h2 + h3; int suf = ls;
#pragma unroll
        for (int o = 1; o < 64; o <<= 1) { const int t = __shfl_down(suf, o); if (lane + o < 64) suf += t; }
        int above = suf - ls, fb = -1, fn = 0;
        if (above < need && need <= above + h3) { fb = 4 * lane + 3; fn = need - above; } above += h3;
        if (above < need && need <= above + h2) { fb = 4 * lane + 2; fn = need - above; } above += h2;
        if (above < need && need <= above + h1) { fb = 4 * lane + 1; fn = need - above; } above += h1;
        if (above < need && need <= above + h0) { fb = 4 * lane + 0; fn = need - above; }
        const unsigned long long fm = __ballot(fb >= 0); const int src = fm ? __builtin_ctzll(fm) : 0;
        const unsigned bin = (unsigned)__builtin_amdgcn_readlane(fb, src); need = __builtin_amdgcn_readlane(fn, src);
        prefix |= bin << shift; mask |= 0xFFu << shift;
        LDS_WAIT();
    }
    const unsigned thr = prefix; const int need_eq = need; int run_gt = 0, run_eq = 0;
    const unsigned long long lm = (1ull << lane) - 1ull;
    for (int g0 = 0; g0 < n4; g0 += 64) {
        const int g = g0 + lane; u32x4 u4 = (u32x4){0u, 0u, 0u, 0u}; if (g < n4) u4 = ((const LAS u32x4*)sc)[g];
        bool gt[4], eq[4]; int pg = 0, pe = 0, tg = 0, te = 0;
#pragma unroll
        for (int e = 0; e < 4; ++e) { const bool in = 4 * g + e < n; gt[e] = in && u4[e] > thr; eq[e] = in && u4[e] == thr;
            const unsigned long long bg = __ballot(gt[e]), be = __ballot(eq[e]); pg += __popcll(bg & lm); pe += __popcll(be & lm); tg += __popcll(bg); te += __popcll(be); }
        int gb = run_gt + pg, eb = run_eq + pe;
#pragma unroll
        for (int e = 0; e < 4; ++e) { const int opos = gb + min(eb, need_eq); if ((gt[e] || (eq[e] && eb < need_eq)) && opos < 256) idxp[opos] = 4 * g + e; gb += gt[e] ? 1 : 0; eb += eq[e] ? 1 : 0; }
        run_gt += tg; run_eq += te;
    }
    LDS_WAIT();
}

constexpr int CW_Q0 = 8192;
DI void phase5(const Args& a, LAS unsigned char* lds, int qb = 0, int pm = 7) {
    const int tid = threadIdx.x, lane = tid & 63, wave = __builtin_amdgcn_readfirstlane(tid >> 6);
    unsigned* ctl = (unsigned*)(a.ws + WS_CTL);
    if (pm & 1) { const int bid = blockIdx.x, G = gridDim.x;
#pragma unroll 1
      for (int j = bid; j < TS; j += G) { idx_item_block(a, lds, TP + j); __syncthreads(); } }
    if (pm & 2) { LAS unsigned char* wl = lds + wave * 8192;
#pragma unroll 1
      for (;;) { const int it = qs_next(ctl + CW_Q0 + qb, lane); if (it >= 128 + 8192) break;
          if (it < 128) { const int g = it & 1, db = it >> 2, tp = (it >> 1) & 1; cmp_item(a, wl, 2 + db, TP + db * 4 + 2 * tp, 8192 + 2 * tp, g, lane); }
          else { const int j = it - 128, g = j & 1, b = (j >> 1) & 1, tp = 2047 - (j >> 2); cmp_item(a, wl, b, b * 4096 + 2 * tp, 2 * tp, g, lane); } } }
    __syncthreads();
    if (pm & 4) { LAS unsigned char* wl = lds + wave * 17408;
#pragma unroll 1
      for (;;) { const int it = qs_next(ctl + CW_Q0 + qb + 2048, lane); if (it >= TP) break; const int b = it & 1, s = 4095 - (it >> 1); idx_item_wave(a, wl, b * 4096 + s, lane); } }
}

DI const float* win_ptr(const Args& a, const RowInfo& ri, int pos, int kv, int g) {
    const float* KW = (const float*)(a.ws + WS_KW);
    if (ri.pr) return KW + ((size_t)ri.b * 4096 + pos) * 256 + kv * 128 + g * 64;
    if (pos < 8192) return (const float*)a.in[I_SWIN] + (((size_t)ri.db * 512 + (pos - 7680)) * 2 + kv) * 128 + g * 64;
    return KW + ((size_t)TP + ri.db * 4 + (pos - 8192)) * 256 + kv * 128 + g * 64;
}
DI const float* slc_ptr(const Args& a, const RowInfo& ri, int pos, int c, int g) {
    if (ri.pr) return a.out + O_NSAP + (((size_t)ri.b * 4096 + pos) * 4 + c) * 128 + g * 64;
    if (pos < 8192) return (const float*)a.in[I_CNSA] + (((size_t)((const int*)a.in[I_PT])[ri.db * NPAGES + (pos >> 7)] * 128 + (pos & 127)) * 4 + c) * 128 + g * 64;
    return a.out + O_NSAS + (((size_t)ri.db * 4 + pos - 8192) * 4 + c) * 128 + g * 64;
}
constexpr float C64 = 0.125f * LOG2E, C128 = 0.08838834764831845f * LOG2E;
DI void nsa2_item_sample(const Args& a, LAS unsigned char* lds, int r, int g, int lane) {
    unsigned char* ws = a.ws;
    int wv = __builtin_amdgcn_readfirstlane(threadIdx.x >> 6); asm volatile("" : "+s"(wv));
    LAS unsigned char* wl = lds + wv * DSA_WL;
    const RowInfo ri = rowinfo(r); const int qpos = ri.pos;
    const int kg = lane >> 4, c16 = lane & 15, hh = c16 & 7, head = g * 8 + hh;
    const int kpar = lane >> 5, kvoff = ((lane >> 4) & 1) * 128 + (lane & 15) * 4;
    bf16x8 qf[2];
    { const bf16_t* QR = (const bf16_t*)(ws + WS_QR);
#pragma unroll
      for (int ks = 0; ks < 2; ++ks) qf[ks] = *(const bf16x8*)(QR + (size_t)r * 1024 + head * 64 + 32 * ks + 8 * kg); }
    Flash<64> fw; flash_init(fw);
    Flash<64> fs; flash_init(fs);
    f32x4 rg[16];
    { const int lo = max(0, qpos - 511), b0 = lo & ~31, nst = ((qpos - b0) >> 5) + 1;
#define WLOAD(BASE) { _Pragma("unroll") for (int j = 0; j < 16; ++j) rg[j] = *(const f32x4*)(win_ptr(a, ri, min(max((BASE) + 2 * j + kpar, lo), qpos), 0, g) + kvoff); }
      WLOAD(b0)
      for (int st = 0; st < nst; ++st) { const int base = b0 + 32 * st;
          LDS_WAIT(); st64(wl, rg, lane);
          if (st + 1 < nst) WLOAD(base + 32)
          unsigned okm = 0u;
#pragma unroll
          for (int j = 0; j < 8; ++j) { const int p = base + kslot(kg, j); okm |= (p >= lo && p <= qpos) ? (1u << j) : 0u; }
          LDS_WAIT(); lds_step<64>(fw, qf, wl, okm, C64, lane);
      }
#undef WLOAD
    }
    { const int* selp = (const int*)(ws + WS_SEL) + ((size_t)r * 2 + g) * 16;
      const int sbl = lane < 16 ? selp[lane] : -1;
      const float* bptr = nullptr;
      if (sbl >= 0) { const int p0 = sbl * 64; bptr = p0 < 8192 ? (const float*)a.in[I_CNSA] + ((size_t)((const int*)a.in[I_PT])[ri.db * NPAGES + (p0 >> 7)] * 128 + (p0 & 127)) * 512 + 256 + g * 64
                                                                  : a.out + O_NSAS + (size_t)ri.db * 4 * 512 + 256 + g * 64; }
      const int sb2 = __shfl(sbl, lane >> 1); const int hbase = sb2 * 64 + (lane & 1) * 32;
      unsigned long long m = __ballot(lane < 32 && sb2 >= 0 && hbase <= qpos);
      int left = __popcll(m);
      if (left) {
          const unsigned long long plo = (unsigned long long)bptr;
#define SLOAD(L_) { const int L = (L_); const int bl = L >> 1; const unsigned long long pb64 = ((unsigned long long)(unsigned)__builtin_amdgcn_readlane((int)(plo >> 32), bl) << 32) | (unsigned)__builtin_amdgcn_readlane((int)plo, bl); \
          const int hb = __builtin_amdgcn_readlane(hbase, L); const float* bp = (const float*)pb64 + (size_t)(L & 1) * 32 * 512; \
          _Pragma("unroll") for (int j = 0; j < 16; ++j) { const int kk = min(2 * j + kpar, qpos - hb); rg[j] = *(const f32x4*)(bp + (size_t)kk * 512 + kvoff); } }
          int Lc = __builtin_ctzll(m); m &= m - 1ull;
          SLOAD(Lc)
          for (;;) {
              LDS_WAIT(); st64(wl, rg, lane);
              const int hb = __builtin_amdgcn_readlane(hbase, Lc);
              int Ln = 0; const bool more = m != 0ull;
              if (more) { Ln = __builtin_ctzll(m); m &= m - 1ull; SLOAD(Ln) }
              unsigned okm = 0u;
#pragma unroll
              for (int j = 0; j < 8; ++j) okm |= (hb + kslot(kg, j) <= qpos) ? (1u << j) : 0u;
              LDS_WAIT(); lds_step<64>(fs, qf, wl, okm, C64, lane);
              if (!more) break; Lc = Ln;
          }
#undef SLOAD
      } }
    LDS_WAIT();
    const float* GN = (const float*)(ws + WS_GN) + (size_t)r * 48;
    const float g0 = GN[head], g1 = GN[16 + head] * flash_linv(fs), g2 = GN[32 + head] * flash_linv(fw);
    const float* OC = (const float*)(ws + WS_OCMP) + (size_t)r * 1024 + head * 64 + 4 * kg;
    bf16_t* ON = (bf16_t*)(ws + WS_ONSA) + (size_t)r * 2048 + head * 64 + 4 * kg;
#pragma unroll
    for (int dt = 0; dt < 4; ++dt) { const f32x4 oc = *(const f32x4*)(OC + 16 * dt); const f32x4 o = oc * g0 + fs.o[dt] * g1 + fw.o[dt] * g2; if (c16 < 8) *(u32x2*)(ON + 16 * dt) = cvt4(o); }
}
DI void slc_walk(Flash<64>& fs, const bf16x8 (&qf)[2], const bf16_t* tb, const int* selp, int qpos, int lane) {
    const int kg = lane >> 4;
    const int sbl = lane < 32 ? selp[lane >> 1] : -1; const int Tl = 2 * sbl + (lane & 1);
    unsigned long long m = __ballot(lane < 32 && sbl >= 0 && 32 * Tl <= qpos);
    int left = __popcll(m);
    if (!left) return;
    Tile64 buf[3]; int Tq[3] = {0, 0, 0};
#define SLC_POP(i) { if (m) { Tq[i] = __builtin_amdgcn_readlane(Tl, __builtin_ctzll(m)); m &= m - 1ull; load_tile64(buf[i], tb + (size_t)Tq[i] * 8192, tb + (size_t)Tq[i] * 8192 + 2048, lane); } }
    SLC_POP(0) SLC_POP(1)
#define SLC_STEP(i) { SLC_POP(((i) + 2) % 3) const int T = Tq[i]; const bool full = 32 * T + 31 <= qpos; unsigned okm = 0xFFu; \
        if (!full) { okm = 0u; _Pragma("unroll") for (int j = 0; j < 8; ++j) okm |= (32 * T + kslot(kg, j) <= qpos) ? (1u << j) : 0u; } \
        flash_tile64(fs, qf, buf[i], full, okm, C64); if (--left == 0) break; }
    for (;;) { SLC_STEP(0) SLC_STEP(1) SLC_STEP(2) }
#undef SLC_STEP
#undef SLC_POP
}
DI void nsa2_item_pair(const Args& a, int r0, int g, int lane) {
    unsigned char* ws = a.ws;
    const int b = r0 >> 12, qpos0 = r0 & 4095;
    const int kg = lane >> 4, c16 = lane & 15, tl = c16 >> 3, hh = c16 & 7, head = g * 8 + hh, myrow = r0 + tl, qposc = qpos0 + tl;
    const bf16_t* QR = (const bf16_t*)(ws + WS_QR);
    const bf16_t* tb = (const bf16_t*)(ws + WS_NSAF) + (size_t)((b * 2 + g) * 128) * 8192;
    Flash<64> fw; flash_init(fw);
    { bf16x8 qf[2];
#pragma unroll
      for (int ks = 0; ks < 2; ++ks) qf[ks] = *(const bf16x8*)(QR + (size_t)myrow * 1024 + head * 64 + 32 * ks + 8 * kg);
      const int lo0 = max(0, qpos0 - 511), lo1 = max(0, qpos0 - 510), T0 = lo0 >> 5, T1 = (qpos0 + 1) >> 5, loc = max(0, qposc - 511);
      Tile64 buf[3]; int T = T0;
#define WIN_LD(i, TT_) { if ((TT_) <= T1) load_tile64(buf[i], tb + (size_t)(TT_) * 8192 + 4096, tb + (size_t)(TT_) * 8192 + 6144, lane); }
      WIN_LD(0, T0) WIN_LD(1, T0 + 1)
#define WIN_STEP(i) { WIN_LD(((i) + 2) % 3, T + 2) \
        const bool full = 32 * T >= lo1 && 32 * T + 31 <= qpos0; unsigned okm = 0xFFu; \
        if (!full) { okm = 0u; _Pragma("unroll") for (int j = 0; j < 8; ++j) { const int p = 32 * T + kslot(kg, j); okm |= (p >= loc && p <= qposc) ? (1u << j) : 0u; } } \
        flash_tile64(fw, qf, buf[i], full, okm, C64); if (++T > T1) break; }
      for (;;) { WIN_STEP(0) WIN_STEP(1) WIN_STEP(2) }
#undef WIN_LD
#undef WIN_STEP
    }
    Flash<64> fs0; flash_init(fs0);
    { bf16x8 qf[2];
#pragma unroll
      for (int ks = 0; ks < 2; ++ks) qf[ks] = *(const bf16x8*)(QR + (size_t)r0 * 1024 + head * 64 + 32 * ks + 8 * kg);
      slc_walk(fs0, qf, tb, (const int*)(ws + WS_SEL) + ((size_t)r0 * 2 + g) * 16, qpos0, lane); }
    Flash<64> fs1; flash_init(fs1);
    { bf16x8 qf[2];
#pragma unroll
      for (int ks = 0; ks < 2; ++ks) qf[ks] = *(const bf16x8*)(QR + (size_t)(r0 + 1) * 1024 + head * 64 + 32 * ks + 8 * kg);
      slc_walk(fs1, qf, tb, (const int*)(ws + WS_SEL) + ((size_t)(r0 + 1) * 2 + g) * 16, qpos0 + 1, lane); }
    const float* GN = (const float*)(ws + WS_GN) + (size_t)myrow * 48;
    const float li0 = flash_linv(fs0), li1 = flash_linv(fs1);
    const float g0 = GN[head], g1 = GN[16 + head] * (tl ? li1 : li0), g2 = GN[32 + head] * flash_linv(fw);
    const float* OC = (const float*)(ws + WS_OCMP) + (size_t)myrow * 1024 + head * 64 + 4 * kg;
    bf16_t* ON = (bf16_t*)(ws + WS_ONSA) + (size_t)myrow * 2048 + head * 64 + 4 * kg;
#pragma unroll
    for (int dt = 0; dt < 4; ++dt) { const f32x4 oc = *(const f32x4*)(OC + 16 * dt); const f32x4 os = tl ? fs1.o[dt] : fs0.o[dt]; *(u32x2*)(ON + 16 * dt) = cvt4(oc * g0 + os * g1 + fw.o[dt] * g2); }
}
DI void dsa_item(const Args& a, LAS unsigned char* wl, int r, int lane) {
    unsigned char* ws = a.ws;
    const RowInfo ri = rowinfo(r); const int nvalid = min(256, ri.pos + 1);
    const int kg = lane >> 4, c16 = lane & 15, hh = c16 & 7;
    bf16x8 qf[4];
    { const bf16_t* QB = (const bf16_t*)(ws + WS_QB);
#pragma unroll
      for (int ks = 0; ks < 4; ++ks) qf[ks] = *(const bf16x8*)(QB + (size_t)r * 1024 + hh * 128 + 32 * ks + 8 * kg); }
    const int* idxp = (const int*)(ws + WS_IDX) + (size_t)r * 256;
    Flash<128> f; flash_init(f);
    const int nst = (nvalid + 31) >> 5;
    LAS int* lidx = (LAS int*)(wl + 32 * DSA_LSTRIDE);
#pragma unroll
    for (int q = 0; q < 4; ++q) lidx[lane + 64 * q] = idxp[lane + 64 * q];
    LDS_WAIT();
    if (ri.pr) {
        const bf16_t* DB = (const bf16_t*)(ws + WS_DSAB) + (size_t)ri.b * 4096 * 256;
        const int hr = lane >> 5, ch = lane & 31;
        u32x4 rg[16];
#pragma unroll
        for (int i = 0; i < 16; ++i) { const int id = lidx[2 * i + hr]; rg[i] = *(const u32x4*)(DB + (size_t)max(id, 0) * 256 + ch * 8); }
        for (int st = 0; st < nst; ++st) {
            LDS_WAIT();
#pragma unroll
            for (int i = 0; i < 16; ++i) *(LAS u32x4*)(wl + (2 * i + hr) * DSA_LSTRIDE + ch * 16) = rg[i];
            unsigned okm = 0u;
#pragma unroll
            for (int j = 0; j < 8; ++j) okm |= (lidx[32 * st + kslot(kg, j)] >= 0) ? (1u << j) : 0u;
            if (st + 1 < nst) {
#pragma unroll
                for (int i = 0; i < 16; ++i) { const int id = lidx[32 * (st + 1) + 2 * i + hr]; rg[i] = *(const u32x4*)(DB + (size_t)max(id, 0) * 256 + ch * 8); } }
            LDS_WAIT();
            lds_step<128>(f, qf, wl, okm, C128, lane);
        }
    } else {
        LAS int* lpt = lidx + 256;
        lpt[lane] = ((const int*)a.in[I_PT])[ri.db * NPAGES + lane];
        LDS_WAIT();
        f32x4 rg[32];
#define DLOAD(ST) { _Pragma("unroll") for (int i = 0; i < 32; ++i) { const int id = max(lidx[32 * (ST) + i], 0); \
            const float* rp = id < 8192 ? (const float*)a.in[I_CDSA] + ((size_t)lpt[id >> 7] * 128 + (id & 127)) * 320 : a.out + O_DSAS + ((size_t)ri.db * 4 + id - 8192) * 320; rg[i] = *(const f32x4*)(rp + 4 * lane); } }
        DLOAD(0)
        for (int st = 0; st < nst; ++st) {
            LDS_WAIT(); st128(wl, rg, lane);
            unsigned okm = 0u;
#pragma unroll
            for (int j = 0; j < 8; ++j) okm |= (lidx[32 * st + kslot(kg, j)] >= 0) ? (1u << j) : 0u;
            if (st + 1 < nst) DLOAD(st + 1)
            LDS_WAIT();
            lds_step<128>(f, qf, wl, okm, C128, lane);
        }
#undef DLOAD
    }
    LDS_WAIT();
    const float inv = flash_linv(f);
    bf16_t* OD = (bf16_t*)(ws + WS_ONSA) + (size_t)r * 2048 + 1024 + hh * 128 + 4 * kg;
#pragma unroll
    for (int dt = 0; dt < 8; ++dt) if (c16 < 8) *(u32x2*)(OD + 16 * dt) = cvt4(f.o[dt] * inv);
}
DI void phase6(const Args& a, LAS unsigned char* lds, int qb = 0, int pm = 3) {
    const int tid = threadIdx.x, lane = tid & 63, wave = __builtin_amdgcn_readfirstlane(tid >> 6);
    unsigned* ctl = (unsigned*)(a.ws + WS_CTL);
#pragma unroll 1
    for (;;) { if (!(pm & 1)) break; const int it = qs_next(ctl + CW_Q0 + qb + 4096, lane); if (it >= 2 * TS + TP) break;
        if (it < 2 * TS) nsa2_item_sample(a, lds, TP + (it >> 1), it & 1, lane);
        else { const int j = it - 2 * TS, g = j & 1, b = (j >> 1) & 1, tp = 2047 - (j >> 2); nsa2_item_pair(a, b * 4096 + 2 * tp, g, lane); } }
    if (pm & 2) { LAS unsigned char* wl = lds + wave * DSA_WL;
#pragma unroll 1
      for (;;) { const int it = qs_next(ctl + CW_Q0 + qb + 6144, lane); if (it >= TT) break; dsa_item(a, wl, it < TS ? TP + it : it - TS, lane); } }
}

DI void phase11(const Args& a, LAS unsigned char* lds) {
    const int tid = threadIdx.x, lane = tid & 63, wave = __builtin_amdgcn_readfirstlane(tid >> 6);
    const int gw = blockIdx.x * NWAVES + wave, NGW = gridDim.x * NWAVES;
    unsigned char* ws = a.ws;
    const int kg = lane >> 4, c16 = lane & 15;
#pragma unroll 1
    for (int it = gw; it < 2048 + 128; it += NGW) {
        int myrow, h; const float* kvb; bool st_ok;
        if (it < 2048) { const int rg = it >> 2; h = it & 3; myrow = rg * 16 + c16; kvb = a.out + O_MEMP + (size_t)(rg >> 8) * 256 * 1024 + h * 128; st_ok = true; }
        else { const int j = it - 2048, db = j >> 2; h = j & 3; myrow = TP + db * 4 + (c16 & 3); kvb = (const float*)a.in[I_CMEM] + (size_t)db * 256 * 1024 + h * 128; st_ok = c16 < 4; }
        bf16x8 qf[4];
        { const bf16_t* QM = (const bf16_t*)(ws + WS_QMB);
#pragma unroll
          for (int ks = 0; ks < 4; ++ks) qf[ks] = *(const bf16x8*)(QM + (size_t)myrow * 512 + h * 128 + 32 * ks + 8 * kg); }
        Flash<128> f; flash_init(f);
        LAS unsigned char* wl = lds + wave * DSA_WL;
        f32x4 rg[32];
#define MLOAD(ST) { _Pragma("unroll") for (int i = 0; i < 32; ++i) rg[i] = *(const f32x4*)(kvb + (size_t)(32 * (ST) + i) * 1024 + (lane >> 5) * 512 + (lane & 31) * 4); }
        MLOAD(0)
        for (int st = 0; st < 8; ++st) {
            LDS_WAIT(); st128(wl, rg, lane);
            if (st + 1 < 8) MLOAD(st + 1)
            LDS_WAIT();
            lds_step<128>(f, qf, wl, 0xFFu, C128, lane);
        }
#undef MLOAD
        LDS_WAIT();
        const float inv = flash_linv(f);
        bf16_t* OM = (bf16_t*)(ws + WS_OM) + (size_t)myrow * 512 + h * 128 + 4 * kg;
#pragma unroll
        for (int dt = 0; dt < 8; ++dt) if (st_ok) *(u32x2*)(OM + 16 * dt) = cvt4(f.o[dt] * inv);
    }
}
DI f32x4 ldbf4(const bf16_t* p) { const u32x2 w = *(const u32x2*)p; f32x4 r; r.x = __uint_as_float(w.x << 16); r.y = __uint_as_float(w.x & 0xffff0000u); r.z = __uint_as_float(w.y << 16); r.w = __uint_as_float(w.y & 0xffff0000u); return r; }
struct EpiMerge {
    static constexpr bool HAS_MID = true;
    const bf16_t* GAB; bf16_t* MG; float* part;
    DI void mid(f32x4 (&acc)[2][2][4][2], const pg8::Unit& u, int wr, int wc, int fr, int fq) const {
        if (u.pm >= 32) return;
        int z = 0; asm volatile("" : "+v"(z));
#pragma unroll
        for (int ai = 0; ai < 2; ++ai)
#pragma unroll
            for (int m = 0; m < 4; ++m) { const size_t r = (size_t)(u.pm * 256 + ai * 128 + wr * 64 + m * 16 + fr + z);
#pragma unroll
                for (int bj = 0; bj < 2; ++bj)
#pragma unroll
                    for (int n = 0; n < 2; ++n) { const int c = u.pn * 256 + bj * 128 + wc * 32 + n * 16 + 4 * fq;
                        const f32x4 ga = ldbf4(GAB + r * 4096 + c), gb = ldbf4(GAB + r * 4096 + 2048 + c); f32x4 q;
                        q.x = ga.x * __builtin_amdgcn_rcpf(fmaxf(gb.x, 1e-30f)); q.y = ga.y * __builtin_amdgcn_rcpf(fmaxf(gb.y, 1e-30f)); q.z = ga.z * __builtin_amdgcn_rcpf(fmaxf(gb.z, 1e-30f)); q.w = ga.w * __builtin_amdgcn_rcpf(fmaxf(gb.w, 1e-30f));
                        acc[ai][bj][m][n] *= q; }
                asm volatile("" ::: "memory"); }
    }
    DI void operator()(const f32x4 (&acc)[2][2][4][2], const pg8::Unit& u, int wr, int wc, int fr, int fq) const {
        if (u.pm >= 32) {
#pragma unroll
            for (int m = 0; m < 4; ++m) { const int row = wr * 64 + m * 16 + fr;
#pragma unroll
                for (int bj = 0; bj < 2; ++bj)
#pragma unroll
                    for (int n = 0; n < 2; ++n) { const int c = u.pn * 256 + bj * 128 + wc * 32 + n * 16 + 4 * fq;
                        const f32x4 g = ldbf4(GAB + (size_t)(TP + row) * 4096 + (u.ks < 4 ? 0 : 2048) + c); *(f32x4*)(part + ((size_t)u.ks * 128 + row) * DM + c) = acc[0][bj][m][n] * g; } }
            return; }
#pragma unroll
        for (int ai = 0; ai < 2; ++ai)
#pragma unroll
            for (int m = 0; m < 4; ++m) { const size_t r = (size_t)u.pm * 256 + ai * 128 + wr * 64 + m * 16 + fr;
#pragma unroll
                for (int bj = 0; bj < 2; ++bj)
#pragma unroll
                    for (int n = 0; n < 2; ++n) { const int c = u.pn * 256 + bj * 128 + wc * 32 + n * 16 + 4 * fq;
                        *(u32x2*)(MG + r * DM + c) = cvt4(acc[ai][bj][m][n] * ldbf4(GAB + r * 4096 + 2048 + c)); } }
    }
};
struct ComboOrder { pg8::StaticOrder so; int n, ld;
    DI void init(int G, int c, int K) { so.init(TP / 256, DM / 256, G, c, K, K); n = 256 + 8 * (K / 256); ld = K; }
    DI bool next(int i, pg8::Unit& u) const { const long L = (long)i * so.G + so.c; if (L < 256) return so.at(L, u); if (L >= n) return false; const int j = (int)L - 256; u.pm = 32; u.pn = j & 7; u.ks = j >> 3; return true; }
    DI size_t offA(const pg8::Unit& u) const { return u.pm < 32 ? so.offA(u) : ((size_t)TP * ld + (size_t)u.ks * 256) * 2; }
    DI size_t offB(const pg8::Unit& u) const { return u.pm < 32 ? so.offB(u) : ((size_t)u.pn * 256 * ld + (size_t)u.ks * 256) * 2; }
    DI int ktiles(const pg8::Unit& u, int K) const { return u.pm < 32 ? K : 256; }
};
DI void phase7(const Args& a, LAS unsigned char* lds) {
    unsigned char* ws = a.ws;
    pg8::Gemm g{(const bf16_t*)(ws + WS_ONSA), (const bf16_t*)(ws + WS_BT_OA), DM, DM, DM};
    ComboOrder S; S.init(gridDim.x, blockIdx.x, DM);
    EpiMerge E{(const bf16_t*)(ws + WS_GAB), (bf16_t*)(ws + WS_MG), (float*)(ws + WS_PART)};
    pg8::gemm_phase(lds, g, S, E);
}
DI void phase7b(const Args& a) {
    const int tid = threadIdx.x, lane = tid & 63, wave = __builtin_amdgcn_readfirstlane(tid >> 6);
    const int gw = blockIdx.x * NWAVES + wave, NGW = gridDim.x * NWAVES;
    for (int q = gw; q < TS; q += NGW) {
        f32x4 v[8];
#pragma unroll
        for (int j = 0; j < 8; ++j) v[j] = (f32x4){0.f, 0.f, 0.f, 0.f};
#pragma unroll 2
        for (int k = 0; k < 8; ++k) { const f32x4* pr = (const f32x4*)((const float*)(a.ws + WS_PART) + ((size_t)k * 128 + q) * DM) + lane;
#pragma unroll
            for (int j = 0; j < 8; ++j) v[j] += pr[64 * j]; }
        u32x2* o8 = (u32x2*)((bf16_t*)(a.ws + WS_MG) + (size_t)(TP + q) * DM) + lane;
#pragma unroll
        for (int j = 0; j < 8; ++j) o8[64 * j] = cvt4(v[j]);
    }
}
struct FResX { const float* xp; const float* xs; float* dst; DI void operator()(const pg8::Unit& u, int row, int col, f32x4 v) const { const int r = u.pm * 256 + row, c = u.pn * 256 + col;
    f32x4 o = (f32x4){0.f, 0.f, 0.f, 0.f}; if (r < TT) o = v + (r < TP ? *(const f32x4*)(xp + (size_t)r * DM + c) : *(const f32x4*)(xs + (size_t)(r - TP) * DM + c)); *(f32x4*)(dst + (size_t)r * DM + c) = o; } };
struct FResW { const float* base; float* dst; DI void operator()(const pg8::Unit& u, int row, int col, f32x4 v) const { const int r = u.pm * 256 + row, c = u.pn * 256 + col;
    f32x4 o = (f32x4){0.f, 0.f, 0.f, 0.f}; if (r < TT) o = v + *(const f32x4*)(base + (size_t)r * DM + c); *(f32x4*)(dst + (size_t)r * DM + c) = o; } };
struct FStoreBf { bf16_t* C; int ldc; DI void operator()(const pg8::Unit& u, int row, int col, f32x4 v) const { *(u32x2*)(C + (size_t)(u.pm * 256 + row) * ldc + u.pn * 256 + col) = cvt4(v); } };

struct EpiResNorm {
    static constexpr bool HAS_MID = false;
    const float* base; float* dst; bf16_t* an; const float* gain; float* ss; float* part;
    DI void operator()(const f32x4 (&acc)[2][2][4][2], const pg8::Unit& u, int wr, int wc, int fr, int fq) const {
        if (u.pm >= 32) {
#pragma unroll
            for (int m = 0; m < 4; ++m) { const int row = wr * 64 + m * 16 + fr;
#pragma unroll
                for (int bj = 0; bj < 2; ++bj)
#pragma unroll
                    for (int n = 0; n < 2; ++n) *(f32x4*)(part + ((size_t)u.ks * 128 + row) * DM + u.pn * 256 + bj * 128 + wc * 32 + n * 16 + 4 * fq) = acc[0][bj][m][n]; }
            return; }
        const int c0 = u.pn * 256 + wc * 32 + 4 * fq;
#pragma unroll
        for (int ai = 0; ai < 2; ++ai)
#pragma unroll
            for (int m = 0; m < 4; ++m) { const size_t r = (size_t)u.pm * 256 + ai * 128 + wr * 64 + m * 16 + fr; float s = 0.f;
#pragma unroll
                for (int bj = 0; bj < 2; ++bj)
#pragma unroll
                    for (int n = 0; n < 2; ++n) { const size_t o = r * DM + c0 + bj * 128 + n * 16; const f32x4 x = acc[ai][bj][m][n] + *(const f32x4*)(base + o);
                        *(f32x4*)(dst + o) = x; *(u32x2*)(an + o) = cvt4(x * *(const f32x4*)(gain + c0 + bj * 128 + n * 16)); s += (x.x * x.x + x.y * x.y) + (x.z * x.z + x.w * x.w); }
                s = xsum32(xsum16(s));
                if (fq == 0) __hip_atomic_fetch_add(ss + r, s, __ATOMIC_RELAXED, __HIP_MEMORY_SCOPE_AGENT);
                asm volatile("" ::: "memory"); }
    }
};
DI void gemm_resnorm(const Args& a, LAS unsigned char* lds, size_t ws_a, size_t ws_bt, int K, const float* base, size_t ws_dst, int gidx, int which) {
    unsigned char* ws = a.ws;
    pg8::Gemm g{(const bf16_t*)(ws + ws_a), (const bf16_t*)(ws + ws_bt), K, K, K};
    ComboOrder S; S.init(gridDim.x, blockIdx.x, K);
    EpiResNorm E{base, (float*)(ws + ws_dst), (bf16_t*)(ws + WS_XN), (const float*)a.in[I_NG] + gidx * DM, (float*)(ws + WS_SS) + (size_t)which * TP, (float*)(ws + WS_PART)};
    pg8::gemm_phase(lds, g, S, E);
}
struct FStoreBfRs { bf16_t* C; int ldc; const float* rs; DI void operator()(const pg8::Unit& u, int row, int col, f32x4 v) const { const int r = u.pm * 256 + row;
    *(u32x2*)(C + (size_t)r * ldc + u.pn * 256 + col) = cvt4(v * rs[r]); } };
template <class F> struct FCombo { F f; float* part; DI void operator()(const pg8::Unit& u, int row, int col, f32x4 v) const {
    if (u.pm < 32) f(u, row, col, v); else if (row < 128) *(f32x4*)(part + ((size_t)u.ks * 128 + row) * DM + u.pn * 256 + col) = v; } };
template <class F> DI void gemm_n2048(const Args& a, LAS unsigned char* lds, size_t ws_a, size_t ws_bt, int K, const F& f) {
    unsigned char* ws = a.ws;
    pg8::Gemm g{(const bf16_t*)(ws + ws_a), (const bf16_t*)(ws + ws_bt), K, K, K};
    ComboOrder S; S.init(gridDim.x, blockIdx.x, K);
    pg8::EpiEach<FCombo<F>> E{FCombo<F>{f, (float*)(ws + WS_PART)}};
    pg8::gemm_phase(lds, g, S, E);
}
DI void phase8(const Args& a, LAS unsigned char* lds) {
    gemm_n2048(a, lds, WS_MG, WS_BT_O, DM, FResX{(const float*)a.in[I_XP], (const float*)a.in[I_XS], (float*)(a.ws + WS_X1)});
}
DI void sample_row_sum(const Args& a, const float* base_row, int q, int S, int lane, f32x4 (&v)[8]) {
    const f32x4* br = (const f32x4*)base_row + lane;
#pragma unroll
    for (int j = 0; j < 8; ++j) v[j] = br[64 * j];
#pragma unroll 2
    for (int k = 0; k < S; ++k) { const f32x4* pr = (const f32x4*)((const float*)(a.ws + WS_PART) + ((size_t)k * 128 + q) * DM) + lane;
#pragma unroll
        for (int j = 0; j < 8; ++j) v[j] += pr[64 * j]; }
}
DI void phase_norm(const Args& a, size_t ws_x, const float* sbase, int S, int gidx, int which) {
    const int tid = threadIdx.x, lane = tid & 63, wave = __builtin_amdgcn_readfirstlane(tid >> 6);
    const int gw = blockIdx.x * NWAVES + wave, NGW = gridDim.x * NWAVES;
    float* X = (float*)(a.ws + ws_x); const float* g = (const float*)a.in[I_NG] + gidx * DM; bf16_t* XN = (bf16_t*)(a.ws + WS_XN);
    for (int r = gw; r < TT; r += NGW) {
        if (r < TP) { rms_row_bf16(X + (size_t)r * DM, g, XN + (size_t)r * DM, lane); continue; }
        f32x4 v[8]; sample_row_sum(a, sbase + (size_t)(r - TP) * DM, r - TP, S, lane, v);
        float ss = 0.f; f32x4* xo = (f32x4*)(X + (size_t)r * DM) + lane;
#pragma unroll
        for (int j = 0; j < 8; ++j) { xo[64 * j] = v[j]; ss += (v[j].x * v[j].x + v[j].y * v[j].y) + (v[j].z * v[j].z + v[j].w * v[j].w); }
        const float rstd = rsqrtf(wave_sum(ss) * (1.f / 2048.f) + 1e-6f);
        const f32x4* gr = (const f32x4*)g + lane; u32x2* o8 = (u32x2*)(XN + (size_t)r * DM) + lane;
#pragma unroll
        for (int j = 0; j < 8; ++j) o8[64 * j] = cvt4(v[j] * rstd * gr[64 * j]);
    }
}
DI void phase10(const Args& a, LAS unsigned char* lds) {
    unsigned char* ws = a.ws;
    pg8::Gemm g{(const bf16_t*)(ws + WS_XN), (const bf16_t*)(ws + WS_BT_MQ), DM, DM, DM};
    pg8::StaticOrder S; S.init(MP / 256, 2, gridDim.x, blockIdx.x, DM, DM);
    pg8::EpiEach<FStoreBf> E{FStoreBf{(bf16_t*)(ws + WS_QMB), 512}};
    pg8::gemm_phase(lds, g, S, E);
}
DI void phase12(const Args& a, LAS unsigned char* lds) {
    gemm_n2048(a, lds, WS_OM, WS_BT_MO, 512, FResW{(const float*)(a.ws + WS_X1), (float*)(a.ws + WS_X2)});
}
DI void phase14(const Args& a, LAS unsigned char* lds) {
    unsigned char* ws = a.ws;
    pg8::Gemm g{(const bf16_t*)(ws + WS_XN), (const bf16_t*)(ws + WS_BT_UP), DM, DM, DM};
    pg8::StaticOrder S; S.init(MP / 256, DFF2 / 256, gridDim.x, blockIdx.x, DM, DM);
    pg8::EpiEach<FStoreBf> E{FStoreBf{(bf16_t*)(ws + WS_UB), DFF2}};
    pg8::gemm_phase(lds, g, S, E);
}
DI void phase15(const Args& a, LAS unsigned char* lds) {
    const int tid = threadIdx.x, lane = tid & 63, wave = __builtin_amdgcn_readfirstlane(tid >> 6);
    const int gw = blockIdx.x * NWAVES + wave, NGW = gridDim.x * NWAVES;
    unsigned char* ws = a.ws;
    const bf16_t* U = (const bf16_t*)(ws + WS_UB); bf16_t* ACT = (bf16_t*)(ws + WS_ACT);
    const float* cw = (const float*)a.in[I_CVW]; const float* cb = (const float*)a.in[I_CVB];
    constexpr int NRUN = TP / 32 + 32, NCH = DFF / 256;
#pragma unroll 1
    for (int it = gw; it < NRUN * NCH; it += NGW) {
        const int run = it / NCH, ch = it % NCH, c = 256 * ch + 4 * lane;
        int r0, nrow, t0; const float* st = nullptr; float* cout = nullptr; int cfirst = 1 << 30;
        if (run < TP / 32) { r0 = run * 32; nrow = 32; t0 = r0 & 4095; if (t0 == SEQ - 32) { cfirst = 30; cout = a.out + O_CONVP + (size_t)(r0 >> 12) * 2 * DFF2; } }
        else { const int db = run - TP / 32; r0 = TP + db * 4; nrow = 4; t0 = 0; st = (const float*)a.in[I_SCONV] + (size_t)db * 2 * DFF2; cfirst = 2; cout = a.out + O_CONVS + (size_t)db * 2 * DFF2; }
        f32x4 pb[2], w0[2], w1[2], w2[2], u1[2], u2[2];
#pragma unroll
        for (int hf = 0; hf < 2; ++hf) { const int cc = c + hf * DFF;
            pb[hf] = *(const f32x4*)(cb + cc); w0[hf] = *(const f32x4*)(cw + cc); w1[hf] = *(const f32x4*)(cw + DFF2 + cc); w2[hf] = *(const f32x4*)(cw + 2 * DFF2 + cc);
            if (st) { u2[hf] = *(const f32x4*)(st + cc); u1[hf] = *(const f32x4*)(st + DFF2 + cc); }
            else { u1[hf] = t0 >= 1 ? ldbf4(U + (size_t)(r0 - 1) * DFF2 + cc) : (f32x4){0.f, 0.f, 0.f, 0.f}; u2[hf] = t0 >= 2 ? ldbf4(U + (size_t)(r0 - 2) * DFF2 + cc) : (f32x4){0.f, 0.f, 0.f, 0.f}; } }
        f32x4 nx[2] = {ldbf4(U + (size_t)r0 * DFF2 + c), ldbf4(U + (size_t)r0 * DFF2 + c + DFF)};
        for (int i = 0; i < nrow; ++i) {
            const f32x4 u0[2] = {nx[0], nx[1]};
            if (i + 1 < nrow) { nx[0] = ldbf4(U + (size_t)(r0 + i + 1) * DFF2 + c); nx[1] = ldbf4(U + (size_t)(r0 + i + 1) * DFF2 + c + DFF); }
            const f32x4 gt = pb[0] + u2[0] * w0[0] + u1[0] * w1[0] + u0[0] * w2[0], up = pb[1] + u2[1] * w0[1] + u1[1] * w1[1] + u0[1] * w2[1];
            f32x4 o; o.x = gt.x * sigmoidf_(gt.x) * up.x; o.y = gt.y * sigmoidf_(gt.y) * up.y; o.z = gt.z * sigmoidf_(gt.z) * up.z; o.w = gt.w * sigmoidf_(gt.w) * up.w;
            *(u32x2*)(ACT + (size_t)(r0 + i) * DFF + c) = cvt4(o);
            if (i >= cfirst) { *(f32x4*)(cout + (size_t)(i - cfirst) * DFF2 + c) = u0[0]; *(f32x4*)(cout + (size_t)(i - cfirst) * DFF2 + c + DFF) = u0[1]; }
            u2[0] = u1[0]; u2[1] = u1[1]; u1[0] = u0[0]; u1[1] = u0[1];
        }
    }
}
DI void phase16(const Args& a, LAS unsigned char* lds) {
    gemm_n2048(a, lds, WS_ACT, WS_BT_DN, DFF, FResW{(const float*)(a.ws + WS_X2), (float*)(a.ws + WS_X3)});
}
DI void phase17(const Args& a) {
    const int tid = threadIdx.x, lane = tid & 63, wave = __builtin_amdgcn_readfirstlane(tid >> 6);
    const int gw = blockIdx.x * NWAVES + wave, NGW = gridDim.x * NWAVES;
    const float* X3 = (const float*)(a.ws + WS_X3); const f32x4* gr = (const f32x4*)a.in[I_FG] + lane;
    for (int r = gw; r < TT; r += NGW) {
        const f32x4* xr = (const f32x4*)(X3 + (size_t)r * DM) + lane; f32x4 v[8]; float s = 0.f;
        if (r < TP) {
#pragma unroll
            for (int j = 0; j < 8; ++j) v[j] = xr[64 * j];
        } else sample_row_sum(a, (const float*)(a.ws + WS_X2) + (size_t)r * DM, r - TP, DFF / 256, lane, v);
#pragma unroll
        for (int j = 0; j < 8; ++j) s += (v[j].x * v[j].x + v[j].y * v[j].y) + (v[j].z * v[j].z + v[j].w * v[j].w);
        const float rstd = rsqrtf(wave_sum(s) * (1.f / 2048.f) + 1e-6f);
        f32x4* o = (f32x4*)(a.out + (r < TP ? O_YP + (size_t)r * DM : O_YS + (size_t)(r - TP) * DM)) + lane;
#pragma unroll
        for (int j = 0; j < 8; ++j) o[64 * j] = v[j] * rstd * gr[64 * j];
    }
}
#define PHASES_REST \
    if (IN(3)) { phase3(args, lds); } SEAM(3); \
    if (IN(4)) { phase4(args, lds); } SEAM(4); \
    if (IN(5)) { phase5(args, lds); } SEAM(5); \
    if (IN(6)) { phase6(args, lds); } SEAM(6); \
    if (IN(7)) { phase7(args, lds); } SEAM(7); \
    if (IN(8)) { phase7b(args); } SEAM(8); \
    if (IN(9)) { phase8(args, lds); } SEAM(9); \
    if (IN(10)) { phase_norm(args, WS_X1, (const float*)args.in[I_XS], DM / 256, 1, 0); } SEAM(10); \
    if (IN(11)) { phase10(args, lds); } SEAM(11); \
    if (IN(12)) { phase11(args, lds); } SEAM(12); \
    if (IN(13)) { phase12(args, lds); } SEAM(13); \
    if (IN(14)) { phase_norm(args, WS_X2, (const float*)(args.ws + WS_X1) + (size_t)TP * DM, 512 / 256, 3, 1); } SEAM(14); \
    if (IN(15)) { phase14(args, lds); } SEAM(15); \
    if (IN(16)) { phase15(args, lds); } SEAM(16); \
    if (IN(17)) { phase16(args, lds); } SEAM(17); \
    if (IN(18)) { phase17(args); }
#ifndef MK_N_LAUNCHES
#define MK_N_LAUNCHES 1
#endif
constexpr int N_PHASES = 19;
__global__ void __launch_bounds__(NTHR, 2) mk_fwd(Args args) {
    extern __shared__ __attribute__((aligned(16))) unsigned char lds_raw[];
    LAS unsigned char* lds = (LAS unsigned char*)lds_raw;
    volatile LAS unsigned* MISC = (volatile LAS unsigned*)(lds + MISC_OFF);
    const int tid = threadIdx.x;
    for (int u = tid; u < 64; u += NTHR) ((LAS unsigned*)(lds + MISC_OFF))[u] = 0u;
    __syncthreads();
    unsigned* ctl = (unsigned*)(args.ws + WS_CTL);
    XcdBarrier bar; bar.bar = ctl + CW_BAR; bar.x = 0; bar.st = nullptr;
    const bool use_bar = (args.ph_hi - args.ph_lo) > 1;
    if (use_bar) bar = xcd_barrier_post(ctl + CW_BAR, MISC + 8);
    const int lo = args.ph_lo, hi = args.ph_hi;
#define IN(k) (lo <= (k) && (k) < hi)
#define SEAM(k) do { if (IN(k) && IN((k) + 1)) xcd_barrier(bar); } while (0)
    if (IN(0)) { phase0(args, lds); } SEAM(0);
    if (IN(1)) { phase1(args, lds); } SEAM(1);
    if (IN(2)) { phase2(args, lds); } SEAM(2);
    PHASES_REST
#undef IN
#undef SEAM
}

extern "C" void kernel_launch(void* const* d_in, const int* in_sizes, int n_in, void* d_out, int out_size, void* d_ws, size_t ws_size, hipStream_t stream) {
    static int grid = 0;
    if (grid == 0) {
        if (n_in != N_IN || (size_t)out_size != O_END || ws_size < WS_END) { fprintf(stderr, "kernel_launch: unexpected shapes: n_in %d out %d ws %zu (need %zu)\n", n_in, out_size, ws_size, (size_t)WS_END); grid = -1; return; }
        int dev = 0, cus = 0, per_cu = 0;
        if (hipGetDevice(&dev) != hipSuccess || hipDeviceGetAttribute(&cus, hipDeviceAttributeMultiprocessorCount, dev) != hipSuccess) { grid = -1; return; }
        if (hipFuncSetAttribute((const void*)mk_fwd, hipFuncAttributeMaxDynamicSharedMemorySize, LDS_BYTES) != hipSuccess) { fprintf(stderr, "kernel_launch: hipFuncSetAttribute failed\n"); grid = -1; return; }
        if (hipOccupancyMaxActiveBlocksPerMultiprocessor(&per_cu, (const void*)mk_fwd, NTHR, LDS_BYTES) != hipSuccess || per_cu < 1) fprintf(stderr, "kernel_launch: occupancy query reports %d\n", per_cu);
        (void)hipGetLastError();
        grid = cus;
    }
    if (grid < 0) return;
    (void)hipMemsetAsync((char*)d_ws + WS_CTL, 0, CTL_BYTES, stream);
    Args a{};
    for (int i = 0; i < N_IN; ++i) a.in[i] = d_in[i];
    a.out = (float*)d_out; a.ws = (unsigned char*)d_ws;
#if MK_N_LAUNCHES == 1
    a.ph_lo = 0; a.ph_hi = N_PHASES;
    hipLaunchKernelGGL(mk_fwd, dim3(grid), dim3(NTHR), LDS_BYTES, stream, a);
#else
    for (int p = 0; p < N_PHASES; ++p) { a.ph_lo = p; a.ph_hi = p + 1; hipLaunchKernelGGL(mk_fwd, dim3(grid), dim3(NTHR), LDS_BYTES, stream, a); }
#endif
}
```

```cpp
#include <hip/hip_runtime.h>
#include <cstdio>
#include <cstdint>

#define DI __device__ __forceinline__
#define LAS __attribute__((address_space(3)))
typedef unsigned short bf16_t;
typedef short bf16x8 __attribute__((ext_vector_type(8)));
typedef float f32x4 __attribute__((ext_vector_type(4)));
typedef float f32x2 __attribute__((ext_vector_type(2)));
typedef unsigned u32x4 __attribute__((ext_vector_type(4)));
typedef unsigned u32x2 __attribute__((ext_vector_type(2)));

constexpr int DM = 2048, SEQ = 4096, TP = 8192, TS = 128, TT = 8320, MP = 8448;
constexpr int DIN = 8320, DINP = 8448, DFF = 5632, DFF2 = 11264;
constexpr int NPAGES = 64;
constexpr int C_QA = 0, C_KVA = 1024, C_GA = 1792, C_QB = 1840, C_KVB = 2864, C_QI = 3120, C_KI = 4144, C_WI = 4208, C_GM = 4224;
constexpr size_t O_YP = 0, O_YS = O_YP + (size_t)TP * DM, O_NSAP = O_YS + (size_t)TS * DM, O_NSAS = O_NSAP + (size_t)TP * 512, O_WINP = O_NSAS + (size_t)TS * 512,
                 O_WINS = O_WINP + (size_t)2 * 512 * 256, O_DSAP = O_WINS + (size_t)32 * 512 * 256, O_DSAS = O_DSAP + (size_t)TP * 320, O_MEMP = O_DSAS + (size_t)TS * 320,
                 O_CONVP = O_MEMP + (size_t)512 * 1024, O_CONVS = O_CONVP + (size_t)2 * 2 * DFF2, O_END = O_CONVS + (size_t)32 * 2 * DFF2;
static_assert(O_END == 29708288, "output size");
enum { I_XP = 0, I_XS, I_MEM, I_CNSA, I_SWIN, I_CDSA, I_CMEM, I_SCONV, I_PT, I_NG, I_WIN, I_PE, I_CW1, I_CB1, I_CW2, I_WOA, I_WOB, I_WO, I_WMQ, I_WMKV, I_WMO, I_WUP, I_CVW, I_CVB, I_WDN, I_FG, N_IN };

constexpr size_t al256(size_t x) { return (x + 255) & ~(size_t)255; }
constexpr size_t WS_CTL = 0, CTL_BYTES = 1u << 20;
constexpr size_t WS_BT_IN = CTL_BYTES;
constexpr size_t WS_BT_OA = WS_BT_IN + (size_t)DINP * DM * 2;
constexpr size_t WS_BT_OB = WS_BT_OA + (size_t)DM * 1024 * 2;
constexpr size_t WS_BT_O = WS_BT_OB + (size_t)DM * 1024 * 2;
constexpr size_t WS_BT_MQ = WS_BT_O + (size_t)DM * DM * 2;
constexpr size_t WS_BT_MKV = WS_BT_MQ + (size_t)512 * DM * 2;
constexpr size_t WS_BT_MO = WS_BT_MKV + (size_t)1024 * DM * 2;
constexpr size_t WS_BT_UP = WS_BT_MO + (size_t)DM * 512 * 2;
constexpr size_t WS_BT_DN = WS_BT_UP + (size_t)DFF2 * DM * 2;
constexpr size_t WS_BT_C1 = WS_BT_DN + (size_t)DM * DFF * 2;
constexpr size_t WS_XN = WS_BT_C1 + (size_t)2 * 256 * 2048 * 2;
constexpr size_t WS_MEMN = WS_XN + (size_t)MP * DM * 2;
constexpr size_t WS_P = WS_MEMN + (size_t)512 * DM * 2;
constexpr size_t WS_QC = WS_P + (size_t)MP * DINP * 4;
constexpr size_t WS_QR = WS_QC + (size_t)MP * 1024 * 2;
constexpr size_t WS_QB = WS_QR + (size_t)MP * 1024 * 2;
constexpr size_t WS_QI = WS_QB + (size_t)MP * 1024 * 2;
constexpr size_t WS_GN = WS_QI + (size_t)MP * 1024 * 2;
constexpr size_t WS_WI = WS_GN + (size_t)MP * 48 * 4;
constexpr size_t WS_GAB = WS_WI + (size_t)MP * 16 * 4;
constexpr size_t WS_KW = WS_GAB + (size_t)MP * 4096 * 2;
constexpr int KCP_ROWS = SEQ + 32;
constexpr size_t WS_KCRAW = WS_KW + (size_t)MP * 256 * 4;
constexpr size_t KCS_OFF = (size_t)8 * KCP_ROWS * 64;
constexpr size_t WS_BPART = al256(WS_KCRAW + (KCS_OFF + (size_t)128 * 8192 * 64 + 64 * 64) * 2);
constexpr size_t WS_BIASC = WS_BPART + 16 * 512 * 4;
constexpr int HC_ROWS = 132 * 256;
constexpr size_t WS_HC = WS_BIASC + 512 * 4;
constexpr size_t WS_KCV = WS_HC + (size_t)2 * HC_ROWS * 256 * 2;
constexpr size_t WS_OCMP = WS_KCV + (size_t)34 * 4 * 512 * 64 * 4;
constexpr size_t WS_SEL = WS_OCMP + (size_t)MP * 1024 * 4;
constexpr size_t WS_IDX = WS_SEL + (size_t)MP * 32 * 4;
constexpr size_t WS_ONSA = WS_IDX + (size_t)MP * 256 * 4;
constexpr size_t WS_ODSA = WS_ONSA + (size_t)MP * 1024 * 2;
constexpr size_t WS_TMPG = WS_ODSA + (size_t)MP * 1024 * 2;
constexpr size_t WS_MG = WS_TMPG + (size_t)MP * DM * 4;
constexpr size_t WS_X1 = WS_MG + (size_t)MP * DM * 2;
constexpr size_t WS_X2 = WS_X1 + (size_t)TP * DM * 2;
constexpr size_t WS_X3 = WS_X2 + (size_t)TP * DM * 2;
constexpr size_t WS_XS1 = WS_X3 + (size_t)TP * DM * 2;
constexpr size_t WS_XS2 = WS_XS1 + (size_t)TS * DM * 4;
constexpr size_t WS_QMB = WS_XS2 + (size_t)TS * DM * 4;
constexpr size_t WS_OM = WS_QMB + (size_t)MP * 512 * 2;
constexpr size_t WS_UB = WS_OM + (size_t)MP * 512 * 2;
constexpr size_t WS_ACT = WS_UB + (size_t)MP * DFF2 * 2;
constexpr size_t WS_NSAF = WS_ACT + (size_t)MP * DFF * 2;
constexpr size_t WS_KCF = WS_NSAF + (size_t)4 * 128 * 8192 * 2;
constexpr size_t WS_KIF = WS_KCF + (size_t)34 * 2 * 16 * 4096 * 2;
constexpr size_t WS_DSAB = WS_KIF + (size_t)2 * 256 * 1024 * 2;
constexpr size_t WS_PART = WS_DSAB + (size_t)2 * 4096 * 256 * 2;
constexpr size_t WS_KIFS = WS_PART + (size_t)22 * 128 * DM * 4;
constexpr size_t WS_SS = WS_KIFS + (size_t)32 * 513 * 1024 * 2;
constexpr size_t WS_RS = WS_SS + (size_t)2 * TP * 4;
constexpr size_t WS_END = WS_RS + (size_t)2 * MP * 4;
static_assert(WS_END < (size_t)2400 * 1024 * 1024, "ws map too large");
constexpr int CW_BAR = 4096;

constexpr int RING_BYTES = 131072, LDS_BYTES = 147456, MISC_OFF = LDS_BYTES - 256;

#define LDS_WAIT() asm volatile("s_waitcnt lgkmcnt(0)" ::: "memory")
#define VM_WAIT() asm volatile("s_waitcnt vmcnt(0)" ::: "memory")
DI unsigned cvt_pk_bf16(float lo, float hi) { unsigned r; asm volatile("v_cvt_pk_bf16_f32 %0, %1, %2" : "=v"(r) : "v"(lo), "v"(hi)); return r; }
DI float bf2f(bf16_t b) { return __uint_as_float(((unsigned)b) << 16); }
DI bf16x8 cvt8(f32x4 a, f32x4 b) { u32x4 w; w.x = cvt_pk_bf16(a.x, a.y); w.y = cvt_pk_bf16(a.z, a.w); w.z = cvt_pk_bf16(b.x, b.y); w.w = cvt_pk_bf16(b.z, b.w); return __builtin_bit_cast(bf16x8, w); }
DI u32x2 cvt4(f32x4 a) { u32x2 w; w.x = cvt_pk_bf16(a.x, a.y); w.y = cvt_pk_bf16(a.z, a.w); return w; }
template <int CTRL> DI float dpp_f_(float x) { return __int_as_float(__builtin_amdgcn_update_dpp(0, __float_as_int(x), CTRL, 0xF, 0xF, true)); }
DI float wave_sum(float v) {
    v += dpp_f_<0xB1>(v); v += dpp_f_<0x4E>(v); v += dpp_f_<0x141>(v); v += dpp_f_<0x140>(v);
    { const auto r = __builtin_amdgcn_permlane16_swap(__float_as_uint(v), __float_as_uint(v), false, false); v = __uint_as_float(r[0]) + __uint_as_float(r[1]); }
    { const auto r = __builtin_amdgcn_permlane32_swap(__float_as_uint(v), __float_as_uint(v), false, false); v = __uint_as_float(r[0]) + __uint_as_float(r[1]); }
    return v;
}
DI f32x4 shfl_xor4(f32x4 v, int m) { f32x4 r; r.x = __shfl_xor(v.x, m); r.y = __shfl_xor(v.y, m); r.z = __shfl_xor(v.z, m); r.w = __shfl_xor(v.w, m); return r; }
DI float sigmoidf_(float x) { return 1.f / (1.f + __expf(-x)); }
#define MFMA16(a, b, c) __builtin_amdgcn_mfma_f32_16x16x32_bf16((a), (b), (c), 0, 0, 0)
namespace pg8 {
constexpr int BM = 256, BK = 64, HALF = 128, HTB = HALF * BK * 2  , STAGE_BYTES = 8 * HTB, NXCD = 8, WGM = 8;
__host__ __device__ __forceinline__ int lds_byte(int r, int c) { const int st = (r >> 4) * 2 + (c >> 5), rr = r & 15, cc = c & 31, ob = rr * 64 + cc * 2; return st * 1024 + (ob ^ (((ob >> 9) & 1) << 5)); }
__host__ __device__ __forceinline__ void stage_rc(int b, int& R, int& C) { const int st = b / 1024, sb = b % 1024, swz = sb ^ (((sb >> 9) & 1) << 5); R = (st >> 1) * 16 + swz / 64; C = (st & 1) * 32 + (swz % 64) / 2; }

struct Unit { int pm, pn, ks; };
struct Gemm { const bf16_t* A; const bf16_t* Bt; int lda, ldb, K; };

struct StaticOrder {
    int nM, nN, nwg, G, c, lda, ldb;
    __device__ void init(int nM_, int nN_, int G_, int c_, int lda_, int ldb_) { nM = nM_; nN = nN_; nwg = nM * nN; G = G_; c = c_; lda = lda_; ldb = ldb_; }
    __device__ bool next(int i, Unit& u) const { return at((long)i * G + c, u); }
    __device__ bool at(long L, Unit& u) const {
        if (L >= nwg) return false;
        int wgid = (int)L; { const int q = nwg / NXCD, r = nwg % NXCD, xcd = wgid % NXCD, off = wgid / NXCD; wgid = (xcd < r ? xcd * (q + 1) : r * (q + 1) + (xcd - r) * q) + off; }
        const int nig = WGM * nN, gid = wgid / nig, fm = gid * WGM, gsz = (nM - fm) < WGM ? (nM - fm) : WGM;
        u.pm = fm + ((wgid % nig) % gsz); u.pn = (wgid % nig) / gsz; u.ks = 0; return true;
    }
    __device__ __forceinline__ size_t offA(const Unit& u) const { return (size_t)u.pm * BM * lda * 2; }
    __device__ __forceinline__ size_t offB(const Unit& u) const { return (size_t)u.pn * BM * ldb * 2; }
    __device__ __forceinline__ int ktiles(const Unit&, int K) const { return K; }
};

template <class F> struct EpiEach {
    static constexpr bool HAS_MID = false;
    F f;
    __device__ __forceinline__ void operator()(const f32x4 (&acc)[2][2][4][2], const Unit& u, int wr, int wc, int fr, int fq) const {
#pragma unroll
        for (int ai = 0; ai < 2; ++ai)
#pragma unroll
            for (int m = 0; m < 4; ++m) { const int row = ai * HALF + wr * 64 + m * 16 + fr;
#pragma unroll
                for (int bj = 0; bj < 2; ++bj)
#pragma unroll
                    for (int n = 0; n < 2; ++n) f(u, row, bj * HALF + wc * 32 + n * 16 + 4 * fq, acc[ai][bj][m][n]); }
    }
};

template <class Epi, class Sched>
__device__ __forceinline__ void gemm_phase(LAS unsigned char* lds, const Gemm g, const Sched& S, const Epi& E) {
    const int tid = threadIdx.x, wid = __builtin_amdgcn_readfirstlane(tid >> 6), lane = tid & 63, wr = wid >> 2, wc = wid & 3, fr = lane & 15, fq = lane >> 4;
    unsigned voffA[2], voffB[2];
#pragma unroll
    for (int i = 0; i < 2; ++i) { int R, C; stage_rc(tid * 16 + i * 8192, R, C); voffA[i] = (unsigned)(R * g.lda + C) * 2u; voffB[i] = (unsigned)(R * g.ldb + C) * 2u; }
    const size_t kstep = (size_t)(BK * 2);
    const size_t hA = (size_t)HALF * g.lda * 2, hB = (size_t)HALF * g.ldb * 2;
    const unsigned ldsw = (unsigned)wid * 1024u;
    const int aoff = lds_byte(wr * 64 + fr, fq * 8), boff = lds_byte(wc * 32 + fr, fq * 8);
#define PG8_SA(b, h) (((b) * 2 + (h)) * HTB)
#define PG8_SB(b, h) ((4 + (b) * 2 + (h)) * HTB)
#define PG8_STAGE(bufoff, gbase, voff) do { _Pragma("unroll") for (int _i = 0; _i < 2; ++_i) \
        __builtin_amdgcn_global_load_lds((const unsigned*)((const char*)(gbase) + (voff)[_i]), (LAS unsigned*)(lds + (bufoff) + ldsw + _i * 8192), 16, 0, 0); } while (0)
#define PG8_LDA(dst, b, h) do { _Pragma("unroll") for (int m = 0; m < 4; ++m) _Pragma("unroll") for (int k = 0; k < 2; ++k) dst[m][k] = *(const LAS bf16x8*)(lds + PG8_SA(b, h) + aoff + m * 2048 + k * 1024); } while (0)
#define PG8_LDB(dst, b, h) do { _Pragma("unroll") for (int n = 0; n < 2; ++n) _Pragma("unroll") for (int k = 0; k < 2; ++k) dst[n][k] = *(const LAS bf16x8*)(lds + PG8_SB(b, h) + boff + n * 2048 + k * 1024); } while (0)
#define PG8_MMA(ai, bj, At, Bt) do { __builtin_amdgcn_s_setprio(1); _Pragma("unroll") for (int m = 0; m < 4; ++m) _Pragma("unroll") for (int n = 0; n < 2; ++n) _Pragma("unroll") for (int k = 0; k < 2; ++k) \
        acc[ai][bj][m][n] = __builtin_amdgcn_mfma_f32_16x16x32_bf16(Bt[n][k], At[m][k], acc[ai][bj][m][n], 0, 0, 0); __builtin_amdgcn_s_setprio(0); } while (0)
#define PG8_WAIT_V(n) asm volatile("s_waitcnt vmcnt(" #n ")" ::: "memory")
#define PG8_WAIT_L(n) asm volatile("s_waitcnt lgkmcnt(" #n ")" ::: "memory")
#define PG8_BAR __builtin_amdgcn_s_barrier()
#define PG8_SCHED __builtin_amdgcn_sched_barrier(0)
    Unit cur, nxt; int ui = 0;
    if (!S.next(0, cur)) return;
    f32x4 acc[2][2][4][2];
#pragma unroll
    for (int a = 0; a < 2; ++a)
#pragma unroll
        for (int b = 0; b < 2; ++b)
#pragma unroll
            for (int m = 0; m < 4; ++m)
#pragma unroll
                for (int n = 0; n < 2; ++n) acc[a][b][m][n] = (f32x4){0.f, 0.f, 0.f, 0.f};
    bf16x8 At[4][2], B0[2][2], B1[2][2];
    const char* cA = (const char*)g.A + S.offA(cur); const char* cB = (const char*)g.Bt + S.offB(cur);
    PG8_STAGE(PG8_SB(0, 0), cB, voffB); PG8_STAGE(PG8_SB(0, 1), cB + hB, voffB); PG8_STAGE(PG8_SA(0, 0), cA, voffA); PG8_STAGE(PG8_SA(0, 1), cA + hA, voffA);
    if (wr == 1) PG8_BAR;
    PG8_WAIT_V(2); PG8_BAR;
    PG8_STAGE(PG8_SB(1, 0), cB + kstep, voffB); PG8_STAGE(PG8_SA(1, 0), cA + kstep, voffA); PG8_STAGE(PG8_SB(1, 1), cB + hB + kstep, voffB);
    PG8_WAIT_V(6); PG8_BAR;
    for (;;) {
        const bool has_next = S.next(ui + 1, nxt);
        const int nt = S.ktiles(cur, g.K) / BK;
        const char* nA = has_next ? (const char*)g.A + S.offA(nxt) : cA; const char* nB = has_next ? (const char*)g.Bt + S.offB(nxt) : cB;
        constexpr int NHALF = Epi::HAS_MID ? 2 : 1; const int tlen = nt / NHALF;
#pragma unroll 1
        for (int hf = 0; hf < NHALF; ++hf) {
#pragma unroll 1
        for (int t = hf * tlen; t < (hf + 1) * tlen; t += 2) {
            const bool last = (t == nt - 2);
            const char* a1 = cA + (size_t)(t + 1) * kstep;
            const char* a2 = last ? nA : cA + (size_t)(t + 2) * kstep; const char* b2 = last ? nB : cB + (size_t)(t + 2) * kstep;
            const char* a3 = a2 + kstep; const char* b3 = b2 + kstep;
            PG8_LDB(B0, 0, 0); PG8_LDB(B1, 0, 1); PG8_SCHED; PG8_LDA(At, 0, 0); PG8_STAGE(PG8_SA(1, 1), a1 + hA, voffA);
            PG8_WAIT_V(8); PG8_WAIT_L(0); PG8_BAR; PG8_MMA(0, 0, At, B0); PG8_MMA(0, 1, At, B1); PG8_BAR; PG8_SCHED;
            PG8_LDA(At, 0, 1); PG8_STAGE(PG8_SB(0, 0), b2, voffB); PG8_STAGE(PG8_SB(0, 1), b2 + hB, voffB); PG8_STAGE(PG8_SA(0, 0), a2, voffA);
            PG8_WAIT_V(8); PG8_WAIT_L(0); PG8_BAR; PG8_MMA(1, 0, At, B0); PG8_MMA(1, 1, At, B1); PG8_BAR; PG8_SCHED;
            PG8_LDB(B0, 1, 0); PG8_LDB(B1, 1, 1); PG8_SCHED; PG8_LDA(At, 1, 0); PG8_STAGE(PG8_SA(0, 1), a2 + hA, voffA);
            PG8_WAIT_V(8); PG8_WAIT_L(0); PG8_BAR; PG8_MMA(0, 0, At, B0); PG8_MMA(0, 1, At, B1); PG8_BAR; PG8_SCHED;
            PG8_LDA(At, 1, 1); PG8_STAGE(PG8_SB(1, 0), b3, voffB); PG8_STAGE(PG8_SB(1, 1), b3 + hB, voffB); PG8_STAGE(PG8_SA(1, 0), a3, voffA);
            PG8_WAIT_V(8); PG8_WAIT_L(0); PG8_BAR; PG8_MMA(1, 0, At, B0); PG8_MMA(1, 1, At, B1); PG8_BAR; PG8_SCHED;
        }
        if constexpr (Epi::HAS_MID) { if (hf == 0) E.mid(acc, cur, wr, wc, fr, fq); }
        }
        if (wr == 0) PG8_BAR;
        E(acc, cur, wr, wc, fr, fq);
        if (!has_next) break;
#pragma unroll
        for (int a = 0; a < 2; ++a)
#pragma unroll
            for (int b = 0; b < 2; ++b)
#pragma unroll
                for (int m = 0; m < 4; ++m)
#pragma unroll
                    for (int n = 0; n < 2; ++n) acc[a][b][m][n] = (f32x4){0.f, 0.f, 0.f, 0.f};
        cur = nxt; cA = nA; cB = nB; ++ui;
        if (wr == 1) PG8_BAR;
    }
    PG8_WAIT_V(0);
    PG8_BAR;
#undef PG8_SA
#undef PG8_SB
#undef PG8_STAGE
#undef PG8_LDA
#undef PG8_LDB
#undef PG8_MMA
#undef PG8_WAIT_V
#undef PG8_WAIT_L
#undef PG8_BAR
#undef PG8_SCHED
}
}
#define XB_TMO      128
#define XB_XCNT(j)  (256  + 64 * (j))
#define XB_XSUB(j)  (1280 + 64 * (j))
#define XB_XGEN(j)  (2304 + 64 * (j))
#define XB_TOP      3328
#define XB_TOPGEN   3392
#define XCD_BAR_WORDS 3456
#define XB_SPIN_CAP (1u << 18)

__device__ __forceinline__ unsigned xb_ld(unsigned* p)              { return __hip_atomic_load(p, __ATOMIC_RELAXED, __HIP_MEMORY_SCOPE_AGENT); }
__device__ __forceinline__ unsigned xb_add(unsigned* p, unsigned v) { return __hip_atomic_fetch_add(p, v, __ATOMIC_RELAXED, __HIP_MEMORY_SCOPE_AGENT); }
__device__ __forceinline__ unsigned xb_xcc_id() { return (unsigned)__builtin_amdgcn_s_getreg((3 << 11) | 20) & 0xFu; }
#define XB_SPIN(cond, bar) do { unsigned _sp = 0; while (cond) { __builtin_amdgcn_s_sleep(1); \
    if ((++_sp & 255u) == 0u) { if (xb_ld(&(bar)[XB_TMO])) break; if (_sp > XB_SPIN_CAP) { atomicAdd(&(bar)[XB_TMO], 1u); break; } } } } while (0)

struct XcdBarrier {
    unsigned* bar; unsigned x;
    volatile LAS unsigned* st;
};

__device__ __forceinline__ XcdBarrier xcd_barrier_post(unsigned* bar, volatile LAS unsigned* st) {
    XcdBarrier b; b.bar = bar; b.x = xb_xcc_id(); b.st = st;
    if (threadIdx.x == 0) (void)xb_add(&bar[XB_XCNT(b.x)], 1u);
    return b;
}
__device__ __forceinline__ void xcd_barrier_complete(unsigned* bar, unsigned x, unsigned& nloc, unsigned& nx) {
    const unsigned G = gridDim.x * gridDim.y * gridDim.z;
    unsigned sum, cnt, mine, sp = 0u;
    for (;;) {
        sum = 0u; cnt = 0u; mine = 0u;
#pragma unroll
        for (unsigned j = 0; j < 16; ++j) { const unsigned c = xb_ld(&bar[XB_XCNT(j)]); sum += c; cnt += (c > 0u) ? 1u : 0u; mine = (j == x) ? c : mine; }
        if (sum == G) break;
        __builtin_amdgcn_s_sleep(1);
        if ((++sp & 255u) == 0u) { if (xb_ld(&bar[XB_TMO])) break; if (sp > XB_SPIN_CAP) { atomicAdd(&bar[XB_TMO], 1u); break; } }
    }
    nloc = mine > 0u ? mine : 1u; nx = cnt > 0u ? cnt : 1u;
}

__device__ __forceinline__ void xcd_barrier(const XcdBarrier& b) {
    asm volatile("s_waitcnt vmcnt(0)" ::: "memory");
    __syncthreads();
    if (threadIdx.x == 0) {
        unsigned* bar = b.bar;
        __builtin_amdgcn_s_waitcnt(0);
        unsigned nloc = b.st[0], nx = b.st[1];
        if (nloc == 0u) { xcd_barrier_complete(bar, b.x, nloc, nx); b.st[0] = nloc; b.st[1] = nx; }
        const unsigned old = xb_add(&bar[XB_XSUB(b.x)], 1u);
        const unsigned gen = old / nloc;
        if (old + 1u == (gen + 1u) * nloc) {
            __builtin_amdgcn_fence(__ATOMIC_RELEASE, "agent");
            asm volatile("s_waitcnt vmcnt(0)" ::: "memory");
            const unsigned og = xb_add(&bar[XB_TOP], 1u);
            const unsigned tg = og / nx;
            if (og + 1u == (tg + 1u) * nx) xb_add(&bar[XB_TOPGEN], 1u);
            else XB_SPIN(xb_ld(&bar[XB_TOPGEN]) == tg, bar);
            __builtin_amdgcn_fence(__ATOMIC_ACQUIRE, "agent");
            xb_add(&bar[XB_XGEN(b.x)], 1u);
            asm volatile("s_waitcnt vmcnt(0)" ::: "memory");
        } else {
            XB_SPIN(xb_ld(&bar[XB_XGEN(b.x)]) == gen, bar);
            __builtin_amdgcn_fence(__ATOMIC_ACQUIRE, "agent");
            asm volatile("s_waitcnt vmcnt(0)" ::: "memory");
        }
    }
    __syncthreads();
}
struct Args { const void* in[N_IN]; float* out; unsigned char* ws; int ph_lo, ph_hi; };
constexpr int NWAVES = 8, NTHR = 512;

struct FStoreF32 { float* C; int ldc; DI void operator()(const pg8::Unit& u, int row, int col, f32x4 v) const { *(f32x4*)(C + (size_t)(u.pm * 256 + row) * ldc + u.pn * 256 + col) = v; } };

DI void p0_transpose_item(const float* W, int K, int N, bf16_t* WT, LAS float* scr, int item, int lane, int ldw = 0) {
    if (ldw == 0) ldw = K;
    const int nblk = N / 32, kb = item / nblk, nb = item % nblk, k0 = 64 * kb, n0 = 32 * nb;
#pragma unroll 8
    for (int i = 0; i < 32; ++i) { const int kk = 2 * i + (lane >> 5); scr[kk * 33 + (lane & 31)] = W[(size_t)(k0 + kk) * N + n0 + (lane & 31)]; }
    LDS_WAIT();
    const int c = lane & 7;
#pragma unroll
    for (int j = 0; j < 4; ++j) { const int n = (lane >> 3) + 8 * j; const LAS float* s = scr + (8 * c) * 33 + n;
        u32x4 o; o.x = cvt_pk_bf16(s[0 * 33], s[1 * 33]); o.y = cvt_pk_bf16(s[2 * 33], s[3 * 33]); o.z = cvt_pk_bf16(s[4 * 33], s[5 * 33]); o.w = cvt_pk_bf16(s[6 * 33], s[7 * 33]);
        *(u32x4*)(WT + (size_t)(n0 + n) * ldw + k0 + 8 * c) = o; }
    LDS_WAIT();
}
struct TrItem { const float* W; bf16_t* WT; int N, ldw, k0, n0; };
DI void tr_load(const TrItem& t, int lane, float (&v)[32]) {
#pragma unroll
    for (int i = 0; i < 32; ++i) v[i] = t.W[(size_t)(t.k0 + 2 * i + (lane >> 5)) * t.N + t.n0 + (lane & 31)];
}
DI void tr_store(const TrItem& t, LAS float* scr, int lane, const float (&v)[32]) {
#pragma unroll
    for (int i = 0; i < 32; ++i) scr[(2 * i + (lane >> 5)) * 33 + (lane & 31)] = v[i];
    LDS_WAIT();
    const int c = lane & 7;
#pragma unroll
    for (int j = 0; j < 4; ++j) { const int n = (lane >> 3) + 8 * j; const LAS float* s = scr + (8 * c) * 33 + n;
        u32x4 o; o.x = cvt_pk_bf16(s[0 * 33], s[1 * 33]); o.y = cvt_pk_bf16(s[2 * 33], s[3 * 33]); o.z = cvt_pk_bf16(s[4 * 33], s[5 * 33]); o.w = cvt_pk_bf16(s[6 * 33], s[7 * 33]);
        *(u32x4*)(t.WT + (size_t)(t.n0 + n) * t.ldw + t.k0 + 8 * c) = o; }
    LDS_WAIT();
}
DI void rms_row_bf16(const float* xrow, const float* g, bf16_t* orow, int lane) {
    const f32x4* xr = (const f32x4*)xrow + lane; const f32x4* gr = (const f32x4*)g + lane;
    f32x4 v[8]; float s = 0.f;
#pragma unroll
    for (int j = 0; j < 8; ++j) { v[j] = xr[64 * j]; s += (v[j].x * v[j].x + v[j].y * v[j].y) + (v[j].z * v[j].z + v[j].w * v[j].w); }
    const float rstd = rsqrtf(wave_sum(s) * (1.f / 2048.f) + 1e-6f);
    u32x2* o8 = (u32x2*)orow + lane;
#pragma unroll
    for (int j = 0; j < 8; ++j) { const f32x4 gg = gr[64 * j]; o8[64 * j] = cvt4(v[j] * rstd * gg); }
}

constexpr int NT_IN = 32 * 260, NT_OA = 16 * 64, NT_O = 32 * 64, NT_MQ = 32 * 16, NT_MKV = 32 * 32, NT_MO = 8 * 64, NT_UP = 32 * 352, NT_DN = 88 * 64, NT_C1 = 32 * 8;
constexpr int N_PG = 32 * NPAGES, N_BP = 128, N_WC = 32 * 508;
constexpr int NT_ALL = NT_UP + NT_IN + NT_DN + NT_O + 2 * NT_OA + NT_MQ + NT_MKV + NT_MO + 2 * NT_C1;
constexpr int PI_REST = TT + 512 + 2 * N_PG + N_BP + N_WC;
constexpr int NT_FIRST = NT_IN + NT_MKV + 2 * NT_C1;
DI TrItem tr_decode(const Args& a, int tix) {
    unsigned char* ws = a.ws; int r = tix; const float* W; bf16_t* WT; int K, N, ldw;
    if (r < NT_IN) { W = (const float*)a.in[I_WIN]; K = DM; N = DIN; WT = (bf16_t*)(ws + WS_BT_IN); ldw = K; }
    else if ((r -= NT_IN) < NT_MKV) { W = (const float*)a.in[I_WMKV]; K = DM; N = 1024; WT = (bf16_t*)(ws + WS_BT_MKV); ldw = K; }
    else if ((r -= NT_MKV) < NT_C1) { W = (const float*)a.in[I_CW1]; K = 2048; N = 256; WT = (bf16_t*)(ws + WS_BT_C1); ldw = K; }
    else if ((r -= NT_C1) < NT_C1) { W = (const float*)a.in[I_CW1] + (size_t)2048 * 256; K = 2048; N = 256; WT = (bf16_t*)(ws + WS_BT_C1) + (size_t)256 * 2048; ldw = K; }
    else if ((r -= NT_C1) < NT_UP) { W = (const float*)a.in[I_WUP]; K = DM; N = DFF2; WT = (bf16_t*)(ws + WS_BT_UP); ldw = K; }
    else if ((r -= NT_UP) < NT_DN) { W = (const float*)a.in[I_WDN]; K = DFF; N = DM; WT = (bf16_t*)(ws + WS_BT_DN); ldw = K; }
    else if ((r -= NT_DN) < NT_O) { W = (const float*)a.in[I_WO]; K = DM; N = DM; WT = (bf16_t*)(ws + WS_BT_O); ldw = K; }
    else if ((r -= NT_O) < NT_OA) { W = (const float*)a.in[I_WOA]; K = 1024; N = DM; WT = (bf16_t*)(ws + WS_BT_OA); ldw = 2048; }
    else if ((r -= NT_OA) < NT_OA) { W = (const float*)a.in[I_WOB]; K = 1024; N = DM; WT = (bf16_t*)(ws + WS_BT_OA) + 1024; ldw = 2048; }
    else if ((r -= NT_OA) < NT_MQ) { W = (const float*)a.in[I_WMQ]; K = DM; N = 512; WT = (bf16_t*)(ws + WS_BT_MQ); ldw = K; }
    else { r -= NT_MQ; W = (const float*)a.in[I_WMO]; K = 512; N = DM; WT = (bf16_t*)(ws + WS_BT_MO); ldw = K; }
    const int nblk = N / 32; TrItem t; t.W = W; t.WT = WT; t.N = N; t.ldw = ldw; t.k0 = 64 * (r / nblk); t.n0 = 32 * (r % nblk); return t;
}
DI void tr_fill(const Args& a, LAS unsigned char* lds, unsigned* ctr, int lo, int hi) {
    const int tid = threadIdx.x, lane = tid & 63, wave = __builtin_amdgcn_readfirstlane(tid >> 6);
    LAS float* scr = (LAS float*)(lds + wave * 16384);
    unsigned* sctr = ctr + 64 * (blockIdx.x & 31);
#define TRQ() ({ int v_ = 0; if (lane == 0) v_ = (int)__hip_atomic_fetch_add(sctr, 1u, __ATOMIC_RELAXED, __HIP_MEMORY_SCOPE_AGENT); lo + (int)(blockIdx.x & 31) + 32 * __builtin_amdgcn_readfirstlane(v_); })
    int i0 = TRQ(); if (i0 >= hi) return;
    float va[32], vb[32]; TrItem ta = tr_decode(a, i0), tb = ta; tr_load(ta, lane, va);
#pragma unroll 1
    for (;;) {
        const int i1 = TRQ(); const bool h1 = i1 < hi; if (h1) { tb = tr_decode(a, i1); tr_load(tb, lane, vb); }
        tr_store(ta, scr, lane, va);
        if (!h1) break;
        const int i2 = TRQ(); const bool h2 = i2 < hi; if (h2) { ta = tr_decode(a, i2); tr_load(ta, lane, va); }
        tr_store(tb, scr, lane, vb);
        if (!h2) break;
    }
#undef TRQ
}
DI void prologue_item(const Args& a, LAS float* scr, int lane, int it) {
    unsigned char* ws = a.ws; int r = it;
    if (r < TT) {
        const float* xrow = r < TP ? (const float*)a.in[I_XP] + (size_t)r * DM : (const float*)a.in[I_XS] + (size_t)(r - TP) * DM;
        rms_row_bf16(xrow, (const float*)a.in[I_NG], (bf16_t*)(ws + WS_XN) + (size_t)r * DM, lane); return; } r -= TT;
    if (r < 512) { rms_row_bf16((const float*)a.in[I_MEM] + (size_t)r * DM, (const float*)a.in[I_NG] + 2 * DM, (bf16_t*)(ws + WS_MEMN) + (size_t)r * DM, lane); return; } r -= 512;
    if (r < N_PG) {
        const int db = r >> 6, pj = r & 63; const int page = ((const int*)a.in[I_PT])[db * NPAGES + pj];
        const float* src = (const float*)a.in[I_CNSA] + (size_t)page * 128 * 512;
        bf16_t* dst = (bf16_t*)(ws + WS_KCRAW) + KCS_OFF;
        const int c = lane >> 5, g = (lane >> 4) & 1, d0 = (lane & 15) * 4;
        bf16_t* drow = dst + ((size_t)((db * 2 + c) * 2 + g) * 8192 + pj * 128) * 64 + d0;
#pragma unroll 16
        for (int s = 0; s < 128; ++s) { const f32x4 v = *(const f32x4*)(src + (size_t)s * 512 + lane * 4); *(u32x2*)(drow + (size_t)s * 64) = cvt4(v); }
        return; } r -= N_PG;
    if (r < N_PG) {
        const int db = r >> 6, pj = r & 63; const int page = ((const int*)a.in[I_PT])[db * NPAGES + pj];
        const float* src = (const float*)a.in[I_CDSA] + (size_t)page * 128 * 320 + 256;
        bf16_t* dst = (bf16_t*)(ws + WS_KIFS) + ((size_t)db * 513 + pj * 8) * 1024;
        const int sl = lane >> 4, d0 = (lane & 15) * 4;
#pragma unroll 16
        for (int i = 0; i < 32; ++i) { const int slot = 4 * i + sl; const f32x4 v = *(const f32x4*)(src + (size_t)slot * 320 + d0);
            *(u32x2*)(dst + ((size_t)(slot >> 4) * 2 + (d0 >> 5)) * 512 + (((d0 >> 3) & 3) * 16 + (slot & 15)) * 8 + ((d0 >> 2) & 1) * 4) = cvt4(v); }
        return; } r -= N_PG;
    if (r < N_BP) {
        const int kv = r >> 6, nch = (r >> 4) & 3, kch = r & 15, n = nch * 64 + lane;
        const float* pe = (const float*)a.in[I_PE] + (size_t)kv * 2048 + kch * 128; const float* w1 = (const float*)a.in[I_CW1] + ((size_t)kv * 2048 + kch * 128) * 256 + n;
        float acc = 0.f;
#pragma unroll 8
        for (int k = 0; k < 128; ++k) acc += pe[k] * w1[(size_t)k * 256];
        ((float*)(ws + WS_BPART))[(kch * 2 + kv) * 256 + n] = acc; return; } r -= N_BP;
    {
        const int db = r / 508, j = r % 508;
        const f32x4 v = *((const f32x4*)((const float*)a.in[I_SWIN] + ((size_t)db * 512 + j + 4) * 256) + lane);
        *((f32x4*)(a.out + O_WINS + ((size_t)db * 512 + j) * 256) + lane) = v; }
}
DI void tr_strided(const Args& a, LAS float* scr, int lane, int lo, int hi, int widx, int nw) {
    if (lo + widx >= hi) return;
    float va[32], vb[32]; TrItem ta = tr_decode(a, lo + widx), tb = ta; tr_load(ta, lane, va);
#pragma unroll 1
    for (int tix = lo + widx; tix < hi; tix += 2 * nw) {
        const bool h1 = tix + nw < hi; if (h1) { tb = tr_decode(a, tix + nw); tr_load(tb, lane, vb); }
        tr_store(ta, scr, lane, va);
        if (!h1) break;
        const bool h2 = tix + 2 * nw < hi; if (h2) { ta = tr_decode(a, tix + 2 * nw); tr_load(ta, lane, va); }
        tr_store(tb, scr, lane, vb);
    }
}
DI void phase0(const Args& a, LAS unsigned char* lds, int pm = 3, int r0 = 0, int r1 = PI_REST) {
    const int tid = threadIdx.x, lane = tid & 63, wave = __builtin_amdgcn_readfirstlane(tid >> 6);
    const int gw = blockIdx.x * NWAVES + wave, NGW = gridDim.x * NWAVES;
    LAS float* scr = (LAS float*)(lds + wave * 16384);
    unsigned char* ws = a.ws;
    if (pm & 1) tr_strided(a, scr, lane, 0, NT_FIRST, gw, NGW);
    if (pm & 2) {
#pragma unroll 1
        for (int it = r0 + gw; it < r1; it += NGW) prologue_item(a, scr, lane, it); }
    { const size_t gt = (size_t)blockIdx.x * NTHR + tid, NG = (size_t)gridDim.x * NTHR; const u32x4 z = (u32x4){0u, 0u, 0u, 0u};
      u32x4* p1 = (u32x4*)((bf16_t*)(ws + WS_BT_IN) + (size_t)DIN * DM); u32x4* p2 = (u32x4*)((bf16_t*)(ws + WS_XN) + (size_t)TT * DM);
      for (size_t i = gt; i < (size_t)128 * DM / 8; i += NG) { p1[i] = z; p2[i] = z; }
      float* ss = (float*)(ws + WS_SS); for (size_t i = gt; i < (size_t)2 * TP; i += NG) ss[i] = 0.f; }
}

DI f32x4 rope4(f32x4 v, f32x4 pv, int d0, int half, int tb, float cv, float sv) {
    const int fi = tb + (d0 & (half - 1));
    f32x4 c, s;
    c.x = __shfl(cv, fi); c.y = __shfl(cv, fi + 1); c.z = __shfl(cv, fi + 2); c.w = __shfl(cv, fi + 3);
    s.x = __shfl(sv, fi); s.y = __shfl(sv, fi + 1); s.z = __shfl(sv, fi + 2); s.w = __shfl(sv, fi + 3);
    const f32x4 lo = v * c - pv * s, hi = v * c + pv * s;
    return d0 < half ? lo : (d0 < 2 * half ? hi : v);
}
DI f32x4 ldbf4p(const bf16_t* p) { const u32x2 w = *(const u32x2*)p; f32x4 r; r.x = __uint_as_float(w.x << 16); r.y = __uint_as_float(w.x & 0xffff0000u); r.z = __uint_as_float(w.y << 16); r.w = __uint_as_float(w.y & 0xffff0000u); return r; }
DI f32x4 sig4(f32x4 v) { f32x4 r; r.x = sigmoidf_(v.x); r.y = sigmoidf_(v.y); r.z = sigmoidf_(v.z); r.w = sigmoidf_(v.w); return r; }

DI void phase2(const Args& a, LAS unsigned char* lds) {
    const int tid = threadIdx.x, lane = tid & 63, wave = __builtin_amdgcn_readfirstlane(tid >> 6);
    const int gw = blockIdx.x * NWAVES + wave, NGW = gridDim.x * NWAVES;
    unsigned char* ws = a.ws; float* out = a.out;
    const bf16_t* P = (const bf16_t*)(ws + WS_P);
    bf16_t* QC = (bf16_t*)(ws + WS_QC); bf16_t* QR = (bf16_t*)(ws + WS_QR); bf16_t* QB = (bf16_t*)(ws + WS_QB); bf16_t* QI = (bf16_t*)(ws + WS_QI);
    float* GN = (float*)(ws + WS_GN); float* WI = (float*)(ws + WS_WI); bf16_t* GAB = (bf16_t*)(ws + WS_GAB); float* KW = (float*)(ws + WS_KW);
    bf16_t* KCP = (bf16_t*)(ws + WS_KCRAW); bf16_t* NSAF = (bf16_t*)(ws + WS_NSAF);
    if (gw == 0) {
        for (int i = lane; i < 512; i += 64) { float s = ((const float*)a.in[I_CB1])[i];
            for (int k = 0; k < 16; ++k) s += ((const float*)(ws + WS_BPART))[k * 512 + i];
            ((float*)(ws + WS_BIASC))[i] = s; }
    }
    for (int r = gw; r < TT; r += NGW) {
        const bool pr = r < TP; const int b = r >> 12, s = r & 4095, q = r - TP, db = q >> 2, tt = q & 3;
        const int pos = pr ? s : 8192 + tt;
        float cv, sv; { const float e = lane < 8 ? -(float)lane / 8.f : -(float)((lane - 8) & 15) / 16.f; const float inv = powf(500000.f, e); const float ang = (float)pos * inv; cv = cosf(ang); sv = sinf(ang); }
        const bf16_t* Pr = P + (size_t)r * DINP;
        f32x4 L_qa[4], L_kva[3], L_qb[4], L_qi[4], L_gm[16];
#pragma unroll
        for (int i = 0; i < 4; ++i) { L_qa[i] = ldbf4p(Pr + C_QA + 256 * i + 4 * lane); L_qb[i] = ldbf4p(Pr + C_QB + 256 * i + 4 * lane); L_qi[i] = ldbf4p(Pr + C_QI + 256 * i + 4 * lane); }
#pragma unroll
        for (int i = 0; i < 3; ++i) L_kva[i] = ldbf4p(Pr + C_KVA + 256 * i + 4 * lane);
#pragma unroll
        for (int i = 0; i < 16; ++i) L_gm[i] = ldbf4p(Pr + C_GM + 256 * i + 4 * lane);
        const f32x4 L_ga = lane < 12 ? ldbf4p(Pr + C_GA + 4 * lane) : (f32x4){0.f, 0.f, 0.f, 0.f};
        const f32x4 L_kvb = ldbf4p(Pr + C_KVB + 4 * lane);
        const f32x4 L_ki = lane < 16 ? ldbf4p(Pr + C_KI + 4 * lane) : (f32x4){0.f, 0.f, 0.f, 0.f};
        const f32x4 L_wi = lane < 4 ? ldbf4p(Pr + C_WI + 4 * lane) : (f32x4){0.f, 0.f, 0.f, 0.f};
#pragma unroll
        for (int i = 0; i < 4; ++i) { const int col = 256 * i + 4 * lane; const f32x4 v = L_qa[i]; const f32x4 pv = shfl_xor4(v, 2);
            const f32x4 rv = rope4(v, pv, (4 * lane) & 63, 8, 0, cv, sv);
            *(u32x2*)(QC + (size_t)r * 1024 + col) = cvt4(v); *(u32x2*)(QR + (size_t)r * 1024 + col) = cvt4(rv); }
#pragma unroll
        for (int i = 0; i < 3; ++i) { const int cl = 256 * i + 4 * lane; const f32x4 v = L_kva[i]; const f32x4 pv = shfl_xor4(v, 2);
            const int j = cl >> 7, g = (cl >> 6) & 1, d0 = cl & 63;
            const f32x4 rv = rope4(v, pv, d0, 8, 0, cv, sv); const f32x4 o = (j == 2 || j == 4) ? rv : v;
            if (pr && j >= 2) {
                bf16_t* tile = NSAF + ((size_t)((b * 2 + g) * 128 + (s >> 5)) * 4 + (j - 2)) * 2048; const int slot = s & 31;
                if ((j & 1) == 0) { *(u32x2*)(tile + (((d0 >> 5) * 2 + (slot >> 4)) * 64 + ((d0 >> 3) & 3) * 16 + (slot & 15)) * 8 + ((d0 >> 2) & 1) * 4) = cvt4(o); }
                else { const int kgv = (slot & 15) >> 2, jv = (slot & 3) + ((slot >> 4) << 2); const u32x2 w = cvt4(o);
                    bf16_t* t0 = tile + (((d0 >> 4) * 64 + kgv * 16 + (d0 & 15)) * 8) + jv;
                    t0[0] = (bf16_t)(w.x & 0xffffu); t0[8] = (bf16_t)(w.x >> 16); t0[16] = (bf16_t)(w.y & 0xffffu); t0[24] = (bf16_t)(w.y >> 16); }
            }
            if (j < 4) {
                float* dst = pr ? out + O_NSAP + ((size_t)r * 4 + j) * 128 + g * 64 + d0 : out + O_NSAS + ((size_t)q * 4 + j) * 128 + g * 64 + d0;
                *(f32x4*)dst = o;
                if (pr && j < 2) *(u32x2*)(KCP + ((size_t)((b * 2 + j) * 2 + g) * KCP_ROWS + s) * 64 + d0) = cvt4(o);
            } else {
                const int kv = j - 4;
                *(f32x4*)(KW + (size_t)r * 256 + kv * 128 + g * 64 + d0) = o;
                if (pr) { if (s >= SEQ - 512) *(f32x4*)(out + O_WINP + (((size_t)b * 512 + s - (SEQ - 512)) * 2 + kv) * 128 + g * 64 + d0) = o; }
                else *(f32x4*)(out + O_WINS + (((size_t)db * 512 + 508 + tt) * 2 + kv) * 128 + g * 64 + d0) = o;
            } }
        if (lane < 12) { const f32x4 v = L_ga; *(f32x4*)(GN + (size_t)r * 48 + 4 * lane) = sig4(v); }
#pragma unroll
        for (int i = 0; i < 4; ++i) { const int col = 256 * i + 4 * lane; const f32x4 v = L_qb[i]; const f32x4 pv = shfl_xor4(v, 4);
            const f32x4 rv = rope4(v, pv, (4 * lane) & 127, 16, 8, cv, sv);
            *(u32x2*)(QB + (size_t)r * 1024 + col) = cvt4(rv); }
        { const int cl = 4 * lane; const f32x4 v = L_kvb; const f32x4 pv = shfl_xor4(v, 4);
          const f32x4 rv = rope4(v, pv, cl & 127, 16, 8, cv, sv); const f32x4 o = cl < 128 ? rv : v;
          float* dst = pr ? out + O_DSAP + (size_t)r * 320 + cl : out + O_DSAS + (size_t)q * 320 + cl; *(f32x4*)dst = o;
          if (pr) *(u32x2*)((bf16_t*)(ws + WS_DSAB) + (size_t)r * 256 + cl) = cvt4(o); }
#pragma unroll
        for (int i = 0; i < 4; ++i) { const int col = 256 * i + 4 * lane; const f32x4 v = L_qi[i]; const f32x4 pv = shfl_xor4(v, 2);
            const f32x4 rv = rope4(v, pv, (4 * lane) & 63, 8, 0, cv, sv);
            *(u32x2*)(QI + (size_t)r * 1024 + col) = cvt4(rv); }
        { const f32x4 v = L_ki; const f32x4 pv = shfl_xor4(v, 2);
          const f32x4 rv = rope4(v, pv, (4 * lane) & 63, 8, 0, cv, sv);
          if (lane < 16) { float* dst = pr ? out + O_DSAP + (size_t)r * 320 + 256 + 4 * lane : out + O_DSAS + (size_t)q * 320 + 256 + 4 * lane; *(f32x4*)dst = rv;
              const int d0 = 4 * lane;
              if (pr) *(u32x2*)((bf16_t*)(ws + WS_KIF) + ((size_t)(b * 256 + (s >> 4)) * 2 + (d0 >> 5)) * 512 + (((d0 >> 3) & 3) * 16 + (s & 15)) * 8 + ((d0 >> 2) & 1) * 4) = cvt4(rv);
              else *(u32x2*)((bf16_t*)(ws + WS_KIFS) + ((size_t)(db * 513 + 512) * 2 + (d0 >> 5)) * 512 + (((d0 >> 3) & 3) * 16 + tt) * 8 + ((d0 >> 2) & 1) * 4) = cvt4(rv); }
          if (lane < 4) *(f32x4*)(WI + (size_t)r * 16 + 4 * lane) = L_wi; }
#pragma unroll
        for (int i = 0; i < 16; ++i) { const int col = 256 * i + 4 * lane; const f32x4 v = L_gm[i]; *(u32x2*)(GAB + (size_t)r * 4096 + col) = cvt4(sig4(v)); }
    }
}
struct P1Order { pg8::StaticOrder so;
    DI bool next(int i, pg8::Unit& u) const { const long L = (long)i * so.G + so.c; if (L < so.nwg) return so.at(L, u); const int j = (int)(L - so.nwg); if (j >= 8) return false; u.pm = j >> 2; u.pn = j & 3; u.ks = 1; return true; }
    DI size_t offA(const pg8::Unit& u) const { return (size_t)u.pm * 256 * DM * 2 + (u.ks ? (WS_MEMN - WS_XN) : 0); }
    DI size_t offB(const pg8::Unit& u) const { return (size_t)u.pn * 256 * DM * 2 + (u.ks ? (WS_BT_MKV - WS_BT_IN) : 0); }
    DI int ktiles(const pg8::Unit&, int K) const { return K; }
};
struct FP1 { bf16_t* P; float* memkv; DI void operator()(const pg8::Unit& u, int row, int col, f32x4 v) const {
    if (u.ks) *(f32x4*)(memkv + (size_t)(u.pm * 256 + row) * 1024 + u.pn * 256 + col) = v; else *(u32x2*)(P + (size_t)(u.pm * 256 + row) * DINP + u.pn * 256 + col) = cvt4(v); } };
DI void phase1(const Args& a, LAS unsigned char* lds) {
    unsigned char* ws = a.ws;
    pg8::Gemm g{(const bf16_t*)(ws + WS_XN), (const bf16_t*)(ws + WS_BT_IN), DM, DM, DM};
    P1Order S; S.so.init(MP / 256, DINP / 256, gridDim.x, blockIdx.x, DM, DM);
    pg8::EpiEach<FP1> E{FP1{(bf16_t*)(ws + WS_P), a.out + O_MEMP}};
    pg8::gemm_phase(lds, g, S, E);
}
struct CmpOrder { int G, c;
    DI bool next(int i, pg8::Unit& u) const { const int L = i * G + c; if (L >= 264) return false; u.pn = L / 132; u.pm = L % 132; u.ks = 0; return true; }
    DI size_t offA(const pg8::Unit& u) const { const int rt = u.pm, kv = u.pn; size_t e;
        if (rt < 4) { const int b = rt >> 1, g = rt & 1; e = (size_t)((b * 2 + kv) * 2 + g) * KCP_ROWS * 64; }
        else { const int s = rt - 4, db = s >> 2, g = (s >> 1) & 1, half = s & 1; e = KCS_OFF + ((size_t)((db * 2 + kv) * 2 + g) * 8192 + half * 4096) * 64; }
        return e * 2; }
    DI size_t offB(const pg8::Unit& u) const { return (size_t)u.pn * 256 * 2048 * 2; }
    DI int ktiles(const pg8::Unit&, int K) const { return K; }
};
DI float gelu_tanh(float x) { const float u = 0.7978845608028654f * (x + 0.044715f * x * x * x); const float t = 1.f - 2.f / (1.f + __expf(2.f * u)); return 0.5f * x * (1.f + t); }
struct FCmpH { const float* biasc; bf16_t* HC;
    DI void operator()(const pg8::Unit& u, int row, int col, f32x4 v) const { const f32x4 bb = *(const f32x4*)(biasc + u.pn * 256 + col); f32x4 x = v + bb;
        x.x = gelu_tanh(x.x); x.y = gelu_tanh(x.y); x.z = gelu_tanh(x.z); x.w = gelu_tanh(x.w);
        *(u32x2*)(HC + ((size_t)(u.pn * 132 + u.pm) * 256 + row) * 256 + col) = cvt4(x); } };
DI void cmp_layer2_own(const Args& a, LAS unsigned char* lds) {
    const int tid = threadIdx.x, lane = tid & 63, wave = __builtin_amdgcn_readfirstlane(tid >> 6);
    unsigned char* ws = a.ws;
    LAS bf16_t* W2T = (LAS bf16_t*)lds;
    const float* w2 = (const float*)a.in[I_CW2];
    for (int idx = tid; idx < 2 * 256 * 64; idx += NTHR) { const int kv = idx >> 14, k = (idx >> 6) & 255, n = idx & 63; W2T[(kv * 64 + n) * 264 + k] = (bf16_t)(cvt_pk_bf16(w2[idx], 0.f) & 0xffffu); }
    __syncthreads();
    const bf16_t* HC = (const bf16_t*)(ws + WS_HC); bf16_t* KCF = (bf16_t*)(ws + WS_KCF);
    const int kg = lane >> 4, c16 = lane & 15;
    for (int L = blockIdx.x; L < 264; L += gridDim.x)
    for (int rgp = wave; rgp < 16; rgp += NWAVES) {
        const int kv = L / 132, row0 = (L % 132) * 256 + rgp * 16;
        f32x4 acc[4];
#pragma unroll
        for (int nt = 0; nt < 4; ++nt) acc[nt] = (f32x4){0.f, 0.f, 0.f, 0.f};
#pragma unroll
        for (int ks = 0; ks < 8; ++ks) {
            const bf16x8 bfr = *(const bf16x8*)(HC + ((size_t)kv * HC_ROWS + row0 + c16) * 256 + 32 * ks + 8 * kg);
#pragma unroll
            for (int nt = 0; nt < 4; ++nt) { const bf16x8 afr = *(const LAS bf16x8*)(W2T + (kv * 64 + 16 * nt + c16) * 264 + 32 * ks + 8 * kg); acc[nt] = MFMA16(afr, bfr, acc[nt]); }
        }
        const int R = row0 + c16, rt = R >> 8, iin = R & 255; int seq, g, blk;
        if (rt < 4) { seq = rt >> 1; g = rt & 1; blk = iin; } else { const int s = rt - 4; seq = 2 + (s >> 2); g = (s >> 1) & 1; blk = (s & 1) * 256 + iin; }
        bf16_t* tile = KCF + ((size_t)(seq * 2 + g) * 16 + (blk >> 5)) * 4096; const int slot = blk & 31;
        if (kv == 0) {
#pragma unroll
            for (int nt = 0; nt < 4; ++nt) { const int d0 = 16 * nt + 4 * kg; *(u32x2*)(tile + (((d0 >> 5) * 2 + (slot >> 4)) * 64 + ((d0 >> 3) & 3) * 16 + (slot & 15)) * 8 + ((d0 >> 2) & 1) * 4) = cvt4(acc[nt]); }
        } else {
            const int kgv = (slot & 15) >> 2, jv = (slot & 3) + ((slot >> 4) << 2);
#pragma unroll
            for (int nt = 0; nt < 4; ++nt) { const u32x2 w = cvt4(acc[nt]); bf16_t* t0 = tile + 2048 + ((nt * 64 + kgv * 16 + 4 * kg) * 8) + jv;
                t0[0] = (bf16_t)(w.x & 0xffffu); t0[8] = (bf16_t)(w.x >> 16); t0[16] = (bf16_t)(w.y & 0xffffu); t0[24] = (bf16_t)(w.y >> 16); }
        }
    }
}
DI void phase3(const Args& a, LAS unsigned char* lds) {
    unsigned char* ws = a.ws;
    pg8::Gemm g{(const bf16_t*)(ws + WS_KCRAW), (const bf16_t*)(ws + WS_BT_C1), 1024, 2048, 2048};
    CmpOrder S{(int)gridDim.x, (int)blockIdx.x};
    pg8::EpiEach<FCmpH> E{FCmpH{(const float*)(ws + WS_BIASC), (bf16_t*)(ws + WS_HC)}};
    pg8::gemm_phase(lds, g, S, E);
    cmp_layer2_own(a, lds);
    __syncthreads();
    if (blockIdx.x >= 8) { const int wave = __builtin_amdgcn_readfirstlane(threadIdx.x >> 6);
        tr_strided(a, (LAS float*)(lds + wave * 16384), threadIdx.x & 63, NT_FIRST, NT_ALL, (blockIdx.x - 8) * NWAVES + wave, (gridDim.x - 8) * NWAVES); }
}

constexpr int DSA_LSTRIDE = 528, DSA_WL = 32 * DSA_LSTRIDE + 1024 + 256;
struct RowInfo { bool pr; int b, db, pos, seq; };
DI RowInfo rowinfo(int r) { RowInfo ri; ri.pr = r < TP; const int q = r - TP; ri.b = r >> 12; ri.db = q >> 2; ri.pos = ri.pr ? (r & 4095) : 8192 + (q & 3); ri.seq = ri.pr ? ri.b : 2 + ri.db; return ri; }
DI float xmax16(float x) { const auto r = __builtin_amdgcn_permlane16_swap(__float_as_uint(x), __float_as_uint(x), false, false); return fmaxf(__uint_as_float(r[0]), __uint_as_float(r[1])); }
DI float xmax32(float x) { const auto r = __builtin_amdgcn_permlane32_swap(__float_as_uint(x), __float_as_uint(x), false, false); return fmaxf(__uint_as_float(r[0]), __uint_as_float(r[1])); }
DI float xsum16(float x) { const auto r = __builtin_amdgcn_permlane16_swap(__float_as_uint(x), __float_as_uint(x), false, false); return __uint_as_float(r[0]) + __uint_as_float(r[1]); }
DI float xsum32(float x) { const auto r = __builtin_amdgcn_permlane32_swap(__float_as_uint(x), __float_as_uint(x), false, false); return __uint_as_float(r[0]) + __uint_as_float(r[1]); }
template <int CTRL> DI float dppf(float x) { return __int_as_float(__builtin_amdgcn_update_dpp(0, __float_as_int(x), CTRL, 0xF, 0xF, true)); }
DI float sum8(float x) { x += dppf<0xB1>(x); x += dppf<0x4E>(x); x += dppf<0x141>(x); return x; }
DI float sum16r(float x) { x = sum8(x); x += dppf<0x140>(x); return x; }
DI int q_next(unsigned* ctr, int lane) { int v = 0; if (lane == 0) v = (int)__hip_atomic_fetch_add(ctr, 1u, __ATOMIC_RELAXED, __HIP_MEMORY_SCOPE_AGENT); return __builtin_amdgcn_readfirstlane(v); }
constexpr int QSH = 32;
DI int qs_next(unsigned* ctr, int lane) { const int sh = blockIdx.x & (QSH - 1); return sh + QSH * q_next(ctr + 64 * sh, lane); }

template <int D> struct Flash { f32x4 o[D / 16]; float m, l; };
template <int D> DI void flash_init(Flash<D>& f) {
#pragma unroll
    for (int i = 0; i < D / 16; ++i) f.o[i] = (f32x4){0.f, 0.f, 0.f, 0.f};
    f.m = -INFINITY; f.l = 0.f; }
template <int D> DI float flash_linv(const Flash<D>& f) { return 1.f / fmaxf(xsum32(xsum16(f.l)), 1e-30f); }
DI bf16x8 ldk8(const float* p) { return cvt8(*(const f32x4*)p, *(const f32x4*)(p + 4)); }
DI int kslot(int kg, int j) { return j < 4 ? 4 * kg + j : 16 + 4 * kg + (j - 4); }
constexpr float LOG2E = 1.4426950408889634f;
DI float max8(const float (&v)[8]) { return fmaxf(fmaxf(fmaxf(v[0], v[1]), fmaxf(v[2], v[3])), fmaxf(fmaxf(v[4], v[5]), fmaxf(v[6], v[7]))); }
template <int D> DI void flash_rebase(Flash<D>& f, float mx) {
    mx = xmax32(xmax16(mx));
    const float mnew = fmaxf(f.m, mx), msafe = (mnew == -INFINITY) ? 0.f : mnew, alpha = __builtin_amdgcn_exp2f(f.m - msafe);
    f.l *= alpha; f.m = mnew;
#pragma unroll
    for (int dt = 0; dt < D / 16; ++dt) f.o[dt] *= alpha;
}
DI bf16x8 pack_p(const float (&p)[8]) { u32x4 w; w.x = cvt_pk_bf16(p[0], p[1]); w.y = cvt_pk_bf16(p[2], p[3]); w.z = cvt_pk_bf16(p[4], p[5]); w.w = cvt_pk_bf16(p[6], p[7]); return __builtin_bit_cast(bf16x8, w); }
template <int D> DI bf16x8 flash_update(Flash<D>& f, const float (&t)[8]) {
    const float mx = max8(t);
    if (!__all(mx <= f.m + 11.5f)) flash_rebase<D>(f, mx);
    const float mref = (f.m == -INFINITY) ? 0.f : f.m;
    float p[8], sum = 0.f;
#pragma unroll
    for (int e = 0; e < 8; ++e) { p[e] = __builtin_amdgcn_exp2f(t[e] - mref); sum += p[e]; }
    f.l += sum;
    return pack_p(p);
}
template <int D> DI bf16x8 flash_update_full(Flash<D>& f, const f32x4& s0, const f32x4& s1, float c) {
    const float r[8] = {s0[0], s0[1], s0[2], s0[3], s1[0], s1[1], s1[2], s1[3]};
    const float mx = max8(r) * c;
    if (!__all(mx <= f.m + 11.5f)) flash_rebase<D>(f, mx);
    const float nm = -f.m;
    float p[8], sum = 0.f;
#pragma unroll
    for (int e = 0; e < 8; ++e) { p[e] = __builtin_amdgcn_exp2f(fmaf(r[e], c, nm)); sum += p[e]; }
    f.l += sum;
    return pack_p(p);
}
template <int D> DI void flash_step(Flash<D>& f, const bf16x8 (&qf)[D / 32], const float* kp0, const float* kp1, const float* const (&vp)[8], unsigned okm, float c, int lane) {
    const int kg = lane >> 4, c16 = lane & 15;
    f32x4 s0 = (f32x4){0.f, 0.f, 0.f, 0.f}, s1 = s0;
#pragma unroll
    for (int ks = 0; ks < D / 32; ++ks) { const bf16x8 a0 = ldk8(kp0 + 32 * ks + 8 * kg), a1 = ldk8(kp1 + 32 * ks + 8 * kg); s0 = MFMA16(a0, qf[ks], s0); s1 = MFMA16(a1, qf[ks], s1); }
    float v[8];
#pragma unroll
    for (int j = 0; j < 4; ++j) { v[j] = ((okm >> j) & 1u) ? s0[j] * c : -INFINITY; v[4 + j] = ((okm >> (4 + j)) & 1u) ? s1[j] * c : -INFINITY; }
    const bf16x8 pb = flash_update<D>(f, v);
#pragma unroll
    for (int dt = 0; dt < D / 16; ++dt) {
        float x[8];
#pragma unroll
        for (int j = 0; j < 8; ++j) x[j] = vp[j][16 * dt + c16];
        u32x4 aw; aw.x = cvt_pk_bf16(x[0], x[1]); aw.y = cvt_pk_bf16(x[2], x[3]); aw.z = cvt_pk_bf16(x[4], x[5]); aw.w = cvt_pk_bf16(x[6], x[7]);
        f.o[dt] = MFMA16(__builtin_bit_cast(bf16x8, aw), pb, f.o[dt]);
    }
}
struct Tile64 { bf16x8 k[4]; bf16x8 v[4]; };
DI void load_tile64(Tile64& t, const bf16_t* kt, const bf16_t* vt, int lane) {
#pragma unroll
    for (int i = 0; i < 4; ++i) t.k[i] = *(const bf16x8*)(kt + (i * 64 + lane) * 8);
#pragma unroll
    for (int i = 0; i < 4; ++i) t.v[i] = *(const bf16x8*)(vt + (i * 64 + lane) * 8);
}
DI void flash_tile64(Flash<64>& f, const bf16x8 (&qf)[2], const Tile64& t, bool full, unsigned okm, float c) {
    f32x4 s0 = (f32x4){0.f, 0.f, 0.f, 0.f}, s1 = s0;
#pragma unroll
    for (int ks = 0; ks < 2; ++ks) { s0 = MFMA16(t.k[ks * 2], qf[ks], s0); s1 = MFMA16(t.k[ks * 2 + 1], qf[ks], s1); }
    bf16x8 pb;
    if (full) pb = flash_update_full<64>(f, s0, s1, c);
    else { float v[8];
#pragma unroll
        for (int j = 0; j < 4; ++j) { v[j] = ((okm >> j) & 1u) ? s0[j] * c : -INFINITY; v[4 + j] = ((okm >> (4 + j)) & 1u) ? s1[j] * c : -INFINITY; }
        pb = flash_update<64>(f, v); }
#pragma unroll
    for (int dt = 0; dt < 4; ++dt) f.o[dt] = MFMA16(t.v[dt], pb, f.o[dt]);
}

template <int OFF> DI void tr_read4(unsigned alo, unsigned ahi, u32x2 (&l)[4], u32x2 (&h)[4]) {
    asm volatile("ds_read_b64_tr_b16 %0, %8 offset:%10\n\tds_read_b64_tr_b16 %1, %9 offset:%10\n\tds_read_b64_tr_b16 %2, %8 offset:%11\n\tds_read_b64_tr_b16 %3, %9 offset:%11\n\t"
                 "ds_read_b64_tr_b16 %4, %8 offset:%12\n\tds_read_b64_tr_b16 %5, %9 offset:%12\n\tds_read_b64_tr_b16 %6, %8 offset:%13\n\tds_read_b64_tr_b16 %7, %9 offset:%13\n\ts_waitcnt lgkmcnt(0)"
                 : "=&v"(l[0]), "=&v"(h[0]), "=&v"(l[1]), "=&v"(h[1]), "=&v"(l[2]), "=&v"(h[2]), "=&v"(l[3]), "=&v"(h[3])
                 : "v"(alo), "v"(ahi), "i"(OFF), "i"(OFF + 32), "i"(OFF + 64), "i"(OFF + 96) : "memory");
}
template <int D> DI void lds_step(Flash<D>& f, const bf16x8 (&qf)[D / 32], LAS unsigned char* wl, unsigned okm, float c, int lane) {
    constexpr int P = 4 * D + 16;
    const int kg = lane >> 4, c16 = lane & 15;
    f32x4 s0 = (f32x4){0.f, 0.f, 0.f, 0.f}, s1 = s0;
#pragma unroll
    for (int ks = 0; ks < D / 32; ++ks) { const bf16x8 a0 = *(const LAS bf16x8*)(wl + c16 * P + (32 * ks + 8 * kg) * 2), a1 = *(const LAS bf16x8*)(wl + (16 + c16) * P + (32 * ks + 8 * kg) * 2);
        s0 = MFMA16(a0, qf[ks], s0); s1 = MFMA16(a1, qf[ks], s1); }
    float v[8];
#pragma unroll
    for (int j = 0; j < 4; ++j) { v[j] = ((okm >> j) & 1u) ? s0[j] * c : -INFINITY; v[4 + j] = ((okm >> (4 + j)) & 1u) ? s1[j] * c : -INFINITY; }
    const bf16x8 pb = flash_update<D>(f, v);
    const unsigned alo = (unsigned)(__SIZE_TYPE__)wl + (unsigned)((4 * kg + (c16 >> 2)) * P + 2 * D + 8 * (c16 & 3)), ahi = alo + 16u * P;
    { u32x2 vl[4], vh[4]; tr_read4<0>(alo, ahi, vl, vh);
#pragma unroll
      for (int dt = 0; dt < 4; ++dt) { u32x4 aw; aw.x = vl[dt].x; aw.y = vl[dt].y; aw.z = vh[dt].x; aw.w = vh[dt].y; f.o[dt] = MFMA16(__builtin_bit_cast(bf16x8, aw), pb, f.o[dt]); } }
    if constexpr (D == 128) { u32x2 vl[4], vh[4]; tr_read4<128>(alo, ahi, vl, vh);
#pragma unroll
      for (int dt = 0; dt < 4; ++dt) { u32x4 aw; aw.x = vl[dt].x; aw.y = vl[dt].y; aw.z = vh[dt].x; aw.w = vh[dt].y; f.o[4 + dt] = MFMA16(__builtin_bit_cast(bf16x8, aw), pb, f.o[4 + dt]); } }
}
DI void st128(LAS unsigned char* wl, const f32x4 (&rg)[32], int lane) {
#pragma unroll
    for (int i = 0; i < 32; ++i) *(LAS u32x2*)(wl + i * 528 + (lane >> 5) * 256 + (lane & 31) * 8) = cvt4(rg[i]);
}
DI void st64(LAS unsigned char* wl, const f32x4 (&rg)[16], int lane) {
#pragma unroll
    for (int j = 0; j < 16; ++j) *(LAS u32x2*)(wl + (2 * j + (lane >> 5)) * 272 + ((lane >> 4) & 1) * 128 + (lane & 15) * 8) = cvt4(rg[j]);
}

DI void cmp_item(const Args& a, LAS unsigned char* wl, int seq, int r0, int pos0, int g, int lane) {
    unsigned char* ws = a.ws;
    LAS float* imp = (LAS float*)wl; LAS float* scv = imp + 1040;
    const int kg = lane >> 4, c16 = lane & 15, tl = c16 >> 3, hh = c16 & 7;
    const int myrow = r0 + tl, qpos = pos0 + tl, head = g * 8 + hh;
    const bf16_t* QC = (const bf16_t*)(ws + WS_QC);
    bf16x8 qf[2];
#pragma unroll
    for (int ks = 0; ks < 2; ++ks) qf[ks] = *(const bf16x8*)(QC + (size_t)myrow * 1024 + head * 64 + 32 * ks + 8 * kg);
    const bf16_t* tb = (const bf16_t*)(ws + WS_KCF) + (size_t)(seq * 2 + g) * 16 * 4096;
    const int qlast = pos0 + 1, NV = qlast >= 31 ? ((qlast - 31) >> 4) + 1 : 0, nsteps = (NV + 31) >> 5;
    for (int i = lane; i < 1040; i += 64) imp[i] = 0.f;
    float m = -INFINITY, l = 0.f;
    { bf16x8 kc[4], kn[4];
#pragma unroll
      for (int i = 0; i < 4; ++i) { kc[i] = *(const bf16x8*)(tb + (i * 64 + lane) * 8); kn[i] = kc[i]; }
      for (int st = 0; st < nsteps; ++st) {
          if (st + 1 < nsteps) {
#pragma unroll
              for (int i = 0; i < 4; ++i) kn[i] = *(const bf16x8*)(tb + (size_t)(st + 1) * 4096 + (i * 64 + lane) * 8); }
          f32x4 s0 = (f32x4){0.f, 0.f, 0.f, 0.f}, s1 = s0;
#pragma unroll
          for (int ks = 0; ks < 2; ++ks) { s0 = MFMA16(kc[ks * 2], qf[ks], s0); s1 = MFMA16(kc[ks * 2 + 1], qf[ks], s1); }
          float v[8];
#pragma unroll
          for (int j = 0; j < 4; ++j) { const int n = 32 * st + 4 * kg + j; v[j] = (16 * n + 31 <= qpos) ? s0[j] * 0.125f : -INFINITY; v[4 + j] = (16 * (n + 16) + 31 <= qpos) ? s1[j] * 0.125f : -INFINITY; }
          float mx = fmaxf(fmaxf(fmaxf(v[0], v[1]), fmaxf(v[2], v[3])), fmaxf(fmaxf(v[4], v[5]), fmaxf(v[6], v[7])));
          if (!__all(mx <= m + 8.f)) { mx = xmax32(xmax16(mx)); const float mnew = fmaxf(m, mx), msafe = (mnew == -INFINITY) ? 0.f : mnew; l *= __expf(m - msafe); m = mnew; }
          const float mref = (m == -INFINITY) ? 0.f : m;
#pragma unroll
          for (int e = 0; e < 8; ++e) l += __expf(v[e] - mref);
#pragma unroll
          for (int i = 0; i < 4; ++i) kc[i] = kn[i];
      } }
    const float msafe = (m == -INFINITY) ? 0.f : m, linv = 1.f / fmaxf(xsum32(xsum16(l)), 1e-30f);
    f32x4 o[4];
#pragma unroll
    for (int dt = 0; dt < 4; ++dt) o[dt] = (f32x4){0.f, 0.f, 0.f, 0.f};
    { Tile64 tc, tn;
      if (nsteps) load_tile64(tc, tb, tb + 2048, lane);
      for (int st = 0; st < nsteps; ++st) {
          if (st + 1 < nsteps) load_tile64(tn, tb + (size_t)(st + 1) * 4096, tb + (size_t)(st + 1) * 4096 + 2048, lane);
          f32x4 s0 = (f32x4){0.f, 0.f, 0.f, 0.f}, s1 = s0;
#pragma unroll
          for (int ks = 0; ks < 2; ++ks) { s0 = MFMA16(tc.k[ks * 2], qf[ks], s0); s1 = MFMA16(tc.k[ks * 2 + 1], qf[ks], s1); }
          float p[8];
#pragma unroll
          for (int j = 0; j < 4; ++j) { const int n = 32 * st + 4 * kg + j;
              p[j] = (16 * n + 31 <= qpos) ? __expf(s0[j] * 0.125f - msafe) * linv : 0.f; p[4 + j] = (16 * (n + 16) + 31 <= qpos) ? __expf(s1[j] * 0.125f - msafe) * linv : 0.f; }
#pragma unroll
          for (int e = 0; e < 8; ++e) { const float t = sum8(p[e]); if (hh == 0) imp[tl * 520 + 32 * st + kslot(kg, e)] = t; }
          const bf16x8 pb = pack_p(p);
#pragma unroll
          for (int dt = 0; dt < 4; ++dt) o[dt] = MFMA16(tc.v[dt], pb, o[dt]);
          if (st + 1 < nsteps) tc = tn;
      } }
    float* OC = (float*)(ws + WS_OCMP) + (size_t)myrow * 1024 + head * 64 + 4 * kg;
#pragma unroll
    for (int dt = 0; dt < 4; ++dt) *(f32x4*)(OC + 16 * dt) = o[dt];
    LDS_WAIT();
    int* SEL = (int*)(ws + WS_SEL);
    for (int t2 = 0; t2 < 2; ++t2) {
        const int qp = pos0 + t2, cur = qp >> 6, nsb = cur + 1;
        int* selp = SEL + ((size_t)(r0 + t2) * 2 + g) * 16;
        if (nsb <= 16) { if (lane < 16) selp[lane] = lane < nsb ? lane : -1; }
        else {
            const LAS float* im = imp + t2 * 520;
            for (int j = lane; j < nsb; j += 64) { const float sc = (im[4 * j] + im[4 * j + 1]) + (im[4 * j + 2] + im[4 * j + 3]) + (j ? im[4 * j - 1] : 0.f);
                scv[j] = (j == 0 || j == cur || j == cur - 1) ? INFINITY : sc; }
            LDS_WAIT();
            for (int j = lane; j < nsb; j += 64) { const float vj = scv[j]; int rank = 0;
                for (int k = 0; k < nsb; ++k) { const float vk = scv[k]; rank += (vk > vj || (vk == vj && k < j)) ? 1 : 0; }
                if (rank < 16) selp[rank] = j; }
            LDS_WAIT();
        }
    }
}

DI const float* dsa_ptr(const Args& a, const RowInfo& ri, int idx) {
    if (ri.pr) return a.out + O_DSAP + ((size_t)ri.b * 4096 + idx) * 320;
    if (idx < 8192) return (const float*)a.in[I_CDSA] + ((size_t)((const int*)a.in[I_PT])[ri.db * NPAGES + (idx >> 7)] * 128 + (idx & 127)) * 320;
    return a.out + O_DSAS + ((size_t)ri.db * 4 + idx - 8192) * 320;
}
DI unsigned sortable(float x) { const unsigned u = __float_as_uint(x); return (u & 0x80000000u) ? ~u : (u | 0x80000000u); }
DI void idx_item_block(const Args& a, LAS unsigned char* lds, int r) {
    const int tid = threadIdx.x, lane = tid & 63, wave = __builtin_amdgcn_readfirstlane(tid >> 6);
    unsigned char* ws = a.ws;
    LAS unsigned* sc = (LAS unsigned*)lds; LAS unsigned* hist = sc + 8200; LAS unsigned* misc = hist + 256; LAS unsigned* wc = misc + 16;
    const RowInfo ri = rowinfo(r); const int n = ri.pos + 1;
    int* idxp = (int*)(ws + WS_IDX) + (size_t)r * 256;
    const int kg = lane >> 4, c16 = lane & 15;
    { const bf16_t* QI = (const bf16_t*)(ws + WS_QI); bf16x8 qa[2];
#pragma unroll
      for (int ks = 0; ks < 2; ++ks) qa[ks] = *(const bf16x8*)(QI + (size_t)r * 1024 + c16 * 64 + 32 * ks + 8 * kg);
      const f32x4 w4 = *(const f32x4*)((const float*)(ws + WS_WI) + (size_t)r * 16 + 4 * kg) * 0.03125f;
      const bf16_t* kb = (const bf16_t*)(ws + WS_KIFS) + (size_t)ri.db * 513 * 1024 + lane * 8;
      const int ntile = (n + 15) >> 4;
      constexpr int GT = 8;
      for (int T0 = wave; T0 < ntile; T0 += NWAVES * GT) {
          bf16x8 gk[GT][2];
#pragma unroll
          for (int i = 0; i < GT; ++i) { const int Tn = min(T0 + NWAVES * i, ntile - 1); gk[i][0] = *(const bf16x8*)(kb + (size_t)Tn * 1024); gk[i][1] = *(const bf16x8*)(kb + (size_t)Tn * 1024 + 512); }
#pragma unroll
          for (int i = 0; i < GT; ++i) { const int T = T0 + NWAVES * i; if (T < ntile) {
              f32x4 d = (f32x4){0.f, 0.f, 0.f, 0.f}; d = MFMA16(qa[0], gk[i][0], d); d = MFMA16(qa[1], gk[i][1], d);
              float x = (fmaxf(d[0], 0.f) * w4[0] + fmaxf(d[1], 0.f) * w4[1]) + (fmaxf(d[2], 0.f) * w4[2] + fmaxf(d[3], 0.f) * w4[3]);
              x = xsum32(xsum16(x)); const int key = 16 * T + c16; if (kg == 0 && key < n) sc[key] = sortable(x); } }
      } }
    __syncthreads();
    unsigned prefix = 0u, mask = 0u; int need = 256;
    for (int pass = 0; pass < 4; ++pass) { const int shift = 24 - 8 * pass;
        if (tid < 256) hist[tid] = 0u;
        __syncthreads();
        for (int i = tid; i < n; i += NTHR) { const unsigned u = sc[i]; if ((u & mask) == prefix) __hip_atomic_fetch_add(&hist[(u >> shift) & 255u], 1u, __ATOMIC_RELAXED, __HIP_MEMORY_SCOPE_WORKGROUP); }
        __syncthreads();
        if (wave == 0) { const int h0 = hist[4 * lane], h1 = hist[4 * lane + 1], h2 = hist[4 * lane + 2], h3 = hist[4 * lane + 3]; const int ls = h0 + h1 + h2 + h3; int suf = ls;
#pragma unroll
            for (int o = 1; o < 64; o <<= 1) { const int t = __shfl_down(suf, o); if (lane + o < 64) suf += t; }
            int above = suf - ls;
            if (above < need && need <= above + h3) { misc[0] = 4 * lane + 3; misc[1] = need - above; } above += h3;
            if (above < need && need <= above + h2) { misc[0] = 4 * lane + 2; misc[1] = need - above; } above += h2;
            if (above < need && need <= above + h1) { misc[0] = 4 * lane + 1; misc[1] = need - above; } above += h1;
            if (above < need && need <= above + h0) { misc[0] = 4 * lane + 0; misc[1] = need - above; } }
        __syncthreads();
        const unsigned bin = misc[0]; need = (int)misc[1]; prefix |= bin << shift; mask |= 0xFFu << shift;
    }
    const unsigned thr = prefix; const int need_eq = need; int run_gt = 0, run_eq = 0;
    for (int base = 0; base < n; base += NTHR) {
        const int i = base + tid; const unsigned u = i < n ? sc[i] : 0u; const bool gt = i < n && u > thr, eq = i < n && u == thr;
        const unsigned long long bg = __ballot(gt), be = __ballot(eq);
        if (lane == 0) { wc[wave * 2] = (unsigned)__popcll(bg); wc[wave * 2 + 1] = (unsigned)__popcll(be); }
        __syncthreads();
        int pg = 0, pe = 0, tg = 0, te = 0;
#pragma unroll
        for (int w = 0; w < NWAVES; ++w) { const int cg = (int)wc[2 * w], ce = (int)wc[2 * w + 1]; if (w < wave) { pg += cg; pe += ce; } tg += cg; te += ce; }
        const unsigned long long lm = (1ull << lane) - 1ull;
        const int gb = run_gt + pg + __popcll(bg & lm), eb = run_eq + pe + __popcll(be & lm);
        const int opos = gb + min(eb, need_eq);
        if ((gt || (eq && eb < need_eq)) && opos < 256) idxp[opos] = i;
        run_gt += tg; run_eq += te;
        __syncthreads();
    }
}
DI void idx_item_wave(const Args& a, LAS unsigned char* wl, int r, int lane) {
    unsigned char* ws = a.ws;
    LAS unsigned* sc = (LAS unsigned*)wl; LAS unsigned* hist = sc + 4096;
    const int b = r >> 12, s = r & 4095, n = s + 1;
    int* idxp = (int*)(ws + WS_IDX) + (size_t)r * 256;
    if (n <= 256) { for (int i = lane; i < 256; i += 64) idxp[i] = i < n ? i : -1; return; }
    const int kg = lane >> 4, c16 = lane & 15;
#pragma unroll
    for (int q = 0; q < 4; ++q) hist[lane + 64 * q] = 0u;
    LDS_WAIT();
    { const bf16_t* QI = (const bf16_t*)(ws + WS_QI); bf16x8 qa[2];
#pragma unroll
      for (int ks = 0; ks < 2; ++ks) qa[ks] = *(const bf16x8*)(QI + (size_t)r * 1024 + c16 * 64 + 32 * ks + 8 * kg);
      const f32x4 w4 = *(const f32x4*)((const float*)(ws + WS_WI) + (size_t)r * 16 + 4 * kg) * 0.03125f;
      const bf16_t* kb = (const bf16_t*)(ws + WS_KIF) + (size_t)b * 256 * 1024 + lane * 8;
      const int ntile = (n + 15) >> 4;
      constexpr int GT = 8;
      bf16x8 ga[GT][2], gb[GT][2];
#define IDX_LOAD(G, T0_) { _Pragma("unroll") for (int i = 0; i < GT; ++i) { const int Tn = min((T0_) + i, ntile - 1); G[i][0] = *(const bf16x8*)(kb + (size_t)Tn * 1024); G[i][1] = *(const bf16x8*)(kb + (size_t)Tn * 1024 + 512); } }
#define IDX_COMP(G, T0_) { _Pragma("unroll") for (int i = 0; i < GT; ++i) { const int T = (T0_) + i; if (T < ntile) { \
          f32x4 d = (f32x4){0.f, 0.f, 0.f, 0.f}; d = MFMA16(qa[0], G[i][0], d); d = MFMA16(qa[1], G[i][1], d); \
          float x = (fmaxf(d[0], 0.f) * w4[0] + fmaxf(d[1], 0.f) * w4[1]) + (fmaxf(d[2], 0.f) * w4[2] + fmaxf(d[3], 0.f) * w4[3]); \
          x = xsum32(xsum16(x)); const int key = 16 * T + c16; \
          if (kg == 0 && key < n) { const unsigned u = sortable(x); sc[key] = u; __hip_atomic_fetch_add(&hist[u >> 24], 1u, __ATOMIC_RELAXED, __HIP_MEMORY_SCOPE_WAVEFRONT); } } } }
      IDX_LOAD(ga, 0)
      for (int T0 = 0; T0 < ntile; T0 += 2 * GT) {
          IDX_LOAD(gb, T0 + GT) IDX_COMP(ga, T0)
          if (T0 + GT >= ntile) break;
          IDX_LOAD(ga, T0 + 2 * GT) IDX_COMP(gb, T0 + GT)
      }
#undef IDX_LOAD
#undef IDX_COMP
    }
    LDS_WAIT();
    const int n4 = (n + 3) >> 2;
    unsigned prefix = 0u, mask = 0u; int need = 256;
    for (int pass = 0; pass < 4; ++pass) { const int shift = 24 - 8 * pass;
        if (pass) {
#pragma unroll
            for (int q = 0; q < 4; ++q) hist[lane + 64 * q] = 0u;
            LDS_WAIT();
            for (int g = lane; g < n4; g += 64) { const u32x4 u4 = ((const LAS u32x4*)sc)[g];
#pragma unroll
                for (int e = 0; e < 4; ++e) { const unsigned u = u4[e]; if (4 * g + e < n && (u & mask) == prefix) __hip_atomic_fetch_add(&hist[(u >> shift) & 255u], 1u, __ATOMIC_RELAXED, __HIP_MEMORY_SCOPE_WAVEFRONT); } }
            LDS_WAIT();
        }
        const int h0 = hist[4 * lane], h1 = hist[4 * lane + 1], h2 = hist[4 * lane + 2], h3 = hist[4 * lane + 3]; const int ls = h0 + h1 + h2 + h3; int suf = ls;
#pragma unroll
        for (int o = 1; o < 64; o <<= 1) { const int t = __shfl_down(suf, o); if (lane + o < 64) suf += t; }
        int above = suf - ls, fb = -1, fn = 0;
        if (above < need && need <= above + h3) { fb = 4 * lane + 3; fn = need - above; } above += h3;
        if (above < need && need <= above + h2) { fb = 4 * lane + 2; fn = need - above; } above += h2;
        if (above < need && need <= above + h1) { fb = 4 * lane + 1; fn = need - above; } above += h1;
        if (above < need && need <= above + h0) { fb = 4 * lane + 0; fn = need - above; }
        const unsigned long long fm = __ballot(fb >= 0); const int src = fm ? __builtin_ctzll(fm) : 0;
        const unsigned bin = (unsigned)__builtin_amdgcn_readlane(fb, src); need = __builtin_amdgcn_readlane(fn, src);
        prefix |= bin << shift; mask |= 0xFFu << shift;
        LDS_WAIT();
    }
    const unsigned thr = prefix; const int need_eq = need; int run_gt = 0, run_eq = 0;
    const unsigned long long lm = (1ull << lane) - 1ull;
    for (int g0 = 0; g0 < n4; g0 += 64) {
        const int g = g0 + lane; u32x4 u4 = (u32x4){0u, 0u, 0u, 0u}; if (g < n4) u4 = ((const LAS u32x4*)sc)[g];
        bool gt[4], eq[4]; int pg = 0, pe = 0, tg = 0, te = 0;
#pragma unroll
        for (int e = 0; e < 4; ++e) { const bool in = 4 * g + e < n; gt[e] = in && u4[e] > thr; eq[e] = in && u4[e] == thr;
            const unsigned long long bg = __ballot(gt[e]), be = __ballot(eq[e]); pg += __popcll(bg & lm); pe += __popcll(be & lm); tg += __popcll(bg); te += __popcll(be); }
        int gb = run_gt + pg, eb = run_eq + pe;
#pragma unroll
        for (int e = 0; e < 4; ++e) { const int opos = gb + min(eb, need_eq); if ((gt[e] || (eq[e] && eb < need_eq)) && opos < 256) idxp[opos] = 4 * g + e; gb += gt[e] ? 1 : 0; eb += eq[e] ? 1 : 0; }
        run_gt += tg; run_eq += te;
    }
    LDS_WAIT();
}

constexpr int CW_Q0 = 8192;
DI void phase5(const Args& a, LAS unsigned char* lds, int qb = 0, int pm = 7) {
    const int tid = threadIdx.x, lane = tid & 63, wave = __builtin_amdgcn_readfirstlane(tid >> 6);
    unsigned* ctl = (unsigned*)(a.ws + WS_CTL);
    if (pm & 1) { const int bid = blockIdx.x, G = gridDim.x;
#pragma unroll 1
      for (int j = bid; j < TS; j += G) { idx_item_block(a, lds, TP + j); __syncthreads(); } }
    if (pm & 2) { LAS unsigned char* wl = lds + wave * 8192;
#pragma unroll 1
      for (;;) { const int it = qs_next(ctl + CW_Q0 + qb, lane); if (it >= 128 + 8192) break;
          if (it < 128) { const int g = it & 1, db = it >> 2, tp = (it >> 1) & 1; cmp_item(a, wl, 2 + db, TP + db * 4 + 2 * tp, 8192 + 2 * tp, g, lane); }
          else { const int j = it - 128, g = j & 1, b = (j >> 1) & 1, tp = 2047 - (j >> 2); cmp_item(a, wl, b, b * 4096 + 2 * tp, 2 * tp, g, lane); } } }
    __syncthreads();
    if (pm & 4) { LAS unsigned char* wl = lds + wave * 17408;
#pragma unroll 1
      for (;;) { const int it = qs_next(ctl + CW_Q0 + qb + 2048, lane); if (it >= TP) break; const int b = it & 1, s = 4095 - (it >> 1); idx_item_wave(a, wl, b * 4096 + s, lane); } }
}

DI const float* win_ptr(const Args& a, const RowInfo& ri, int pos, int kv, int g) {
    const float* KW = (const float*)(a.ws + WS_KW);
    if (ri.pr) return KW + ((size_t)ri.b * 4096 + pos) * 256 + kv * 128 + g * 64;
    if (pos < 8192) return (const float*)a.in[I_SWIN] + (((size_t)ri.db * 512 + (pos - 7680)) * 2 + kv) * 128 + g * 64;
    return KW + ((size_t)TP + ri.db * 4 + (pos - 8192)) * 256 + kv * 128 + g * 64;
}
DI const float* slc_ptr(const Args& a, const RowInfo& ri, int pos, int c, int g) {
    if (ri.pr) return a.out + O_NSAP + (((size_t)ri.b * 4096 + pos) * 4 + c) * 128 + g * 64;
    if (pos < 8192) return (const float*)a.in[I_CNSA] + (((size_t)((const int*)a.in[I_PT])[ri.db * NPAGES + (pos >> 7)] * 128 + (pos & 127)) * 4 + c) * 128 + g * 64;
    return a.out + O_NSAS + (((size_t)ri.db * 4 + pos - 8192) * 4 + c) * 128 + g * 64;
}
constexpr float C64 = 0.125f * LOG2E, C128 = 0.08838834764831845f * LOG2E;
DI void nsa2_item_sample(const Args& a, LAS unsigned char* lds, int r, int g, int lane) {
    unsigned char* ws = a.ws;
    int wv = __builtin_amdgcn_readfirstlane(threadIdx.x >> 6); asm volatile("" : "+s"(wv));
    LAS unsigned char* wl = lds + wv * DSA_WL;
    const RowInfo ri = rowinfo(r); const int qpos = ri.pos;
    const int kg = lane >> 4, c16 = lane & 15, hh = c16 & 7, head = g * 8 + hh;
    const int kpar = lane >> 5, kvoff = ((lane >> 4) & 1) * 128 + (lane & 15) * 4;
    bf16x8 qf[2];
    { const bf16_t* QR = (const bf16_t*)(ws + WS_QR);
#pragma unroll
      for (int ks = 0; ks < 2; ++ks) qf[ks] = *(const bf16x8*)(QR + (size_t)r * 1024 + head * 64 + 32 * ks + 8 * kg); }
    Flash<64> fw; flash_init(fw);
    Flash<64> fs; flash_init(fs);
    f32x4 rg[16];
    { const int lo = max(0, qpos - 511), b0 = lo & ~31, nst = ((qpos - b0) >> 5) + 1;
#define WLOAD(BASE) { _Pragma("unroll") for (int j = 0; j < 16; ++j) rg[j] = *(const f32x4*)(win_ptr(a, ri, min(max((BASE) + 2 * j + kpar, lo), qpos), 0, g) + kvoff); }
      WLOAD(b0)
      for (int st = 0; st < nst; ++st) { const int base = b0 + 32 * st;
          LDS_WAIT(); st64(wl, rg, lane);
          if (st + 1 < nst) WLOAD(base + 32)
          unsigned okm = 0u;
#pragma unroll
          for (int j = 0; j < 8; ++j) { const int p = base + kslot(kg, j); okm |= (p >= lo && p <= qpos) ? (1u << j) : 0u; }
          LDS_WAIT(); lds_step<64>(fw, qf, wl, okm, C64, lane);
      }
#undef WLOAD
    }
    { const int* selp = (const int*)(ws + WS_SEL) + ((size_t)r * 2 + g) * 16;
      const int sbl = lane < 16 ? selp[lane] : -1;
      const float* bptr = nullptr;
      if (sbl >= 0) { const int p0 = sbl * 64; bptr = p0 < 8192 ? (const float*)a.in[I_CNSA] + ((size_t)((const int*)a.in[I_PT])[ri.db * NPAGES + (p0 >> 7)] * 128 + (p0 & 127)) * 512 + 256 + g * 64
                                                                  : a.out + O_NSAS + (size_t)ri.db * 4 * 512 + 256 + g * 64; }
      const int sb2 = __shfl(sbl, lane >> 1); const int hbase = sb2 * 64 + (lane & 1) * 32;
      unsigned long long m = __ballot(lane < 32 && sb2 >= 0 && hbase <= qpos);
      int left = __popcll(m);
      if (left) {
          const unsigned long long plo = (unsigned long long)bptr;
#define SLOAD(L_) { const int L = (L_); const int bl = L >> 1; const unsigned long long pb64 = ((unsigned long long)(unsigned)__builtin_amdgcn_readlane((int)(plo >> 32), bl) << 32) | (unsigned)__builtin_amdgcn_readlane((int)plo, bl); \
          const int hb = __builtin_amdgcn_readlane(hbase, L); const float* bp = (const float*)pb64 + (size_t)(L & 1) * 32 * 512; \
          _Pragma("unroll") for (int j = 0; j < 16; ++j) { const int kk = min(2 * j + kpar, qpos - hb); rg[j] = *(const f32x4*)(bp + (size_t)kk * 512 + kvoff); } }
          int Lc = __builtin_ctzll(m); m &= m - 1ull;
          SLOAD(Lc)
          for (;;) {
              LDS_WAIT(); st64(wl, rg, lane);
              const int hb = __builtin_amdgcn_readlane(hbase, Lc);
              int Ln = 0; const bool more = m != 0ull;
              if (more) { Ln = __builtin_ctzll(m); m &= m - 1ull; SLOAD(Ln) }
              unsigned okm = 0u;
#pragma unroll
              for (int j = 0; j < 8; ++j) okm |= (hb + kslot(kg, j) <= qpos) ? (1u << j) : 0u;
              LDS_WAIT(); lds_step<64>(fs, qf, wl, okm, C64, lane);
              if (!more) break; Lc = Ln;
          }
#undef SLOAD
      } }
    LDS_WAIT();
    const float* GN = (const float*)(ws + WS_GN) + (size_t)r * 48;
    const float g0 = GN[head], g1 = GN[16 + head] * flash_linv(fs), g2 = GN[32 + head] * flash_linv(fw);
    const float* OC = (const float*)(ws + WS_OCMP) + (size_t)r * 1024 + head * 64 + 4 * kg;
    bf16_t* ON = (bf16_t*)(ws + WS_ONSA) + (size_t)r * 2048 + head * 64 + 4 * kg;
#pragma unroll
    for (int dt = 0; dt < 4; ++dt) { const f32x4 oc = *(const f32x4*)(OC + 16 * dt); const f32x4 o = oc * g0 + fs.o[dt] * g1 + fw.o[dt] * g2; if (c16 < 8) *(u32x2*)(ON + 16 * dt) = cvt4(o); }
}
DI void slc_walk(Flash<64>& fs, const bf16x8 (&qf)[2], const bf16_t* tb, const int* selp, int qpos, int lane) {
    const int kg = lane >> 4;
    const int sbl = lane < 32 ? selp[lane >> 1] : -1; const int Tl = 2 * sbl + (lane & 1);
    unsigned long long m = __ballot(lane < 32 && sbl >= 0 && 32 * Tl <= qpos);
    int left = __popcll(m);
    if (!left) return;
    Tile64 buf[3]; int Tq[3] = {0, 0, 0};
#define SLC_POP(i) { if (m) { Tq[i] = __builtin_amdgcn_readlane(Tl, __builtin_ctzll(m)); m &= m - 1ull; load_tile64(buf[i], tb + (size_t)Tq[i] * 8192, tb + (size_t)Tq[i] * 8192 + 2048, lane); } }
    SLC_POP(0) SLC_POP(1)
#define SLC_STEP(i) { SLC_POP(((i) + 2) % 3) const int T = Tq[i]; const bool full = 32 * T + 31 <= qpos; unsigned okm = 0xFFu; \
        if (!full) { okm = 0u; _Pragma("unroll") for (int j = 0; j < 8; ++j) okm |= (32 * T + kslot(kg, j) <= qpos) ? (1u << j) : 0u; } \
        flash_tile64(fs, qf, buf[i], full, okm, C64); if (--left == 0) break; }
    for (;;) { SLC_STEP(0) SLC_STEP(1) SLC_STEP(2) }
#undef SLC_STEP
#undef SLC_POP
}
DI void nsa2_item_pair(const Args& a, int r0, int g, int lane) {
    unsigned char* ws = a.ws;
    const int b = r0 >> 12, qpos0 = r0 & 4095;
    const int kg = lane >> 4, c16 = lane & 15, tl = c16 >> 3, hh = c16 & 7, head = g * 8 + hh, myrow = r0 + tl, qposc = qpos0 + tl;
    const bf16_t* QR = (const bf16_t*)(ws + WS_QR);
    const bf16_t* tb = (const bf16_t*)(ws + WS_NSAF) + (size_t)((b * 2 + g) * 128) * 8192;
    Flash<64> fw; flash_init(fw);
    { bf16x8 qf[2];
#pragma unroll
      for (int ks = 0; ks < 2; ++ks) qf[ks] = *(const bf16x8*)(QR + (size_t)myrow * 1024 + head * 64 + 32 * ks + 8 * kg);
      const int lo0 = max(0, qpos0 - 511), lo1 = max(0, qpos0 - 510), T0 = lo0 >> 5, T1 = (qpos0 + 1) >> 5, loc = max(0, qposc - 511);
      Tile64 buf[3]; int T = T0;
#define WIN_LD(i, TT_) { if ((TT_) <= T1) load_tile64(buf[i], tb + (size_t)(TT_) * 8192 + 4096, tb + (size_t)(TT_) * 8192 + 6144, lane); }
      WIN_LD(0, T0) WIN_LD(1, T0 + 1)
#define WIN_STEP(i) { WIN_LD(((i) + 2) % 3, T + 2) \
        const bool full = 32 * T >= lo1 && 32 * T + 31 <= qpos0; unsigned okm = 0xFFu; \
        if (!full) { okm = 0u; _Pragma("unroll") for (int j = 0; j < 8; ++j) { const int p = 32 * T + kslot(kg, j); okm |= (p >= loc && p <= qposc) ? (1u << j) : 0u; } } \
        flash_tile64(fw, qf, buf[i], full, okm, C64); if (++T > T1) break; }
      for (;;) { WIN_STEP(0) WIN_STEP(1) WIN_STEP(2) }
#undef WIN_LD
#undef WIN_STEP
    }
    Flash<64> fs0; flash_init(fs0);
    { bf16x8 qf[2];
#pragma unroll
      for (int ks = 0; ks < 2; ++ks) qf[ks] = *(const bf16x8*)(QR + (size_t)r0 * 1024 + head * 64 + 32 * ks + 8 * kg);
      slc_walk(fs0, qf, tb, (const int*)(ws + WS_SEL) + ((size_t)r0 * 2 + g) * 16, qpos0, lane); }
    Flash<64> fs1; flash_init(fs1);
    { bf16x8 qf[2];
#pragma unroll
      for (int ks = 0; ks < 2; ++ks) qf[ks] = *(const bf16x8*)(QR + (size_t)(r0 + 1) * 1024 + head * 64 + 32 * ks + 8 * kg);
      slc_walk(fs1, qf, tb, (const int*)(ws + WS_SEL) + ((size_t)(r0 + 1) * 2 + g) * 16, qpos0 + 1, lane); }
    const float* GN = (const float*)(ws + WS_GN) + (size_t)myrow * 48;
    const float li0 = flash_linv(fs0), li1 = flash_linv(fs1);
    const float g0 = GN[head], g1 = GN[16 + head] * (tl ? li1 : li0), g2 = GN[32 + head] * flash_linv(fw);
    const float* OC = (const float*)(ws + WS_OCMP) + (size_t)myrow * 1024 + head * 64 + 4 * kg;
    bf16_t* ON = (bf16_t*)(ws + WS_ONSA) + (size_t)myrow * 2048 + head * 64 + 4 * kg;
#pragma unroll
    for (int dt = 0; dt < 4; ++dt) { const f32x4 oc = *(const f32x4*)(OC + 16 * dt); const f32x4 os = tl ? fs1.o[dt] : fs0.o[dt]; *(u32x2*)(ON + 16 * dt) = cvt4(oc * g0 + os * g1 + fw.o[dt] * g2); }
}
DI void dsa_item(const Args& a, LAS unsigned char* wl, int r, int lane) {
    unsigned char* ws = a.ws;
    const RowInfo ri = rowinfo(r); const int nvalid = min(256, ri.pos + 1);
    const int kg = lane >> 4, c16 = lane & 15, hh = c16 & 7;
    bf16x8 qf[4];
    { const bf16_t* QB = (const bf16_t*)(ws + WS_QB);
#pragma unroll
      for (int ks = 0; ks < 4; ++ks) qf[ks] = *(const bf16x8*)(QB + (size_t)r * 1024 + hh * 128 + 32 * ks + 8 * kg); }
    const int* idxp = (const int*)(ws + WS_IDX) + (size_t)r * 256;
    Flash<128> f; flash_init(f);
    const int nst = (nvalid + 31) >> 5;
    LAS int* lidx = (LAS int*)(wl + 32 * DSA_LSTRIDE);
#pragma unroll
    for (int q = 0; q < 4; ++q) lidx[lane + 64 * q] = idxp[lane + 64 * q];
    LDS_WAIT();
    if (ri.pr) {
        const bf16_t* DB = (const bf16_t*)(ws + WS_DSAB) + (size_t)ri.b * 4096 * 256;
        const int hr = lane >> 5, ch = lane & 31;
        u32x4 rg[16];
#pragma unroll
        for (int i = 0; i < 16; ++i) { const int id = lidx[2 * i + hr]; rg[i] = *(const u32x4*)(DB + (size_t)max(id, 0) * 256 + ch * 8); }
        for (int st = 0; st < nst; ++st) {
            LDS_WAIT();
#pragma unroll
            for (int i = 0; i < 16; ++i) *(LAS u32x4*)(wl + (2 * i + hr) * DSA_LSTRIDE + ch * 16) = rg[i];
            unsigned okm = 0u;
#pragma unroll
            for (int j = 0; j < 8; ++j) okm |= (lidx[32 * st + kslot(kg, j)] >= 0) ? (1u << j) : 0u;
            if (st + 1 < nst) {
#pragma unroll
                for (int i = 0; i < 16; ++i) { const int id = lidx[32 * (st + 1) + 2 * i + hr]; rg[i] = *(const u32x4*)(DB + (size_t)max(id, 0) * 256 + ch * 8); } }
            LDS_WAIT();
            lds_step<128>(f, qf, wl, okm, C128, lane);
        }
    } else {
        LAS int* lpt = lidx + 256;
        lpt[lane] = ((const int*)a.in[I_PT])[ri.db * NPAGES + lane];
        LDS_WAIT();
        f32x4 rg[32];
#define DLOAD(ST) { _Pragma("unroll") for (int i = 0; i < 32; ++i) { const int id = max(lidx[32 * (ST) + i], 0); \
            const float* rp = id < 8192 ? (const float*)a.in[I_CDSA] + ((size_t)lpt[id >> 7] * 128 + (id & 127)) * 320 : a.out + O_DSAS + ((size_t)ri.db * 4 + id - 8192) * 320; rg[i] = *(const f32x4*)(rp + 4 * lane); } }
        DLOAD(0)
        for (int st = 0; st < nst; ++st) {
            LDS_WAIT(); st128(wl, rg, lane);
            unsigned okm = 0u;
#pragma unroll
            for (int j = 0; j < 8; ++j) okm |= (lidx[32 * st + kslot(kg, j)] >= 0) ? (1u << j) : 0u;
            if (st + 1 < nst) DLOAD(st + 1)
            LDS_WAIT();
            lds_step<128>(f, qf, wl, okm, C128, lane);
        }
#undef DLOAD
    }
    LDS_WAIT();
    const float inv = flash_linv(f);
    bf16_t* OD = (bf16_t*)(ws + WS_ONSA) + (size_t)r * 2048 + 1024 + hh * 128 + 4 * kg;
#pragma unroll
    for (int dt = 0; dt < 8; ++dt) if (c16 < 8) *(u32x2*)(OD + 16 * dt) = cvt4(f.o[dt] * inv);
}
DI void phase6(const Args& a, LAS unsigned char* lds, int qb = 0, int pm = 3) {
    const int tid = threadIdx.x, lane = tid & 63, wave = __builtin_amdgcn_readfirstlane(tid >> 6);
    unsigned* ctl = (unsigned*)(a.ws + WS_CTL);
#pragma unroll 1
    for (;;) { if (!(pm & 1)) break; const int it = qs_next(ctl + CW_Q0 + qb + 4096, lane); if (it >= 2 * TS + TP) break;
        if (it < 2 * TS) nsa2_item_sample(a, lds, TP + (it >> 1), it & 1, lane);
        else { const int j = it - 2 * TS, g = j & 1, b = (j >> 1) & 1, tp = 2047 - (j >> 2); nsa2_item_pair(a, b * 4096 + 2 * tp, g, lane); } }
    if (pm & 2) { LAS unsigned char* wl = lds + wave * DSA_WL;
#pragma unroll 1
      for (;;) { const int it = qs_next(ctl + CW_Q0 + qb + 6144, lane); if (it >= TT) break; dsa_item(a, wl, it < TS ? TP + it : it - TS, lane); } }
}

DI void phase11(const Args& a, LAS unsigned char* lds) {
    const int tid = threadIdx.x, lane = tid & 63, wave = __builtin_amdgcn_readfirstlane(tid >> 6);
    const int gw = blockIdx.x * NWAVES + wave, NGW = gridDim.x * NWAVES;
    unsigned char* ws = a.ws;
    const int kg = lane >> 4, c16 = lane & 15;
#pragma unroll 1
    for (int it = gw; it < 2048 + 128; it += NGW) {
        int myrow, h; const float* kvb; bool st_ok;
        if (it < 2048) { const int rg = it >> 2; h = it & 3; myrow = rg * 16 + c16; kvb = a.out + O_MEMP + (size_t)(rg >> 8) * 256 * 1024 + h * 128; st_ok = true; }
        else { const int j = it - 2048, db = j >> 2; h = j & 3; myrow = TP + db * 4 + (c16 & 3); kvb = (const float*)a.in[I_CMEM] + (size_t)db * 256 * 1024 + h * 128; st_ok = c16 < 4; }
        bf16x8 qf[4];
        { const bf16_t* QM = (const bf16_t*)(ws + WS_QMB);
#pragma unroll
          for (int ks = 0; ks < 4; ++ks) qf[ks] = *(const bf16x8*)(QM + (size_t)myrow * 512 + h * 128 + 32 * ks + 8 * kg); }
        Flash<128> f; flash_init(f);
        LAS unsigned char* wl = lds + wave * DSA_WL;
        f32x4 rg[32];
#define MLOAD(ST) { _Pragma("unroll") for (int i = 0; i < 32; ++i) rg[i] = *(const f32x4*)(kvb + (size_t)(32 * (ST) + i) * 1024 + (lane >> 5) * 512 + (lane & 31) * 4); }
        MLOAD(0)
        for (int st = 0; st < 8; ++st) {
            LDS_WAIT(); st128(wl, rg, lane);
            if (st + 1 < 8) MLOAD(st + 1)
            LDS_WAIT();
            lds_step<128>(f, qf, wl, 0xFFu, C128, lane);
        }
#undef MLOAD
        LDS_WAIT();
        const float inv = flash_linv(f);
        bf16_t* OM = (bf16_t*)(ws + WS_OM) + (size_t)myrow * 512 + h * 128 + 4 * kg;
#pragma unroll
        for (int dt = 0; dt < 8; ++dt) if (st_ok) *(u32x2*)(OM + 16 * dt) = cvt4(f.o[dt] * inv);
    }
}
DI f32x4 ldbf4(const bf16_t* p) { const u32x2 w = *(const u32x2*)p; f32x4 r; r.x = __uint_as_float(w.x << 16); r.y = __uint_as_float(w.x & 0xffff0000u); r.z = __uint_as_float(w.y << 16); r.w = __uint_as_float(w.y & 0xffff0000u); return r; }
struct EpiMerge {
    static constexpr bool HAS_MID = true;
    const bf16_t* GAB; bf16_t* MG; float* part;
    DI void mid(f32x4 (&acc)[2][2][4][2], const pg8::Unit& u, int wr, int wc, int fr, int fq) const {
        if (u.pm >= 32) return;
        int z = 0; asm volatile("" : "+v"(z));
#pragma unroll
        for (int ai = 0; ai < 2; ++ai)
#pragma unroll
            for (int m = 0; m < 4; ++m) { const size_t r = (size_t)(u.pm * 256 + ai * 128 + wr * 64 + m * 16 + fr + z);
#pragma unroll
                for (int bj = 0; bj < 2; ++bj)
#pragma unroll
                    for (int n = 0; n < 2; ++n) { const int c = u.pn * 256 + bj * 128 + wc * 32 + n * 16 + 4 * fq;
                        const f32x4 ga = ldbf4(GAB + r * 4096 + c), gb = ldbf4(GAB + r * 4096 + 2048 + c); f32x4 q;
                        q.x = ga.x * __builtin_amdgcn_rcpf(fmaxf(gb.x, 1e-30f)); q.y = ga.y * __builtin_amdgcn_rcpf(fmaxf(gb.y, 1e-30f)); q.z = ga.z * __builtin_amdgcn_rcpf(fmaxf(gb.z, 1e-30f)); q.w = ga.w * __builtin_amdgcn_rcpf(fmaxf(gb.w, 1e-30f));
                        acc[ai][bj][m][n] *= q; }
                asm volatile("" ::: "memory"); }
    }
    DI void operator()(const f32x4 (&acc)[2][2][4][2], const pg8::Unit& u, int wr, int wc, int fr, int fq) const {
        if (u.pm >= 32) {
#pragma unroll
            for (int m = 0; m < 4; ++m) { const int row = wr * 64 + m * 16 + fr;
#pragma unroll
                for (int bj = 0; bj < 2; ++bj)
#pragma unroll
                    for (int n = 0; n < 2; ++n) { const int c = u.pn * 256 + bj * 128 + wc * 32 + n * 16 + 4 * fq;
                        const f32x4 g = ldbf4(GAB + (size_t)(TP + row) * 4096 + (u.ks < 4 ? 0 : 2048) + c); *(f32x4*)(part + ((size_t)u.ks * 128 + row) * DM + c) = acc[0][bj][m][n] * g; } }
            return; }
#pragma unroll
        for (int ai = 0; ai < 2; ++ai)
#pragma unroll
            for (int m = 0; m < 4; ++m) { const size_t r = (size_t)u.pm * 256 + ai * 128 + wr * 64 + m * 16 + fr;
#pragma unroll
                for (int bj = 0; bj < 2; ++bj)
#pragma unroll
                    for (int n = 0; n < 2; ++n) { const int c = u.pn * 256 + bj * 128 + wc * 32 + n * 16 + 4 * fq;
                        *(u32x2*)(MG + r * DM + c) = cvt4(acc[ai][bj][m][n] * ldbf4(GAB + r * 4096 + 2048 + c)); } }
    }
};
struct ComboOrder { pg8::StaticOrder so; int n, ld;
    DI void init(int G, int c, int K) { so.init(TP / 256, DM / 256, G, c, K, K); n = 256 + 8 * (K / 256); ld = K; }
    DI bool next(int i, pg8::Unit& u) const { const long L = (long)i * so.G + so.c; if (L < 256) return so.at(L, u); if (L >= n) return false; const int j = (int)L - 256; u.pm = 32; u.pn = j & 7; u.ks = j >> 3; return true; }
    DI size_t offA(const pg8::Unit& u) const { return u.pm < 32 ? so.offA(u) : ((size_t)TP * ld + (size_t)u.ks * 256) * 2; }
    DI size_t offB(const pg8::Unit& u) const { return u.pm < 32 ? so.offB(u) : ((size_t)u.pn * 256 * ld + (size_t)u.ks * 256) * 2; }
    DI int ktiles(const pg8::Unit& u, int K) const { return u.pm < 32 ? K : 256; }
};
DI void phase7(const Args& a, LAS unsigned char* lds) {
    unsigned char* ws = a.ws;
    pg8::Gemm g{(const bf16_t*)(ws + WS_ONSA), (const bf16_t*)(ws + WS_BT_OA), DM, DM, DM};
    ComboOrder S; S.init(gridDim.x, blockIdx.x, DM);
    EpiMerge E{(const bf16_t*)(ws + WS_GAB), (bf16_t*)(ws + WS_MG), (float*)(ws + WS_PART)};
    pg8::gemm_phase(lds, g, S, E);
}
DI void phase7b(const Args& a) {
    const int tid = threadIdx.x, lane = tid & 63, wave = __builtin_amdgcn_readfirstlane(tid >> 6);
    const int gw = blockIdx.x * NWAVES + wave, NGW = gridDim.x * NWAVES;
    for (int q = gw; q < TS; q += NGW) {
        f32x4 v[8];
#pragma unroll
        for (int j = 0; j < 8; ++j) v[j] = (f32x4){0.f, 0.f, 0.f, 0.f};
#pragma unroll 2
        for (int k = 0; k < 8; ++k) { const f32x4* pr = (const f32x4*)((const float*)(a.ws + WS_PART) + ((size_t)k * 128 + q) * DM) + lane;
#pragma unroll
            for (int j = 0; j < 8; ++j) v[j] += pr[64 * j]; }
        u32x2* o8 = (u32x2*)((bf16_t*)(a.ws + WS_MG) + (size_t)(TP + q) * DM) + lane;
#pragma unroll
        for (int j = 0; j < 8; ++j) o8[64 * j] = cvt4(v[j]);
    }
}
struct FResX { const float* xp; bf16_t* dst; DI void operator()(const pg8::Unit& u, int row, int col, f32x4 v) const { const size_t o = (size_t)(u.pm * 256 + row) * DM + u.pn * 256 + col;
    *(u32x2*)(dst + o) = cvt4(v + *(const f32x4*)(xp + o)); } };
struct FResW { const bf16_t* base; bf16_t* dst; DI void operator()(const pg8::Unit& u, int row, int col, f32x4 v) const { const size_t o = (size_t)(u.pm * 256 + row) * DM + u.pn * 256 + col;
    *(u32x2*)(dst + o) = cvt4(v + ldbf4(base + o)); } };
struct FStoreBf { bf16_t* C; int ldc; DI void operator()(const pg8::Unit& u, int row, int col, f32x4 v) const { *(u32x2*)(C + (size_t)(u.pm * 256 + row) * ldc + u.pn * 256 + col) = cvt4(v); } };

struct EpiResNorm {
    static constexpr bool HAS_MID = false;
    const float* base; float* dst; bf16_t* an; const float* gain; float* ss; float* part;
    DI void operator()(const f32x4 (&acc)[2][2][4][2], const pg8::Unit& u, int wr, int wc, int fr, int fq) const {
        if (u.pm >= 32) {
#pragma unroll
            for (int m = 0; m < 4; ++m) { const int row = wr * 64 + m * 16 + fr;
#pragma unroll
                for (int bj = 0; bj < 2; ++bj)
#pragma unroll
                    for (int n = 0; n < 2; ++n) *(f32x4*)(part + ((size_t)u.ks * 128 + row) * DM + u.pn * 256 + bj * 128 + wc * 32 + n * 16 + 4 * fq) = acc[0][bj][m][n]; }
            return; }
        const int c0 = u.pn * 256 + wc * 32 + 4 * fq;
#pragma unroll
        for (int ai = 0; ai < 2; ++ai)
#pragma unroll
            for (int m = 0; m < 4; ++m) { const size_t r = (size_t)u.pm * 256 + ai * 128 + wr * 64 + m * 16 + fr; float s = 0.f;
#pragma unroll
                for (int bj = 0; bj < 2; ++bj)
#pragma unroll
                    for (int n = 0; n < 2; ++n) { const size_t o = r * DM + c0 + bj * 128 + n * 16; const f32x4 x = acc[ai][bj][m][n] + *(const f32x4*)(base + o);
                        *(f32x4*)(dst + o) = x; *(u32x2*)(an + o) = cvt4(x * *(const f32x4*)(gain + c0 + bj * 128 + n * 16)); s += (x.x * x.x + x.y * x.y) + (x.z * x.z + x.w * x.w); }
                s = xsum32(xsum16(s));
                if (fq == 0) __hip_atomic_fetch_add(ss + r, s, __ATOMIC_RELAXED, __HIP_MEMORY_SCOPE_AGENT);
                asm volatile("" ::: "memory"); }
    }
};
DI void gemm_resnorm(const Args& a, LAS unsigned char* lds, size_t ws_a, size_t ws_bt, int K, const float* base, size_t ws_dst, int gidx, int which) {
    unsigned char* ws = a.ws;
    pg8::Gemm g{(const bf16_t*)(ws + ws_a), (const bf16_t*)(ws + ws_bt), K, K, K};
    ComboOrder S; S.init(gridDim.x, blockIdx.x, K);
    EpiResNorm E{base, (float*)(ws + ws_dst), (bf16_t*)(ws + WS_XN), (const float*)a.in[I_NG] + gidx * DM, (float*)(ws + WS_SS) + (size_t)which * TP, (float*)(ws + WS_PART)};
    pg8::gemm_phase(lds, g, S, E);
}
struct FStoreBfRs { bf16_t* C; int ldc; const float* rs; DI void operator()(const pg8::Unit& u, int row, int col, f32x4 v) const { const int r = u.pm * 256 + row;
    *(u32x2*)(C + (size_t)r * ldc + u.pn * 256 + col) = cvt4(v * rs[r]); } };
template <class F> struct FCombo { F f; float* part; DI void operator()(const pg8::Unit& u, int row, int col, f32x4 v) const {
    if (u.pm < 32) f(u, row, col, v); else if (row < 128) *(f32x4*)(part + ((size_t)u.ks * 128 + row) * DM + u.pn * 256 + col) = v; } };
template <class F> DI void gemm_n2048(const Args& a, LAS unsigned char* lds, size_t ws_a, size_t ws_bt, int K, const F& f) {
    unsigned char* ws = a.ws;
    pg8::Gemm g{(const bf16_t*)(ws + ws_a), (const bf16_t*)(ws + ws_bt), K, K, K};
    ComboOrder S; S.init(gridDim.x, blockIdx.x, K);
    pg8::EpiEach<FCombo<F>> E{FCombo<F>{f, (float*)(ws + WS_PART)}};
    pg8::gemm_phase(lds, g, S, E);
}
DI void phase8(const Args& a, LAS unsigned char* lds) {
    gemm_n2048(a, lds, WS_MG, WS_BT_O, DM, FResX{(const float*)a.in[I_XP], (bf16_t*)(a.ws + WS_X1)});
}
DI void sample_row_sum(const Args& a, const float* base_row, int q, int S, int lane, f32x4 (&v)[8]) {
    const f32x4* br = (const f32x4*)base_row + lane;
#pragma unroll
    for (int j = 0; j < 8; ++j) v[j] = br[64 * j];
#pragma unroll 2
    for (int k = 0; k < S; ++k) { const f32x4* pr = (const f32x4*)((const float*)(a.ws + WS_PART) + ((size_t)k * 128 + q) * DM) + lane;
#pragma unroll
        for (int j = 0; j < 8; ++j) v[j] += pr[64 * j]; }
}
DI void ld_row_bf16(const bf16_t* row, int lane, f32x4 (&v)[8]) {
#pragma unroll
    for (int j = 0; j < 8; ++j) v[j] = ldbf4(row + 256 * j + 4 * lane);
}
DI void phase_norm(const Args& a, size_t ws_x, const float* sbase, size_t ws_xs, int S, int gidx) {
    const int tid = threadIdx.x, lane = tid & 63, wave = __builtin_amdgcn_readfirstlane(tid >> 6);
    const int gw = blockIdx.x * NWAVES + wave, NGW = gridDim.x * NWAVES;
    const bf16_t* X = (const bf16_t*)(a.ws + ws_x); float* XS = (float*)(a.ws + ws_xs); const float* g = (const float*)a.in[I_NG] + gidx * DM; bf16_t* XN = (bf16_t*)(a.ws + WS_XN);
    const f32x4* gr = (const f32x4*)g + lane;
    for (int r = gw; r < TT; r += NGW) {
        f32x4 v[8];
        if (r < TP) ld_row_bf16(X + (size_t)r * DM, lane, v);
        else { sample_row_sum(a, sbase + (size_t)(r - TP) * DM, r - TP, S, lane, v); f32x4* xo = (f32x4*)(XS + (size_t)(r - TP) * DM) + lane;
#pragma unroll
            for (int j = 0; j < 8; ++j) xo[64 * j] = v[j]; }
        float ss = 0.f;
#pragma unroll
        for (int j = 0; j < 8; ++j) ss += (v[j].x * v[j].x + v[j].y * v[j].y) + (v[j].z * v[j].z + v[j].w * v[j].w);
        const float rstd = rsqrtf(wave_sum(ss) * (1.f / 2048.f) + 1e-6f);
        u32x2* o8 = (u32x2*)(XN + (size_t)r * DM) + lane;
#pragma unroll
        for (int j = 0; j < 8; ++j) o8[64 * j] = cvt4(v[j] * rstd * gr[64 * j]);
    }
}
DI void phase10(const Args& a, LAS unsigned char* lds) {
    unsigned char* ws = a.ws;
    pg8::Gemm g{(const bf16_t*)(ws + WS_XN), (const bf16_t*)(ws + WS_BT_MQ), DM, DM, DM};
    pg8::StaticOrder S; S.init(MP / 256, 2, gridDim.x, blockIdx.x, DM, DM);
    pg8::EpiEach<FStoreBf> E{FStoreBf{(bf16_t*)(ws + WS_QMB), 512}};
    pg8::gemm_phase(lds, g, S, E);
}
DI void phase12(const Args& a, LAS unsigned char* lds) {
    gemm_n2048(a, lds, WS_OM, WS_BT_MO, 512, FResW{(const bf16_t*)(a.ws + WS_X1), (bf16_t*)(a.ws + WS_X2)});
}
DI void phase14(const Args& a, LAS unsigned char* lds) {
    unsigned char* ws = a.ws;
    pg8::Gemm g{(const bf16_t*)(ws + WS_XN), (const bf16_t*)(ws + WS_BT_UP), DM, DM, DM};
    pg8::StaticOrder S; S.init(MP / 256, DFF2 / 256, gridDim.x, blockIdx.x, DM, DM);
    pg8::EpiEach<FStoreBf> E{FStoreBf{(bf16_t*)(ws + WS_UB), DFF2}};
    pg8::gemm_phase(lds, g, S, E);
}
DI void phase15(const Args& a, LAS unsigned char* lds) {
    const int tid = threadIdx.x, lane = tid & 63, wave = __builtin_amdgcn_readfirstlane(tid >> 6);
    const int gw = blockIdx.x * NWAVES + wave, NGW = gridDim.x * NWAVES;
    unsigned char* ws = a.ws;
    const bf16_t* U = (const bf16_t*)(ws + WS_UB); bf16_t* ACT = (bf16_t*)(ws + WS_ACT);
    const float* cw = (const float*)a.in[I_CVW]; const float* cb = (const float*)a.in[I_CVB];
    constexpr int NRUN = TP / 32 + 32, NCH = DFF / 256;
#pragma unroll 1
    for (int it = gw; it < NRUN * NCH; it += NGW) {
        const int run = it / NCH, ch = it % NCH, c = 256 * ch + 4 * lane;
        int r0, nrow, t0; const float* st = nullptr; float* cout = nullptr; int cfirst = 1 << 30;
        if (run < TP / 32) { r0 = run * 32; nrow = 32; t0 = r0 & 4095; if (t0 == SEQ - 32) { cfirst = 30; cout = a.out + O_CONVP + (size_t)(r0 >> 12) * 2 * DFF2; } }
        else { const int db = run - TP / 32; r0 = TP + db * 4; nrow = 4; t0 = 0; st = (const float*)a.in[I_SCONV] + (size_t)db * 2 * DFF2; cfirst = 2; cout = a.out + O_CONVS + (size_t)db * 2 * DFF2; }
        f32x4 pb[2], w0[2], w1[2], w2[2], u1[2], u2[2];
#pragma unroll
        for (int hf = 0; hf < 2; ++hf) { const int cc = c + hf * DFF;
            pb[hf] = *(const f32x4*)(cb + cc); w0[hf] = *(const f32x4*)(cw + cc); w1[hf] = *(const f32x4*)(cw + DFF2 + cc); w2[hf] = *(const f32x4*)(cw + 2 * DFF2 + cc);
            if (st) { u2[hf] = *(const f32x4*)(st + cc); u1[hf] = *(const f32x4*)(st + DFF2 + cc); }
            else { u1[hf] = t0 >= 1 ? ldbf4(U + (size_t)(r0 - 1) * DFF2 + cc) : (f32x4){0.f, 0.f, 0.f, 0.f}; u2[hf] = t0 >= 2 ? ldbf4(U + (size_t)(r0 - 2) * DFF2 + cc) : (f32x4){0.f, 0.f, 0.f, 0.f}; } }
        u32x2 nq[4][2];
#pragma unroll
        for (int k = 0; k < 4; ++k) { const int rr = min(k, nrow - 1); nq[k][0] = *(const u32x2*)(U + (size_t)(r0 + rr) * DFF2 + c); nq[k][1] = *(const u32x2*)(U + (size_t)(r0 + rr) * DFF2 + c + DFF); }
        for (int i = 0; i < nrow; ++i) {
            f32x4 u0[2];
#pragma unroll
            for (int hf = 0; hf < 2; ++hf) { const u32x2 w = nq[0][hf]; u0[hf].x = __uint_as_float(w.x << 16); u0[hf].y = __uint_as_float(w.x & 0xffff0000u); u0[hf].z = __uint_as_float(w.y << 16); u0[hf].w = __uint_as_float(w.y & 0xffff0000u); }
#pragma unroll
            for (int k = 0; k < 3; ++k) { nq[k][0] = nq[k + 1][0]; nq[k][1] = nq[k + 1][1]; }
            { const int rr = min(i + 4, nrow - 1); nq[3][0] = *(const u32x2*)(U + (size_t)(r0 + rr) * DFF2 + c); nq[3][1] = *(const u32x2*)(U + (size_t)(r0 + rr) * DFF2 + c + DFF); }
            const f32x4 gt = pb[0] + u2[0] * w0[0] + u1[0] * w1[0] + u0[0] * w2[0], up = pb[1] + u2[1] * w0[1] + u1[1] * w1[1] + u0[1] * w2[1];
            f32x4 o; o.x = gt.x * sigmoidf_(gt.x) * up.x; o.y = gt.y * sigmoidf_(gt.y) * up.y; o.z = gt.z * sigmoidf_(gt.z) * up.z; o.w = gt.w * sigmoidf_(gt.w) * up.w;
            *(u32x2*)(ACT + (size_t)(r0 + i) * DFF + c) = cvt4(o);
            if (i >= cfirst) { *(f32x4*)(cout + (size_t)(i - cfirst) * DFF2 + c) = u0[0]; *(f32x4*)(cout + (size_t)(i - cfirst) * DFF2 + c + DFF) = u0[1]; }
            u2[0] = u1[0]; u2[1] = u1[1]; u1[0] = u0[0]; u1[1] = u0[1];
        }
    }
}
DI void phase16(const Args& a, LAS unsigned char* lds) {
    gemm_n2048(a, lds, WS_ACT, WS_BT_DN, DFF, FResW{(const bf16_t*)(a.ws + WS_X2), (bf16_t*)(a.ws + WS_X3)});
}
DI void phase17(const Args& a) {
    const int tid = threadIdx.x, lane = tid & 63, wave = __builtin_amdgcn_readfirstlane(tid >> 6);
    const int gw = blockIdx.x * NWAVES + wave, NGW = gridDim.x * NWAVES;
    const bf16_t* X3 = (const bf16_t*)(a.ws + WS_X3); const f32x4* gr = (const f32x4*)a.in[I_FG] + lane;
    for (int r = gw; r < TT; r += NGW) {
        f32x4 v[8]; float s = 0.f;
        if (r < TP) ld_row_bf16(X3 + (size_t)r * DM, lane, v);
        else sample_row_sum(a, (const float*)(a.ws + WS_XS2) + (size_t)(r - TP) * DM, r - TP, DFF / 256, lane, v);
#pragma unroll
        for (int j = 0; j < 8; ++j) s += (v[j].x * v[j].x + v[j].y * v[j].y) + (v[j].z * v[j].z + v[j].w * v[j].w);
        const float rstd = rsqrtf(wave_sum(s) * (1.f / 2048.f) + 1e-6f);
        f32x4* o = (f32x4*)(a.out + (r < TP ? O_YP + (size_t)r * DM : O_YS + (size_t)(r - TP) * DM)) + lane;
#pragma unroll
        for (int j = 0; j < 8; ++j) o[64 * j] = v[j] * rstd * gr[64 * j];
    }
}
#define PHASES_REST \
    if (IN(3)) { phase3(args, lds); } SEAM(3); \
    if (IN(4)) { phase5(args, lds); } SEAM(4); \
    if (IN(5)) { phase6(args, lds); } SEAM(5); \
    if (IN(6)) { phase7(args, lds); } SEAM(6); \
    if (IN(7)) { phase7b(args); } SEAM(7); \
    if (IN(8)) { phase8(args, lds); } SEAM(8); \
    if (IN(9)) { phase_norm(args, WS_X1, (const float*)args.in[I_XS], WS_XS1, DM / 256, 1); } SEAM(9); \
    if (IN(10)) { phase10(args, lds); } SEAM(10); \
    if (IN(11)) { phase11(args, lds); } SEAM(11); \
    if (IN(12)) { phase12(args, lds); } SEAM(12); \
    if (IN(13)) { phase_norm(args, WS_X2, (const float*)(args.ws + WS_XS1), WS_XS2, 512 / 256, 3); } SEAM(13); \
    if (IN(14)) { phase14(args, lds); } SEAM(14); \
    if (IN(15)) { phase15(args, lds); } SEAM(15); \
    if (IN(16)) { phase16(args, lds); } SEAM(16); \
    if (IN(17)) { phase17(args); }
#ifndef MK_N_LAUNCHES
#define MK_N_LAUNCHES 1
#endif
constexpr int N_PHASES = 18;
__global__ void __launch_bounds__(NTHR, 2) mk_fwd(Args args) {
    extern __shared__ __attribute__((aligned(16))) unsigned char lds_raw[];
    LAS unsigned char* lds = (LAS unsigned char*)lds_raw;
    volatile LAS unsigned* MISC = (volatile LAS unsigned*)(lds + MISC_OFF);
    const int tid = threadIdx.x;
    for (int u = tid; u < 64; u += NTHR) ((LAS unsigned*)(lds + MISC_OFF))[u] = 0u;
    __syncthreads();
    unsigned* ctl = (unsigned*)(args.ws + WS_CTL);
    XcdBarrier bar; bar.bar = ctl + CW_BAR; bar.x = 0; bar.st = nullptr;
    const bool use_bar = (args.ph_hi - args.ph_lo) > 1;
    if (use_bar) bar = xcd_barrier_post(ctl + CW_BAR, MISC + 8);
    const int lo = args.ph_lo, hi = args.ph_hi;
#define IN(k) (lo <= (k) && (k) < hi)
#define SEAM(k) do { if (IN(k) && IN((k) + 1)) xcd_barrier(bar); } while (0)
    if (IN(0)) { phase0(args, lds); } SEAM(0);
    if (IN(1)) { phase1(args, lds); } SEAM(1);
    if (IN(2)) { phase2(args, lds); } SEAM(2);
    PHASES_REST
#undef IN
#undef SEAM
}

extern "C" void kernel_launch(void* const* d_in, const int* in_sizes, int n_in, void* d_out, int out_size, void* d_ws, size_t ws_size, hipStream_t stream) {
    static int grid = 0;
    if (grid == 0) {
        if (n_in != N_IN || (size_t)out_size != O_END || ws_size < WS_END) { fprintf(stderr, "kernel_launch: unexpected shapes: n_in %d out %d ws %zu (need %zu)\n", n_in, out_size, ws_size, (size_t)WS_END); grid = -1; return; }
        int dev = 0, cus = 0, per_cu = 0;
        if (hipGetDevice(&dev) != hipSuccess || hipDeviceGetAttribute(&cus, hipDeviceAttributeMultiprocessorCount, dev) != hipSuccess) { grid = -1; return; }
        if (hipFuncSetAttribute((const void*)mk_fwd, hipFuncAttributeMaxDynamicSharedMemorySize, LDS_BYTES) != hipSuccess) { fprintf(stderr, "kernel_launch: hipFuncSetAttribute failed\n"); grid = -1; return; }
        if (hipOccupancyMaxActiveBlocksPerMultiprocessor(&per_cu, (const void*)mk_fwd, NTHR, LDS_BYTES) != hipSuccess || per_cu < 1) fprintf(stderr, "kernel_launch: occupancy query reports %d\n", per_cu);
        (void)hipGetLastError();
        grid = cus;
    }
    if (grid < 0) return;
    (void)hipMemsetAsync((char*)d_ws + WS_CTL, 0, CTL_BYTES, stream);
    Args a{};
    for (int i = 0; i < N_IN; ++i) a.in[i] = d_in[i];
    a.out = (float*)d_out; a.ws = (unsigned char*)d_ws;
#if MK_N_LAUNCHES == 1
    a.ph_lo = 0; a.ph_hi = N_PHASES;
    hipLaunchKernelGGL(mk_fwd, dim3(grid), dim3(NTHR), LDS_BYTES, stream, a);
#else
    for (int p = 0; p < N_PHASES; ++p) { a.ph_lo = p; a.ph_hi = p + 1; hipLaunchKernelGGL(mk_fwd, dim3(grid), dim3(NTHR), LDS_BYTES, stream, a); }
#endif
}
```
